# Optimizing an MI355X kernel written in HIP

```python
import jax, jax.numpy as jnp
from jax import lax
import numpy as np

D_MODEL = 1024
BATCH = 2
SEQ = 8192
DEPTH = 2

MLA_HEADS = 4
QK_NOPE = 128
QK_ROPE = 64
V_HEAD = 128
Q_RANK = 384
KV_RANK = 256
ROPE_THETA = 10000.0
Q_BLOCK = 128
HG_HEADS = 4
HG_KEY = 128
HG_VAL = 128
HG_CHUNK = 64
MLA_WIDTH = MLA_HEADS * V_HEAD
HG_WIDTH = HG_HEADS * HG_VAL
HG_FDIM = HG_HEADS * HG_KEY
MIX_WIDTH = MLA_WIDTH + HG_WIDTH
IN_COLS = Q_RANK + KV_RANK + QK_ROPE + 2 * HG_FDIM + 2 * HG_WIDTH
DENSE_FF = 2816
N_EXPERTS = 8
TOP_K = 2
EXPERT_FF = 3584
N_DENSE = (DEPTH + 1) // 2
N_MOE = DEPTH // 2
EPS = 1e-6
F_FLOOR = 1e-30

kernel_name = "hybrid_mla_hgrn2_moe_block"

F32 = jnp.float32
NEG_BIG = float(np.finfo(np.float32).min)


def _rmsnorm(x, gain):
    xf = x.astype(F32)
    y = xf * lax.rsqrt(jnp.mean(xf * xf, axis=-1, keepdims=True) + EPS)
    return (y * gain.astype(F32)).astype(x.dtype)


def _rope_tables(positions):
    inv = ROPE_THETA ** (-jnp.arange(0, QK_ROPE, 2, dtype=F32) / QK_ROPE)
    ang = positions.astype(F32)[..., None] * inv
    return jnp.cos(ang), jnp.sin(ang)


def _apply_rope(x, cos, sin):
    x1, x2 = jnp.split(x, 2, axis=-1)
    cos = cos.astype(x.dtype)
    sin = sin.astype(x.dtype)
    return jnp.concatenate([x1 * cos - x2 * sin, x1 * sin + x2 * cos], axis=-1)


def _mla(c_q, c_kv, k_pe, positions, q_a_norm, w_q_b, kv_a_norm, w_kv_b):
    B, S, _ = c_q.shape
    q = (_rmsnorm(c_q, q_a_norm) @ w_q_b).reshape(B, S, MLA_HEADS, QK_NOPE + QK_ROPE)
    q_nope, q_pe = q[..., :QK_NOPE], q[..., QK_NOPE:]
    cos, sin = _rope_tables(positions)
    q_pe = _apply_rope(q_pe, cos[:, :, None, :], sin[:, :, None, :])
    k_pe = _apply_rope(k_pe, cos, sin)
    kv = (_rmsnorm(c_kv, kv_a_norm) @ w_kv_b).reshape(B, S, MLA_HEADS, QK_NOPE + V_HEAD)
    k_nope, v = kv[..., :QK_NOPE], kv[..., QK_NOPE:]
    scale = (QK_NOPE + QK_ROPE) ** -0.5
    nb = S // Q_BLOCK
    qn_blk = (q_nope * scale).reshape(B, nb, Q_BLOCK, MLA_HEADS, QK_NOPE).transpose(1, 0, 2, 3, 4)
    qp_blk = (q_pe * scale).reshape(B, nb, Q_BLOCK, MLA_HEADS, QK_ROPE).transpose(1, 0, 2, 3, 4)
    starts = jnp.arange(nb, dtype=jnp.int32) * Q_BLOCK
    key_idx = jnp.arange(S, dtype=jnp.int32)

    def block(args):
        qn, qp, start = args
        s = jnp.einsum('bqhd,bkhd->bhqk', qn, k_nope, preferred_element_type=F32)
        s = s + jnp.einsum('bqhr,bkr->bhqk', qp, k_pe, preferred_element_type=F32)
        q_idx = start + jnp.arange(Q_BLOCK, dtype=jnp.int32)
        s = jnp.where(key_idx[None, :] <= q_idx[:, None], s, NEG_BIG)
        p = jax.nn.softmax(s, axis=-1).astype(v.dtype)
        return jnp.einsum('bhqk,bkhd->bqhd', p, v)

    o = lax.map(block, (qn_blk, qp_blk, starts))
    return o.transpose(1, 0, 2, 3, 4).reshape(B, S, MLA_WIDTH)


def _hgrn2(q_raw, f_raw, i_in, g_raw, lower_bound, out_norm):
    B, S, _ = q_raw.shape
    nc = S // HG_CHUNK
    q = jax.nn.silu(q_raw.astype(F32))
    z = f_raw.astype(F32)
    lb = lower_bound.astype(F32)
    f = lb + (1.0 - lb) * jax.nn.sigmoid(z)
    log_f = jnp.log(jnp.maximum(f, F_FLOOR))
    k = (1.0 - lb) * jax.nn.sigmoid(-z)

    def to_chunks(t, d):
        return t.reshape(B, nc, HG_CHUNK, HG_HEADS, d).transpose(1, 0, 3, 2, 4)

    qc = to_chunks(q, HG_KEY)
    kc = to_chunks(k, HG_KEY)
    lfc = to_chunks(log_f, HG_KEY)
    vc = to_chunks(i_in.astype(F32), HG_VAL)
    tri = jnp.tril(jnp.ones((HG_CHUNK, HG_CHUNK), dtype=bool))[:, :, None]

    def step(state, inp):
        qb, kb, vb, lfb = inp
        b = jnp.cumsum(lfb, axis=2)
        diff = b[:, :, :, None, :] - b[:, :, None, :, :]
        decay = jnp.where(tri, jnp.exp(jnp.where(tri, diff, 0.0)), 0.0)
        attn = jnp.einsum('bhtd,bhsd,bhtsd->bhts', qb, kb, decay)
        o = jnp.einsum('bhts,bhsv->bhtv', attn, vb) + jnp.einsum('bhtd,bhdv->bhtv', qb * jnp.exp(b), state)
        b_last = b[:, :, -1:, :]
        new_state = jnp.exp(b_last[:, :, 0, :])[..., None] * state + jnp.einsum('bhsd,bhsv->bhdv', kb * jnp.exp(b_last - b), vb)
        return new_state, o

    s0 = jnp.zeros((B, HG_HEADS, HG_KEY, HG_VAL), F32)
    _, o = lax.scan(step, s0, (qc, kc, vc, lfc))
    o = o.transpose(1, 0, 3, 2, 4).reshape(B, S, HG_HEADS, HG_VAL)
    o = _rmsnorm(o, out_norm) * jax.nn.silu(g_raw.astype(F32).reshape(B, S, HG_HEADS, HG_VAL))
    return o.reshape(B, S, HG_WIDTH)


def _swiglu(h, w_gate, w_up, w_down):
    return (jax.nn.silu(h @ w_gate) * (h @ w_up)) @ w_down


def _moe(h, w_router, w_gate, w_up, w_down):
    B, S, D = h.shape
    T = B * S
    xf = h.reshape(T, D)
    logits = jnp.einsum('td,de->te', xf, w_router, preferred_element_type=F32)
    top_logits, top_idx = lax.top_k(logits, TOP_K)
    gates = jax.nn.softmax(top_logits, axis=-1)
    flat_e = top_idx.reshape(-1)
    flat_tok = jnp.repeat(jnp.arange(T, dtype=jnp.int32), TOP_K)
    order = jnp.argsort(flat_e)
    tok_sorted = flat_tok[order]
    xs = xf[tok_sorted]
    group_sizes = jnp.bincount(flat_e, length=N_EXPERTS).astype(jnp.int32)
    hid = jax.nn.silu(lax.ragged_dot(xs, w_gate, group_sizes)) * lax.ragged_dot(xs, w_up, group_sizes)
    ys = lax.ragged_dot(hid, w_down, group_sizes)
    ys = ys * gates.reshape(-1)[order][:, None].astype(ys.dtype)
    out = jnp.zeros_like(xf).at[tok_sorted].add(ys)
    return out.reshape(B, S, D)


def _normal(key, shape, fan_in):
    return jax.random.normal(key, shape, F32) * (fan_in ** -0.5)


def _gain(key, shape):
    return 1.0 + 0.02 * jax.random.normal(key, shape, F32)


def setup_inputs(seed: int = 0) -> dict:
    key = jax.random.key(seed)
    ks = jax.random.split(key, 24)
    x = jax.random.normal(ks[0], (BATCH, SEQ, D_MODEL), F32)
    offset = jax.random.randint(ks[1], (BATCH, 1), 0, 4096, dtype=jnp.int32)
    positions = offset + jnp.arange(SEQ, dtype=jnp.int32)[None, :]
    return {
        "x": x,
        "positions": positions,
        "mix_norm": _gain(ks[2], (DEPTH, D_MODEL)),
        "w_in": _normal(ks[3], (DEPTH, D_MODEL, IN_COLS), D_MODEL),
        "q_a_norm": _gain(ks[4], (DEPTH, Q_RANK)),
        "w_q_b": _normal(ks[5], (DEPTH, Q_RANK, MLA_HEADS * (QK_NOPE + QK_ROPE)), Q_RANK),
        "kv_a_norm": _gain(ks[6], (DEPTH, KV_RANK)),
        "w_kv_b": _normal(ks[7], (DEPTH, KV_RANK, MLA_HEADS * (QK_NOPE + V_HEAD)), KV_RANK),
        "hg_lower_bounds": 0.5 * jax.random.normal(ks[8], (DEPTH, HG_FDIM), F32),
        "hg_out_norm": _gain(ks[9], (DEPTH, HG_VAL)),
        "w_out": _normal(ks[10], (DEPTH, MIX_WIDTH, D_MODEL), MIX_WIDTH),
        "ffn_norm": _gain(ks[11], (DEPTH, D_MODEL)),
        "dense_w_gate": _normal(ks[12], (N_DENSE, D_MODEL, DENSE_FF), D_MODEL),
        "dense_w_up": _normal(ks[13], (N_DENSE, D_MODEL, DENSE_FF), D_MODEL),
        "dense_w_down": _normal(ks[14], (N_DENSE, DENSE_FF, D_MODEL), DENSE_FF),
        "moe_router": _normal(ks[15], (N_MOE, D_MODEL, N_EXPERTS), D_MODEL),
        "moe_w_gate": _normal(ks[16], (N_MOE, N_EXPERTS, D_MODEL, EXPERT_FF), D_MODEL),
        "moe_w_up": _normal(ks[17], (N_MOE, N_EXPERTS, D_MODEL, EXPERT_FF), D_MODEL),
        "moe_w_down": _normal(ks[18], (N_MOE, N_EXPERTS, EXPERT_FF, D_MODEL), EXPERT_FF),
        "final_norm": _gain(ks[19], (D_MODEL,)),
    }


def reference(x, positions, mix_norm, w_in, q_a_norm, w_q_b, kv_a_norm, w_kv_b, hg_lower_bounds, hg_out_norm, w_out, ffn_norm, dense_w_gate, dense_w_up, dense_w_down, moe_router, moe_w_gate, moe_w_up, moe_w_down, final_norm):
    lb_p = jax.nn.softmax(hg_lower_bounds.astype(F32), axis=0)
    lower = jnp.cumsum(lb_p, axis=0) - lb_p[0:1]
    splits = np.cumsum([Q_RANK, KV_RANK, QK_ROPE, HG_FDIM, HG_FDIM, HG_WIDTH]).tolist()
    for l in range(DEPTH):
        h = _rmsnorm(x, mix_norm[l])
        proj = h @ w_in[l]
        c_q, c_kv, k_pe, hq, hf, hi, hg = jnp.split(proj, splits, axis=-1)
        a = _mla(c_q, c_kv, k_pe, positions, q_a_norm[l], w_q_b[l], kv_a_norm[l], w_kv_b[l])
        r = _hgrn2(hq, hf, hi, hg, lower[l], hg_out_norm[l]).astype(x.dtype)
        x = x + jnp.concatenate([a, r], axis=-1) @ w_out[l]
        h = _rmsnorm(x, ffn_norm[l])
        if l % 2 == 0:
            j = l // 2
            x = x + _swiglu(h, dense_w_gate[j], dense_w_up[j], dense_w_down[j])
        else:
            j = l // 2
            x = x + _moe(h, moe_router[j], moe_w_gate[j], moe_w_up[j], moe_w_down[j])
    return _rmsnorm(x, final_norm)
```

```cpp
#include <hip/hip_runtime.h>
#include <cstdio>
#include <cstdint>

#ifndef N_LAUNCH_MODE
#define N_LAUNCH_MODE 1
#endif

#ifndef FAST_GEMM
#define FAST_GEMM 1
#endif
#ifndef REP_ATTN
#define REP_ATTN 1
#endif
#ifndef REP_INPROJ
#define REP_INPROJ 1
#endif
#ifndef REP_H3
#define REP_H3 1
#endif
#ifndef REP_PRO
#define REP_PRO 1
#endif
#ifndef REP_MOEGU
#define REP_MOEGU 1
#endif
#ifndef REP_MOEDN
#define REP_MOEDN 1
#endif
#ifndef REP_DGU
#define REP_DGU 1
#endif
#ifndef REP_NORM
#define REP_NORM 1
#endif
#ifndef REP_ROUTE
#define REP_ROUTE 1
#endif
#ifndef REP_OUT0
#define REP_OUT0 1
#endif
#ifndef REP_QKV
#define REP_QKV 1
#endif
#define REP_1(stmt) stmt
#define REP_2(stmt) stmt stmt
#define REP_CAT(a, b) a##b
#define REP_X(n, stmt) REP_CAT(REP_, n)(stmt)
#ifndef MOE_FP8
#define MOE_FP8 1
#endif
#ifndef DN_SPLITK
#define DN_SPLITK 1
#endif
#ifndef FUSE_NORM
#define FUSE_NORM 1
#endif
#ifndef XR_BF16
#define XR_BF16 1
#endif
#ifndef HG_V2
#define HG_V2 1
#endif
#ifndef FAST_ATTN
#define FAST_ATTN 1
#endif
#ifndef FAST_HGRN
#define FAST_HGRN 1
#endif
#define GAS __attribute__((address_space(1)))
#define LAS __attribute__((address_space(3)))
typedef unsigned short bf16;
typedef float f32x4 __attribute__((ext_vector_type(4)));
typedef short bf16x8 __attribute__((ext_vector_type(8)));
typedef unsigned u32x4 __attribute__((ext_vector_type(4)));
typedef unsigned u32x2 __attribute__((ext_vector_type(2)));

constexpr int T = 16384, SEQ = 8192, DM = 1024, NLAYER = 2;
constexpr int QR = 384, KVR = 256, ROPE = 64, NPROJ = 2752, NPROJ_P = 2816;
constexpr int NH = 4, DQK = 192, DNOPE = 128, DV = 128;
constexpr int HGW = 512;
constexpr int FF0 = 2816, FFM = 3584, NE = 8;
constexpr int MAXTILES = 136;
constexpr float EPS = 1e-6f;
constexpr int NWAVES = 8, NTHREADS = 512;

constexpr size_t MiB = 1u << 20;
constexpr size_t WS_CTL = 0, CTL_BYTES = 32768;
constexpr size_t WS_MISC = 1 * MiB;
constexpr size_t MISC_LB = 0, MISC_GCNT = 8192, MISC_TILE_E = 16384, MISC_NT = 17408, MISC_TOPI = 65536, MISC_TOPG = 196608, MISC_POS = 327680, MISC_SSXA = 458752, MISC_SSXB = 720896;
constexpr size_t WS_COS = 2 * MiB, WS_SIN = 4 * MiB;
constexpr size_t WS_WT_IN = 6 * MiB, WS_WT_QB = 17 * MiB, WS_WT_KVB = 19 * MiB, WS_WT_OUT = 20 * MiB, WS_WT_GU = 24 * MiB, WS_WT_DN = 35 * MiB, WS_WT_MGU = 41 * MiB, WS_WT_MDN = 153 * MiB;
constexpr size_t WS_XB = 209 * MiB;
constexpr size_t WS_CQ = 242 * MiB, WS_CKV = 254 * MiB, WS_KPE = 262 * MiB, WS_SSQ = 264 * MiB, WS_HQ = 266 * MiB, WS_HK = 282 * MiB, WS_LF = 298 * MiB, WS_HV = 330 * MiB, WS_HG = 346 * MiB;
constexpr size_t WS_Q = 362 * MiB, WS_KN = 386 * MiB, WS_V = 402 * MiB, WS_CC = 418 * MiB, WS_END = 464 * MiB;
constexpr size_t WS_HID = 242 * MiB;
#if MOE_FP8
constexpr size_t WS_XS = 242 * MiB;
constexpr size_t WS_YS = 276 * MiB;
constexpr size_t WS_HIDM = 344 * MiB;
constexpr int CHUNK_TILES = 136;
static_assert(WS_HIDM + (size_t)34816 * 3584 <= 464 * MiB, "MoE hidden fits below the guaranteed workspace size");
#else
constexpr size_t WS_XS = 242 * MiB;
constexpr size_t WS_YS = WS_XS;
constexpr size_t WS_HIDM = 310 * MiB;
constexpr int CHUNK_TILES = 64;
#endif
constexpr size_t WS_AP2 = WS_CQ;
constexpr size_t WS_AML = WS_SSQ;
constexpr size_t WS_HD = WS_XB + 32 * MiB, WS_HR = WS_HD + 512 * 1024;
constexpr size_t WS_XRB = 97 * MiB;
constexpr size_t WS_SLAB = 209 * MiB;
constexpr int CW_BAR = 4096;

constexpr int LDS_BYTES = 147456;
constexpr int LDS_MISC_OFF = 143360;

__device__ __forceinline__ unsigned f2bf(float f) { unsigned u = __float_as_uint(f); return (u + 0x7fffu + ((u >> 16) & 1u)) >> 16; }
__device__ __forceinline__ unsigned pk2(float lo, float hi) { return f2bf(lo) | (f2bf(hi) << 16); }
__device__ __forceinline__ float bf2f(unsigned short b) { return __uint_as_float(((unsigned)b) << 16); }
__device__ __forceinline__ float bflo(unsigned w) { return __uint_as_float(w << 16); }
__device__ __forceinline__ float bfhi(unsigned w) { return __uint_as_float(w & 0xffff0000u); }
__device__ __forceinline__ float clamp8(float x) { return __builtin_amdgcn_fmed3f(x, -448.f, 448.f); }
__device__ __forceinline__ unsigned pk4_fp8(float a, float b, float c, float d) {
    int w = __builtin_amdgcn_cvt_pk_fp8_f32(clamp8(a), clamp8(b), 0, false); w = __builtin_amdgcn_cvt_pk_fp8_f32(clamp8(c), clamp8(d), w, true); return (unsigned)w; }
__device__ __forceinline__ u32x4 pack8(f32x4 a, f32x4 b) { u32x4 w; w.x = pk2(a.x, a.y); w.y = pk2(a.z, a.w); w.z = pk2(b.x, b.y); w.w = pk2(b.z, b.w); return w; }
#if XR_BF16
typedef bf16 xr_t;
#else
typedef float xr_t;
#endif
__device__ __forceinline__ f32x4 ldrow4(const float* row, int idx) { return *((const f32x4*)row + idx); }
__device__ __forceinline__ f32x4 ldrow4(const bf16* row, int idx) { const u32x2 w = *((const u32x2*)row + idx); f32x4 r; r.x = __uint_as_float(w.x << 16); r.y = __uint_as_float(w.x & 0xffff0000u); r.z = __uint_as_float(w.y << 16); r.w = __uint_as_float(w.y & 0xffff0000u); return r; }
__device__ __forceinline__ float wave_sum(float v) {
#pragma unroll
    for (int o = 1; o < 64; o <<= 1) v += __shfl_xor(v, o);
    return v;
}
__device__ __forceinline__ float wave_max(float v) {
#pragma unroll
    for (int o = 1; o < 64; o <<= 1) v = fmaxf(v, __shfl_xor(v, o));
    return v;
}
__device__ __forceinline__ float fast_exp(float x) { return __builtin_amdgcn_exp2f(x * 1.4426950408889634f); }
__device__ __forceinline__ float sigmoidf_(float x) { return __builtin_amdgcn_rcpf(1.f + fast_exp(-x)); }
__device__ __forceinline__ float siluf_(float x) { return x * __builtin_amdgcn_rcpf(1.f + fast_exp(-x)); }
typedef float f32x2v __attribute__((ext_vector_type(2)));
__device__ __forceinline__ f32x2v silu_mul_pk(f32x2v g, f32x2v u) {
    const f32x2v t = g * (-1.4426950408889634f); f32x2v e; e.x = __builtin_amdgcn_exp2f(t.x); e.y = __builtin_amdgcn_exp2f(t.y);
    const f32x2v d = e + 1.0f; f32x2v r; r.x = __builtin_amdgcn_rcpf(d.x); r.y = __builtin_amdgcn_rcpf(d.y);
    return (g * u) * r;
}
__device__ __forceinline__ int perm32(int rho) { const int n = rho >> 4, i = rho & 15; return 8 * (i >> 2) + 4 * n + (i & 3); }

__device__ const double kInvRev[32] = {
    1.59154943091895346e-01, 1.19349370211248862e-01, 8.94994016088910133e-02, 6.71150830052272551e-02, 5.03292121044870353e-02, 3.77415847174197711e-02, 2.83021958306233987e-02, 2.12236527647776604e-02,
    1.59154943091895339e-02, 1.19349370211248862e-02, 8.94994016088910237e-03, 6.71150830052272534e-03, 5.03292121044870370e-03, 3.77415847174197719e-03, 2.83021958306233987e-03, 2.12236527647776622e-03,
    1.59154943091895356e-03, 1.19349370211248849e-03, 8.94994016088910237e-04, 6.71150830052272599e-04, 5.03292121044870326e-04, 3.77415847174197741e-04, 2.83021958306233954e-04, 2.12236527647776605e-04,
    1.59154943091895351e-04, 1.19349370211248862e-04, 8.94994016088910182e-05, 6.71150830052272545e-05, 5.03292121044870354e-05, 3.77415847174197768e-05, 2.83021958306233961e-05, 2.12236527647776592e-05};

#define XB_TMO      128
#define XB_XCNT(j)  (256  + 64 * (j))
#define XB_XSUB(j)  (1280 + 64 * (j))
#define XB_XGEN(j)  (2304 + 64 * (j))
#define XB_TOP      3328
#define XB_TOPGEN   3392
#define XCD_BAR_WORDS 3456
#define XB_SPIN_CAP (1u << 18)
__device__ __forceinline__ unsigned xb_ld(unsigned* p)              { return __hip_atomic_load(p, __ATOMIC_RELAXED, __HIP_MEMORY_SCOPE_AGENT); }
__device__ __forceinline__ unsigned xb_add(unsigned* p, unsigned v) { return __hip_atomic_fetch_add(p, v, __ATOMIC_RELAXED, __HIP_MEMORY_SCOPE_AGENT); }
__device__ __forceinline__ unsigned xb_xcc_id() { return (unsigned)__builtin_amdgcn_s_getreg((3 << 11) | 20) & 0xFu; }
#define XB_SPIN(cond, bar) do { unsigned _sp = 0; while (cond) { __builtin_amdgcn_s_sleep(1); \
    if ((++_sp & 255u) == 0u) { if (xb_ld(&(bar)[XB_TMO])) break; if (_sp > XB_SPIN_CAP) { atomicAdd(&(bar)[XB_TMO], 1u); break; } } } } while (0)
struct XcdBarrier { unsigned* bar; unsigned x; volatile LAS unsigned* st; };
__device__ __forceinline__ XcdBarrier xcd_barrier_post(unsigned* bar, volatile LAS unsigned* st) {
    XcdBarrier b; b.bar = bar; b.x = xb_xcc_id(); b.st = st;
    if (threadIdx.x == 0) (void)xb_add(&bar[XB_XCNT(b.x)], 1u);
    return b;
}
__device__ __forceinline__ void xcd_barrier_complete(unsigned* bar, unsigned x, unsigned& nloc, unsigned& nx) {
    const unsigned G = gridDim.x * gridDim.y * gridDim.z;
    unsigned sum, cnt, mine, sp = 0u;
    for (;;) {
        sum = 0u; cnt = 0u; mine = 0u;
#pragma unroll
        for (unsigned j = 0; j < 16; ++j) { const unsigned c = xb_ld(&bar[XB_XCNT(j)]); sum += c; cnt += (c > 0u) ? 1u : 0u; mine = (j == x) ? c : mine; }
        if (sum == G) break;
        __builtin_amdgcn_s_sleep(1);
        if ((++sp & 255u) == 0u) { if (xb_ld(&bar[XB_TMO])) break; if (sp > XB_SPIN_CAP) { atomicAdd(&bar[XB_TMO], 1u); break; } }
    }
    nloc = mine > 0u ? mine : 1u; nx = cnt > 0u ? cnt : 1u;
}
__device__ __forceinline__ void xcd_barrier(const XcdBarrier& b) {
    asm volatile("s_waitcnt vmcnt(0)" ::: "memory");
    __syncthreads();
    unsigned long long bar_ = (unsigned long long)b.bar; asm volatile("" : "+s"(bar_));
    if (threadIdx.x == 0) {
        unsigned* bar = (unsigned*)(GAS unsigned*)bar_;
        __builtin_amdgcn_s_waitcnt(0);
        unsigned nloc = b.st[0], nx = b.st[1];
        if (nloc == 0u) { xcd_barrier_complete(bar, b.x, nloc, nx); b.st[0] = nloc; b.st[1] = nx; }
        const unsigned old = xb_add(&bar[XB_XSUB(b.x)], 1u);
        const unsigned gen = old / nloc;
        if (old + 1u == (gen + 1u) * nloc) {
            __builtin_amdgcn_fence(__ATOMIC_RELEASE, "agent");
            asm volatile("s_waitcnt vmcnt(0)" ::: "memory");
            const unsigned og = xb_add(&bar[XB_TOP], 1u);
            const unsigned tg = og / nx;
            if (og + 1u == (tg + 1u) * nx) xb_add(&bar[XB_TOPGEN], 1u);
            else XB_SPIN(xb_ld(&bar[XB_TOPGEN]) == tg, bar);
            __builtin_amdgcn_fence(__ATOMIC_ACQUIRE, "agent");
            xb_add(&bar[XB_XGEN(b.x)], 1u);
            asm volatile("s_waitcnt vmcnt(0)" ::: "memory");
        } else {
            XB_SPIN(xb_ld(&bar[XB_XGEN(b.x)]) == gen, bar);
            __builtin_amdgcn_fence(__ATOMIC_ACQUIRE, "agent");
            asm volatile("s_waitcnt vmcnt(0)" ::: "memory");
        }
    }
    __syncthreads();
}

struct Params { const float* in[20]; float* out; unsigned char* ws; int ph_lo, ph_hi; };
enum { I_X = 0, I_POS, I_MIXN, I_WIN, I_QAN, I_WQB, I_KVAN, I_WKVB, I_HLB, I_HON, I_WOUT, I_FFNN, I_DWG, I_DWU, I_DWD, I_ROUTER, I_MWG, I_MWU, I_MWD, I_FINN };

struct Ctx {
    int tid, lane, wave, bid, nblk;
    LAS unsigned char* lds;
};

struct EpiProj {
    unsigned char* ws; int l; int ssx;
    __device__ __forceinline__ void launder() { unsigned long long w = (unsigned long long)ws; asm volatile("" : "+s"(w)); ws = (unsigned char*)(GAS unsigned char*)w;     }
    __device__ __forceinline__ void operator()(int row, int c, f32x4 a, f32x4 b) const {
        bf16* CQ = (bf16*)(ws + WS_CQ); bf16* CKV = (bf16*)(ws + WS_CKV); bf16* KPE = (bf16*)(ws + WS_KPE); bf16* HQ = (bf16*)(ws + WS_HQ); bf16* HK = (bf16*)(ws + WS_HK); bf16* HV = (bf16*)(ws + WS_HV); bf16* HG = (bf16*)(ws + WS_HG);
        float* LF = (float*)(ws + WS_LF); float* SSQ = (float*)(ws + WS_SSQ); const float* LB = (const float*)(ws + WS_MISC + MISC_LB) + l * HGW; const float* COS = (const float*)(ws + WS_COS); const float* SIN = (const float*)(ws + WS_SIN);
        if (ssx) { const float* sx = (const float*)(ws + WS_MISC + ssx) + row; const float rstd = __builtin_amdgcn_rsqf(((sx[0] + sx[T]) + (sx[2 * T] + sx[3 * T])) * (1.f / DM) + EPS); a = a * rstd; b = b * rstd; }
        if (c < 640) {
            float ss = (a.x * a.x + a.y * a.y) + (a.z * a.z + a.w * a.w) + (b.x * b.x + b.y * b.y) + (b.z * b.z + b.w * b.w);
            ss += __shfl_xor(ss, 16); ss += __shfl_xor(ss, 32);
            if ((threadIdx.x & 63) < 16) SSQ[(size_t)(c >> 5) * T + row] = ss;
            const u32x4 w = pack8(a, b);
            if (c < QR) *(u32x4*)(CQ + (size_t)row * QR + c) = w; else *(u32x4*)(CKV + (size_t)row * KVR + (c - QR)) = w;
        } else if (c < 704) {
            const int g = (c - 640) >> 3;
            const f32x4 cs = *(const f32x4*)(COS + (size_t)row * 32 + 4 * g), sn = *(const f32x4*)(SIN + (size_t)row * 32 + 4 * g);
            const f32x4 o1 = a * cs - b * sn, o2 = a * sn + b * cs;
            *(u32x4*)(KPE + (size_t)row * ROPE + 8 * g) = pack8(o1, o2);
        } else if (c < 1216) {
            f32x4 x, y; x.x = siluf_(a.x); x.y = siluf_(a.y); x.z = siluf_(a.z); x.w = siluf_(a.w); y.x = siluf_(b.x); y.y = siluf_(b.y); y.z = siluf_(b.z); y.w = siluf_(b.w);
            *(u32x4*)(HQ + (size_t)row * HGW + (c - 704)) = pack8(x, y);
#if HG_V2
        } else if (c < 1728) {
            *(u32x4*)(HK + (size_t)row * HGW + (c - 1216)) = pack8(a, b);
#else
        } else if (c < 1728) {
            const int d = c - 1216;
            const f32x4 l0 = *(const f32x4*)(LB + d), l1 = *(const f32x4*)(LB + d + 4);
            f32x4 k0, k1, f0, f1;
#define HGATE(z, lb, kk, lf) do { const float zc = fminf(fmaxf((z), -60.f), 60.f); const float e = fast_exp(-zc); const float sg = __builtin_amdgcn_rcpf(1.f + e); const float om = 1.f - (lb); \
                kk = om * (e * sg); const float f = (lb) + om * sg; lf = __builtin_amdgcn_logf(fmaxf(f, 1e-30f)) * 0.6931471805599453f; } while (0)
            HGATE(a.x, l0.x, k0.x, f0.x); HGATE(a.y, l0.y, k0.y, f0.y); HGATE(a.z, l0.z, k0.z, f0.z); HGATE(a.w, l0.w, k0.w, f0.w);
            HGATE(b.x, l1.x, k1.x, f1.x); HGATE(b.y, l1.y, k1.y, f1.y); HGATE(b.z, l1.z, k1.z, f1.z); HGATE(b.w, l1.w, k1.w, f1.w);
#undef HGATE
            *(u32x4*)(HK + (size_t)row * HGW + d) = pack8(k0, k1);
            *(f32x4*)(LF + (size_t)row * HGW + d) = f0; *(f32x4*)(LF + (size_t)row * HGW + d + 4) = f1;
#endif
        } else if (c < 2240) {
            *(u32x4*)(HV + (size_t)row * HGW + (c - 1728)) = pack8(a, b);
        } else if (c < 2752) {
            *(u32x4*)(HG + (size_t)row * HGW + (c - 2240)) = pack8(a, b);
        }
    }
};
struct EpiQ {
    unsigned char* ws;
    __device__ __forceinline__ void launder() { unsigned long long w = (unsigned long long)ws; asm volatile("" : "+s"(w)); ws = (unsigned char*)(GAS unsigned char*)w;     }
    __device__ __forceinline__ void operator()(int row, int c, f32x4 a, f32x4 b) const {
        bf16* Q = (bf16*)(ws + WS_Q); const float* SSQ = (const float*)(ws + WS_SSQ); const float* COS = (const float*)(ws + WS_COS); const float* SIN = (const float*)(ws + WS_SIN);
        float s = 0.f;
#pragma unroll
        for (int i = 0; i < 12; ++i) s += SSQ[(size_t)i * T + row];
        const float rstd = __builtin_amdgcn_rsqf(s * (1.f / QR) + EPS);
        a = a * rstd; b = b * rstd;
        const int h = c / DQK, cc = c - h * DQK, bb = row >> 13, sq = row & (SEQ - 1);
        bf16* dst = Q + ((size_t)((bb * NH + h) * SEQ + sq)) * DQK + cc;
        if (cc < DNOPE) { *(u32x4*)dst = pack8(a, b); }
        else { const int g = (cc - DNOPE) >> 3;
            const f32x4 cs = *(const f32x4*)(COS + (size_t)row * 32 + 4 * g), sn = *(const f32x4*)(SIN + (size_t)row * 32 + 4 * g);
            *(u32x4*)dst = pack8(a * cs - b * sn, a * sn + b * cs); }
    }
};
struct EpiKV {
    unsigned char* ws;
    __device__ __forceinline__ void launder() { unsigned long long w = (unsigned long long)ws; asm volatile("" : "+s"(w)); ws = (unsigned char*)(GAS unsigned char*)w;     }
    __device__ __forceinline__ void operator()(int row, int c, f32x4 a, f32x4 b) const {
        bf16* KN = (bf16*)(ws + WS_KN); bf16* V = (bf16*)(ws + WS_V); const float* SSQ = (const float*)(ws + WS_SSQ);
        float s = 0.f;
#pragma unroll
        for (int i = 12; i < 20; ++i) s += SSQ[(size_t)i * T + row];
        const float rstd = __builtin_amdgcn_rsqf(s * (1.f / KVR) + EPS);
        a = a * rstd; b = b * rstd;
        const int h = c >> 8, cc = c & 255, bb = row >> 13, sq = row & (SEQ - 1);
        const size_t r = ((size_t)((bb * NH + h) * SEQ + sq)) * 128;
        if (cc < 128) *(u32x4*)(KN + r + cc) = pack8(a, b); else *(u32x4*)(V + r + (cc - 128)) = pack8(a, b);
    }
};
template <class TS, class TD> struct EpiResT {
    const TS* SRC; TD* DST;
    __device__ __forceinline__ void launder() {}
    __device__ __forceinline__ void operator()(int row, int c, f32x4 a, f32x4 b) const {
        const size_t o = (size_t)row * DM + c;
        f32x4 s0, s1;
        if constexpr (sizeof(TS) == 4) { s0 = *(const f32x4*)((const float*)SRC + o); s1 = *(const f32x4*)((const float*)SRC + o + 4); }
        else { const u32x4 w = *(const u32x4*)((const bf16*)SRC + o); s0.x = bflo(w.x); s0.y = bfhi(w.x); s0.z = bflo(w.y); s0.w = bfhi(w.y); s1.x = bflo(w.z); s1.y = bfhi(w.z); s1.z = bflo(w.w); s1.w = bfhi(w.w); }
        s0 = s0 + a; s1 = s1 + b;
        if constexpr (sizeof(TD) == 4) { *(f32x4*)((float*)DST + o) = s0; *(f32x4*)((float*)DST + o + 4) = s1; }
        else *(u32x4*)((bf16*)DST + o) = pack8(s0, s1);
    }
};
template <class TS> struct EpiResNormT {
    static constexpr bool HAS_FINISH = true;
    const TS* SRC; bf16* DST; float* SSX; float ssb;
    __device__ __forceinline__ void launder() {}
    __device__ __forceinline__ void operator()(int row, int c, f32x4 a, f32x4 b) {
        const size_t o = (size_t)row * DM + c;
        f32x4 s0, s1;
        if constexpr (sizeof(TS) == 4) { s0 = *(const f32x4*)((const float*)SRC + o); s1 = *(const f32x4*)((const float*)SRC + o + 4); }
        else { const u32x4 w = *(const u32x4*)((const bf16*)SRC + o); s0.x = bflo(w.x); s0.y = bfhi(w.x); s0.z = bflo(w.y); s0.w = bfhi(w.y); s1.x = bflo(w.z); s1.y = bfhi(w.z); s1.z = bflo(w.w); s1.w = bfhi(w.w); }
        s0 = s0 + a; s1 = s1 + b;
        *(u32x4*)(DST + o) = pack8(s0, s1);
        float ss = (s0.x * s0.x + s0.y * s0.y) + (s0.z * s0.z + s0.w * s0.w) + (s1.x * s1.x + s1.y * s1.y) + (s1.z * s1.z + s1.w * s1.w);
        if ((c & 128) == 0) { ssb = ss; }
        else { ss += ssb; ss += __shfl_xor(ss, 16); ss += __shfl_xor(ss, 32);
            if ((threadIdx.x & 63) < 16) part[(row & 255) * 4 + ((c >> 5) & 3)] = ss; }
    }
    LAS float* part;
    __device__ __forceinline__ void finish(int pm, int pn, int tid) {
        asm volatile("s_waitcnt lgkmcnt(0)" ::: "memory"); __builtin_amdgcn_s_barrier(); asm volatile("" ::: "memory");
        if (tid < 256) { const LAS float* q = part + tid * 4; SSX[(size_t)pn * T + pm * 256 + tid] = (q[0] + q[1]) + (q[2] + q[3]); }
    }
};
struct EpiSwiglu {
    bf16* HID; int ff; int rowbase; const float* SSX;
    __device__ __forceinline__ void launder() {}
    __device__ __forceinline__ void operator()(int row, int c, f32x4 a, f32x4 b) const {
        if (SSX) { const float* sx = SSX + row; const float rstd = __builtin_amdgcn_rsqf(((sx[0] + sx[T]) + (sx[2 * T] + sx[3 * T])) * (1.f / DM) + EPS); a = a * rstd; b = b * rstd; }
        const f32x2v h0 = silu_mul_pk((f32x2v){a.x, a.y}, (f32x2v){b.x, b.y}), h1 = silu_mul_pk((f32x2v){a.z, a.w}, (f32x2v){b.z, b.w});
        u32x2 w; w.x = pk2(h0.x, h0.y); w.y = pk2(h1.x, h1.y);
        *(u32x2*)(HID + (size_t)(row - rowbase) * ff + (c >> 1)) = w;
    }
};
struct EpiSwiglu8 {
    unsigned char* HID; int ff; int rowbase;
    __device__ __forceinline__ void launder() {}
    __device__ __forceinline__ void operator()(int row, int c, f32x4 a, f32x4 b) const {
        const f32x2v h0 = silu_mul_pk((f32x2v){a.x, a.y}, (f32x2v){b.x, b.y}), h1 = silu_mul_pk((f32x2v){a.z, a.w}, (f32x2v){b.z, b.w});
        *(unsigned*)(HID + (size_t)(row - rowbase) * ff + (c >> 1)) = pk4_fp8(h0.x, h0.y, h1.x, h1.y);
    }
};
struct EpiProbe {
    float* sink;
    __device__ __forceinline__ void launder() {}
    __device__ __forceinline__ void operator()(int row, int c, f32x4 a, f32x4 b) const { if (a.x == 123456.789f && b.w == -98765.4321f) sink[row * 8 + (c & 7)] = a.y; }
};
struct EpiBf16Plain {
    bf16* O; int ld;
    __device__ __forceinline__ void launder() {}
    __device__ __forceinline__ void operator()(int row, int c, f32x4 a, f32x4 b) const { *(u32x4*)(O + (size_t)row * ld + c) = pack8(a, b); }
};

namespace pg8 {
#define PG8_LAS __attribute__((address_space(3)))
typedef unsigned short bf16_t;
typedef short bf16x8 __attribute__((ext_vector_type(8)));
typedef float f32x4 __attribute__((ext_vector_type(4)));
typedef unsigned u32x4 __attribute__((ext_vector_type(4)));
typedef int v4i_t __attribute__((ext_vector_type(4)));
typedef int v8i_t __attribute__((ext_vector_type(8)));
constexpr int BM = 256, BK = 64, HALF = 128, HTB = HALF * BK * 2  , STAGE_BYTES = 8 * HTB, NXCD = 8, WGM = 8;

__host__ __device__ __forceinline__ int lds_byte(int r, int c) { const int st = (r >> 4) * 2 + (c >> 5), rr = r & 15, cc = c & 31, ob = rr * 64 + cc * 2; return st * 1024 + (ob ^ (((ob >> 9) & 1) << 5)); }
__host__ __device__ __forceinline__ void stage_rc(int b, int& R, int& C) { const int st = b / 1024, sb = b % 1024, swz = sb ^ (((sb >> 9) & 1) << 5); R = (st >> 1) * 16 + swz / 64; C = (st & 1) * 32 + (swz % 64) / 2; }
__host__ __device__ __forceinline__ int perm32(int rho) { const int n = rho >> 4, i = rho & 15; return 8 * (i >> 2) + 4 * n + (i & 3); }

template <class E, class = void> struct has_finish { static constexpr bool value = false; };
template <class E> struct has_finish<E, decltype((void)E::HAS_FINISH)> { static constexpr bool value = true; };
struct Unit { int pm, pn, pa, pb; };
struct Gemm { const bf16_t* A; const bf16_t* Bt; int M, N, K; int wscale; int ld; };

struct StaticOrder {
    int nM, nN, nwg, G, c;
    __host__ __device__ void init(int M, int N, int G_, int c_) { nM = M / BM; nN = N / BM; nwg = nM * nN; G = G_; c = c_; }
    __host__ __device__ bool next(int i, Unit& u) const {
        const long L = (long)i * G + c; if (L >= nwg) return false;
        int wgid = (int)L; { const int q = nwg / NXCD, r = nwg % NXCD, xcd = wgid % NXCD, off = wgid / NXCD; wgid = (xcd < r ? xcd * (q + 1) : r * (q + 1) + (xcd - r) * q) + off; }
        const int nig = WGM * nN, gid = wgid / nig, fm = gid * WGM, gsz = (nM - fm) < WGM ? (nM - fm) : WGM;
        u.pm = fm + ((wgid % nig) % gsz); u.pn = (wgid % nig) / gsz; u.pa = u.pm; u.pb = u.pn; return true;
    }
    __device__ __forceinline__ void a_ready(const Unit&) const {}
    __device__ __forceinline__ void done(const Unit&) const {}
};
template <class Epi, class Sched, bool ALIGN_EPI = false, bool SP2 = false, bool FP8 = false>
__device__ __forceinline__ void gemm_phase(PG8_LAS unsigned char* lds, const Gemm g, const Sched& S, const Epi& E) {
    int tid_ = threadIdx.x; asm volatile("" : "+v"(tid_));
    const int tid = tid_, wid = __builtin_amdgcn_readfirstlane(tid >> 6), lane = tid & 63, wr = wid >> 2, wc = wid & 3, fr = lane & 15, fq = lane >> 4;
    const int K = g.ld ? g.ld : g.K, nt = g.K / BK;
    unsigned voffA[2], voffB[2];
#pragma unroll
    for (int i = 0; i < 2; ++i) { int R, C; stage_rc(tid * 16 + i * 8192, R, C); const int Rb = (R & ~31) + perm32(R & 31);
        voffA[i] = (unsigned)(R * K + C) * 2u; voffB[i] = (unsigned)(Rb * K + C) * 2u; }
    const size_t kstep = (size_t)(BK * 2);
    const size_t hstep = (size_t)HALF * K * 2;
    const size_t tstep = 2 * hstep;
    const unsigned ldsw = (unsigned)wid * 1024u;
    const int aoff = lds_byte(wr * 64 + fr, fq * 8), boff = lds_byte(wc * 32 + fr, fq * 8);
#define PG8_SA(b, h) (((b) * 2 + (h)) * HTB)
#define PG8_SB(b, h) ((4 + (b) * 2 + (h)) * HTB)
#define PG8_STAGE(bufoff, gbase, voff) do { _Pragma("unroll") for (int _i = 0; _i < 2; ++_i) \
        __builtin_amdgcn_global_load_lds((const unsigned*)((const char*)(gbase) + (voff)[_i]), (PG8_LAS unsigned*)(lds + (bufoff) + ldsw + _i * 8192), 16, 0, 0); } while (0)
#define PG8_RD(off) (*(const PG8_LAS bf16x8*)(lds + (off)))
#define PG8_CAT(lo, hi) __builtin_shufflevector(__builtin_bit_cast(v4i_t, lo), __builtin_bit_cast(v4i_t, hi), 0, 1, 2, 3, 4, 5, 6, 7)
#define PG8_LDA(dst, b, h) do { _Pragma("unroll") for (int m = 0; m < 4; ++m) { if constexpr (FP8) dst##8[m] = PG8_CAT(PG8_RD(PG8_SA(b, h) + aoff + m * 2048), PG8_RD(PG8_SA(b, h) + aoff + m * 2048 + 1024)); \
        else { dst[m][0] = PG8_RD(PG8_SA(b, h) + aoff + m * 2048); dst[m][1] = PG8_RD(PG8_SA(b, h) + aoff + m * 2048 + 1024); } } } while (0)
#define PG8_LDB(dst, b, h) do { _Pragma("unroll") for (int n = 0; n < 2; ++n) { if constexpr (FP8) dst##8[n] = PG8_CAT(PG8_RD(PG8_SB(b, h) + boff + n * 2048), PG8_RD(PG8_SB(b, h) + boff + n * 2048 + 1024)); \
        else { dst[n][0] = PG8_RD(PG8_SB(b, h) + boff + n * 2048); dst[n][1] = PG8_RD(PG8_SB(b, h) + boff + n * 2048 + 1024); } } } while (0)
#define PG8_MMA(ai, bj, At, Bt) do { __builtin_amdgcn_s_setprio(1); if constexpr (FP8) { _Pragma("unroll") for (int m = 0; m < 4; ++m) _Pragma("unroll") for (int n = 0; n < 2; ++n) \
        asm volatile("v_mfma_scale_f32_16x16x128_f8f6f4 %0, %1, %2, %0, %3, %4 op_sel_hi:[0,0,0]" : "+v"(acc[ai][bj][m][n]) : "v"(Bt##8[n]), "v"(At##8[m]), "v"(sc_w), "v"(sc_1)); } \
        else { _Pragma("unroll") for (int m = 0; m < 4; ++m) _Pragma("unroll") for (int n = 0; n < 2; ++n) _Pragma("unroll") for (int k = 0; k < 2; ++k) \
        acc[ai][bj][m][n] = __builtin_amdgcn_mfma_f32_16x16x32_bf16(Bt[n][k], At[m][k], acc[ai][bj][m][n], 0, 0, 0); } __builtin_amdgcn_s_setprio(0); } while (0)
#define PG8_WAIT_V(n) asm volatile("s_waitcnt vmcnt(" #n ")" ::: "memory")
#define PG8_WAIT_L(n) asm volatile("s_waitcnt lgkmcnt(" #n ")" ::: "memory")
#define PG8_BAR __builtin_amdgcn_s_barrier()
#define PG8_SCHED __builtin_amdgcn_sched_barrier(0)
    Unit cur, nxt; int ui = 0;
    if (!S.next(0, cur)) return;
    f32x4 acc[2][2][4][2];
#pragma unroll
    for (int a = 0; a < 2; ++a)
#pragma unroll
        for (int b = 0; b < 2; ++b)
#pragma unroll
            for (int m = 0; m < 4; ++m)
#pragma unroll
                for (int n = 0; n < 2; ++n) acc[a][b][m][n] = (f32x4){0.f, 0.f, 0.f, 0.f};
    const int sc_w = g.wscale, sc_1 = 0x7F7F7F7F;
    bf16x8 At[4][2], B0[2][2], B1[2][2]; v8i_t At8[4], B08[2], B18[2];
    const char* cA = (const char*)g.A + (size_t)cur.pa * tstep; const char* cB = (const char*)g.Bt + (size_t)cur.pb * tstep;
    S.a_ready(cur);
    if constexpr (SP2) {
        PG8_STAGE(PG8_SB(0, 0), cB, voffB); PG8_STAGE(PG8_SB(0, 1), cB + hstep, voffB); PG8_STAGE(PG8_SA(0, 0), cA, voffA); PG8_STAGE(PG8_SA(0, 1), cA + hstep, voffA);
        if (wr == 1) PG8_BAR;
        PG8_WAIT_V(2); PG8_BAR;
        PG8_STAGE(PG8_SB(1, 0), cB + kstep, voffB); PG8_STAGE(PG8_SA(1, 0), cA + kstep, voffA); PG8_STAGE(PG8_SB(1, 1), cB + hstep + kstep, voffB);
        PG8_WAIT_V(6); PG8_BAR;
    } else {
        PG8_STAGE(PG8_SB(0, 0), cB, voffB); PG8_STAGE(PG8_SA(0, 0), cA, voffA); PG8_STAGE(PG8_SB(0, 1), cB + hstep, voffB); PG8_STAGE(PG8_SA(0, 1), cA + hstep, voffA);
        if (wr == 1) PG8_BAR;
        PG8_WAIT_V(4); PG8_BAR;
        PG8_STAGE(PG8_SB(1, 0), cB + kstep, voffB); PG8_STAGE(PG8_SA(1, 0), cA + kstep, voffA); PG8_STAGE(PG8_SB(1, 1), cB + hstep + kstep, voffB);
        PG8_WAIT_V(6); PG8_BAR;
    }
    for (;;) {
        const bool has_next = S.next(ui + 1, nxt);
        const char* nA = has_next ? (const char*)g.A + (size_t)nxt.pa * tstep : cA; const char* nB = has_next ? (const char*)g.Bt + (size_t)nxt.pb * tstep : cB;
#pragma nounroll
        for (int t = 0; t < nt; t += 2) {
            const bool last = (t == nt - 2);
            const char* a1 = cA + (size_t)(t + 1) * kstep;
            const char* a2 = last ? nA : cA + (size_t)(t + 2) * kstep; const char* b2 = last ? nB : cB + (size_t)(t + 2) * kstep;
            const char* a3 = a2 + kstep; const char* b3 = b2 + kstep;
            if (last && has_next) S.a_ready(nxt);
            if constexpr (SP2) {
            PG8_LDB(B0, 0, 0); PG8_LDB(B1, 0, 1); PG8_SCHED; PG8_LDA(At, 0, 0); PG8_STAGE(PG8_SA(1, 1), a1 + hstep, voffA);
            PG8_WAIT_V(8); PG8_WAIT_L(0); PG8_BAR; PG8_MMA(0, 0, At, B0); PG8_MMA(0, 1, At, B1); PG8_BAR; PG8_SCHED;
            PG8_LDA(At, 0, 1); PG8_STAGE(PG8_SB(0, 0), b2, voffB); PG8_STAGE(PG8_SB(0, 1), b2 + hstep, voffB); PG8_STAGE(PG8_SA(0, 0), a2, voffA);
            PG8_WAIT_V(8); PG8_WAIT_L(0); PG8_BAR; PG8_MMA(1, 0, At, B0); PG8_MMA(1, 1, At, B1); PG8_BAR; PG8_SCHED;
            PG8_LDB(B0, 1, 0); PG8_LDB(B1, 1, 1); PG8_SCHED; PG8_LDA(At, 1, 0); PG8_STAGE(PG8_SA(0, 1), a2 + hstep, voffA);
            PG8_WAIT_V(8); PG8_WAIT_L(0); PG8_BAR; PG8_MMA(0, 0, At, B0); PG8_MMA(0, 1, At, B1); PG8_BAR; PG8_SCHED;
            PG8_LDA(At, 1, 1); PG8_STAGE(PG8_SB(1, 0), b3, voffB); PG8_STAGE(PG8_SB(1, 1), b3 + hstep, voffB); PG8_STAGE(PG8_SA(1, 0), a3, voffA);
            PG8_WAIT_V(8); PG8_WAIT_L(0); PG8_BAR; PG8_MMA(1, 0, At, B0); PG8_MMA(1, 1, At, B1); PG8_BAR; PG8_SCHED;
            } else {
            PG8_LDB(B0, 0, 0); PG8_SCHED; PG8_LDA(At, 0, 0); PG8_STAGE(PG8_SA(1, 1), a1 + hstep, voffA);
            PG8_WAIT_L(8); PG8_BAR; PG8_WAIT_L(0); PG8_MMA(0, 0, At, B0); PG8_BAR; PG8_SCHED;
            PG8_LDB(B1, 0, 1); PG8_STAGE(PG8_SB(0, 0), b2, voffB);
            PG8_BAR; PG8_WAIT_L(0); PG8_MMA(0, 1, At, B1); PG8_BAR;
            PG8_LDA(At, 0, 1); PG8_STAGE(PG8_SA(0, 0), a2, voffA);
            PG8_BAR; PG8_WAIT_L(0); PG8_MMA(1, 0, At, B0); PG8_BAR; PG8_SCHED;
            PG8_STAGE(PG8_SB(0, 1), b2 + hstep, voffB);
            PG8_WAIT_V(6); PG8_BAR; PG8_MMA(1, 1, At, B1); PG8_BAR;
            PG8_LDB(B0, 1, 0); PG8_SCHED; PG8_LDA(At, 1, 0); PG8_STAGE(PG8_SA(0, 1), a2 + hstep, voffA);
            PG8_WAIT_L(8); PG8_BAR; PG8_WAIT_L(0); PG8_MMA(0, 0, At, B0); PG8_BAR; PG8_SCHED;
            PG8_LDB(B1, 1, 1); PG8_STAGE(PG8_SB(1, 0), b3, voffB);
            PG8_BAR; PG8_WAIT_L(0); PG8_MMA(0, 1, At, B1); PG8_BAR;
            PG8_LDA(At, 1, 1); PG8_STAGE(PG8_SA(1, 0), a3, voffA);
            PG8_BAR; PG8_WAIT_L(0); PG8_MMA(1, 0, At, B0); PG8_BAR; PG8_SCHED;
            PG8_STAGE(PG8_SB(1, 1), b3 + hstep, voffB);
            PG8_WAIT_V(6); PG8_BAR; PG8_MMA(1, 1, At, B1); PG8_BAR;
            }
        }
        if constexpr (ALIGN_EPI) { if (wr == 0) PG8_BAR; }
        if constexpr (FP8) asm volatile("s_nop 15\n\ts_nop 15" ::: "memory");
        {
            int fr_ = fr, fq_ = fq; asm volatile("" : "+v"(fr_), "+v"(fq_));
            const int row0 = cur.pm * BM + wr * 64 + fr_, col0 = cur.pn * BM + wc * 32 + 8 * fq_;
            Epi E2 = E; E2.launder();
#pragma unroll
            for (int ai = 0; ai < 2; ++ai)
#pragma unroll
                for (int m = 0; m < 4; ++m)
#pragma unroll
                    for (int bj = 0; bj < 2; ++bj) E2(row0 + ai * HALF + m * 16, col0 + bj * HALF, acc[ai][bj][m][0], acc[ai][bj][m][1]);
            if constexpr (has_finish<Epi>::value) E2.finish(cur.pm, cur.pn, tid);
            S.done(cur);
        }
        if (!has_next) break;
#pragma unroll
        for (int a = 0; a < 2; ++a)
#pragma unroll
            for (int b = 0; b < 2; ++b)
#pragma unroll
                for (int m = 0; m < 4; ++m)
#pragma unroll
                    for (int n = 0; n < 2; ++n) acc[a][b][m][n] = (f32x4){0.f, 0.f, 0.f, 0.f};
        cur = nxt; cA = nA; cB = nB; ++ui;
        if constexpr (ALIGN_EPI) { if (wr == 1) PG8_BAR; }
    }
    PG8_WAIT_V(0);
    if constexpr (!ALIGN_EPI) { if (wr == 0) PG8_BAR; }
    PG8_BAR;
#undef PG8_SA
#undef PG8_SB
#undef PG8_STAGE
#undef PG8_LDA
#undef PG8_RD
#undef PG8_LDB
#undef PG8_MMA
#undef PG8_CAT
#undef PG8_WAIT_V
#undef PG8_WAIT_L
#undef PG8_BAR
#undef PG8_SCHED
}

struct MoeOrder {
    StaticOrder so; int t0, abase, nN; const int* tile_e;
    __device__ void init(int t0_, int t1_, int N, int G_, int c_, const int* te, int abase_) { so.init((t1_ - t0_) * BM, N, G_, c_); t0 = t0_; abase = abase_; nN = N / BM; tile_e = te; }
    __device__ bool next(int i, Unit& u) const { if (!so.next(i, u)) return false; u.pm += t0; u.pa = u.pm - abase; u.pb = __builtin_amdgcn_readfirstlane(tile_e[u.pm]) * nN + u.pn; return true; }
    __device__ __forceinline__ void a_ready(const Unit&) const {}
    __device__ __forceinline__ void done(const Unit&) const {}
};
}

template <class Epi>
__device__ __forceinline__ void simple_gemm(const Ctx& X, const bf16* A, const bf16* Bt, int row_lo, int nrows, int N, int K, const int* tile_e, size_t expert_stride, int a_rowbase, const Epi& E) {
    const int fr = X.lane & 15, fq = X.lane >> 4;
    const int ncb = N / 32, ntile = (nrows / 16) * ncb;
    const int gw = X.bid * NWAVES + X.wave, ngw = X.nblk * NWAVES;
    for (int t = gw; t < ntile; t += ngw) {
        const int tm = t / ncb, tn = t - tm * ncb, r0 = row_lo + tm * 16, c0 = tn * 32;
        const bf16* Bb = Bt; if (tile_e) Bb += (size_t)tile_e[r0 >> 8] * expert_stride;
        const bf16* arow = A + (size_t)(r0 - a_rowbase + fr) * K + 8 * fq;
        const bf16* b0 = Bb + (size_t)(c0 + perm32(fr)) * K + 8 * fq;
        const bf16* b1 = Bb + (size_t)(c0 + perm32(16 + fr)) * K + 8 * fq;
        f32x4 acc0 = {0.f, 0.f, 0.f, 0.f}, acc1 = {0.f, 0.f, 0.f, 0.f};
        for (int k = 0; k < K; k += 32) {
            const bf16x8 a = *(const bf16x8*)(arow + k), w0 = *(const bf16x8*)(b0 + k), w1 = *(const bf16x8*)(b1 + k);
            acc0 = __builtin_amdgcn_mfma_f32_16x16x32_bf16(w0, a, acc0, 0, 0, 0);
            acc1 = __builtin_amdgcn_mfma_f32_16x16x32_bf16(w1, a, acc1, 0, 0, 0);
        }
        E(r0 + fr, c0 + 8 * fq, acc0, acc1);
    }
}


namespace pg8 { struct OneUnit { Unit u; bool have;
    __device__ bool next(int i, Unit& o) const { if (i != 0 || !have) return false; o = u; return true; }
    __device__ __forceinline__ void a_ready(const Unit&) const {}
    __device__ __forceinline__ void done(const Unit&) const {} }; }
struct EpiSlab {
    float* slab; int ks;
    __device__ __forceinline__ void launder() {}
    __device__ __forceinline__ void operator()(int row, int c, f32x4 a, f32x4 b) const {
        float* d = slab + ((size_t)((((row >> 8) - 128) * 4 + (c >> 8)) * 7 + ks) * 256 + (row & 255)) * 256 + (c & 255);
        *(f32x4*)d = a; *(f32x4*)(d + 4) = b; }
};
template <class Epi>
__device__ __forceinline__ void gemm_dense(const Ctx& X, const bf16* A, const bf16* Bt, int N, int K, const Epi& E) {
#if FAST_GEMM
    pg8::Gemm g{A, Bt, T, N, K, 0}; pg8::StaticOrder S; S.init(T, N, X.nblk, X.bid);
    pg8::gemm_phase<Epi, pg8::StaticOrder, true, true>(X.lds, g, S, E);
#else
    simple_gemm(X, A, Bt, 0, T, N, K, nullptr, 0, 0, E);
#endif
}
template <class Epi>
__device__ __forceinline__ void gemm_moe(const Ctx& X, const bf16* A, const bf16* Bt, int t0, int t1, int N, int K, const int* tile_e, int abase, int wscale, const Epi& E) {
#if FAST_GEMM
    pg8::Gemm g{A, Bt, (t1 - t0) * 256, N, K, wscale, 0}; pg8::MoeOrder S; S.init(t0, t1, N, X.nblk, X.bid, tile_e, abase);
    pg8::gemm_phase<Epi, pg8::MoeOrder, true, true, MOE_FP8 != 0>(X.lds, g, S, E);
#else
    simple_gemm(X, A, Bt, t0 * 256, (t1 - t0) * 256, N, K, tile_e, (size_t)N * K, abase * 256, E);
#endif
}

struct SrcPlain { const float* W; int N; __device__ __forceinline__ f32x4 load4(int k, int n4) const { return *(const f32x4*)(W + (size_t)k * N + n4); } };
struct SrcScaled { const float* W; int N; const float* rs; __device__ __forceinline__ f32x4 load4(int k, int n4) const { return *(const f32x4*)(W + (size_t)k * N + n4) * rs[k]; } };
__device__ __forceinline__ int rope_src(int j) { const int g = j >> 3, jj = j & 7; return (jj < 4) ? (4 * g + jj) : (32 + 4 * g + (jj - 4)); }
struct SrcIn { const float* W; const float* rs;
    __device__ __forceinline__ f32x4 load4(int k, int n4) const { if (n4 >= NPROJ) return (f32x4){0.f, 0.f, 0.f, 0.f}; int m = n4; if (n4 >= 640 && n4 < 704) m = 640 + rope_src(n4 - 640); const f32x4 v = *(const f32x4*)(W + (size_t)k * NPROJ + m); return rs ? v * rs[k] : v; } };
struct SrcQB { const float* W; const float* gain;
    __device__ __forceinline__ f32x4 load4(int k, int n4) const { const int h = n4 / DQK; int c = n4 - h * DQK; if (c >= DNOPE) c = DNOPE + rope_src(c - DNOPE);
        return *(const f32x4*)(W + (size_t)k * (NH * DQK) + h * DQK + c) * (gain[k] * 0.07216878364870322f); } };
struct SrcGU { const float* Wg; const float* Wu; int FF; const float* rs;
    __device__ __forceinline__ f32x4 load4(int k, int n4) const { const int g = n4 >> 3; const long long d = (n4 & 4) ? (long long)(Wu - Wg) : 0ll; const f32x4 v = *(const f32x4*)(Wg + d + (long long)k * FF + 4 * g); return rs ? v * rs[k] : v; } };

template <class Src>
__device__ __forceinline__ void transpose_item(const Src& S, int K, int nblk, bf16* WT, LAS float* scr, int item, int lane) {
    const int kb = item / nblk, nb = item - kb * nblk, k0 = 64 * kb, n0 = 32 * nb;
    const int kk0 = lane >> 3, qd = lane & 7;
    f32x4 v[8];
#pragma unroll
    for (int i = 0; i < 8; ++i) v[i] = S.load4(k0 + 8 * i + kk0, n0 + 4 * qd);
#pragma unroll
    for (int i = 0; i < 8; ++i) { LAS float* d = scr + (8 * i + kk0) * 33 + 4 * qd; d[0] = v[i].x; d[1] = v[i].y; d[2] = v[i].z; d[3] = v[i].w; }
    asm volatile("s_waitcnt lgkmcnt(0)" ::: "memory");
    const int c = lane & 7;
#pragma unroll
    for (int j = 0; j < 4; ++j) { const int n = (lane >> 3) + 8 * j; const LAS float* s = scr + (8 * c) * 33 + n;
        u32x4 o; o.x = pk2(s[0 * 33], s[1 * 33]); o.y = pk2(s[2 * 33], s[3 * 33]); o.z = pk2(s[4 * 33], s[5 * 33]); o.w = pk2(s[6 * 33], s[7 * 33]);
        *(u32x4*)(WT + (size_t)(n0 + n) * K + k0 + 8 * c) = o; }
    asm volatile("s_waitcnt lgkmcnt(0)" ::: "memory");
}

template <class Src>
__device__ __forceinline__ void transpose_item_fp8(const Src& S, int K, int nblk, unsigned char* WT, LAS float* scr, int item, int lane, float scale) {
    const int kb = item / nblk, nb = item - kb * nblk, k0 = 64 * kb, n0 = 32 * nb;
    const int kk0 = lane >> 3, qd = lane & 7;
    f32x4 v[8];
#pragma unroll
    for (int i = 0; i < 8; ++i) v[i] = S.load4(k0 + 8 * i + kk0, n0 + 4 * qd);
#pragma unroll
    for (int i = 0; i < 8; ++i) { LAS float* d = scr + (8 * i + kk0) * 33 + 4 * qd; d[0] = v[i].x * scale; d[1] = v[i].y * scale; d[2] = v[i].z * scale; d[3] = v[i].w * scale; }
    asm volatile("s_waitcnt lgkmcnt(0)" ::: "memory");
    const int c = lane & 3;
#pragma unroll
    for (int j = 0; j < 2; ++j) { const int n = (lane >> 2) + 16 * j; const LAS float* s = scr + (16 * c) * 33 + n;
        u32x4 o; o.x = pk4_fp8(s[0 * 33], s[1 * 33], s[2 * 33], s[3 * 33]); o.y = pk4_fp8(s[4 * 33], s[5 * 33], s[6 * 33], s[7 * 33]);
        o.z = pk4_fp8(s[8 * 33], s[9 * 33], s[10 * 33], s[11 * 33]); o.w = pk4_fp8(s[12 * 33], s[13 * 33], s[14 * 33], s[15 * 33]);
        *(u32x4*)(WT + (size_t)(n0 + n) * K + k0 + 16 * c) = o; }
    asm volatile("s_waitcnt lgkmcnt(0)" ::: "memory");
}

template <int NR, class TS>
__device__ __forceinline__ void norm_rows_bf16(const TS* src, const float* gain, bf16* dst, int row0, int rstep, int lane) {
    f32x4 v[NR][4];
#pragma unroll
    for (int i = 0; i < NR; ++i)
#pragma unroll
        for (int j = 0; j < 4; ++j) v[i][j] = ldrow4(src + (size_t)(row0 + i * rstep) * DM, lane + 64 * j);
    f32x4 g[4];
#pragma unroll
    for (int j = 0; j < 4; ++j) g[j] = *((const f32x4*)gain + lane + 64 * j);
#pragma unroll
    for (int i = 0; i < NR; ++i) { float s = 0.f;
#pragma unroll
        for (int j = 0; j < 4; ++j) s += (v[i][j].x * v[i][j].x + v[i][j].y * v[i][j].y) + (v[i][j].z * v[i][j].z + v[i][j].w * v[i][j].w);
        const float rstd = __builtin_amdgcn_rsqf(wave_sum(s) * (1.f / DM) + EPS);
#pragma unroll
        for (int j = 0; j < 4; ++j) { const f32x4 y = v[i][j] * rstd * g[j]; u32x2 w; w.x = pk2(y.x, y.y); w.y = pk2(y.z, y.w); *((u32x2*)(dst + (size_t)(row0 + i * rstep) * DM) + lane + 64 * j) = w; } }
}
template <class TS>
__device__ __forceinline__ void norm_all_rows(const Ctx& X, const TS* src, const float* gain, bf16* dst) {
    const int gw = X.bid * NWAVES + X.wave, ngw = X.nblk * NWAVES;
    int m = gw;
    for (; m + 3 * ngw < T; m += 4 * ngw) norm_rows_bf16<4, TS>(src, gain, dst, m, ngw, X.lane);
    for (; m < T; m += ngw) norm_rows_bf16<1, TS>(src, gain, dst, m, ngw, X.lane);
}

__device__ __forceinline__ void phase_prologue(const Ctx& X, const Params& p) {
    unsigned char* ws = p.ws;
    LAS float* scr = (LAS float*)(X.lds + X.wave * 16384);
    const int gw = X.bid * NWAVES + X.wave, ngw = X.nblk * NWAVES;
    constexpr int I_IN = 16 * 88, I_QB = 6 * 24, I_KVB = 4 * 32, I_OUT = 16 * 32, I_GU = 16 * 176, I_DN = 44 * 32, I_MGU = 16 * 224, I_MDN = 56 * 32;
    constexpr int I_LAYER = I_IN + I_QB + I_KVB + I_OUT;
    constexpr int NITEMS = 2 * I_LAYER + I_GU + I_DN + NE * (I_MGU + I_MDN);
    for (int it = gw; it < NITEMS; it += ngw) {
        int r = it;
        if (r < 2 * I_LAYER) {
            const int l = r / I_LAYER; r -= l * I_LAYER;
            if (r < I_IN) { SrcIn S{p.in[I_WIN] + (size_t)l * DM * NPROJ, (FUSE_NORM && l == 1) ? p.in[I_MIXN] + DM : nullptr}; transpose_item(S, DM, NPROJ_P / 32, (bf16*)(ws + WS_WT_IN) + (size_t)l * NPROJ_P * DM, scr, r, X.lane); continue; } r -= I_IN;
            if (r < I_QB) { SrcQB S{p.in[I_WQB] + (size_t)l * QR * (NH * DQK), p.in[I_QAN] + l * QR}; transpose_item(S, QR, (NH * DQK) / 32, (bf16*)(ws + WS_WT_QB) + (size_t)l * (NH * DQK) * QR, scr, r, X.lane); continue; } r -= I_QB;
            if (r < I_KVB) { SrcScaled S{p.in[I_WKVB] + (size_t)l * KVR * 1024, 1024, p.in[I_KVAN] + l * KVR}; transpose_item(S, KVR, 1024 / 32, (bf16*)(ws + WS_WT_KVB) + (size_t)l * 1024 * KVR, scr, r, X.lane); continue; } r -= I_KVB;
            { SrcPlain S{p.in[I_WOUT] + (size_t)l * DM * DM, DM}; transpose_item(S, DM, DM / 32, (bf16*)(ws + WS_WT_OUT) + (size_t)l * DM * DM, scr, r, X.lane); continue; }
        }
        r -= 2 * I_LAYER;
        if (r < I_GU) { SrcGU S{p.in[I_DWG], p.in[I_DWU], FF0, FUSE_NORM ? p.in[I_FFNN] : nullptr}; transpose_item(S, DM, (2 * FF0) / 32, (bf16*)(ws + WS_WT_GU), scr, r, X.lane); continue; } r -= I_GU;
        if (r < I_DN) { SrcPlain S{p.in[I_DWD], DM}; transpose_item(S, FF0, DM / 32, (bf16*)(ws + WS_WT_DN), scr, r, X.lane); continue; } r -= I_DN;
        if (r < NE * I_MGU) { const int e = r / I_MGU; r -= e * I_MGU; SrcGU S{p.in[I_MWG] + (size_t)e * DM * FFM, p.in[I_MWU] + (size_t)e * DM * FFM, FFM, nullptr};
#if MOE_FP8
            transpose_item_fp8(S, DM, (2 * FFM) / 32, (unsigned char*)(ws + WS_WT_MGU) + (size_t)e * (2 * FFM) * DM, scr, r, X.lane, 64.f); continue; } r -= NE * I_MGU;
        { const int e = r / I_MDN; r -= e * I_MDN; SrcPlain S{p.in[I_MWD] + (size_t)e * FFM * DM, DM};
            transpose_item_fp8(S, FFM, DM / 32, (unsigned char*)(ws + WS_WT_MDN) + (size_t)e * DM * FFM, scr, r, X.lane, 128.f); }
#else
            transpose_item(S, DM, (2 * FFM) / 32, (bf16*)(ws + WS_WT_MGU) + (size_t)e * (2 * FFM) * DM, scr, r, X.lane); continue; } r -= NE * I_MGU;
        { const int e = r / I_MDN; r -= e * I_MDN; SrcPlain S{p.in[I_MWD] + (size_t)e * FFM * DM, DM};
            transpose_item(S, FFM, DM / 32, (bf16*)(ws + WS_WT_MDN) + (size_t)e * DM * FFM, scr, r, X.lane); }
#endif
    }
    { const int* pos = (const int*)p.in[I_POS]; float* COS = (float*)(ws + WS_COS); float* SIN = (float*)(ws + WS_SIN);
      for (int i = X.bid * NTHREADS + X.tid; i < T * 32; i += X.nblk * NTHREADS) {
          const int row = i >> 5, f = i & 31; const double a = (double)pos[row] * kInvRev[f]; const float rev = (float)(a - floor(a));
          COS[i] = __builtin_amdgcn_cosf(rev); SIN[i] = __builtin_amdgcn_sinf(rev); } }
    if (X.bid == 0) { float* LB = (float*)(ws + WS_MISC + MISC_LB); const float* h = p.in[I_HLB];
        for (int i = X.tid; i < HGW; i += NTHREADS) { LB[i] = 0.f; LB[HGW + i] = 1.f / (1.f + expf(h[i] - h[HGW + i])); } }
    norm_all_rows(X, p.in[I_X], p.in[I_MIXN], (bf16*)(ws + WS_XB));
}

__device__ __forceinline__ void phase_attn_simple(const Ctx& X, const Params& p) {
    unsigned char* ws = p.ws;
    const bf16* Q = (const bf16*)(ws + WS_Q); const bf16* KN = (const bf16*)(ws + WS_KN); const bf16* KPE = (const bf16*)(ws + WS_KPE); const bf16* V = (const bf16*)(ws + WS_V);
    bf16* CC = (bf16*)(ws + WS_CC);
    LAS float* ql = (LAS float*)(X.lds + X.wave * 1024);
    const int gw = X.bid * NWAVES + X.wave, ngw = X.nblk * NWAVES, lane = X.lane;
    for (int idx = gw; idx < 2 * NH * SEQ; idx += ngw) {
        const int bh = idx & 7, q = SEQ - 1 - (idx >> 3), b = bh >> 2, h = bh & 3;
        const bf16* qrow = Q + ((size_t)bh * SEQ + q) * DQK;
        ql[lane] = bf2f(qrow[lane]); ql[64 + lane] = bf2f(qrow[64 + lane]); ql[128 + lane] = bf2f(qrow[128 + lane]);
        asm volatile("s_waitcnt lgkmcnt(0)" ::: "memory");
        float m = -1e30f, l = 0.f, o0 = 0.f, o1 = 0.f;
        for (int k0 = 0; k0 <= q; k0 += 64) {
            const int key = k0 + lane; const bool valid = key <= q;
            float s = 0.f;
            const bf16* kr = KN + ((size_t)bh * SEQ + key) * 128; const bf16* kp = KPE + ((size_t)b * SEQ + key) * ROPE;
#pragma unroll 4
            for (int c = 0; c < 16; ++c) { const u32x4 w = *(const u32x4*)(kr + 8 * c); const LAS float* qq = ql + 8 * c;
                s += bflo(w.x) * qq[0] + bfhi(w.x) * qq[1] + bflo(w.y) * qq[2] + bfhi(w.y) * qq[3] + bflo(w.z) * qq[4] + bfhi(w.z) * qq[5] + bflo(w.w) * qq[6] + bfhi(w.w) * qq[7]; }
#pragma unroll 4
            for (int c = 0; c < 8; ++c) { const u32x4 w = *(const u32x4*)(kp + 8 * c); const LAS float* qq = ql + 128 + 8 * c;
                s += bflo(w.x) * qq[0] + bfhi(w.x) * qq[1] + bflo(w.y) * qq[2] + bfhi(w.y) * qq[3] + bflo(w.z) * qq[4] + bfhi(w.z) * qq[5] + bflo(w.w) * qq[6] + bfhi(w.w) * qq[7]; }
            if (!valid) s = -1e30f;
            const float mx = wave_max(s), mn = fmaxf(m, mx), alpha = fast_exp(m - mn);
            const float pr = valid ? fast_exp(s - mn) : 0.f;
            l = l * alpha + wave_sum(pr); o0 *= alpha; o1 *= alpha; m = mn;
            const bf16* vb = V + ((size_t)bh * SEQ + k0) * 128 + 2 * lane;
            for (int j = 0; j < 64; ++j) { const float pj = __shfl(pr, j); const unsigned w = *(const unsigned*)(vb + (size_t)j * 128); o0 += pj * bflo(w); o1 += pj * bfhi(w); }
        }
        const float inv = 1.f / l;
        *(unsigned*)(CC + ((size_t)(b * SEQ + q)) * DM + h * 128 + 2 * lane) = pk2(o0 * inv, o1 * inv);
    }
}


namespace att {
typedef short s16x4 __attribute__((ext_vector_type(4)));
typedef float f32x16 __attribute__((ext_vector_type(16)));
constexpr int NW = 8, QBLK = 32, KVBLK = 64, QB = 256, NQB = SEQ / QB;
constexpr int KROW = 400, SHM_V = KVBLK * 128 * 2, SHM_K = KVBLK * KROW;
constexpr int LDS_V = 0, LDS_K = 2 * SHM_V, LDS_WS = LDS_K + 2 * SHM_K, LDS_TOTAL = LDS_WS + NW * 64 * 4;
constexpr float THR = 8.f;
#define SBAR() __builtin_amdgcn_sched_barrier(0)
__device__ __forceinline__ int v_st(int k, int c) { const int kk = (k & ~0xC) | ((k & 4) << 1) | ((k & 8) >> 1); return ((kk >> 3) * 4 + (c >> 5)) * 512 + ((kk & 7) * 32 + (c & 31)) * 2; }
__device__ __forceinline__ int v_rd_base(int lane) { return ((lane & 3) << 3) | (((lane >> 2) & 3) << 6) | (((lane >> 4) & 1) << 5) | (((lane >> 5) & 1) << 8); }
constexpr int v_rd_off(int d0, int ks, int half) { return d0 * 512 + ks * 4096 + half * 2048; }
__device__ __forceinline__ int crow(int r, int hi) { return (r & 3) + 8 * (r >> 2) + 4 * hi; }
__device__ __forceinline__ unsigned cvtpk(float lo, float hi) { unsigned r; asm volatile("v_cvt_pk_bf16_f32 %0, %1, %2" : "=v"(r) : "v"(lo), "v"(hi)); return r; }
__device__ __forceinline__ bf16x8 load8(const bf16* p) { return *reinterpret_cast<const bf16x8*>(p); }
__device__ __forceinline__ bf16x8 bload8(__amdgpu_buffer_rsrc_t r, unsigned voff, unsigned soff) { const u32x4 x = __builtin_amdgcn_raw_buffer_load_b128(r, voff, soff, 0); return __builtin_bit_cast(bf16x8, x); }
__device__ __forceinline__ void mask_tile(f32x16& p0, f32x16& p1, int dq) {
    const float NEG = -__builtin_inff();
#pragma unroll
    for (int r = 0; r < 16; ++r) { const int c = (r & 3) + 8 * (r >> 2); if (dq - c < 0) p0[r] = NEG; if (dq - c - 32 < 0) p1[r] = NEG; }
}
__device__ __forceinline__ void partialSM(f32x16& p0, f32x16& p1, float& m_reg, float& mn, float& alpha) {
    float pmax = p0[0]; for (int r = 1; r < 16; ++r) pmax = fmaxf(pmax, p0[r]); for (int r = 0; r < 16; ++r) pmax = fmaxf(pmax, p1[r]);
    { auto rr = __builtin_amdgcn_permlane32_swap(__float_as_uint(pmax), __float_as_uint(pmax), false, false);
      pmax = fmaxf(__uint_as_float(rr[0]), __uint_as_float(rr[1])); }
    constexpr float C2 = 1.4426950408889634f;
    if (__builtin_expect(__all((pmax - m_reg) <= THR), 1)) { mn = m_reg; alpha = 1.f; }
    else { mn = fmaxf(m_reg, pmax); alpha = __builtin_amdgcn_exp2f((m_reg - mn) * C2); m_reg = mn; }
    const float mnL = -mn * C2;
    for (int r = 0; r < 16; ++r) p0[r] = fmaf(p0[r], C2, mnL); for (int r = 0; r < 16; ++r) p1[r] = fmaf(p1[r], C2, mnL);
    for (int r = 0; r < 16; ++r) p0[r] = __builtin_amdgcn_exp2f(p0[r]);
}
__device__ __forceinline__ void finishSM(f32x16& p0, f32x16& p1, float alpha, float& l_reg, bf16x8& pa0, bf16x8& pa1, bf16x8& pa2, bf16x8& pa3) {
    for (int r = 0; r < 16; ++r) p1[r] = __builtin_amdgcn_exp2f(p1[r]);
    float ps = 0; for (int r = 0; r < 16; ++r) ps += p0[r]; for (int r = 0; r < 16; ++r) ps += p1[r];
    { auto rr = __builtin_amdgcn_permlane32_swap(__float_as_uint(ps), __float_as_uint(ps), false, false);
      ps = __uint_as_float(rr[0]) + __uint_as_float(rr[1]); }
    l_reg = l_reg * alpha + ps;
#define PK4(P, B_, OUT) do { unsigned a0 = cvtpk(P[B_+0], P[B_+1]), a1 = cvtpk(P[B_+2], P[B_+3]);                          \
        unsigned b0 = cvtpk(P[B_+4], P[B_+5]), b1 = cvtpk(P[B_+6], P[B_+7]);                                             \
        auto r0 = __builtin_amdgcn_permlane32_swap(a0, b0, false, false); auto r1 = __builtin_amdgcn_permlane32_swap(a1, b1, false, false); \
        u32x4 w = {r0[0], r1[0], r0[1], r1[1]}; OUT = *reinterpret_cast<bf16x8*>(&w); } while (0)
    PK4(p0, 0, pa0); PK4(p0, 8, pa1); PK4(p1, 0, pa2); PK4(p1, 8, pa3);
#undef PK4
}
template <int KB>
__device__ __forceinline__ void qkt(f32x16& p0, f32x16& p1, const LAS char* K_lds, int r32, int hi, const bf16x8* qr) {
    p0 = f32x16{}; p1 = f32x16{};
    const LAS char* kb = K_lds + KB * SHM_K + r32 * KROW + hi * 16;
#pragma unroll
    for (int d0 = 0; d0 < 12; ++d0) {
        const bf16x8 b0 = *reinterpret_cast<const LAS bf16x8*>(kb + d0 * 32);
        const bf16x8 b1 = *reinterpret_cast<const LAS bf16x8*>(kb + d0 * 32 + 32 * KROW);
        p0 = __builtin_amdgcn_mfma_f32_32x32x16_bf16(b0, qr[d0], p0, 0, 0, 0);
        p1 = __builtin_amdgcn_mfma_f32_32x32x16_bf16(b1, qr[d0], p1, 0, 0, 0); }
}
template <int VB>
__device__ __forceinline__ void pv_tile(f32x16* o, int vb0, bf16x8 pa0, bf16x8 pa1, bf16x8 pa2, bf16x8 pa3) {
#define TRRD(dst, off) asm volatile("ds_read_b64_tr_b16 %0, %1 offset:%2" : "=&v"(dst) : "v"(vb0), "i"(off) : "memory")
#define PV_D0(d0) do { s16x4 l0, l1, l2, l3, h0, h1, h2, h3; constexpr int b_ = VB * SHM_V + v_rd_off(d0, 0, 0); \
        TRRD(l0, b_); TRRD(h0, b_ + 2048); TRRD(l1, b_ + 4096); TRRD(h1, b_ + 6144); TRRD(l2, b_ + 8192); TRRD(h2, b_ + 10240); TRRD(l3, b_ + 12288); TRRD(h3, b_ + 14336); \
        asm volatile("s_waitcnt lgkmcnt(0)" ::: "memory"); SBAR();   \
        o[d0] = __builtin_amdgcn_mfma_f32_32x32x16_bf16(pa0, (bf16x8){l0[0], l0[1], l0[2], l0[3], h0[0], h0[1], h0[2], h0[3]}, o[d0], 0, 0, 0);   \
        o[d0] = __builtin_amdgcn_mfma_f32_32x32x16_bf16(pa1, (bf16x8){l1[0], l1[1], l1[2], l1[3], h1[0], h1[1], h1[2], h1[3]}, o[d0], 0, 0, 0);   \
        o[d0] = __builtin_amdgcn_mfma_f32_32x32x16_bf16(pa2, (bf16x8){l2[0], l2[1], l2[2], l2[3], h2[0], h2[1], h2[2], h2[3]}, o[d0], 0, 0, 0);   \
        o[d0] = __builtin_amdgcn_mfma_f32_32x32x16_bf16(pa3, (bf16x8){l3[0], l3[1], l3[2], l3[3], h3[0], h3[1], h3[2], h3[3]}, o[d0], 0, 0, 0); } while (0)
    PV_D0(0); PV_D0(1); PV_D0(2); PV_D0(3);
#undef PV_D0
#undef TRRD
}
struct BlockRef { const bf16* Q; const bf16* KN; const bf16* KP; const bf16* V; bf16* O; float* ML; int ostride, P0, par, NT; };
struct Seam { bf16x8 qr[12]; bf16x8 st_v0, st_v1, st_k0, st_k1, st_k2; };
#define VMW() asm volatile("s_waitcnt vmcnt(0)" ::: "memory")
#define VMWN(n) asm volatile("s_waitcnt vmcnt(%0)" :: "i"(n) : "memory")
#define SLOAD(R, k0) do { const unsigned so_ = (unsigned)(k0) * 256u, sp_ = (unsigned)(k0) * 128u; \
                          S.st_v0 = bload8(rV, lofs, so_); S.st_v1 = bload8(rV, lofs, so_ + 8192u); S.st_k0 = bload8(rK, lofs, so_); S.st_k1 = bload8(rK, lofs, so_ + 8192u); S.st_k2 = bload8(rP, lofp, sp_); } while (0)
#define SWRITE_K(bf) do { *(LAS bf16x8*)(K_lds + (bf) * SHM_K + kws) = S.st_k0; *(LAS bf16x8*)(K_lds + (bf) * SHM_K + kws + 32 * KROW) = S.st_k1; *(LAS bf16x8*)(K_lds + (bf) * SHM_K + kwp) = S.st_k2; } while (0)
#define SWRITE_V(bf) do { *(LAS bf16x8*)(V_lds + (bf) * SHM_V + vst0) = S.st_v0; *(LAS bf16x8*)(V_lds + (bf) * SHM_V + vst1) = S.st_v1; } while (0)
#define KBASE_OF(R, t) (((R).par + 2 * (t)) * KVBLK)
__device__ __forceinline__ void attn_block(const BlockRef& cur, LAS char* lds, int tid) {
    Seam S;
    const int wid = __builtin_amdgcn_readfirstlane(tid >> 6), lane = tid & 63, r32 = lane & 31, hi = lane >> 5;
    const int NT = cur.NT;
    const int qlo = cur.P0 + wid * QBLK, qm = qlo + r32 - 4 * hi;
    LAS char* V_lds = lds + LDS_V; LAS char* K_lds = lds + LDS_K;
    LAS float* wsc = (LAS float*)(lds + LDS_WS) + wid * 64; LAS float* li_l = wsc; LAS float* al_l = wsc + 32;
    float m_reg = -1e30f, l_reg = 0; f32x16 o[4] = {};
    const int sr = tid >> 4, sc = (tid & 15) * 8, vst0 = v_st(sr, sc), vst1 = v_st(32 + sr, sc), kws = sr * KROW + sc * 2, pr = tid >> 3, pc = (tid & 7) * 8, kwp = pr * KROW + 256 + pc * 2;
    const unsigned lofs = (unsigned)(sr * 128 + sc) * 2u, lofp = (unsigned)(pr * 64 + pc) * 2u;
    const __amdgpu_buffer_rsrc_t rV = __builtin_amdgcn_make_buffer_rsrc((void*)cur.V, 0, SEQ * 128 * 2, 0x00020000), rK = __builtin_amdgcn_make_buffer_rsrc((void*)cur.KN, 0, SEQ * 128 * 2, 0x00020000),
                                 rP = __builtin_amdgcn_make_buffer_rsrc((void*)cur.KP, 0, SEQ * ROPE * 2, 0x00020000);
    const int vb0 = (int)(unsigned)(size_t)V_lds + v_rd_base(lane);
#define RESC(a) do { if (__any((a) < 1.f)) { if (hi == 0) al_l[r32] = (a); asm volatile("s_waitcnt lgkmcnt(0)" ::: "memory");              \
                     for (int d_ = 0; d_ < 4; ++d_) for (int r = 0; r < 16; ++r) o[d_][r] *= al_l[crow(r, hi)]; } } while (0)
#define KBASE(t) KBASE_OF(cur, t)
#define MASKT(P0_, P1_, t) do { const int kb_ = KBASE(t); if (kb_ + KVBLK - 1 > qlo) mask_tile(P0_, P1_, qm - kb_); } while (0)
    f32x16 pA0, pA1, pB0, pB1; float mnA, mnB, alA, alB; bf16x8 pa0, pa1, pa2, pa3;
#pragma unroll
    for (int d0 = 0; d0 < 12; ++d0) S.qr[d0] = load8(cur.Q + (size_t)(wid * QBLK + r32) * DQK + d0 * 16 + hi * 8);
    SLOAD(cur, KBASE(0)); VMW(); SWRITE_K(0); SWRITE_V(0);
    __syncthreads();
    SLOAD(cur, KBASE(1));
    SBAR(); qkt<0>(pA0, pA1, K_lds, r32, hi, S.qr);
    MASKT(pA0, pA1, 0); partialSM(pA0, pA1, m_reg, mnA, alA);
    VMW(); SWRITE_V(1); SWRITE_K(1);
    __syncthreads();
#define HALF_STEP(PX0, PX1, mnX, alX, PY0, PY1, alY, t, KB, VB, SB) do {                                                      \
        SBAR(); qkt<KB>(PX0, PX1, K_lds, r32, hi, S.qr);                                                                      \
        finishSM(PY0, PY1, alY, l_reg, pa0, pa1, pa2, pa3); SBAR();                                                           \
        if ((t) + 1 < NT) { SLOAD(cur, KBASE((t) + 1)); SBAR(); }                                                             \
        pv_tile<VB>(o, vb0, pa0, pa1, pa2, pa3); MASKT(PX0, PX1, (t)); partialSM(PX0, PX1, m_reg, mnX, alX);                  \
        __syncthreads();                                                                                                      \
        if ((t) + 1 < NT) { VMW(); SWRITE_V(SB); SWRITE_K(SB); }                                                              \
        RESC(alX); __syncthreads(); } while (0)
    for (int t = 1; t + 1 < NT; t += 2) {
        HALF_STEP(pB0, pB1, mnB, alB, pA0, pA1, alA, t, 1, 0, 0);
        HALF_STEP(pA0, pA1, mnA, alA, pB0, pB1, alB, t + 1, 0, 1, 1);
    }
    SBAR(); qkt<1>(pB0, pB1, K_lds, r32, hi, S.qr); SBAR();
    finishSM(pA0, pA1, alA, l_reg, pa0, pa1, pa2, pa3); SBAR();
    pv_tile<0>(o, vb0, pa0, pa1, pa2, pa3);
    MASKT(pB0, pB1, NT - 1); partialSM(pB0, pB1, m_reg, mnB, alB); __syncthreads(); RESC(alB);
    finishSM(pB0, pB1, alB, l_reg, pa0, pa1, pa2, pa3); SBAR(); pv_tile<1>(o, vb0, pa0, pa1, pa2, pa3);
    if (hi == 0) { li_l[r32] = l_reg; *(float2*)(cur.ML + (size_t)(wid * QBLK + r32) * 2) = make_float2(m_reg, l_reg); }
    asm volatile("s_waitcnt lgkmcnt(0)" ::: "memory");
    float rli[16];
#pragma unroll
    for (int r = 0; r < 16; ++r) { const float lv = li_l[crow(r, hi)]; rli[r] = lv > 0.f ? __builtin_amdgcn_rcpf(lv) : 0.f; }
    bf16* Ow = cur.O + (size_t)(wid * QBLK) * cur.ostride;
#pragma unroll
    for (int r = 0; r < 16; ++r) { const int orow = crow(r, hi);
#pragma unroll
        for (int d0 = 0; d0 < 4; ++d0) { const float v = o[d0][r] * rli[r]; const float vn = __shfl_xor(v, 1);
            if ((r32 & 1) == 0) *(unsigned*)(Ow + (size_t)orow * cur.ostride + d0 * 32 + r32) = cvtpk(v, vn); } }
    __syncthreads();
#undef RESC
#undef KBASE
#undef MASKT
#undef HALF_STEP
}
#undef SLOAD
#undef SWRITE_K
#undef SWRITE_V
#undef VMW
#undef VMWN
struct Item { int bh, x, par; };
__device__ __forceinline__ Item decode(int L) { Item it; it.bh = L & 7; const int rest = L >> 3; it.x = rest >> 1; it.par = rest & 1; return it; }
__device__ __forceinline__ BlockRef make_ref(unsigned char* ws, const Item& it, int pass) {
    const int qb = pass ? (NQB - 1 - it.x) : it.x, bh = it.bh; BlockRef r;
    r.Q = (const bf16*)(ws + WS_Q) + ((size_t)bh * SEQ + (size_t)qb * QB) * DQK;
    r.KN = (const bf16*)(ws + WS_KN) + (size_t)bh * SEQ * 128; r.KP = (const bf16*)(ws + WS_KPE) + (size_t)(bh >> 2) * SEQ * ROPE; r.V = (const bf16*)(ws + WS_V) + (size_t)bh * SEQ * 128;
    if (it.par == 0) { r.O = (bf16*)(ws + WS_CC) + ((size_t)((bh >> 2) * SEQ + qb * QB)) * DM + (bh & 3) * 128; r.ostride = DM; }
    else { r.O = (bf16*)(ws + WS_AP2) + ((size_t)bh * SEQ + (size_t)qb * QB) * 128; r.ostride = 128; }
    r.ML = (float*)(ws + WS_AML) + ((size_t)(it.par * 8 + bh) * SEQ + (size_t)qb * QB) * 2;
    r.P0 = qb * QB; r.par = it.par; r.NT = 2 * (qb + 1);
    return r;
}
}
__device__ __forceinline__ void phase_attn_fast(const Ctx& X, unsigned char* ws) {
    constexpr int TOTAL = 2 * NH * (att::NQB / 2) * 2;
    int L = X.bid; if (L >= TOTAL) return;
    const int stride = X.nblk;
    LAS char* lds = (LAS char*)X.lds;
    for (; L < TOTAL; L += stride) {
        const att::Item it = att::decode(L);
#pragma nounroll
        for (int pass = 0; pass < 2; ++pass) { const att::BlockRef cur = att::make_ref(ws, it, pass); att::attn_block(cur, lds, X.tid); }
    }
}
__device__ __forceinline__ void phase_attn_combine(const Ctx& X, unsigned char* ws) {
    bf16* CC = (bf16*)(ws + WS_CC); const bf16* P2 = (const bf16*)(ws + WS_AP2); const float* ML = (const float*)(ws + WS_AML);
    const int gw = X.bid * NWAVES + X.wave, ngw = X.nblk * NWAVES, lane = X.lane, h = lane >> 4, dd = (lane & 15) * 8;
    for (int r0 = gw; r0 < T; r0 += 4 * ngw) {
        u32x4 a[4], q[4]; float2 s1[4], s2[4];
#pragma unroll
        for (int i = 0; i < 4; ++i) { const int row = (r0 + i * ngw < T) ? r0 + i * ngw : r0, b = row >> 13, sq = row & (SEQ - 1), bh = b * NH + h;
            a[i] = *(const u32x4*)(CC + (size_t)row * DM + h * 128 + dd); q[i] = *(const u32x4*)(P2 + ((size_t)bh * SEQ + sq) * 128 + dd);
            s1[i] = *(const float2*)(ML + ((size_t)bh * SEQ + sq) * 2); s2[i] = *(const float2*)(ML + ((size_t)(8 + bh) * SEQ + sq) * 2); }
#pragma unroll
        for (int i = 0; i < 4; ++i) { const int row = (r0 + i * ngw < T) ? r0 + i * ngw : r0;
            const float m = fmaxf(s1[i].x, s2[i].x), w1 = s1[i].y * fast_exp(s1[i].x - m), w2 = s2[i].y * fast_exp(s2[i].x - m), inv = __builtin_amdgcn_rcpf(w1 + w2), c1 = w1 * inv, c2 = w2 * inv;
            u32x4 o; o.x = pk2(c1 * bflo(a[i].x) + c2 * bflo(q[i].x), c1 * bfhi(a[i].x) + c2 * bfhi(q[i].x)); o.y = pk2(c1 * bflo(a[i].y) + c2 * bflo(q[i].y), c1 * bfhi(a[i].y) + c2 * bfhi(q[i].y));
            o.z = pk2(c1 * bflo(a[i].z) + c2 * bflo(q[i].z), c1 * bfhi(a[i].z) + c2 * bfhi(q[i].z)); o.w = pk2(c1 * bflo(a[i].w) + c2 * bflo(q[i].w), c1 * bfhi(a[i].w) + c2 * bfhi(q[i].w));
            *(u32x4*)(CC + (size_t)row * DM + h * 128 + dd) = o; }
    }
}

namespace hg {
using att::s16x4; using att::f32x16; using att::v_st; using att::v_rd_base; using att::v_rd_off; using att::crow; using att::cvtpk;
constexpr int CH = 64, NCH = SEQ / CH;
constexpr int KROW2 = 272;
constexpr int TILE_V = 16384, TILE_K2 = CH * KROW2;
constexpr size_t US_BH = (size_t)NCH * 16384;
#define TRRD2(dst, base, off) asm volatile("ds_read_b64_tr_b16 %0, %1 offset:%2" : "=&v"(dst) : "v"(base), "i"(off) : "memory")
__device__ __forceinline__ float ex(float x) { return __builtin_amdgcn_exp2f(x * 1.4426950408889634f); }
#if HG_V2
__device__ __forceinline__ void h1_unit(const Ctx& X, unsigned char* ws, int u, const float* lbl) {
    int tid_ = X.tid; asm volatile("" : "+v"(tid_));
    const int bb = u >> 7, c = u & 127, row0 = bb * SEQ + c * CH, tid = tid_, lane = tid & 63, wave = X.wave;
    const bf16* HZ = (const bf16*)(ws + WS_HK); const bf16* HQ = (const bf16*)(ws + WS_HQ); const bf16* HV = (const bf16*)(ws + WS_HV);
    bf16* KRB = (bf16*)(ws + WS_LF); bf16* QRB = (bf16*)(ws + WS_LF + 16 * MiB);
    float* Dd = (float*)(ws + WS_HD); float* Rr = (float*)(ws + WS_HR); bf16* US = (bf16*)(ws + WS_XB);
    LAS char* lds = (LAS char*)X.lds;
    {
        const int t0 = tid >> 4, c8 = (tid & 15) * 8; const size_t g0 = (size_t)(row0 + t0) * HGW + c8; const int vst0 = v_st(t0, c8);
        u32x4 vw[8];
#pragma unroll
        for (int j = 0; j < 8; ++j) vw[j] = *(const u32x4*)(HV + g0 + (size_t)((j & 1) * 32 * HGW + (j >> 1) * 128));
#pragma unroll
        for (int j = 0; j < 8; ++j) *(LAS u32x4*)(lds + 65536 + (j >> 1) * TILE_V + vst0 + (j & 1) * 8192) = vw[j];
    }
    {
        const int head = tid >> 7, d = tid & 127; const unsigned vo = (unsigned)tid * 2u; const size_t cb = (size_t)row0 * HGW * 2;
        const __amdgpu_buffer_rsrc_t rZ = __builtin_amdgcn_make_buffer_rsrc((void*)((const char*)HZ + cb), 0, CH * HGW * 2, 0x00020000), rQ = __builtin_amdgcn_make_buffer_rsrc((void*)((const char*)HQ + cb), 0, CH * HGW * 2, 0x00020000),
                                     rK = __builtin_amdgcn_make_buffer_rsrc((void*)((char*)KRB + cb), 0, CH * HGW * 2, 0x00020000), rR = __builtin_amdgcn_make_buffer_rsrc((void*)((char*)QRB + cb), 0, CH * HGW * 2, 0x00020000);
        float zl[CH], qv[CH];
#pragma unroll
        for (int t = 0; t < CH; ++t) { zl[t] = bf2f((unsigned short)__builtin_amdgcn_raw_buffer_load_b16(rZ, vo, t * HGW * 2, 0)); qv[t] = bf2f((unsigned short)__builtin_amdgcn_raw_buffer_load_b16(rQ, vo, t * HGW * 2, 0)); }
        const float lb = lbl[tid], om = 1.f - lb;
        float b = 0.f, r = 0.f;
#pragma unroll
        for (int t = 0; t < CH; ++t) { const float zc = fminf(fmaxf(zl[t], -60.f), 60.f), e = fast_exp(-zc), sg = __builtin_amdgcn_rcpf(1.f + e), f = lb + om * sg;
            const float lf = __builtin_amdgcn_logf(fmaxf(f, 1e-30f)) * 0.6931471805599453f; zl[t] = lf; b += lf; if (t == 31) r = b; }
        const float bl = b; r = fmaxf(r, -60.f);
        Dd[(size_t)u * HGW + tid] = ex(bl); Rr[(size_t)u * HGW + tid] = ex(r);
        b = 0.f;
        LAS char* kd = lds + head * TILE_V + ((d >> 5) * 512 + (d & 31) * 2);
#pragma unroll
        for (int t = 0; t < CH; ++t) { const float lf = zl[t]; b += lf; const float kk = 1.f - ex(lf);
            __builtin_amdgcn_raw_buffer_store_b16((short)pk2(kk * ex(fminf(r - b, 80.f)), 0.f), rK, vo, t * HGW * 2, 0);
            __builtin_amdgcn_raw_buffer_store_b16((short)pk2(qv[t] * ex(fminf(b - r, 80.f)), 0.f), rR, vo, t * HGW * 2, 0);
            constexpr int dummy = 0; (void)dummy;
            const int kk_t = (t & ~0xC) | ((t & 4) << 1) | ((t & 8) >> 1);
            *(LAS unsigned short*)(kd + (kk_t >> 3) * 4 * 512 + (kk_t & 7) * 64) = (unsigned short)pk2(kk * ex(bl - b), 0.f); }
    }
    __syncthreads();
#else
__device__ __forceinline__ void h1_unit(const Ctx& X, unsigned char* ws, int u) {
    const int bb = u >> 7, c = u & 127, row0 = bb * SEQ + c * CH, tid = X.tid, lane = X.lane, wave = X.wave;
    float* LFB = (float*)(ws + WS_LF); const bf16* HK = (const bf16*)(ws + WS_HK); const bf16* HV = (const bf16*)(ws + WS_HV);
    float* Dd = (float*)(ws + WS_HD); float* Rr = (float*)(ws + WS_HR); bf16* US = (bf16*)(ws + WS_XB);
    LAS char* lds = (LAS char*)X.lds; LAS float* bl = (LAS float*)(lds + 131072);
    {
        float* col = LFB + (size_t)row0 * HGW + tid; float b = 0.f, r = 0.f;
#pragma unroll 1
        for (int t0 = 0; t0 < CH; t0 += 8) { float x[8];
#pragma unroll
            for (int i = 0; i < 8; ++i) x[i] = col[(size_t)(t0 + i) * HGW];
#pragma unroll
            for (int i = 0; i < 8; ++i) { b += x[i]; col[(size_t)(t0 + i) * HGW] = b; if (t0 + i == 31) r = b; } }
        bl[tid] = b; r = fmaxf(r, -60.f);
        Dd[(size_t)u * HGW + tid] = ex(b); Rr[(size_t)u * HGW + tid] = ex(r);
    }
    asm volatile("s_waitcnt vmcnt(0)" ::: "memory");
    __syncthreads();
#pragma unroll 2
    for (int j = 0; j < 8; ++j) { const int i = tid + 512 * j, head = i >> 10, rem = i & 1023, t = rem >> 4, c8 = (rem & 15) * 8; const size_t g = (size_t)(row0 + t) * HGW + head * 128 + c8;
        const u32x4 kw = *(const u32x4*)(HK + g), vw = *(const u32x4*)(HV + g); const f32x4 b0 = *(const f32x4*)(LFB + g), b1 = *(const f32x4*)(LFB + g + 4);
        const f32x4 l0 = *(const LAS f32x4*)(bl + head * 128 + c8), l1 = *(const LAS f32x4*)(bl + head * 128 + c8 + 4);
        u32x4 o; o.x = pk2(bflo(kw.x) * ex(l0.x - b0.x), bfhi(kw.x) * ex(l0.y - b0.y)); o.y = pk2(bflo(kw.y) * ex(l0.z - b0.z), bfhi(kw.y) * ex(l0.w - b0.w));
        o.z = pk2(bflo(kw.z) * ex(l1.x - b1.x), bfhi(kw.z) * ex(l1.y - b1.y)); o.w = pk2(bflo(kw.w) * ex(l1.z - b1.z), bfhi(kw.w) * ex(l1.w - b1.w));
        *(LAS u32x4*)(lds + head * TILE_V + v_st(t, c8)) = o; *(LAS u32x4*)(lds + 65536 + head * TILE_V + v_st(t, c8)) = vw; }
    __syncthreads();
#endif
    {
        const int head = wave >> 1, db0 = (wave & 1) * 2, r32 = lane & 31, hiC = lane >> 5;
        const int ab = (int)(unsigned)(size_t)(lds + head * TILE_V) + v_rd_base(lane), vb = (int)(unsigned)(size_t)(lds + 65536 + head * TILE_V) + v_rd_base(lane);
        f32x16 acc[2][4];
#pragma unroll
        for (int a = 0; a < 2; ++a)
#pragma unroll
            for (int v = 0; v < 4; ++v) acc[a][v] = f32x16{};
#define FRAG(dst, base, d0, ks) do { s16x4 lo_, hi_; TRRD2(lo_, base, v_rd_off(d0, ks, 0)); TRRD2(hi_, base, v_rd_off(d0, ks, 1)); asm volatile("s_waitcnt lgkmcnt(0)" ::: "memory"); __builtin_amdgcn_sched_barrier(0); \
            dst = (bf16x8){lo_[0], lo_[1], lo_[2], lo_[3], hi_[0], hi_[1], hi_[2], hi_[3]}; } while (0)
#define U_KS(ks) do { bf16x8 a0, a1, b0, b1, b2, b3; \
            if (db0 == 0) { FRAG(a0, ab, 0, ks); FRAG(a1, ab, 1, ks); } else { FRAG(a0, ab, 2, ks); FRAG(a1, ab, 3, ks); } \
            FRAG(b0, vb, 0, ks); FRAG(b1, vb, 1, ks); FRAG(b2, vb, 2, ks); FRAG(b3, vb, 3, ks); \
            acc[0][0] = __builtin_amdgcn_mfma_f32_32x32x16_bf16(a0, b0, acc[0][0], 0, 0, 0); acc[0][1] = __builtin_amdgcn_mfma_f32_32x32x16_bf16(a0, b1, acc[0][1], 0, 0, 0); \
            acc[0][2] = __builtin_amdgcn_mfma_f32_32x32x16_bf16(a0, b2, acc[0][2], 0, 0, 0); acc[0][3] = __builtin_amdgcn_mfma_f32_32x32x16_bf16(a0, b3, acc[0][3], 0, 0, 0); \
            acc[1][0] = __builtin_amdgcn_mfma_f32_32x32x16_bf16(a1, b0, acc[1][0], 0, 0, 0); acc[1][1] = __builtin_amdgcn_mfma_f32_32x32x16_bf16(a1, b1, acc[1][1], 0, 0, 0); \
            acc[1][2] = __builtin_amdgcn_mfma_f32_32x32x16_bf16(a1, b2, acc[1][2], 0, 0, 0); acc[1][3] = __builtin_amdgcn_mfma_f32_32x32x16_bf16(a1, b3, acc[1][3], 0, 0, 0); } while (0)
        U_KS(0); U_KS(1); U_KS(2); U_KS(3);
#undef U_KS
        bf16* Ub = US + ((size_t)(bb * NH + head) * NCH + c) * 16384;
#pragma unroll
        for (int a = 0; a < 2; ++a)
#pragma unroll
            for (int v = 0; v < 4; ++v)
#pragma unroll
                for (int q4 = 0; q4 < 4; ++q4) { const int ks = 2 * (db0 + a) + (q4 >> 1), lanep = (q4 & 1) * 32 + r32;
                    u32x2 w; w.x = pk2(acc[a][v][4 * q4 + 0], acc[a][v][4 * q4 + 1]); w.y = pk2(acc[a][v][4 * q4 + 2], acc[a][v][4 * q4 + 3]);
                    *(u32x2*)(Ub + ((size_t)((ks * 4 + v) * 64 + lanep)) * 8 + 4 * hiC) = w; }
    }
    __syncthreads();
}
#if HG_V2
__device__ __forceinline__ void phase_h1(const Ctx& X, unsigned char* ws, int l) { const float* lbl = (const float*)(ws + WS_MISC + MISC_LB) + l * HGW; for (int u = X.bid; u < 2 * NCH; u += X.nblk) h1_unit(X, ws, u, lbl); }
#else
__device__ __forceinline__ void phase_h1(const Ctx& X, unsigned char* ws, int) { for (int u = X.bid; u < 2 * NCH; u += X.nblk) h1_unit(X, ws, u); }
#endif
__device__ __forceinline__ void phase_h2(const Ctx& X, unsigned char* ws) {
    bf16* US = (bf16*)(ws + WS_XB); const float* Dd = (const float*)(ws + WS_HD); const float* Rr = (const float*)(ws + WS_HR);
    for (int u = X.bid; u < 256; u += X.nblk) {
        if (X.tid < 256) {
            const int bh = u >> 5, slot = u & 31, ks = slot >> 2, bb = bh >> 2, h = bh & 3, lanep = X.tid >> 2, j = 2 * (X.tid & 3), d = 16 * ks + 8 * (lanep >> 5) + j;
            unsigned* p = (unsigned*)(US + (size_t)bh * US_BH + (size_t)slot * 512 + 2 * X.tid);
            const float* dp = Dd + (size_t)bb * NCH * HGW + h * 128 + d; const float* rp = Rr + (size_t)bb * NCH * HGW + h * 128 + d;
            float s0 = 0.f, s1 = 0.f;
#pragma unroll 1
            for (int c0 = 0; c0 < NCH; c0 += 8) { unsigned uw[8]; float2 dv[8], rv[8];
#pragma unroll
                for (int i = 0; i < 8; ++i) { uw[i] = p[(size_t)(c0 + i) * 8192]; dv[i] = *(const float2*)(dp + (size_t)(c0 + i) * HGW); rv[i] = *(const float2*)(rp + (size_t)(c0 + i) * HGW); }
#pragma unroll
                for (int i = 0; i < 8; ++i) { p[(size_t)(c0 + i) * 8192] = pk2(rv[i].x * s0, rv[i].y * s1); s0 = dv[i].x * s0 + bflo(uw[i]); s1 = dv[i].y * s1 + bfhi(uw[i]); } }
        }
    }
}
__device__ __forceinline__ void h3_unit(const Ctx& X, unsigned char* ws, const float* onorm, int u) {
    const int bb = u >> 7, c = u & 127, row0 = bb * SEQ + c * CH, tid = X.tid, lane = X.lane, wave = X.wave;
    const float* LFB = (const float*)(ws + WS_LF); const bf16* HQ = (const bf16*)(ws + WS_HQ); const bf16* HK = (const bf16*)(ws + WS_HK); const bf16* HV = (const bf16*)(ws + WS_HV); const bf16* HG = (const bf16*)(ws + WS_HG);
    const bf16* US = (const bf16*)(ws + WS_XB); bf16* CC = (bf16*)(ws + WS_CC);
    LAS char* lds = (LAS char*)X.lds;
#if HG_V2
    const bf16* KRB = (const bf16*)(ws + WS_LF); const bf16* QRB = (const bf16*)(ws + WS_LF + 16 * MiB);
    const int head = wave >> 1, th = wave & 1, r32 = lane & 31, hi = lane >> 5, trow = row0 + 32 * th + r32;
    bf16x8 qr[8];
    { const int t0 = tid >> 4, c8 = (tid & 15) * 8; const size_t g0 = (size_t)(row0 + t0) * HGW + c8; const int kst0 = t0 * KROW2 + c8 * 2, vst0 = 4 * TILE_K2 + v_st(t0, c8);
      u32x4 kw[8], vw[8];
#pragma unroll
      for (int j = 0; j < 8; ++j) { const size_t g = g0 + (size_t)((j & 1) * 32 * HGW + (j >> 1) * 128); kw[j] = *(const u32x4*)(KRB + g); vw[j] = *(const u32x4*)(HV + g); }
      const size_t gq = (size_t)trow * HGW + head * 128 + hi * 8;
#pragma unroll
      for (int d0 = 0; d0 < 8; ++d0) qr[d0] = *reinterpret_cast<const bf16x8*>(QRB + gq + d0 * 16);
#pragma unroll
      for (int j = 0; j < 8; ++j) { *(LAS u32x4*)(lds + kst0 + (j >> 1) * TILE_K2 + (j & 1) * 32 * KROW2) = kw[j]; *(LAS u32x4*)(lds + vst0 + (j >> 1) * TILE_V + (j & 1) * 8192) = vw[j]; } }
#else
#pragma unroll 2
    for (int j = 0; j < 8; ++j) { const int i = tid + 512 * j, head = i >> 10, rem = i & 1023, t = rem >> 4, c8 = (rem & 15) * 8; const size_t g = (size_t)(row0 + t) * HGW + head * 128 + c8, gr = (size_t)(row0 + 31) * HGW + head * 128 + c8;
        const u32x4 kw = *(const u32x4*)(HK + g), vw = *(const u32x4*)(HV + g); const f32x4 b0 = *(const f32x4*)(LFB + g), b1 = *(const f32x4*)(LFB + g + 4); f32x4 r0 = *(const f32x4*)(LFB + gr), r1 = *(const f32x4*)(LFB + gr + 4);
#define KE(rr, bv) ex(fminf(fmaxf((rr), -60.f) - (bv), 80.f))
        u32x4 o; o.x = pk2(bflo(kw.x) * KE(r0.x, b0.x), bfhi(kw.x) * KE(r0.y, b0.y)); o.y = pk2(bflo(kw.y) * KE(r0.z, b0.z), bfhi(kw.y) * KE(r0.w, b0.w));
        o.z = pk2(bflo(kw.z) * KE(r1.x, b1.x), bfhi(kw.z) * KE(r1.y, b1.y)); o.w = pk2(bflo(kw.w) * KE(r1.z, b1.z), bfhi(kw.w) * KE(r1.w, b1.w));
#undef KE
        *(LAS u32x4*)(lds + head * TILE_K2 + t * KROW2 + c8 * 2) = o; *(LAS u32x4*)(lds + 4 * TILE_K2 + head * TILE_V + v_st(t, c8)) = vw; }
    const int head = wave >> 1, th = wave & 1, r32 = lane & 31, hi = lane >> 5, trow = row0 + 32 * th + r32;
    bf16x8 qr[8];
    {
        const size_t g = (size_t)trow * HGW + head * 128 + hi * 8, gr = (size_t)(row0 + 31) * HGW + head * 128 + hi * 8;
#pragma unroll
        for (int d0 = 0; d0 < 8; ++d0) { const u32x4 qw = *(const u32x4*)(HQ + g + d0 * 16); const f32x4 b0 = *(const f32x4*)(LFB + g + d0 * 16), b1 = *(const f32x4*)(LFB + g + d0 * 16 + 4), r0 = *(const f32x4*)(LFB + gr + d0 * 16), r1 = *(const f32x4*)(LFB + gr + d0 * 16 + 4);
#define QE(bv, rr) ex(fminf((bv) - fmaxf((rr), -60.f), 80.f))
            u32x4 o; o.x = pk2(bflo(qw.x) * QE(b0.x, r0.x), bfhi(qw.x) * QE(b0.y, r0.y)); o.y = pk2(bflo(qw.y) * QE(b0.z, r0.z), bfhi(qw.y) * QE(b0.w, r0.w));
            o.z = pk2(bflo(qw.z) * QE(b1.x, r1.x), bfhi(qw.z) * QE(b1.y, r1.y)); o.w = pk2(bflo(qw.w) * QE(b1.z, r1.z), bfhi(qw.w) * QE(b1.w, r1.w));
#undef QE
            qr[d0] = __builtin_bit_cast(bf16x8, o); }
    }
#endif
    __syncthreads();
    f32x16 p0 = f32x16{}, p1 = f32x16{};
    { const LAS char* kb = lds + head * TILE_K2 + r32 * KROW2 + hi * 16;
#pragma unroll
      for (int d0 = 0; d0 < 8; ++d0) { const bf16x8 k0 = *reinterpret_cast<const LAS bf16x8*>(kb + d0 * 32); p0 = __builtin_amdgcn_mfma_f32_32x32x16_bf16(k0, qr[d0], p0, 0, 0, 0);
          if (th) { const bf16x8 k1 = *reinterpret_cast<const LAS bf16x8*>(kb + d0 * 32 + 32 * KROW2); p1 = __builtin_amdgcn_mfma_f32_32x32x16_bf16(k1, qr[d0], p1, 0, 0, 0); } } }
    { const int tq = 32 * th + r32 - 4 * hi;
#pragma unroll
      for (int r = 0; r < 16; ++r) { const int cr = (r & 3) + 8 * (r >> 2); if (tq - cr < 0) p0[r] = 0.f; if (tq - cr - 32 < 0) p1[r] = 0.f; } }
    bf16x8 pa0, pa1, pa2, pa3;
#define PK4(P, B_, OUT) do { unsigned a0 = cvtpk(P[B_+0], P[B_+1]), a1 = cvtpk(P[B_+2], P[B_+3]);                          \
        unsigned b0 = cvtpk(P[B_+4], P[B_+5]), b1 = cvtpk(P[B_+6], P[B_+7]);                                             \
        auto r0 = __builtin_amdgcn_permlane32_swap(a0, b0, false, false); auto r1 = __builtin_amdgcn_permlane32_swap(a1, b1, false, false); \
        u32x4 w = {r0[0], r1[0], r0[1], r1[1]}; OUT = *reinterpret_cast<bf16x8*>(&w); } while (0)
    PK4(p0, 0, pa0); PK4(p0, 8, pa1); PK4(p1, 0, pa2); PK4(p1, 8, pa3);
#undef PK4
    f32x16 o[4] = {};
    { const int vb = (int)(unsigned)(size_t)(lds + 4 * TILE_K2 + head * TILE_V) + v_rd_base(lane);
#define PV(d0) do { bf16x8 f0, f1, f2, f3; FRAG(f0, vb, d0, 0); FRAG(f1, vb, d0, 1); FRAG(f2, vb, d0, 2); FRAG(f3, vb, d0, 3); \
        o[d0] = __builtin_amdgcn_mfma_f32_32x32x16_bf16(pa0, f0, o[d0], 0, 0, 0); o[d0] = __builtin_amdgcn_mfma_f32_32x32x16_bf16(pa1, f1, o[d0], 0, 0, 0); \
        o[d0] = __builtin_amdgcn_mfma_f32_32x32x16_bf16(pa2, f2, o[d0], 0, 0, 0); o[d0] = __builtin_amdgcn_mfma_f32_32x32x16_bf16(pa3, f3, o[d0], 0, 0, 0); } while (0)
      PV(0); PV(1); PV(2); PV(3);
#undef PV
    }
    { const bf16* Sb = US + ((size_t)(bb * NH + head) * NCH + c) * 16384 + (size_t)lane * 8;
#pragma unroll
      for (int vb = 0; vb < 4; ++vb)
#pragma unroll
          for (int ks = 0; ks < 8; ++ks) { const bf16x8 sf = *reinterpret_cast<const bf16x8*>(Sb + (size_t)(ks * 4 + vb) * 512); o[vb] = __builtin_amdgcn_mfma_f32_32x32x16_bf16(qr[ks], sf, o[vb], 0, 0, 0); } }
    float rs[16];
#pragma unroll
    for (int r = 0; r < 16; ++r) { float q = o[0][r] * o[0][r] + o[1][r] * o[1][r] + o[2][r] * o[2][r] + o[3][r] * o[3][r];
        q += __shfl_xor(q, 1); q += __shfl_xor(q, 2); q += __shfl_xor(q, 4); q += __shfl_xor(q, 8); q += __shfl_xor(q, 16); rs[r] = rsqrtf(q * (1.f / 128.f) + EPS); }
#pragma unroll
    for (int vb = 0; vb < 4; ++vb) { const float gn = onorm[32 * vb + r32];
#pragma unroll
        for (int r = 0; r < 16; ++r) { const size_t row = (size_t)(row0 + 32 * th + crow(r, hi));
            const float g = bf2f(HG[row * HGW + head * 128 + 32 * vb + r32]); const float val = o[vb][r] * rs[r] * gn * siluf_(g); const float vn = __shfl_xor(val, 1);
            if ((r32 & 1) == 0) *(unsigned*)(CC + row * DM + 512 + head * 128 + 32 * vb + r32) = cvtpk(val, vn); } }
    __syncthreads();
}
#undef FRAG
#undef TRRD2
__device__ __forceinline__ void phase_h3(const Ctx& X, unsigned char* ws, const float* onorm) { for (int u = X.bid; u < 2 * NCH; u += X.nblk) h3_unit(X, ws, onorm, u); }
}

__device__ __forceinline__ void phase_hgrn_simple(const Ctx& X, const Params& p) {
    unsigned char* ws = p.ws;
    const bf16* HQ = (const bf16*)(ws + WS_HQ); const bf16* HK = (const bf16*)(ws + WS_HK); const bf16* HV = (const bf16*)(ws + WS_HV); const float* LF = (const float*)(ws + WS_LF);
    float* OB = (float*)(ws + WS_XB);
    for (int bh = X.bid; bh < 2 * NH; bh += X.nblk) {
        if (X.tid < 256) {
            const int v = X.tid >> 1, hf = X.tid & 1, b = bh >> 2, h = bh & 3;
            float S[64];
#pragma unroll
            for (int j = 0; j < 64; ++j) S[j] = 0.f;
            for (int t = 0; t < SEQ; ++t) {
                const size_t base = ((size_t)(b * SEQ + t)) * HGW + h * 128;
                const float vt = bf2f(HV[base + v]);
                float o = 0.f;
#pragma unroll
                for (int j8 = 0; j8 < 8; ++j8) {
                    const size_t bj = base + 64 * hf + 8 * j8;
                    const f32x4 f0 = *(const f32x4*)(LF + bj), f1 = *(const f32x4*)(LF + bj + 4);
                    const u32x4 kw = *(const u32x4*)(HK + bj), qw = *(const u32x4*)(HQ + bj);
#define HSTEP(J, lf, kk, qq) do { S[8 * j8 + J] = fast_exp(lf) * S[8 * j8 + J] + (kk) * vt; o += (qq) * S[8 * j8 + J]; } while (0)
                    HSTEP(0, f0.x, bflo(kw.x), bflo(qw.x)); HSTEP(1, f0.y, bfhi(kw.x), bfhi(qw.x)); HSTEP(2, f0.z, bflo(kw.y), bflo(qw.y)); HSTEP(3, f0.w, bfhi(kw.y), bfhi(qw.y));
                    HSTEP(4, f1.x, bflo(kw.z), bflo(qw.z)); HSTEP(5, f1.y, bfhi(kw.z), bfhi(qw.z)); HSTEP(6, f1.z, bflo(kw.w), bflo(qw.w)); HSTEP(7, f1.w, bfhi(kw.w), bfhi(qw.w));
#undef HSTEP
                }
                o += __shfl_xor(o, 1);
                if (hf == 0) OB[base + v] = o;
            }
        }
    }
}
__device__ __forceinline__ void phase_hgrn_out(const Ctx& X, const Params& p, int l) {
    unsigned char* ws = p.ws;
    const float* OB = (const float*)(ws + WS_XB); const bf16* HG = (const bf16*)(ws + WS_HG); bf16* CC = (bf16*)(ws + WS_CC); const float* on = p.in[I_HON] + l * 128;
    const int gw = X.bid * NWAVES + X.wave, ngw = X.nblk * NWAVES, lane = X.lane;
    for (int i = gw; i < T * NH; i += ngw) {
        const int row = i >> 2, h = i & 3; const size_t base = (size_t)row * HGW + h * 128 + 2 * lane;
        const float o0 = OB[base], o1 = OB[base + 1];
        const float rstd = rsqrtf(wave_sum(o0 * o0 + o1 * o1) * (1.f / 128.f) + EPS);
        const unsigned gw2 = *(const unsigned*)(HG + base);
        *(unsigned*)(CC + (size_t)row * DM + 512 + h * 128 + 2 * lane) = pk2(o0 * rstd * on[2 * lane] * siluf_(bflo(gw2)), o1 * rstd * on[2 * lane + 1] * siluf_(bfhi(gw2)));
    }
}

template <class TS>
__device__ __forceinline__ void phase_norm(const Ctx& X, const Params& p, const TS* src, const float* gain) { norm_all_rows(X, src, gain, (bf16*)(p.ws + WS_XB)); }
template <class TS>
__device__ __forceinline__ void phase_norm_route(const Ctx& X, const Params& p, const TS* src, const float* gain) {
    unsigned char* ws = p.ws;
    int* GCNT = (int*)(ws + WS_MISC + MISC_GCNT); int* TOPI = (int*)(ws + WS_MISC + MISC_TOPI); float* TOPG = (float*)(ws + WS_MISC + MISC_TOPG);
    const float* wr = p.in[I_ROUTER];
    LAS int* wcnt = (LAS int*)(X.lds);
    const int lane = X.lane, b5 = lane >> 5, b4 = (lane >> 4) & 1, b3 = (lane >> 3) & 1;
    f32x4 w0[4][4], w1[4][4], gn[4];
#pragma unroll
    for (int j = 0; j < 4; ++j) { gn[j] = *((const f32x4*)gain + lane + 64 * j);
#pragma unroll
        for (int q = 0; q < 4; ++q) { const float* wp = wr + (size_t)(4 * (lane + 64 * j) + q) * NE; w0[j][q] = *(const f32x4*)wp; w1[j][q] = *(const f32x4*)(wp + 4); } }
    for (int g = X.bid; g < T / 64; g += X.nblk) {
        int cn[NE];
#pragma unroll
        for (int e = 0; e < NE; ++e) cn[e] = 0;
#pragma unroll 1
        for (int bt = 0; bt < 4; ++bt) {
            const int rbase = g * 64 + X.wave * 8 + 2 * bt;
            f32x4 v[2][4];
#pragma unroll
            for (int i = 0; i < 2; ++i)
#pragma unroll
                for (int j = 0; j < 4; ++j) v[i][j] = ldrow4(src + (size_t)(rbase + i) * DM, lane + 64 * j);
#pragma unroll
            for (int i = 0; i < 2; ++i) { const int row = rbase + i; float s = 0.f;
#pragma unroll
                for (int j = 0; j < 4; ++j) s += (v[i][j].x * v[i][j].x + v[i][j].y * v[i][j].y) + (v[i][j].z * v[i][j].z + v[i][j].w * v[i][j].w);
                const float rstd = __builtin_amdgcn_rsqf(wave_sum(s) * (1.f / DM) + EPS);
                float lg[NE];
#pragma unroll
                for (int e = 0; e < NE; ++e) lg[e] = 0.f;
#pragma unroll
                for (int j = 0; j < 4; ++j) { const f32x4 y = v[i][j] * rstd * gn[j];
                    *((unsigned*)((unsigned char*)(ws + WS_XB) + (size_t)row * DM) + lane + 64 * j) = pk4_fp8(y.x, y.y, y.z, y.w);
#pragma unroll
                    for (int q = 0; q < 4; ++q) { const float yv = (q == 0) ? y.x : (q == 1) ? y.y : (q == 2) ? y.z : y.w;
                        lg[0] += yv * w0[j][q].x; lg[1] += yv * w0[j][q].y; lg[2] += yv * w0[j][q].z; lg[3] += yv * w0[j][q].w; lg[4] += yv * w1[j][q].x; lg[5] += yv * w1[j][q].y; lg[6] += yv * w1[j][q].z; lg[7] += yv * w1[j][q].w; } }
                float k4[4], k2[2], k1;
#pragma unroll
                for (int t = 0; t < 4; ++t) { const float keep = b5 ? lg[4 + t] : lg[t], send = b5 ? lg[t] : lg[4 + t]; k4[t] = keep + __shfl_xor(send, 32); }
#pragma unroll
                for (int t = 0; t < 2; ++t) { const float keep = b4 ? k4[2 + t] : k4[t], send = b4 ? k4[t] : k4[2 + t]; k2[t] = keep + __shfl_xor(send, 16); }
                { const float keep = b3 ? k2[1] : k2[0], send = b3 ? k2[0] : k2[1]; k1 = keep + __shfl_xor(send, 8); }
                k1 += __shfl_xor(k1, 4); k1 += __shfl_xor(k1, 2); k1 += __shfl_xor(k1, 1);
                float tl[NE];
#pragma unroll
                for (int e = 0; e < NE; ++e) tl[e] = __int_as_float(__builtin_amdgcn_readlane(__float_as_int(k1), (e >> 2) * 32 + ((e >> 1) & 1) * 16 + (e & 1) * 8));
                int e1 = 0; float l1 = tl[0];
#pragma unroll
                for (int e = 1; e < NE; ++e) if (tl[e] > l1) { l1 = tl[e]; e1 = e; }
                int e2 = -1; float l2 = -3.0e38f;
#pragma unroll
                for (int e = 0; e < NE; ++e) if (e != e1 && tl[e] > l2) { l2 = tl[e]; e2 = e; }
#pragma unroll
                for (int e = 0; e < NE; ++e) cn[e] += (e == e1) + (e == e2);
                if (lane == 0) { const float g1 = 1.f / (1.f + expf(l2 - l1)); TOPI[row * 2] = e1; TOPI[row * 2 + 1] = e2; TOPG[row * 2] = g1; TOPG[row * 2 + 1] = 1.f - g1; }
            }
        }
        if (lane == 0) {
#pragma unroll
            for (int e = 0; e < NE; ++e) wcnt[X.wave * NE + e] = cn[e]; }
        __syncthreads();
        if (X.tid < NE) { int t = 0;
#pragma unroll
            for (int w = 0; w < NWAVES; ++w) t += wcnt[w * NE + X.tid];
            GCNT[g * NE + X.tid] = t; }
        __syncthreads();
    }
}
__device__ __forceinline__ void phase_scatter(const Ctx& X, const Params& p) {
    unsigned char* ws = p.ws;
    const int* GCNT = (const int*)(ws + WS_MISC + MISC_GCNT); const int* TOPI = (const int*)(ws + WS_MISC + MISC_TOPI); int* POS = (int*)(ws + WS_MISC + MISC_POS);
    int* TILE_E = (int*)(ws + WS_MISC + MISC_TILE_E); int* NT = (int*)(ws + WS_MISC + MISC_NT);
    const unsigned char* XF = (const unsigned char*)(ws + WS_XB); unsigned char* XS = (unsigned char*)(ws + WS_XS);
    LAS int* gc = (LAS int*)(X.lds);
    LAS int* pstart = gc + 256 * NE;
    LAS int* ntot = pstart + 8;
    LAS int* basel = ntot + 8;
    LAS int* posl = basel + 8;
    for (int i = X.tid; i < 256 * NE; i += NTHREADS) gc[i] = GCNT[i];
    __syncthreads();
    { const int e = X.wave; int n = 0;
#pragma unroll
      for (int k = 0; k < 4; ++k) n += gc[(X.lane + 64 * k) * NE + e];
#pragma unroll
      for (int o = 1; o < 64; o <<= 1) n += __shfl_xor(n, o);
      if (X.lane == 0) ntot[e] = n; }
    __syncthreads();
    if (X.tid == 0) { int acc = 0;
        for (int e = 0; e < NE; ++e) { pstart[e] = acc; const int nt = (ntot[e] + 255) >> 8; if (X.bid == 0) for (int t = 0; t < nt; ++t) TILE_E[(acc >> 8) + t] = e; acc += nt * 256; }
        if (X.bid == 0) NT[0] = acc >> 8; }
    __syncthreads();
    for (int g = X.bid; g < T / 64; g += X.nblk) {
        { const int e = X.wave; int n = 0;
#pragma unroll
          for (int k = 0; k < 4; ++k) { const int gg = X.lane + 64 * k; n += (gg < g) ? gc[gg * NE + e] : 0; }
#pragma unroll
          for (int o = 1; o < 64; o <<= 1) n += __shfl_xor(n, o);
          if (X.lane == 0) basel[e] = pstart[e] + n; }
        __syncthreads();
        if (X.wave == 0) {
            const int row = g * 64 + X.lane; const int e1 = TOPI[row * 2], e2 = TOPI[row * 2 + 1];
            int p1 = 0, p2 = 0;
            const unsigned long long lt = (1ull << X.lane) - 1ull;
#pragma unroll
            for (int e = 0; e < NE; ++e) {
                const int base = basel[e];
                const unsigned long long m1 = __ballot(e1 == e), m2 = __ballot(e2 == e);
                if (e1 == e) p1 = base + __popcll(m1 & lt);
                if (e2 == e) p2 = base + __popcll(m1) + __popcll(m2 & lt);
            }
            POS[row * 2] = p1; POS[row * 2 + 1] = p2; posl[X.lane * 2] = p1; posl[X.lane * 2 + 1] = p2;
        }
        __syncthreads();
        { u32x4 a[8];
#pragma unroll
          for (int i = 0; i < 8; ++i) a[i] = ((const u32x4*)(XF + (size_t)(g * 64 + X.wave * 8 + i) * DM))[X.lane];
#pragma unroll
          for (int i = 0; i < 8; ++i) { const int r = X.wave * 8 + i; ((u32x4*)(XS + (size_t)posl[r * 2] * DM))[X.lane] = a[i]; ((u32x4*)(XS + (size_t)posl[r * 2 + 1] * DM))[X.lane] = a[i]; } }
        __syncthreads();
    }
}
template <class TS>
__device__ __forceinline__ void phase_combine(const Ctx& X, const Params& p, const TS* xr) {
    unsigned char* ws = p.ws;
    const int* POS = (const int*)(ws + WS_MISC + MISC_POS); const float* TOPG = (const float*)(ws + WS_MISC + MISC_TOPG); const bf16* YS = (const bf16*)(ws + WS_YS);
    const float* fn = p.in[I_FINN];
    const int gw = X.bid * NWAVES + X.wave, ngw = X.nblk * NWAVES, lane = X.lane;
    f32x4 gf[4];
#pragma unroll
    for (int j = 0; j < 4; ++j) gf[j] = *((const f32x4*)fn + lane + 64 * j);
    for (int r0 = gw; r0 < T; r0 += 2 * ngw) {
        int pp[2][2]; float gg[2][2]; f32x4 v[2][4]; u32x2 ya[2][4], yb[2][4];
#pragma unroll
        for (int i = 0; i < 2; ++i) { const int row = (r0 + i * ngw < T) ? r0 + i * ngw : r0; pp[i][0] = POS[row * 2]; pp[i][1] = POS[row * 2 + 1]; gg[i][0] = TOPG[row * 2]; gg[i][1] = TOPG[row * 2 + 1];
#pragma unroll
            for (int j = 0; j < 4; ++j) v[i][j] = ldrow4(xr + (size_t)row * DM, lane + 64 * j); }
#pragma unroll
        for (int i = 0; i < 2; ++i)
#pragma unroll
            for (int j = 0; j < 4; ++j) { ya[i][j] = *((const u32x2*)(YS + (size_t)pp[i][0] * DM) + lane + 64 * j); yb[i][j] = *((const u32x2*)(YS + (size_t)pp[i][1] * DM) + lane + 64 * j); }
#if DN_SPLITK
#pragma unroll
        for (int i = 0; i < 2; ++i)
#pragma unroll
            for (int k = 0; k < 2; ++k) { const int pos = pp[i][k];
                if (pos >= 128 * 256) { const float* sl = (const float*)(ws + WS_SLAB) + ((size_t)(((pos >> 8) - 128) * 4) * 7 * 256 + (pos & 255)) * 256 + 4 * lane;
#pragma unroll
                    for (int j = 0; j < 4; ++j) { f32x4 acc = *(const f32x4*)(sl + (size_t)(j * 7) * 65536);
#pragma unroll
                        for (int q = 1; q < 7; ++q) acc = acc + *(const f32x4*)(sl + (size_t)(j * 7 + q) * 65536);
                        u32x2 w; w.x = pk2(acc.x, acc.y); w.y = pk2(acc.z, acc.w); if (k == 0) ya[i][j] = w; else yb[i][j] = w; } } }
#endif
#pragma unroll
        for (int i = 0; i < 2; ++i) { const int row = (r0 + i * ngw < T) ? r0 + i * ngw : r0; const float g1 = gg[i][0], g2 = gg[i][1]; float s = 0.f;
#pragma unroll
            for (int j = 0; j < 4; ++j) { const u32x2 a = ya[i][j], b = yb[i][j]; f32x4& x = v[i][j];
                x.x += g1 * bflo(a.x) + g2 * bflo(b.x); x.y += g1 * bfhi(a.x) + g2 * bfhi(b.x); x.z += g1 * bflo(a.y) + g2 * bflo(b.y); x.w += g1 * bfhi(a.y) + g2 * bfhi(b.y);
                s += (x.x * x.x + x.y * x.y) + (x.z * x.z + x.w * x.w); }
            const float rstd = __builtin_amdgcn_rsqf(wave_sum(s) * (1.f / DM) + EPS);
#pragma unroll
            for (int j = 0; j < 4; ++j) *((f32x4*)(p.out + (size_t)row * DM) + lane + 64 * j) = v[i][j] * rstd * gf[j]; }
    }
}

__device__ __forceinline__ bool relaunder(Ctx& X, unsigned char*& ws, const Params& p) {
    int t = threadIdx.x; asm volatile("" : "+v"(t)); X.tid = t; X.lane = t & 63; X.wave = __builtin_amdgcn_readfirstlane(t >> 6);
    unsigned long long w = (unsigned long long)p.ws; asm volatile("" : "+s"(w)); ws = (unsigned char*)(GAS unsigned char*)w;
    return true;
}
constexpr int NPHASES = 26;
#define PHASE(k) relaunder(X, ws, p)
#define SEAM(k) xcd_barrier(bar)
template <int L>
__device__ __forceinline__ void run_layer(Ctx& X, const Params& p, const XcdBarrier& bar) {
    unsigned char* ws;
#if XR_BF16
    xr_t* XR = (xr_t*)(p.ws + WS_XRB);
#else
    xr_t* XR = p.out;
#endif
    PHASE(pb + 0); {
        EpiProj E{ws, L, (FUSE_NORM && L == 1) ? (int)MISC_SSXB : 0};
        gemm_dense(X, (FUSE_NORM && L == 1) ? (const bf16*)XR : (const bf16*)(ws + WS_XB), (const bf16*)(ws + WS_WT_IN) + (size_t)L * NPROJ_P * DM, NPROJ_P, DM, E);
#ifdef PROBE_INPROJ_NOEPI
        { EpiProbe EP{(float*)(ws + WS_CC)}; gemm_dense(X, (const bf16*)(ws + WS_XB), (const bf16*)(ws + WS_WT_IN) + (size_t)L * NPROJ_P * DM, NPROJ_P, DM, EP); }
#endif
    } SEAM(pb + 0);
    PHASE(pb + 1); {
        EpiQ EQ{ws}; EpiKV EK{ws};
        REP_X(REP_QKV, gemm_dense(X, (const bf16*)(ws + WS_CQ), (const bf16*)(ws + WS_WT_QB) + (size_t)L * (NH * DQK) * QR, NH * DQK, QR, EQ);
        gemm_dense(X, (const bf16*)(ws + WS_CKV), (const bf16*)(ws + WS_WT_KVB) + (size_t)L * 1024 * KVR, 1024, KVR, EK);)
#if FAST_HGRN
        hg::phase_h1(X, ws, L);
#endif
    } SEAM(pb + 1);
#if FAST_ATTN
    PHASE(pb + 2); {
#if FAST_HGRN
        hg::phase_h2(X, ws);
#endif
        REP_X(REP_ATTN, phase_attn_fast(X, ws);) } SEAM(pb + 2);
#else
    PHASE(pb + 2); { phase_attn_simple(X, p); } SEAM(pb + 2);
#endif
#if !FAST_HGRN
    PHASE(pb + 3); { phase_hgrn_simple(X, p); } SEAM(pb + 3);
#endif
#if FAST_ATTN
#if FAST_HGRN
    PHASE(pb + 4); { phase_attn_combine(X, ws); REP_X(REP_H3, hg::phase_h3(X, ws, p.in[I_HON] + L * 128);) } SEAM(pb + 4);
#else
    PHASE(pb + 4); { phase_attn_combine(X, ws); phase_hgrn_out(X, p, L); } SEAM(pb + 4);
#endif
#else
    PHASE(pb + 4); { phase_hgrn_out(X, p, L); } SEAM(pb + 4);
#endif
    PHASE(pb + 5); {
#if FUSE_NORM
        if (L == 0) { EpiResNormT<float> E{p.in[I_X], XR, (float*)(ws + WS_MISC + MISC_SSXA), 0.f, (LAS float*)(X.lds + 131072)}; gemm_dense(X, (const bf16*)(ws + WS_CC), (const bf16*)(ws + WS_WT_OUT) + (size_t)L * DM * DM, DM, DM, E); }
#else
        if (L == 0) { EpiResT<float, xr_t> E{p.in[I_X], XR}; gemm_dense(X, (const bf16*)(ws + WS_CC), (const bf16*)(ws + WS_WT_OUT) + (size_t)L * DM * DM, DM, DM, E); }
#endif
        else { EpiResT<xr_t, xr_t> E{XR, XR}; gemm_dense(X, (const bf16*)(ws + WS_CC), (const bf16*)(ws + WS_WT_OUT) + (size_t)L * DM * DM, DM, DM, E); }
    } SEAM(pb + 5);
#if FUSE_NORM
    if (L == 1) { PHASE(pb + 6); { phase_norm_route(X, p, XR, p.in[I_FFNN] + DM); } SEAM(pb + 6); }
    if (L == 0) {
        PHASE(8); { EpiSwiglu E{(bf16*)(ws + WS_HID), FF0, 0, (const float*)(ws + WS_MISC + MISC_SSXA)};
            gemm_dense(X, (const bf16*)XR, (const bf16*)(ws + WS_WT_GU), 2 * FF0, DM, E); } SEAM(8);
        PHASE(9); { EpiResNormT<xr_t> E{XR, XR, (float*)(ws + WS_MISC + MISC_SSXB), 0.f, (LAS float*)(X.lds + 131072)};
            gemm_dense(X, (const bf16*)(ws + WS_HID), (const bf16*)(ws + WS_WT_DN), DM, FF0, E); } SEAM(9);
    }
#else
    PHASE(pb + 6); { if (L == 0) { phase_norm(X, p, XR, p.in[I_FFNN]); } else { phase_norm_route(X, p, XR, p.in[I_FFNN] + DM); } } SEAM(pb + 6);
    if (L == 0) {
        PHASE(8); { EpiSwiglu E{(bf16*)(ws + WS_HID), FF0, 0, nullptr};
            gemm_dense(X, (const bf16*)(ws + WS_XB), (const bf16*)(ws + WS_WT_GU), 2 * FF0, DM, E); } SEAM(8);
        PHASE(9); { EpiResT<xr_t, xr_t> E{XR, XR};
            gemm_dense(X, (const bf16*)(ws + WS_HID), (const bf16*)(ws + WS_WT_DN), DM, FF0, E); } SEAM(9);
        PHASE(10); { phase_norm(X, p, XR, p.in[I_MIXN] + DM); } SEAM(10);
    }
#endif
}

__global__ void __launch_bounds__(NTHREADS, 2) mega(Params p) {
    extern __shared__ __attribute__((aligned(16))) unsigned char lds_raw[];
    Ctx X; X.tid = threadIdx.x; X.lane = X.tid & 63; X.wave = __builtin_amdgcn_readfirstlane(X.tid >> 6); X.bid = blockIdx.x; X.nblk = gridDim.x; X.lds = (LAS unsigned char*)lds_raw;
    unsigned char* ws = p.ws;
    volatile LAS unsigned* MISC = (volatile LAS unsigned*)(X.lds + LDS_MISC_OFF);
    if (X.tid < 32) MISC[X.tid] = 0u;
    __syncthreads();
    const XcdBarrier bar = xcd_barrier_post((unsigned*)(ws + WS_CTL) + CW_BAR, MISC + 8);

    PHASE(0); { REP_X(REP_PRO, phase_prologue(X, p);) } SEAM(0);
    run_layer<0>(X, p, bar);
    run_layer<1>(X, p, bar);
    PHASE(18); { REP_X(REP_ROUTE, phase_scatter(X, p);) } SEAM(18);
#if MOE_FP8
    PHASE(19); { const int* NTp = (const int*)(ws + WS_MISC + MISC_NT); const int* TILE_E = (const int*)(ws + WS_MISC + MISC_TILE_E); const int nt = NTp[0];
        EpiSwiglu8 E{(unsigned char*)(ws + WS_HIDM), FFM, 0};
        REP_X(REP_MOEGU, gemm_moe(X, (const bf16*)(ws + WS_XS), (const bf16*)(ws + WS_WT_MGU), 0, nt, 2 * FFM, DM / 2, TILE_E, 0, 0x79797979, E);) } SEAM(19);
    PHASE(20); { const int* NTp = (const int*)(ws + WS_MISC + MISC_NT); const int* TILE_E = (const int*)(ws + WS_MISC + MISC_TILE_E); const int nt = NTp[0];
        EpiBf16Plain E{(bf16*)(ws + WS_YS), DM};
#if DN_SPLITK
        const int nfull = nt < 128 ? nt : 128;
        gemm_moe(X, (const bf16*)(ws + WS_HIDM), (const bf16*)(ws + WS_WT_MDN), 0, nfull, DM, FFM / 2, TILE_E, 0, 0x78787878, E);
        { const int nsub = (nt - nfull) * 4 * 7, sidx = (int)X.bid;
          pg8::OneUnit S1; S1.have = sidx < nsub;
          const int ks = sidx % 7, up = sidx / 7, pn = up & 3, pm = nfull + (up >> 2);
          S1.u.pm = pm; S1.u.pn = pn; S1.u.pa = pm; S1.u.pb = (S1.have ? __builtin_amdgcn_readfirstlane(TILE_E[pm]) : 0) * 4 + pn;
          pg8::Gemm g1{(const bf16*)(ws + WS_HIDM + (size_t)ks * 512), (const bf16*)(ws + WS_WT_MDN + (size_t)ks * 512), 256, DM, 256, 0x78787878, FFM / 2};
          EpiSlab E1{(float*)(ws + WS_SLAB), ks};
          pg8::gemm_phase<EpiSlab, pg8::OneUnit, true, true, true>(X.lds, g1, S1, E1); }
        } SEAM(20);
#else
        REP_X(REP_MOEDN, gemm_moe(X, (const bf16*)(ws + WS_HIDM), (const bf16*)(ws + WS_WT_MDN), 0, nt, DM, FFM / 2, TILE_E, 0, 0x78787878, E);) } SEAM(20);
#endif
#else
    for (int c = 0; c < 3; ++c) {
        PHASE(19 + 2 * c); { const int* NTp = (const int*)(ws + WS_MISC + MISC_NT); const int* TILE_E = (const int*)(ws + WS_MISC + MISC_TILE_E);
            const int nt = NTp[0], t0 = CHUNK_TILES * c, t1 = min(nt, t0 + CHUNK_TILES);
            if (t1 > t0) { EpiSwiglu E{(bf16*)(ws + WS_HIDM), FFM, t0 * 256, nullptr};
                REP_X(REP_MOEGU, gemm_moe(X, (const bf16*)(ws + WS_XS), (const bf16*)(ws + WS_WT_MGU), t0, t1, 2 * FFM, DM, TILE_E, 0, 0, E);) } } SEAM(19 + 2 * c);
        PHASE(20 + 2 * c); { const int* NTp = (const int*)(ws + WS_MISC + MISC_NT); const int* TILE_E = (const int*)(ws + WS_MISC + MISC_TILE_E);
            const int nt = NTp[0], t0 = CHUNK_TILES * c, t1 = min(nt, t0 + CHUNK_TILES);
            if (t1 > t0) { EpiBf16Plain E{(bf16*)(ws + WS_YS), DM};
                REP_X(REP_MOEDN, gemm_moe(X, (const bf16*)(ws + WS_HIDM), (const bf16*)(ws + WS_WT_MDN), t0, t1, DM, FFM, TILE_E, t0, 0, E);) } } SEAM(20 + 2 * c);
    }
#endif
#if XR_BF16
    PHASE(25); { phase_combine(X, p, (const xr_t*)(p.ws + WS_XRB)); }
#else
    PHASE(25); { phase_combine(X, p, (const xr_t*)p.out); }
#endif
}
#undef PHASE
#undef SEAM

extern "C" void kernel_launch(void* const* d_in, const int* in_sizes, int n_in, void* d_out, int out_size, void* d_ws, size_t ws_size, hipStream_t stream) {
    static int grid = 0;
    if (grid == 0) {
        if (n_in != 20 || out_size != T * DM || ws_size < WS_END) { fprintf(stderr, "kernel_launch: unexpected shapes (n_in %d out %d ws %zu)\n", n_in, out_size, ws_size); grid = -1; return; }
        int dev = 0, cus = 0;
        if (hipGetDevice(&dev) != hipSuccess || hipDeviceGetAttribute(&cus, hipDeviceAttributeMultiprocessorCount, dev) != hipSuccess) { grid = -1; return; }
        if (hipFuncSetAttribute((const void*)mega, hipFuncAttributeMaxDynamicSharedMemorySize, LDS_BYTES) != hipSuccess) { fprintf(stderr, "kernel_launch: hipFuncSetAttribute failed\n"); grid = -1; return; }
        int per_cu = 0; (void)hipOccupancyMaxActiveBlocksPerMultiprocessor(&per_cu, (const void*)mega, NTHREADS, LDS_BYTES); (void)hipGetLastError();
        grid = cus;
    }
    if (grid < 0) return;
    (void)hipMemsetAsync((char*)d_ws + WS_CTL, 0, CTL_BYTES, stream);
    Params p{};
    for (int i = 0; i < 20; ++i) p.in[i] = (const float*)d_in[i];
    p.out = (float*)d_out; p.ws = (unsigned char*)d_ws;
    p.ph_lo = 0; p.ph_hi = NPHASES;
    hipLaunchKernelGGL(mega, dim3(grid), dim3(NTHREADS), LDS_BYTES, stream, p);
}
```

```cpp
#include <hip/hip_runtime.h>
#include <cstdio>
#include <cstdint>

#ifndef N_LAUNCH_MODE
#define N_LAUNCH_MODE 1
#endif

#ifndef FAST_GEMM
#define FAST_GEMM 1
#endif
#ifndef REP_ATTN
#define REP_ATTN 1
#endif
#ifndef REP_INPROJ
#define REP_INPROJ 1
#endif
#ifndef REP_H3
#define REP_H3 1
#endif
#ifndef REP_PRO
#define REP_PRO 1
#endif
#ifndef REP_MOEGU
#define REP_MOEGU 1
#endif
#ifndef REP_MOEDN
#define REP_MOEDN 1
#endif
#ifndef REP_DGU
#define REP_DGU 1
#endif
#ifndef REP_NORM
#define REP_NORM 1
#endif
#ifndef REP_ROUTE
#define REP_ROUTE 1
#endif
#ifndef REP_OUT0
#define REP_OUT0 1
#endif
#ifndef REP_QKV
#define REP_QKV 1
#endif
#define REP_1(stmt) stmt
#define REP_2(stmt) stmt stmt
#define REP_CAT(a, b) a##b
#define REP_X(n, stmt) REP_CAT(REP_, n)(stmt)
#ifndef MOE_FP8
#define MOE_FP8 1
#endif
#ifndef DN_SPLITK
#define DN_SPLITK 1
#endif
#ifndef FUSE_NORM
#define FUSE_NORM 1
#endif
#ifndef XR_BF16
#define XR_BF16 1
#endif
#ifndef HG_V2
#define HG_V2 1
#endif
#ifndef FAST_ATTN
#define FAST_ATTN 1
#endif
#ifndef FAST_HGRN
#define FAST_HGRN 1
#endif
#define GAS __attribute__((address_space(1)))
#define LAS __attribute__((address_space(3)))
typedef unsigned short bf16;
typedef float f32x4 __attribute__((ext_vector_type(4)));
typedef short bf16x8 __attribute__((ext_vector_type(8)));
typedef unsigned u32x4 __attribute__((ext_vector_type(4)));
typedef unsigned u32x2 __attribute__((ext_vector_type(2)));

constexpr int T = 16384, SEQ = 8192, DM = 1024, NLAYER = 2;
constexpr int QR = 384, KVR = 256, ROPE = 64, NPROJ = 2752, NPROJ_P = 2816;
constexpr int NH = 4, DQK = 192, DNOPE = 128, DV = 128;
constexpr int HGW = 512;
constexpr int FF0 = 2816, FFM = 3584, NE = 8;
constexpr int MAXTILES = 136;
constexpr float EPS = 1e-6f;
constexpr int NWAVES = 8, NTHREADS = 512;

constexpr size_t MiB = 1u << 20;
constexpr size_t WS_CTL = 0, CTL_BYTES = 32768;
constexpr size_t WS_MISC = 1 * MiB;
constexpr size_t MISC_LB = 0, MISC_GCNT = 8192, MISC_TILE_E = 16384, MISC_NT = 17408, MISC_TOPI = 65536, MISC_TOPG = 196608, MISC_POS = 327680, MISC_SSXA = 458752, MISC_SSXB = 720896;
constexpr size_t WS_COS = 2 * MiB, WS_SIN = 4 * MiB;
constexpr size_t WS_WT_IN = 6 * MiB, WS_WT_QB = 17 * MiB, WS_WT_KVB = 19 * MiB, WS_WT_OUT = 20 * MiB, WS_WT_GU = 24 * MiB, WS_WT_DN = 35 * MiB, WS_WT_MGU = 41 * MiB, WS_WT_MDN = 153 * MiB;
constexpr size_t WS_XB = 209 * MiB;
constexpr size_t WS_CQ = 242 * MiB, WS_CKV = 254 * MiB, WS_KPE = 262 * MiB, WS_SSQ = 264 * MiB, WS_HQ = 266 * MiB, WS_HK = 282 * MiB, WS_LF = 298 * MiB, WS_HV = 330 * MiB, WS_HG = 346 * MiB;
constexpr size_t WS_Q = 362 * MiB, WS_KN = 386 * MiB, WS_V = 402 * MiB, WS_CC = 418 * MiB, WS_END = 464 * MiB;
constexpr size_t WS_HID = 242 * MiB;
#if MOE_FP8
constexpr size_t WS_XS = 242 * MiB;
constexpr size_t WS_YS = 276 * MiB;
constexpr size_t WS_HIDM = 344 * MiB;
constexpr int CHUNK_TILES = 136;
static_assert(WS_HIDM + (size_t)34816 * 3584 <= 464 * MiB, "MoE hidden fits below the guaranteed workspace size");
#else
constexpr size_t WS_XS = 242 * MiB;
constexpr size_t WS_YS = WS_XS;
constexpr size_t WS_HIDM = 310 * MiB;
constexpr int CHUNK_TILES = 64;
#endif
constexpr size_t WS_AP2 = WS_CQ;
constexpr size_t WS_AML = WS_SSQ;
constexpr size_t WS_HD = WS_XB + 32 * MiB, WS_HR = WS_HD + 512 * 1024;
constexpr size_t WS_XRB = 97 * MiB;
constexpr size_t WS_SLAB = 209 * MiB;
constexpr int CW_BAR = 4096;

constexpr int LDS_BYTES = 147456;
constexpr int LDS_MISC_OFF = 143360;

__device__ __forceinline__ unsigned f2bf(float f) { unsigned u = __float_as_uint(f); return (u + 0x7fffu + ((u >> 16) & 1u)) >> 16; }
__device__ __forceinline__ unsigned pk2(float lo, float hi) { return f2bf(lo) | (f2bf(hi) << 16); }
__device__ __forceinline__ float bf2f(unsigned short b) { return __uint_as_float(((unsigned)b) << 16); }
__device__ __forceinline__ float bflo(unsigned w) { return __uint_as_float(w << 16); }
__device__ __forceinline__ float bfhi(unsigned w) { return __uint_as_float(w & 0xffff0000u); }
__device__ __forceinline__ float clamp8(float x) { return __builtin_amdgcn_fmed3f(x, -448.f, 448.f); }
__device__ __forceinline__ unsigned pk4_fp8(float a, float b, float c, float d) {
    int w = __builtin_amdgcn_cvt_pk_fp8_f32(clamp8(a), clamp8(b), 0, false); w = __builtin_amdgcn_cvt_pk_fp8_f32(clamp8(c), clamp8(d), w, true); return (unsigned)w; }
__device__ __forceinline__ u32x4 pack8(f32x4 a, f32x4 b) { u32x4 w; w.x = pk2(a.x, a.y); w.y = pk2(a.z, a.w); w.z = pk2(b.x, b.y); w.w = pk2(b.z, b.w); return w; }
#if XR_BF16
typedef bf16 xr_t;
#else
typedef float xr_t;
#endif
__device__ __forceinline__ f32x4 ldrow4(const float* row, int idx) { return *((const f32x4*)row + idx); }
__device__ __forceinline__ f32x4 ldrow4(const bf16* row, int idx) { const u32x2 w = *((const u32x2*)row + idx); f32x4 r; r.x = __uint_as_float(w.x << 16); r.y = __uint_as_float(w.x & 0xffff0000u); r.z = __uint_as_float(w.y << 16); r.w = __uint_as_float(w.y & 0xffff0000u); return r; }
__device__ __forceinline__ float wave_sum(float v) {
#pragma unroll
    for (int o = 1; o < 64; o <<= 1) v += __shfl_xor(v, o);
    return v;
}
__device__ __forceinline__ float wave_max(float v) {
#pragma unroll
    for (int o = 1; o < 64; o <<= 1) v = fmaxf(v, __shfl_xor(v, o));
    return v;
}
__device__ __forceinline__ float fast_exp(float x) { return __builtin_amdgcn_exp2f(x * 1.4426950408889634f); }
__device__ __forceinline__ float sigmoidf_(float x) { return __builtin_amdgcn_rcpf(1.f + fast_exp(-x)); }
__device__ __forceinline__ float siluf_(float x) { return x * __builtin_amdgcn_rcpf(1.f + fast_exp(-x)); }
typedef float f32x2v __attribute__((ext_vector_type(2)));
__device__ __forceinline__ f32x2v silu_mul_pk(f32x2v g, f32x2v u) {
    const f32x2v t = g * (-1.4426950408889634f); f32x2v e; e.x = __builtin_amdgcn_exp2f(t.x); e.y = __builtin_amdgcn_exp2f(t.y);
    const f32x2v d = e + 1.0f; f32x2v r; r.x = __builtin_amdgcn_rcpf(d.x); r.y = __builtin_amdgcn_rcpf(d.y);
    return (g * u) * r;
}
__device__ __forceinline__ int perm32(int rho) { const int n = rho >> 4, i = rho & 15; return 8 * (i >> 2) + 4 * n + (i & 3); }

__device__ const double kInvRev[32] = {
    1.59154943091895346e-01, 1.19349370211248862e-01, 8.94994016088910133e-02, 6.71150830052272551e-02, 5.03292121044870353e-02, 3.77415847174197711e-02, 2.83021958306233987e-02, 2.12236527647776604e-02,
    1.59154943091895339e-02, 1.19349370211248862e-02, 8.94994016088910237e-03, 6.71150830052272534e-03, 5.03292121044870370e-03, 3.77415847174197719e-03, 2.83021958306233987e-03, 2.12236527647776622e-03,
    1.59154943091895356e-03, 1.19349370211248849e-03, 8.94994016088910237e-04, 6.71150830052272599e-04, 5.03292121044870326e-04, 3.77415847174197741e-04, 2.83021958306233954e-04, 2.12236527647776605e-04,
    1.59154943091895351e-04, 1.19349370211248862e-04, 8.94994016088910182e-05, 6.71150830052272545e-05, 5.03292121044870354e-05, 3.77415847174197768e-05, 2.83021958306233961e-05, 2.12236527647776592e-05};

#define XB_TMO      128
#define XB_XCNT(j)  (256  + 64 * (j))
#define XB_XSUB(j)  (1280 + 64 * (j))
#define XB_XGEN(j)  (2304 + 64 * (j))
#define XB_TOP      3328
#define XB_TOPGEN   3392
#define XCD_BAR_WORDS 3456
#define XB_SPIN_CAP (1u << 18)
__device__ __forceinline__ unsigned xb_ld(unsigned* p)              { return __hip_atomic_load(p, __ATOMIC_RELAXED, __HIP_MEMORY_SCOPE_AGENT); }
__device__ __forceinline__ unsigned xb_add(unsigned* p, unsigned v) { return __hip_atomic_fetch_add(p, v, __ATOMIC_RELAXED, __HIP_MEMORY_SCOPE_AGENT); }
__device__ __forceinline__ unsigned xb_xcc_id() { return (unsigned)__builtin_amdgcn_s_getreg((3 << 11) | 20) & 0xFu; }
#define XB_SPIN(cond, bar) do { unsigned _sp = 0; while (cond) { __builtin_amdgcn_s_sleep(1); \
    if ((++_sp & 255u) == 0u) { if (xb_ld(&(bar)[XB_TMO])) break; if (_sp > XB_SPIN_CAP) { atomicAdd(&(bar)[XB_TMO], 1u); break; } } } } while (0)
struct XcdBarrier { unsigned* bar; unsigned x; volatile LAS unsigned* st; };
__device__ __forceinline__ XcdBarrier xcd_barrier_post(unsigned* bar, volatile LAS unsigned* st) {
    XcdBarrier b; b.bar = bar; b.x = xb_xcc_id(); b.st = st;
    if (threadIdx.x == 0) (void)xb_add(&bar[XB_XCNT(b.x)], 1u);
    return b;
}
__device__ __forceinline__ void xcd_barrier_complete(unsigned* bar, unsigned x, unsigned& nloc, unsigned& nx) {
    const unsigned G = gridDim.x * gridDim.y * gridDim.z;
    unsigned sum, cnt, mine, sp = 0u;
    for (;;) {
        sum = 0u; cnt = 0u; mine = 0u;
#pragma unroll
        for (unsigned j = 0; j < 16; ++j) { const unsigned c = xb_ld(&bar[XB_XCNT(j)]); sum += c; cnt += (c > 0u) ? 1u : 0u; mine = (j == x) ? c : mine; }
        if (sum == G) break;
        __builtin_amdgcn_s_sleep(1);
        if ((++sp & 255u) == 0u) { if (xb_ld(&bar[XB_TMO])) break; if (sp > XB_SPIN_CAP) { atomicAdd(&bar[XB_TMO], 1u); break; } }
    }
    nloc = mine > 0u ? mine : 1u; nx = cnt > 0u ? cnt : 1u;
}
__device__ __forceinline__ void xcd_barrier(const XcdBarrier& b) {
    asm volatile("s_waitcnt vmcnt(0)" ::: "memory");
    __syncthreads();
    unsigned long long bar_ = (unsigned long long)b.bar; asm volatile("" : "+s"(bar_));
    if (threadIdx.x == 0) {
        unsigned* bar = (unsigned*)(GAS unsigned*)bar_;
        __builtin_amdgcn_s_waitcnt(0);
        unsigned nloc = b.st[0], nx = b.st[1];
        if (nloc == 0u) { xcd_barrier_complete(bar, b.x, nloc, nx); b.st[0] = nloc; b.st[1] = nx; }
        const unsigned old = xb_add(&bar[XB_XSUB(b.x)], 1u);
        const unsigned gen = old / nloc;
        if (old + 1u == (gen + 1u) * nloc) {
            __builtin_amdgcn_fence(__ATOMIC_RELEASE, "agent");
            asm volatile("s_waitcnt vmcnt(0)" ::: "memory");
            const unsigned og = xb_add(&bar[XB_TOP], 1u);
            const unsigned tg = og / nx;
            if (og + 1u == (tg + 1u) * nx) xb_add(&bar[XB_TOPGEN], 1u);
            else XB_SPIN(xb_ld(&bar[XB_TOPGEN]) == tg, bar);
            __builtin_amdgcn_fence(__ATOMIC_ACQUIRE, "agent");
            xb_add(&bar[XB_XGEN(b.x)], 1u);
            asm volatile("s_waitcnt vmcnt(0)" ::: "memory");
        } else {
            XB_SPIN(xb_ld(&bar[XB_XGEN(b.x)]) == gen, bar);
            __builtin_amdgcn_fence(__ATOMIC_ACQUIRE, "agent");
            asm volatile("s_waitcnt vmcnt(0)" ::: "memory");
        }
    }
    __syncthreads();
}

struct Params { const float* in[20]; float* out; unsigned char* ws; int ph_lo, ph_hi; };
enum { I_X = 0, I_POS, I_MIXN, I_WIN, I_QAN, I_WQB, I_KVAN, I_WKVB, I_HLB, I_HON, I_WOUT, I_FFNN, I_DWG, I_DWU, I_DWD, I_ROUTER, I_MWG, I_MWU, I_MWD, I_FINN };

struct Ctx {
    int tid, lane, wave, bid, nblk;
    LAS unsigned char* lds;
};

struct EpiProj {
    unsigned char* ws; int l; int ssx;
    __device__ __forceinline__ void launder() { unsigned long long w = (unsigned long long)ws; asm volatile("" : "+s"(w)); ws = (unsigned char*)(GAS unsigned char*)w;     }
    static constexpr int HAS_ROWSCALE = 1;
    __device__ __forceinline__ float rowscale(int row) const { if (!ssx) return 1.f; const float* sx = (const float*)(ws + WS_MISC + ssx) + row; return __builtin_amdgcn_rsqf(((sx[0] + sx[T]) + (sx[2 * T] + sx[3 * T])) * (1.f / DM) + EPS); }
    __device__ __forceinline__ void operator()(int row, int c, f32x4 a, f32x4 b) const {
        bf16* CQ = (bf16*)(ws + WS_CQ); bf16* CKV = (bf16*)(ws + WS_CKV); bf16* KPE = (bf16*)(ws + WS_KPE); bf16* HQ = (bf16*)(ws + WS_HQ); bf16* HK = (bf16*)(ws + WS_HK); bf16* HV = (bf16*)(ws + WS_HV); bf16* HG = (bf16*)(ws + WS_HG);
        float* LF = (float*)(ws + WS_LF); float* SSQ = (float*)(ws + WS_SSQ); const float* LB = (const float*)(ws + WS_MISC + MISC_LB) + l * HGW; const float* COS = (const float*)(ws + WS_COS); const float* SIN = (const float*)(ws + WS_SIN);
        if (c < 640) {
            float ss = (a.x * a.x + a.y * a.y) + (a.z * a.z + a.w * a.w) + (b.x * b.x + b.y * b.y) + (b.z * b.z + b.w * b.w);
            ss += __shfl_xor(ss, 16); ss += __shfl_xor(ss, 32);
            if ((threadIdx.x & 63) < 16) SSQ[(size_t)(c >> 5) * T + row] = ss;
            const u32x4 w = pack8(a, b);
            if (c < QR) *(u32x4*)(CQ + (size_t)row * QR + c) = w; else *(u32x4*)(CKV + (size_t)row * KVR + (c - QR)) = w;
        } else if (c < 704) {
            const int g = (c - 640) >> 3;
            const f32x4 cs = *(const f32x4*)(COS + (size_t)row * 32 + 4 * g), sn = *(const f32x4*)(SIN + (size_t)row * 32 + 4 * g);
            const f32x4 o1 = a * cs - b * sn, o2 = a * sn + b * cs;
            *(u32x4*)(KPE + (size_t)row * ROPE + 8 * g) = pack8(o1, o2);
        } else if (c < 1216) {
            f32x4 x, y; x.x = siluf_(a.x); x.y = siluf_(a.y); x.z = siluf_(a.z); x.w = siluf_(a.w); y.x = siluf_(b.x); y.y = siluf_(b.y); y.z = siluf_(b.z); y.w = siluf_(b.w);
            *(u32x4*)(HQ + (size_t)row * HGW + (c - 704)) = pack8(x, y);
#if HG_V2
        } else if (c < 1728) {
            *(u32x4*)(HK + (size_t)row * HGW + (c - 1216)) = pack8(a, b);
#else
        } else if (c < 1728) {
            const int d = c - 1216;
            const f32x4 l0 = *(const f32x4*)(LB + d), l1 = *(const f32x4*)(LB + d + 4);
            f32x4 k0, k1, f0, f1;
#define HGATE(z, lb, kk, lf) do { const float zc = fminf(fmaxf((z), -60.f), 60.f); const float e = fast_exp(-zc); const float sg = __builtin_amdgcn_rcpf(1.f + e); const float om = 1.f - (lb); \
                kk = om * (e * sg); const float f = (lb) + om * sg; lf = __builtin_amdgcn_logf(fmaxf(f, 1e-30f)) * 0.6931471805599453f; } while (0)
            HGATE(a.x, l0.x, k0.x, f0.x); HGATE(a.y, l0.y, k0.y, f0.y); HGATE(a.z, l0.z, k0.z, f0.z); HGATE(a.w, l0.w, k0.w, f0.w);
            HGATE(b.x, l1.x, k1.x, f1.x); HGATE(b.y, l1.y, k1.y, f1.y); HGATE(b.z, l1.z, k1.z, f1.z); HGATE(b.w, l1.w, k1.w, f1.w);
#undef HGATE
            *(u32x4*)(HK + (size_t)row * HGW + d) = pack8(k0, k1);
            *(f32x4*)(LF + (size_t)row * HGW + d) = f0; *(f32x4*)(LF + (size_t)row * HGW + d + 4) = f1;
#endif
        } else if (c < 2240) {
            *(u32x4*)(HV + (size_t)row * HGW + (c - 1728)) = pack8(a, b);
        } else if (c < 2752) {
            *(u32x4*)(HG + (size_t)row * HGW + (c - 2240)) = pack8(a, b);
        }
    }
};
struct EpiQ {
    unsigned char* ws;
    __device__ __forceinline__ void launder() { unsigned long long w = (unsigned long long)ws; asm volatile("" : "+s"(w)); ws = (unsigned char*)(GAS unsigned char*)w;     }
    __device__ __forceinline__ void operator()(int row, int c, f32x4 a, f32x4 b) const {
        bf16* Q = (bf16*)(ws + WS_Q); const float* SSQ = (const float*)(ws + WS_SSQ); const float* COS = (const float*)(ws + WS_COS); const float* SIN = (const float*)(ws + WS_SIN);
        float s = 0.f;
#pragma unroll
        for (int i = 0; i < 12; ++i) s += SSQ[(size_t)i * T + row];
        const float rstd = __builtin_amdgcn_rsqf(s * (1.f / QR) + EPS);
        a = a * rstd; b = b * rstd;
        const int h = c / DQK, cc = c - h * DQK, bb = row >> 13, sq = row & (SEQ - 1);
        bf16* dst = Q + ((size_t)((bb * NH + h) * SEQ + sq)) * DQK + cc;
        if (cc < DNOPE) { *(u32x4*)dst = pack8(a, b); }
        else { const int g = (cc - DNOPE) >> 3;
            const f32x4 cs = *(const f32x4*)(COS + (size_t)row * 32 + 4 * g), sn = *(const f32x4*)(SIN + (size_t)row * 32 + 4 * g);
            *(u32x4*)dst = pack8(a * cs - b * sn, a * sn + b * cs); }
    }
};
struct EpiKV {
    unsigned char* ws;
    __device__ __forceinline__ void launder() { unsigned long long w = (unsigned long long)ws; asm volatile("" : "+s"(w)); ws = (unsigned char*)(GAS unsigned char*)w;     }
    __device__ __forceinline__ void operator()(int row, int c, f32x4 a, f32x4 b) const {
        bf16* KN = (bf16*)(ws + WS_KN); bf16* V = (bf16*)(ws + WS_V); const float* SSQ = (const float*)(ws + WS_SSQ);
        float s = 0.f;
#pragma unroll
        for (int i = 12; i < 20; ++i) s += SSQ[(size_t)i * T + row];
        const float rstd = __builtin_amdgcn_rsqf(s * (1.f / KVR) + EPS);
        a = a * rstd; b = b * rstd;
        const int h = c >> 8, cc = c & 255, bb = row >> 13, sq = row & (SEQ - 1);
        const size_t r = ((size_t)((bb * NH + h) * SEQ + sq)) * 128;
        if (cc < 128) *(u32x4*)(KN + r + cc) = pack8(a, b); else *(u32x4*)(V + r + (cc - 128)) = pack8(a, b);
    }
};
template <class TS, class TD> struct EpiResT {
    const TS* SRC; TD* DST;
    __device__ __forceinline__ void launder() {}
    __device__ __forceinline__ void operator()(int row, int c, f32x4 a, f32x4 b) const {
        const size_t o = (size_t)row * DM + c;
        f32x4 s0, s1;
        if constexpr (sizeof(TS) == 4) { s0 = *(const f32x4*)((const float*)SRC + o); s1 = *(const f32x4*)((const float*)SRC + o + 4); }
        else { const u32x4 w = *(const u32x4*)((const bf16*)SRC + o); s0.x = bflo(w.x); s0.y = bfhi(w.x); s0.z = bflo(w.y); s0.w = bfhi(w.y); s1.x = bflo(w.z); s1.y = bfhi(w.z); s1.z = bflo(w.w); s1.w = bfhi(w.w); }
        s0 = s0 + a; s1 = s1 + b;
        if constexpr (sizeof(TD) == 4) { *(f32x4*)((float*)DST + o) = s0; *(f32x4*)((float*)DST + o + 4) = s1; }
        else *(u32x4*)((bf16*)DST + o) = pack8(s0, s1);
    }
};
template <class TS> struct EpiResNormT {
    static constexpr bool HAS_FINISH = true;
    const TS* SRC; bf16* DST; float* SSX; float ssb;
    __device__ __forceinline__ void launder() {}
    __device__ __forceinline__ void operator()(int row, int c, f32x4 a, f32x4 b) {
        const size_t o = (size_t)row * DM + c;
        f32x4 s0, s1;
        if constexpr (sizeof(TS) == 4) { s0 = *(const f32x4*)((const float*)SRC + o); s1 = *(const f32x4*)((const float*)SRC + o + 4); }
        else { const u32x4 w = *(const u32x4*)((const bf16*)SRC + o); s0.x = bflo(w.x); s0.y = bfhi(w.x); s0.z = bflo(w.y); s0.w = bfhi(w.y); s1.x = bflo(w.z); s1.y = bfhi(w.z); s1.z = bflo(w.w); s1.w = bfhi(w.w); }
        s0 = s0 + a; s1 = s1 + b;
        *(u32x4*)(DST + o) = pack8(s0, s1);
        float ss = (s0.x * s0.x + s0.y * s0.y) + (s0.z * s0.z + s0.w * s0.w) + (s1.x * s1.x + s1.y * s1.y) + (s1.z * s1.z + s1.w * s1.w);
        if ((c & 128) == 0) { ssb = ss; }
        else { ss += ssb; ss += __shfl_xor(ss, 16); ss += __shfl_xor(ss, 32);
            if ((threadIdx.x & 63) < 16) part[(row & 255) * 4 + ((c >> 5) & 3)] = ss; }
    }
    LAS float* part;
    __device__ __forceinline__ void finish(int pm, int pn, int tid) {
        asm volatile("s_waitcnt lgkmcnt(0)" ::: "memory"); __builtin_amdgcn_s_barrier(); asm volatile("" ::: "memory");
        if (tid < 256) { const LAS float* q = part + tid * 4; SSX[(size_t)pn * T + pm * 256 + tid] = (q[0] + q[1]) + (q[2] + q[3]); }
    }
};
struct EpiSwiglu {
    bf16* HID; int ff; int rowbase; const float* SSX;
    static constexpr int HAS_ROWSCALE = 1;
    __device__ __forceinline__ void launder() {}
    __device__ __forceinline__ float rowscale(int row) const { if (!SSX) return 1.f; const float* sx = SSX + row; return __builtin_amdgcn_rsqf(((sx[0] + sx[T]) + (sx[2 * T] + sx[3 * T])) * (1.f / DM) + EPS); }
    __device__ __forceinline__ void operator()(int row, int c, f32x4 a, f32x4 b) const {
        const f32x2v h0 = silu_mul_pk((f32x2v){a.x, a.y}, (f32x2v){b.x, b.y}), h1 = silu_mul_pk((f32x2v){a.z, a.w}, (f32x2v){b.z, b.w});
        u32x2 w; w.x = pk2(h0.x, h0.y); w.y = pk2(h1.x, h1.y);
        *(u32x2*)(HID + (size_t)(row - rowbase) * ff + (c >> 1)) = w;
    }
};
struct EpiSwiglu8 {
    unsigned char* HID; int ff; int rowbase;
    __device__ __forceinline__ void launder() {}
    __device__ __forceinline__ void operator()(int row, int c, f32x4 a, f32x4 b) const {
        const f32x2v h0 = silu_mul_pk((f32x2v){a.x, a.y}, (f32x2v){b.x, b.y}), h1 = silu_mul_pk((f32x2v){a.z, a.w}, (f32x2v){b.z, b.w});
        *(unsigned*)(HID + (size_t)(row - rowbase) * ff + (c >> 1)) = pk4_fp8(h0.x, h0.y, h1.x, h1.y);
    }
};
struct EpiProbe {
    float* sink;
    __device__ __forceinline__ void launder() {}
    __device__ __forceinline__ void operator()(int row, int c, f32x4 a, f32x4 b) const { if (a.x == 123456.789f && b.w == -98765.4321f) sink[row * 8 + (c & 7)] = a.y; }
};
struct EpiBf16Plain {
    bf16* O; int ld;
    __device__ __forceinline__ void launder() {}
    __device__ __forceinline__ void operator()(int row, int c, f32x4 a, f32x4 b) const { *(u32x4*)(O + (size_t)row * ld + c) = pack8(a, b); }
};

namespace pg8 {
#define PG8_LAS __attribute__((address_space(3)))
typedef unsigned short bf16_t;
typedef short bf16x8 __attribute__((ext_vector_type(8)));
typedef float f32x4 __attribute__((ext_vector_type(4)));
typedef unsigned u32x4 __attribute__((ext_vector_type(4)));
typedef int v4i_t __attribute__((ext_vector_type(4)));
typedef int v8i_t __attribute__((ext_vector_type(8)));
constexpr int BM = 256, BK = 64, HALF = 128, HTB = HALF * BK * 2  , STAGE_BYTES = 8 * HTB, NXCD = 8, WGM = 8;

__host__ __device__ __forceinline__ int lds_byte(int r, int c) { const int st = (r >> 4) * 2 + (c >> 5), rr = r & 15, cc = c & 31, ob = rr * 64 + cc * 2; return st * 1024 + (ob ^ (((ob >> 9) & 1) << 5)); }
__host__ __device__ __forceinline__ void stage_rc(int b, int& R, int& C) { const int st = b / 1024, sb = b % 1024, swz = sb ^ (((sb >> 9) & 1) << 5); R = (st >> 1) * 16 + swz / 64; C = (st & 1) * 32 + (swz % 64) / 2; }
__host__ __device__ __forceinline__ int perm32(int rho) { const int n = rho >> 4, i = rho & 15; return 8 * (i >> 2) + 4 * n + (i & 3); }

template <class E, class = void> struct has_finish { static constexpr bool value = false; };
template <class E> struct has_finish<E, decltype((void)E::HAS_FINISH)> { static constexpr bool value = true; };
template <class E, class = void> struct has_rowscale { static constexpr bool value = false; };
template <class E> struct has_rowscale<E, decltype((void)E::HAS_ROWSCALE)> { static constexpr bool value = true; };
struct Unit { int pm, pn, pa, pb; };
struct Gemm { const bf16_t* A; const bf16_t* Bt; int M, N, K; int wscale; int ld; };

struct StaticOrder {
    int nM, nN, nwg, G, c;
    __host__ __device__ void init(int M, int N, int G_, int c_) { nM = M / BM; nN = N / BM; nwg = nM * nN; G = G_; c = c_; }
    __host__ __device__ bool next(int i, Unit& u) const {
        const long L = (long)i * G + c; if (L >= nwg) return false;
        int wgid = (int)L; { const int q = nwg / NXCD, r = nwg % NXCD, xcd = wgid % NXCD, off = wgid / NXCD; wgid = (xcd < r ? xcd * (q + 1) : r * (q + 1) + (xcd - r) * q) + off; }
        const int nig = WGM * nN, gid = wgid / nig, fm = gid * WGM, gsz = (nM - fm) < WGM ? (nM - fm) : WGM;
        u.pm = fm + ((wgid % nig) % gsz); u.pn = (wgid % nig) / gsz; u.pa = u.pm; u.pb = u.pn; return true;
    }
    __device__ __forceinline__ void a_ready(const Unit&) const {}
    __device__ __forceinline__ void done(const Unit&) const {}
};
template <class Epi, class Sched, bool ALIGN_EPI = false, bool SP2 = false, bool FP8 = false>
__device__ __forceinline__ void gemm_phase(PG8_LAS unsigned char* lds, const Gemm g, const Sched& S, const Epi& E) {
    int tid_ = threadIdx.x; asm volatile("" : "+v"(tid_));
    const int tid = tid_, wid = __builtin_amdgcn_readfirstlane(tid >> 6), lane = tid & 63, wr = wid >> 2, wc = wid & 3, fr = lane & 15, fq = lane >> 4;
    const int K = g.ld ? g.ld : g.K, nt = g.K / BK;
    unsigned voffA[2], voffB[2];
#pragma unroll
    for (int i = 0; i < 2; ++i) { int R, C; stage_rc(tid * 16 + i * 8192, R, C); const int Rb = (R & ~31) + perm32(R & 31);
        voffA[i] = (unsigned)(R * K + C) * 2u; voffB[i] = (unsigned)(Rb * K + C) * 2u; }
    const size_t kstep = (size_t)(BK * 2);
    const size_t hstep = (size_t)HALF * K * 2;
    const size_t tstep = 2 * hstep;
    const unsigned ldsw = (unsigned)wid * 1024u;
    const int aoff = lds_byte(wr * 64 + fr, fq * 8), boff = lds_byte(wc * 32 + fr, fq * 8);
#define PG8_SA(b, h) (((b) * 2 + (h)) * HTB)
#define PG8_SB(b, h) ((4 + (b) * 2 + (h)) * HTB)
#define PG8_STAGE(bufoff, gbase, voff) do { _Pragma("unroll") for (int _i = 0; _i < 2; ++_i) \
        __builtin_amdgcn_global_load_lds((const unsigned*)((const char*)(gbase) + (voff)[_i]), (PG8_LAS unsigned*)(lds + (bufoff) + ldsw + _i * 8192), 16, 0, 0); } while (0)
#define PG8_RD(off) (*(const PG8_LAS bf16x8*)(lds + (off)))
#define PG8_CAT(lo, hi) __builtin_shufflevector(__builtin_bit_cast(v4i_t, lo), __builtin_bit_cast(v4i_t, hi), 0, 1, 2, 3, 4, 5, 6, 7)
#define PG8_LDA(dst, b, h) do { _Pragma("unroll") for (int m = 0; m < 4; ++m) { if constexpr (FP8) dst##8[m] = PG8_CAT(PG8_RD(PG8_SA(b, h) + aoff + m * 2048), PG8_RD(PG8_SA(b, h) + aoff + m * 2048 + 1024)); \
        else { dst[m][0] = PG8_RD(PG8_SA(b, h) + aoff + m * 2048); dst[m][1] = PG8_RD(PG8_SA(b, h) + aoff + m * 2048 + 1024); } } } while (0)
#define PG8_LDB(dst, b, h) do { _Pragma("unroll") for (int n = 0; n < 2; ++n) { if constexpr (FP8) dst##8[n] = PG8_CAT(PG8_RD(PG8_SB(b, h) + boff + n * 2048), PG8_RD(PG8_SB(b, h) + boff + n * 2048 + 1024)); \
        else { dst[n][0] = PG8_RD(PG8_SB(b, h) + boff + n * 2048); dst[n][1] = PG8_RD(PG8_SB(b, h) + boff + n * 2048 + 1024); } } } while (0)
#define PG8_MMA(ai, bj, At, Bt) do { __builtin_amdgcn_s_setprio(1); if constexpr (FP8) { _Pragma("unroll") for (int m = 0; m < 4; ++m) _Pragma("unroll") for (int n = 0; n < 2; ++n) \
        asm volatile("v_mfma_scale_f32_16x16x128_f8f6f4 %0, %1, %2, %0, %3, %4 op_sel_hi:[0,0,0]" : "+v"(acc[ai][bj][m][n]) : "v"(Bt##8[n]), "v"(At##8[m]), "v"(sc_w), "v"(sc_1)); } \
        else { _Pragma("unroll") for (int m = 0; m < 4; ++m) _Pragma("unroll") for (int n = 0; n < 2; ++n) _Pragma("unroll") for (int k = 0; k < 2; ++k) \
        acc[ai][bj][m][n] = __builtin_amdgcn_mfma_f32_16x16x32_bf16(Bt[n][k], At[m][k], acc[ai][bj][m][n], 0, 0, 0); } __builtin_amdgcn_s_setprio(0); } while (0)
#define PG8_WAIT_V(n) asm volatile("s_waitcnt vmcnt(" #n ")" ::: "memory")
#define PG8_WAIT_L(n) asm volatile("s_waitcnt lgkmcnt(" #n ")" ::: "memory")
#define PG8_BAR __builtin_amdgcn_s_barrier()
#define PG8_SCHED __builtin_amdgcn_sched_barrier(0)
    Unit cur, nxt; int ui = 0;
    if (!S.next(0, cur)) return;
    f32x4 acc[2][2][4][2];
#pragma unroll
    for (int a = 0; a < 2; ++a)
#pragma unroll
        for (int b = 0; b < 2; ++b)
#pragma unroll
            for (int m = 0; m < 4; ++m)
#pragma unroll
                for (int n = 0; n < 2; ++n) acc[a][b][m][n] = (f32x4){0.f, 0.f, 0.f, 0.f};
    const int sc_w = g.wscale, sc_1 = 0x7F7F7F7F;
    bf16x8 At[4][2], B0[2][2], B1[2][2]; v8i_t At8[4], B08[2], B18[2];
    const char* cA = (const char*)g.A + (size_t)cur.pa * tstep; const char* cB = (const char*)g.Bt + (size_t)cur.pb * tstep;
    S.a_ready(cur);
    if constexpr (SP2) {
        PG8_STAGE(PG8_SB(0, 0), cB, voffB); PG8_STAGE(PG8_SB(0, 1), cB + hstep, voffB); PG8_STAGE(PG8_SA(0, 0), cA, voffA); PG8_STAGE(PG8_SA(0, 1), cA + hstep, voffA);
        if (wr == 1) PG8_BAR;
        PG8_WAIT_V(2); PG8_BAR;
        PG8_STAGE(PG8_SB(1, 0), cB + kstep, voffB); PG8_STAGE(PG8_SA(1, 0), cA + kstep, voffA); PG8_STAGE(PG8_SB(1, 1), cB + hstep + kstep, voffB);
        PG8_WAIT_V(6); PG8_BAR;
    } else {
        PG8_STAGE(PG8_SB(0, 0), cB, voffB); PG8_STAGE(PG8_SA(0, 0), cA, voffA); PG8_STAGE(PG8_SB(0, 1), cB + hstep, voffB); PG8_STAGE(PG8_SA(0, 1), cA + hstep, voffA);
        if (wr == 1) PG8_BAR;
        PG8_WAIT_V(4); PG8_BAR;
        PG8_STAGE(PG8_SB(1, 0), cB + kstep, voffB); PG8_STAGE(PG8_SA(1, 0), cA + kstep, voffA); PG8_STAGE(PG8_SB(1, 1), cB + hstep + kstep, voffB);
        PG8_WAIT_V(6); PG8_BAR;
    }
    for (;;) {
        const bool has_next = S.next(ui + 1, nxt);
        const char* nA = has_next ? (const char*)g.A + (size_t)nxt.pa * tstep : cA; const char* nB = has_next ? (const char*)g.Bt + (size_t)nxt.pb * tstep : cB;
#pragma nounroll
        for (int t = 0; t < nt; t += 2) {
            const bool last = (t == nt - 2);
            const char* a1 = cA + (size_t)(t + 1) * kstep;
            const char* a2 = last ? nA : cA + (size_t)(t + 2) * kstep; const char* b2 = last ? nB : cB + (size_t)(t + 2) * kstep;
            const char* a3 = a2 + kstep; const char* b3 = b2 + kstep;
            if (last && has_next) S.a_ready(nxt);
            if constexpr (SP2) {
            PG8_LDB(B0, 0, 0); PG8_LDB(B1, 0, 1); PG8_SCHED; PG8_LDA(At, 0, 0); PG8_STAGE(PG8_SA(1, 1), a1 + hstep, voffA);
            PG8_WAIT_V(8); PG8_WAIT_L(0); PG8_BAR; PG8_MMA(0, 0, At, B0); PG8_MMA(0, 1, At, B1); PG8_BAR; PG8_SCHED;
            PG8_LDA(At, 0, 1); PG8_STAGE(PG8_SB(0, 0), b2, voffB); PG8_STAGE(PG8_SB(0, 1), b2 + hstep, voffB); PG8_STAGE(PG8_SA(0, 0), a2, voffA);
            PG8_WAIT_V(8); PG8_WAIT_L(0); PG8_BAR; PG8_MMA(1, 0, At, B0); PG8_MMA(1, 1, At, B1); PG8_BAR; PG8_SCHED;
            PG8_LDB(B0, 1, 0); PG8_LDB(B1, 1, 1); PG8_SCHED; PG8_LDA(At, 1, 0); PG8_STAGE(PG8_SA(0, 1), a2 + hstep, voffA);
            PG8_WAIT_V(8); PG8_WAIT_L(0); PG8_BAR; PG8_MMA(0, 0, At, B0); PG8_MMA(0, 1, At, B1); PG8_BAR; PG8_SCHED;
            PG8_LDA(At, 1, 1); PG8_STAGE(PG8_SB(1, 0), b3, voffB); PG8_STAGE(PG8_SB(1, 1), b3 + hstep, voffB); PG8_STAGE(PG8_SA(1, 0), a3, voffA);
            PG8_WAIT_V(8); PG8_WAIT_L(0); PG8_BAR; PG8_MMA(1, 0, At, B0); PG8_MMA(1, 1, At, B1); PG8_BAR; PG8_SCHED;
            } else {
            PG8_LDB(B0, 0, 0); PG8_SCHED; PG8_LDA(At, 0, 0); PG8_STAGE(PG8_SA(1, 1), a1 + hstep, voffA);
            PG8_WAIT_L(8); PG8_BAR; PG8_WAIT_L(0); PG8_MMA(0, 0, At, B0); PG8_BAR; PG8_SCHED;
            PG8_LDB(B1, 0, 1); PG8_STAGE(PG8_SB(0, 0), b2, voffB);
            PG8_BAR; PG8_WAIT_L(0); PG8_MMA(0, 1, At, B1); PG8_BAR;
            PG8_LDA(At, 0, 1); PG8_STAGE(PG8_SA(0, 0), a2, voffA);
            PG8_BAR; PG8_WAIT_L(0); PG8_MMA(1, 0, At, B0); PG8_BAR; PG8_SCHED;
            PG8_STAGE(PG8_SB(0, 1), b2 + hstep, voffB);
            PG8_WAIT_V(6); PG8_BAR; PG8_MMA(1, 1, At, B1); PG8_BAR;
            PG8_LDB(B0, 1, 0); PG8_SCHED; PG8_LDA(At, 1, 0); PG8_STAGE(PG8_SA(0, 1), a2 + hstep, voffA);
            PG8_WAIT_L(8); PG8_BAR; PG8_WAIT_L(0); PG8_MMA(0, 0, At, B0); PG8_BAR; PG8_SCHED;
            PG8_LDB(B1, 1, 1); PG8_STAGE(PG8_SB(1, 0), b3, voffB);
            PG8_BAR; PG8_WAIT_L(0); PG8_MMA(0, 1, At, B1); PG8_BAR;
            PG8_LDA(At, 1, 1); PG8_STAGE(PG8_SA(1, 0), a3, voffA);
            PG8_BAR; PG8_WAIT_L(0); PG8_MMA(1, 0, At, B0); PG8_BAR; PG8_SCHED;
            PG8_STAGE(PG8_SB(1, 1), b3 + hstep, voffB);
            PG8_WAIT_V(6); PG8_BAR; PG8_MMA(1, 1, At, B1); PG8_BAR;
            }
        }
        if constexpr (ALIGN_EPI) { if (wr == 0) PG8_BAR; }
        if constexpr (FP8) asm volatile("s_nop 15\n\ts_nop 15" ::: "memory");
        {
            int fr_ = fr, fq_ = fq; asm volatile("" : "+v"(fr_), "+v"(fq_));
            const int row0 = cur.pm * BM + wr * 64 + fr_, col0 = cur.pn * BM + wc * 32 + 8 * fq_;
            Epi E2 = E; E2.launder();
            if constexpr (has_rowscale<Epi>::value) {
                float rs[2][4];
#pragma unroll
                for (int ai = 0; ai < 2; ++ai)
#pragma unroll
                    for (int m = 0; m < 4; ++m) rs[ai][m] = E2.rowscale(row0 + ai * HALF + m * 16);
#pragma unroll
                for (int ai = 0; ai < 2; ++ai)
#pragma unroll
                    for (int m = 0; m < 4; ++m)
#pragma unroll
                        for (int bj = 0; bj < 2; ++bj) E2(row0 + ai * HALF + m * 16, col0 + bj * HALF, acc[ai][bj][m][0] * rs[ai][m], acc[ai][bj][m][1] * rs[ai][m]);
            } else {
#pragma unroll
            for (int ai = 0; ai < 2; ++ai)
#pragma unroll
                for (int m = 0; m < 4; ++m)
#pragma unroll
                    for (int bj = 0; bj < 2; ++bj) E2(row0 + ai * HALF + m * 16, col0 + bj * HALF, acc[ai][bj][m][0], acc[ai][bj][m][1]);
            }
            if constexpr (has_finish<Epi>::value) E2.finish(cur.pm, cur.pn, tid);
            S.done(cur);
        }
        if (!has_next) break;
#pragma unroll
        for (int a = 0; a < 2; ++a)
#pragma unroll
            for (int b = 0; b < 2; ++b)
#pragma unroll
                for (int m = 0; m < 4; ++m)
#pragma unroll
                    for (int n = 0; n < 2; ++n) acc[a][b][m][n] = (f32x4){0.f, 0.f, 0.f, 0.f};
        cur = nxt; cA = nA; cB = nB; ++ui;
        if constexpr (ALIGN_EPI) { if (wr == 1) PG8_BAR; }
    }
    PG8_WAIT_V(0);
    if constexpr (!ALIGN_EPI) { if (wr == 0) PG8_BAR; }
    PG8_BAR;
#undef PG8_SA
#undef PG8_SB
#undef PG8_STAGE
#undef PG8_LDA
#undef PG8_RD
#undef PG8_LDB
#undef PG8_MMA
#undef PG8_CAT
#undef PG8_WAIT_V
#undef PG8_WAIT_L
#undef PG8_BAR
#undef PG8_SCHED
}

struct MoeOrder {
    StaticOrder so; int t0, abase, nN; const int* tile_e;
    __device__ void init(int t0_, int t1_, int N, int G_, int c_, const int* te, int abase_) { so.init((t1_ - t0_) * BM, N, G_, c_); t0 = t0_; abase = abase_; nN = N / BM; tile_e = te; }
    __device__ bool next(int i, Unit& u) const { if (!so.next(i, u)) return false; u.pm += t0; u.pa = u.pm - abase; u.pb = __builtin_amdgcn_readfirstlane(tile_e[u.pm]) * nN + u.pn; return true; }
    __device__ __forceinline__ void a_ready(const Unit&) const {}
    __device__ __forceinline__ void done(const Unit&) const {}
};
}

template <class Epi>
__device__ __forceinline__ void simple_gemm(const Ctx& X, const bf16* A, const bf16* Bt, int row_lo, int nrows, int N, int K, const int* tile_e, size_t expert_stride, int a_rowbase, const Epi& E) {
    const int fr = X.lane & 15, fq = X.lane >> 4;
    const int ncb = N / 32, ntile = (nrows / 16) * ncb;
    const int gw = X.bid * NWAVES + X.wave, ngw = X.nblk * NWAVES;
    for (int t = gw; t < ntile; t += ngw) {
        const int tm = t / ncb, tn = t - tm * ncb, r0 = row_lo + tm * 16, c0 = tn * 32;
        const bf16* Bb = Bt; if (tile_e) Bb += (size_t)tile_e[r0 >> 8] * expert_stride;
        const bf16* arow = A + (size_t)(r0 - a_rowbase + fr) * K + 8 * fq;
        const bf16* b0 = Bb + (size_t)(c0 + perm32(fr)) * K + 8 * fq;
        const bf16* b1 = Bb + (size_t)(c0 + perm32(16 + fr)) * K + 8 * fq;
        f32x4 acc0 = {0.f, 0.f, 0.f, 0.f}, acc1 = {0.f, 0.f, 0.f, 0.f};
        for (int k = 0; k < K; k += 32) {
            const bf16x8 a = *(const bf16x8*)(arow + k), w0 = *(const bf16x8*)(b0 + k), w1 = *(const bf16x8*)(b1 + k);
            acc0 = __builtin_amdgcn_mfma_f32_16x16x32_bf16(w0, a, acc0, 0, 0, 0);
            acc1 = __builtin_amdgcn_mfma_f32_16x16x32_bf16(w1, a, acc1, 0, 0, 0);
        }
        E(r0 + fr, c0 + 8 * fq, acc0, acc1);
    }
}


namespace pg8 { struct OneUnit { Unit u; bool have;
    __device__ bool next(int i, Unit& o) const { if (i != 0 || !have) return false; o = u; return true; }
    __device__ __forceinline__ void a_ready(const Unit&) const {}
    __device__ __forceinline__ void done(const Unit&) const {} }; }
struct EpiSlab {
    float* slab; int ks;
    __device__ __forceinline__ void launder() {}
    __device__ __forceinline__ void operator()(int row, int c, f32x4 a, f32x4 b) const {
        float* d = slab + ((size_t)((((row >> 8) - 128) * 4 + (c >> 8)) * 7 + ks) * 256 + (row & 255)) * 256 + (c & 255);
        *(f32x4*)d = a; *(f32x4*)(d + 4) = b; }
};
template <class Epi>
__device__ __forceinline__ void gemm_dense(const Ctx& X, const bf16* A, const bf16* Bt, int N, int K, const Epi& E) {
#if FAST_GEMM
    pg8::Gemm g{A, Bt, T, N, K, 0}; pg8::StaticOrder S; S.init(T, N, X.nblk, X.bid);
    pg8::gemm_phase<Epi, pg8::StaticOrder, true, true>(X.lds, g, S, E);
#else
    simple_gemm(X, A, Bt, 0, T, N, K, nullptr, 0, 0, E);
#endif
}
template <class Epi>
__device__ __forceinline__ void gemm_moe(const Ctx& X, const bf16* A, const bf16* Bt, int t0, int t1, int N, int K, const int* tile_e, int abase, int wscale, const Epi& E) {
#if FAST_GEMM
    pg8::Gemm g{A, Bt, (t1 - t0) * 256, N, K, wscale, 0}; pg8::MoeOrder S; S.init(t0, t1, N, X.nblk, X.bid, tile_e, abase);
    pg8::gemm_phase<Epi, pg8::MoeOrder, true, true, MOE_FP8 != 0>(X.lds, g, S, E);
#else
    simple_gemm(X, A, Bt, t0 * 256, (t1 - t0) * 256, N, K, tile_e, (size_t)N * K, abase * 256, E);
#endif
}

struct SrcPlain { const float* W; int N; __device__ __forceinline__ f32x4 load4(int k, int n4) const { return *(const f32x4*)(W + (size_t)k * N + n4); } };
struct SrcScaled { const float* W; int N; const float* rs; __device__ __forceinline__ f32x4 load4(int k, int n4) const { return *(const f32x4*)(W + (size_t)k * N + n4) * rs[k]; } };
__device__ __forceinline__ int rope_src(int j) { const int g = j >> 3, jj = j & 7; return (jj < 4) ? (4 * g + jj) : (32 + 4 * g + (jj - 4)); }
struct SrcIn { const float* W; const float* rs;
    __device__ __forceinline__ f32x4 load4(int k, int n4) const { if (n4 >= NPROJ) return (f32x4){0.f, 0.f, 0.f, 0.f}; int m = n4; if (n4 >= 640 && n4 < 704) m = 640 + rope_src(n4 - 640); const f32x4 v = *(const f32x4*)(W + (size_t)k * NPROJ + m); return rs ? v * rs[k] : v; } };
struct SrcQB { const float* W; const float* gain;
    __device__ __forceinline__ f32x4 load4(int k, int n4) const { const int h = n4 / DQK; int c = n4 - h * DQK; if (c >= DNOPE) c = DNOPE + rope_src(c - DNOPE);
        return *(const f32x4*)(W + (size_t)k * (NH * DQK) + h * DQK + c) * (gain[k] * 0.07216878364870322f); } };
struct SrcGU { const float* Wg; const float* Wu; int FF; const float* rs;
    __device__ __forceinline__ f32x4 load4(int k, int n4) const { const int g = n4 >> 3; const long long d = (n4 & 4) ? (long long)(Wu - Wg) : 0ll; const f32x4 v = *(const f32x4*)(Wg + d + (long long)k * FF + 4 * g); return rs ? v * rs[k] : v; } };

template <class Src>
__device__ __forceinline__ void transpose_item(const Src& S, int K, int nblk, bf16* WT, LAS float* scr, int item, int lane) {
    const int kb = item / nblk, nb = item - kb * nblk, k0 = 64 * kb, n0 = 32 * nb;
    const int kk0 = lane >> 3, qd = lane & 7;
    f32x4 v[8];
#pragma unroll
    for (int i = 0; i < 8; ++i) v[i] = S.load4(k0 + 8 * i + kk0, n0 + 4 * qd);
#pragma unroll
    for (int i = 0; i < 8; ++i) { LAS float* d = scr + (8 * i + kk0) * 33 + 4 * qd; d[0] = v[i].x; d[1] = v[i].y; d[2] = v[i].z; d[3] = v[i].w; }
    asm volatile("s_waitcnt lgkmcnt(0)" ::: "memory");
    const int c = lane & 7;
#pragma unroll
    for (int j = 0; j < 4; ++j) { const int n = (lane >> 3) + 8 * j; const LAS float* s = scr + (8 * c) * 33 + n;
        u32x4 o; o.x = pk2(s[0 * 33], s[1 * 33]); o.y = pk2(s[2 * 33], s[3 * 33]); o.z = pk2(s[4 * 33], s[5 * 33]); o.w = pk2(s[6 * 33], s[7 * 33]);
        *(u32x4*)(WT + (size_t)(n0 + n) * K + k0 + 8 * c) = o; }
    asm volatile("s_waitcnt lgkmcnt(0)" ::: "memory");
}

template <class Src>
__device__ __forceinline__ void transpose_item_fp8(const Src& S, int K, int nblk, unsigned char* WT, LAS float* scr, int item, int lane, float scale) {
    const int kb = item / nblk, nb = item - kb * nblk, k0 = 64 * kb, n0 = 32 * nb;
    const int kk0 = lane >> 3, qd = lane & 7;
    f32x4 v[8];
#pragma unroll
    for (int i = 0; i < 8; ++i) v[i] = S.load4(k0 + 8 * i + kk0, n0 + 4 * qd);
#pragma unroll
    for (int i = 0; i < 8; ++i) { LAS float* d = scr + (8 * i + kk0) * 33 + 4 * qd; d[0] = v[i].x * scale; d[1] = v[i].y * scale; d[2] = v[i].z * scale; d[3] = v[i].w * scale; }
    asm volatile("s_waitcnt lgkmcnt(0)" ::: "memory");
    const int c = lane & 3;
#pragma unroll
    for (int j = 0; j < 2; ++j) { const int n = (lane >> 2) + 16 * j; const LAS float* s = scr + (16 * c) * 33 + n;
        u32x4 o; o.x = pk4_fp8(s[0 * 33], s[1 * 33], s[2 * 33], s[3 * 33]); o.y = pk4_fp8(s[4 * 33], s[5 * 33], s[6 * 33], s[7 * 33]);
        o.z = pk4_fp8(s[8 * 33], s[9 * 33], s[10 * 33], s[11 * 33]); o.w = pk4_fp8(s[12 * 33], s[13 * 33], s[14 * 33], s[15 * 33]);
        *(u32x4*)(WT + (size_t)(n0 + n) * K + k0 + 16 * c) = o; }
    asm volatile("s_waitcnt lgkmcnt(0)" ::: "memory");
}

template <int NR, class TS>
__device__ __forceinline__ void norm_rows_bf16(const TS* src, const float* gain, bf16* dst, int row0, int rstep, int lane) {
    f32x4 v[NR][4];
#pragma unroll
    for (int i = 0; i < NR; ++i)
#pragma unroll
        for (int j = 0; j < 4; ++j) v[i][j] = ldrow4(src + (size_t)(row0 + i * rstep) * DM, lane + 64 * j);
    f32x4 g[4];
#pragma unroll
    for (int j = 0; j < 4; ++j) g[j] = *((const f32x4*)gain + lane + 64 * j);
#pragma unroll
    for (int i = 0; i < NR; ++i) { float s = 0.f;
#pragma unroll
        for (int j = 0; j < 4; ++j) s += (v[i][j].x * v[i][j].x + v[i][j].y * v[i][j].y) + (v[i][j].z * v[i][j].z + v[i][j].w * v[i][j].w);
        const float rstd = __builtin_amdgcn_rsqf(wave_sum(s) * (1.f / DM) + EPS);
#pragma unroll
        for (int j = 0; j < 4; ++j) { const f32x4 y = v[i][j] * rstd * g[j]; u32x2 w; w.x = pk2(y.x, y.y); w.y = pk2(y.z, y.w); *((u32x2*)(dst + (size_t)(row0 + i * rstep) * DM) + lane + 64 * j) = w; } }
}
template <class TS>
__device__ __forceinline__ void norm_all_rows(const Ctx& X, const TS* src, const float* gain, bf16* dst) {
    const int gw = X.bid * NWAVES + X.wave, ngw = X.nblk * NWAVES;
    int m = gw;
    for (; m + 3 * ngw < T; m += 4 * ngw) norm_rows_bf16<4, TS>(src, gain, dst, m, ngw, X.lane);
    for (; m < T; m += ngw) norm_rows_bf16<1, TS>(src, gain, dst, m, ngw, X.lane);
}

__device__ __forceinline__ void phase_prologue(const Ctx& X, const Params& p) {
    unsigned char* ws = p.ws;
    LAS float* scr = (LAS float*)(X.lds + X.wave * 16384);
    const int gw = X.bid * NWAVES + X.wave, ngw = X.nblk * NWAVES;
    constexpr int I_IN = 16 * 88, I_QB = 6 * 24, I_KVB = 4 * 32, I_OUT = 16 * 32, I_GU = 16 * 176, I_DN = 44 * 32, I_MGU = 16 * 224, I_MDN = 56 * 32;
    constexpr int I_LAYER = I_IN + I_QB + I_KVB + I_OUT;
    constexpr int NITEMS = 2 * I_LAYER + I_GU + I_DN + NE * (I_MGU + I_MDN);
    for (int it = gw; it < NITEMS; it += ngw) {
        int r = it;
        if (r < 2 * I_LAYER) {
            const int l = r / I_LAYER; r -= l * I_LAYER;
            if (r < I_IN) { SrcIn S{p.in[I_WIN] + (size_t)l * DM * NPROJ, (FUSE_NORM && l == 1) ? p.in[I_MIXN] + DM : nullptr}; transpose_item(S, DM, NPROJ_P / 32, (bf16*)(ws + WS_WT_IN) + (size_t)l * NPROJ_P * DM, scr, r, X.lane); continue; } r -= I_IN;
            if (r < I_QB) { SrcQB S{p.in[I_WQB] + (size_t)l * QR * (NH * DQK), p.in[I_QAN] + l * QR}; transpose_item(S, QR, (NH * DQK) / 32, (bf16*)(ws + WS_WT_QB) + (size_t)l * (NH * DQK) * QR, scr, r, X.lane); continue; } r -= I_QB;
            if (r < I_KVB) { SrcScaled S{p.in[I_WKVB] + (size_t)l * KVR * 1024, 1024, p.in[I_KVAN] + l * KVR}; transpose_item(S, KVR, 1024 / 32, (bf16*)(ws + WS_WT_KVB) + (size_t)l * 1024 * KVR, scr, r, X.lane); continue; } r -= I_KVB;
            { SrcPlain S{p.in[I_WOUT] + (size_t)l * DM * DM, DM}; transpose_item(S, DM, DM / 32, (bf16*)(ws + WS_WT_OUT) + (size_t)l * DM * DM, scr, r, X.lane); continue; }
        }
        r -= 2 * I_LAYER;
        if (r < I_GU) { SrcGU S{p.in[I_DWG], p.in[I_DWU], FF0, FUSE_NORM ? p.in[I_FFNN] : nullptr}; transpose_item(S, DM, (2 * FF0) / 32, (bf16*)(ws + WS_WT_GU), scr, r, X.lane); continue; } r -= I_GU;
        if (r < I_DN) { SrcPlain S{p.in[I_DWD], DM}; transpose_item(S, FF0, DM / 32, (bf16*)(ws + WS_WT_DN), scr, r, X.lane); continue; } r -= I_DN;
        if (r < NE * I_MGU) { const int e = r / I_MGU; r -= e * I_MGU; SrcGU S{p.in[I_MWG] + (size_t)e * DM * FFM, p.in[I_MWU] + (size_t)e * DM * FFM, FFM, nullptr};
#if MOE_FP8
            transpose_item_fp8(S, DM, (2 * FFM) / 32, (unsigned char*)(ws + WS_WT_MGU) + (size_t)e * (2 * FFM) * DM, scr, r, X.lane, 64.f); continue; } r -= NE * I_MGU;
        { const int e = r / I_MDN; r -= e * I_MDN; SrcPlain S{p.in[I_MWD] + (size_t)e * FFM * DM, DM};
            transpose_item_fp8(S, FFM, DM / 32, (unsigned char*)(ws + WS_WT_MDN) + (size_t)e * DM * FFM, scr, r, X.lane, 128.f); }
#else
            transpose_item(S, DM, (2 * FFM) / 32, (bf16*)(ws + WS_WT_MGU) + (size_t)e * (2 * FFM) * DM, scr, r, X.lane); continue; } r -= NE * I_MGU;
        { const int e = r / I_MDN; r -= e * I_MDN; SrcPlain S{p.in[I_MWD] + (size_t)e * FFM * DM, DM};
            transpose_item(S, FFM, DM / 32, (bf16*)(ws + WS_WT_MDN) + (size_t)e * DM * FFM, scr, r, X.lane); }
#endif
    }
    { const int* pos = (const int*)p.in[I_POS]; float* COS = (float*)(ws + WS_COS); float* SIN = (float*)(ws + WS_SIN);
      for (int i = X.bid * NTHREADS + X.tid; i < T * 32; i += X.nblk * NTHREADS) {
          const int row = i >> 5, f = i & 31; const double a = (double)pos[row] * kInvRev[f]; const float rev = (float)(a - floor(a));
          COS[i] = __builtin_amdgcn_cosf(rev); SIN[i] = __builtin_amdgcn_sinf(rev); } }
    if (X.bid == 0) { float* LB = (float*)(ws + WS_MISC + MISC_LB); const float* h = p.in[I_HLB];
        for (int i = X.tid; i < HGW; i += NTHREADS) { LB[i] = 0.f; LB[HGW + i] = 1.f / (1.f + expf(h[i] - h[HGW + i])); } }
    norm_all_rows(X, p.in[I_X], p.in[I_MIXN], (bf16*)(ws + WS_XB));
}

__device__ __forceinline__ void phase_attn_simple(const Ctx& X, const Params& p) {
    unsigned char* ws = p.ws;
    const bf16* Q = (const bf16*)(ws + WS_Q); const bf16* KN = (const bf16*)(ws + WS_KN); const bf16* KPE = (const bf16*)(ws + WS_KPE); const bf16* V = (const bf16*)(ws + WS_V);
    bf16* CC = (bf16*)(ws + WS_CC);
    LAS float* ql = (LAS float*)(X.lds + X.wave * 1024);
    const int gw = X.bid * NWAVES + X.wave, ngw = X.nblk * NWAVES, lane = X.lane;
    for (int idx = gw; idx < 2 * NH * SEQ; idx += ngw) {
        const int bh = idx & 7, q = SEQ - 1 - (idx >> 3), b = bh >> 2, h = bh & 3;
        const bf16* qrow = Q + ((size_t)bh * SEQ + q) * DQK;
        ql[lane] = bf2f(qrow[lane]); ql[64 + lane] = bf2f(qrow[64 + lane]); ql[128 + lane] = bf2f(qrow[128 + lane]);
        asm volatile("s_waitcnt lgkmcnt(0)" ::: "memory");
        float m = -1e30f, l = 0.f, o0 = 0.f, o1 = 0.f;
        for (int k0 = 0; k0 <= q; k0 += 64) {
            const int key = k0 + lane; const bool valid = key <= q;
            float s = 0.f;
            const bf16* kr = KN + ((size_t)bh * SEQ + key) * 128; const bf16* kp = KPE + ((size_t)b * SEQ + key) * ROPE;
#pragma unroll 4
            for (int c = 0; c < 16; ++c) { const u32x4 w = *(const u32x4*)(kr + 8 * c); const LAS float* qq = ql + 8 * c;
                s += bflo(w.x) * qq[0] + bfhi(w.x) * qq[1] + bflo(w.y) * qq[2] + bfhi(w.y) * qq[3] + bflo(w.z) * qq[4] + bfhi(w.z) * qq[5] + bflo(w.w) * qq[6] + bfhi(w.w) * qq[7]; }
#pragma unroll 4
            for (int c = 0; c < 8; ++c) { const u32x4 w = *(const u32x4*)(kp + 8 * c); const LAS float* qq = ql + 128 + 8 * c;
                s += bflo(w.x) * qq[0] + bfhi(w.x) * qq[1] + bflo(w.y) * qq[2] + bfhi(w.y) * qq[3] + bflo(w.z) * qq[4] + bfhi(w.z) * qq[5] + bflo(w.w) * qq[6] + bfhi(w.w) * qq[7]; }
            if (!valid) s = -1e30f;
            const float mx = wave_max(s), mn = fmaxf(m, mx), alpha = fast_exp(m - mn);
            const float pr = valid ? fast_exp(s - mn) : 0.f;
            l = l * alpha + wave_sum(pr); o0 *= alpha; o1 *= alpha; m = mn;
            const bf16* vb = V + ((size_t)bh * SEQ + k0) * 128 + 2 * lane;
            for (int j = 0; j < 64; ++j) { const float pj = __shfl(pr, j); const unsigned w = *(const unsigned*)(vb + (size_t)j * 128); o0 += pj * bflo(w); o1 += pj * bfhi(w); }
        }
        const float inv = 1.f / l;
        *(unsigned*)(CC + ((size_t)(b * SEQ + q)) * DM + h * 128 + 2 * lane) = pk2(o0 * inv, o1 * inv);
    }
}


namespace att {
typedef short s16x4 __attribute__((ext_vector_type(4)));
typedef float f32x16 __attribute__((ext_vector_type(16)));
constexpr int NW = 8, QBLK = 32, KVBLK = 64, QB = 256, NQB = SEQ / QB;
constexpr int KROW = 400, SHM_V = KVBLK * 128 * 2, SHM_K = KVBLK * KROW;
constexpr int LDS_V = 0, LDS_K = 2 * SHM_V, LDS_WS = LDS_K + 2 * SHM_K, LDS_TOTAL = LDS_WS + NW * 64 * 4;
constexpr float THR = 8.f;
#define SBAR() __builtin_amdgcn_sched_barrier(0)
__device__ __forceinline__ int v_st(int k, int c) { const int kk = (k & ~0xC) | ((k & 4) << 1) | ((k & 8) >> 1); return ((kk >> 3) * 4 + (c >> 5)) * 512 + ((kk & 7) * 32 + (c & 31)) * 2; }
__device__ __forceinline__ int v_rd_base(int lane) { return ((lane & 3) << 3) | (((lane >> 2) & 3) << 6) | (((lane >> 4) & 1) << 5) | (((lane >> 5) & 1) << 8); }
constexpr int v_rd_off(int d0, int ks, int half) { return d0 * 512 + ks * 4096 + half * 2048; }
__device__ __forceinline__ int crow(int r, int hi) { return (r & 3) + 8 * (r >> 2) + 4 * hi; }
__device__ __forceinline__ unsigned cvtpk(float lo, float hi) { unsigned r; asm volatile("v_cvt_pk_bf16_f32 %0, %1, %2" : "=v"(r) : "v"(lo), "v"(hi)); return r; }
__device__ __forceinline__ bf16x8 load8(const bf16* p) { return *reinterpret_cast<const bf16x8*>(p); }
__device__ __forceinline__ bf16x8 bload8(__amdgpu_buffer_rsrc_t r, unsigned voff, unsigned soff) { const u32x4 x = __builtin_amdgcn_raw_buffer_load_b128(r, voff, soff, 0); return __builtin_bit_cast(bf16x8, x); }
__device__ __forceinline__ void mask_tile(f32x16& p0, f32x16& p1, int dq) {
    const float NEG = -__builtin_inff();
#pragma unroll
    for (int r = 0; r < 16; ++r) { const int c = (r & 3) + 8 * (r >> 2); if (dq - c < 0) p0[r] = NEG; if (dq - c - 32 < 0) p1[r] = NEG; }
}
__device__ __forceinline__ void partialSM(f32x16& p0, f32x16& p1, float& m_reg, float& mn, float& alpha) {
    float pmax = p0[0]; for (int r = 1; r < 16; ++r) pmax = fmaxf(pmax, p0[r]); for (int r = 0; r < 16; ++r) pmax = fmaxf(pmax, p1[r]);
    { auto rr = __builtin_amdgcn_permlane32_swap(__float_as_uint(pmax), __float_as_uint(pmax), false, false);
      pmax = fmaxf(__uint_as_float(rr[0]), __uint_as_float(rr[1])); }
    constexpr float C2 = 1.4426950408889634f;
    if (__builtin_expect(__all((pmax - m_reg) <= THR), 1)) { mn = m_reg; alpha = 1.f; }
    else { mn = fmaxf(m_reg, pmax); alpha = __builtin_amdgcn_exp2f((m_reg - mn) * C2); m_reg = mn; }
    const float mnL = -mn * C2;
    for (int r = 0; r < 16; ++r) p0[r] = fmaf(p0[r], C2, mnL); for (int r = 0; r < 16; ++r) p1[r] = fmaf(p1[r], C2, mnL);
    for (int r = 0; r < 16; ++r) p0[r] = __builtin_amdgcn_exp2f(p0[r]);
}
__device__ __forceinline__ void finishSM(f32x16& p0, f32x16& p1, float alpha, float& l_reg, bf16x8& pa0, bf16x8& pa1, bf16x8& pa2, bf16x8& pa3) {
    for (int r = 0; r < 16; ++r) p1[r] = __builtin_amdgcn_exp2f(p1[r]);
    float ps = 0; for (int r = 0; r < 16; ++r) ps += p0[r]; for (int r = 0; r < 16; ++r) ps += p1[r];
    { auto rr = __builtin_amdgcn_permlane32_swap(__float_as_uint(ps), __float_as_uint(ps), false, false);
      ps = __uint_as_float(rr[0]) + __uint_as_float(rr[1]); }
    l_reg = l_reg * alpha + ps;
#define PK4(P, B_, OUT) do { unsigned a0 = cvtpk(P[B_+0], P[B_+1]), a1 = cvtpk(P[B_+2], P[B_+3]);                          \
        unsigned b0 = cvtpk(P[B_+4], P[B_+5]), b1 = cvtpk(P[B_+6], P[B_+7]);                                             \
        auto r0 = __builtin_amdgcn_permlane32_swap(a0, b0, false, false); auto r1 = __builtin_amdgcn_permlane32_swap(a1, b1, false, false); \
        u32x4 w = {r0[0], r1[0], r0[1], r1[1]}; OUT = *reinterpret_cast<bf16x8*>(&w); } while (0)
    PK4(p0, 0, pa0); PK4(p0, 8, pa1); PK4(p1, 0, pa2); PK4(p1, 8, pa3);
#undef PK4
}
template <int KB>
__device__ __forceinline__ void qkt(f32x16& p0, f32x16& p1, const LAS char* K_lds, int r32, int hi, const bf16x8* qr) {
    p0 = f32x16{}; p1 = f32x16{};
    const LAS char* kb = K_lds + KB * SHM_K + r32 * KROW + hi * 16;
#pragma unroll
    for (int d0 = 0; d0 < 12; ++d0) {
        const bf16x8 b0 = *reinterpret_cast<const LAS bf16x8*>(kb + d0 * 32);
        const bf16x8 b1 = *reinterpret_cast<const LAS bf16x8*>(kb + d0 * 32 + 32 * KROW);
        p0 = __builtin_amdgcn_mfma_f32_32x32x16_bf16(b0, qr[d0], p0, 0, 0, 0);
        p1 = __builtin_amdgcn_mfma_f32_32x32x16_bf16(b1, qr[d0], p1, 0, 0, 0); }
}
template <int VB>
__device__ __forceinline__ void pv_tile(f32x16* o, int vb0, bf16x8 pa0, bf16x8 pa1, bf16x8 pa2, bf16x8 pa3) {
#define TRRD(dst, off) asm volatile("ds_read_b64_tr_b16 %0, %1 offset:%2" : "=&v"(dst) : "v"(vb0), "i"(off) : "memory")
#define PV_D0(d0) do { s16x4 l0, l1, l2, l3, h0, h1, h2, h3; constexpr int b_ = VB * SHM_V + v_rd_off(d0, 0, 0); \
        TRRD(l0, b_); TRRD(h0, b_ + 2048); TRRD(l1, b_ + 4096); TRRD(h1, b_ + 6144); TRRD(l2, b_ + 8192); TRRD(h2, b_ + 10240); TRRD(l3, b_ + 12288); TRRD(h3, b_ + 14336); \
        asm volatile("s_waitcnt lgkmcnt(0)" ::: "memory"); SBAR();   \
        o[d0] = __builtin_amdgcn_mfma_f32_32x32x16_bf16(pa0, (bf16x8){l0[0], l0[1], l0[2], l0[3], h0[0], h0[1], h0[2], h0[3]}, o[d0], 0, 0, 0);   \
        o[d0] = __builtin_amdgcn_mfma_f32_32x32x16_bf16(pa1, (bf16x8){l1[0], l1[1], l1[2], l1[3], h1[0], h1[1], h1[2], h1[3]}, o[d0], 0, 0, 0);   \
        o[d0] = __builtin_amdgcn_mfma_f32_32x32x16_bf16(pa2, (bf16x8){l2[0], l2[1], l2[2], l2[3], h2[0], h2[1], h2[2], h2[3]}, o[d0], 0, 0, 0);   \
        o[d0] = __builtin_amdgcn_mfma_f32_32x32x16_bf16(pa3, (bf16x8){l3[0], l3[1], l3[2], l3[3], h3[0], h3[1], h3[2], h3[3]}, o[d0], 0, 0, 0); } while (0)
    PV_D0(0); PV_D0(1); PV_D0(2); PV_D0(3);
#undef PV_D0
#undef TRRD
}
struct BlockRef { const bf16* Q; const bf16* KN; const bf16* KP; const bf16* V; bf16* O; float* ML; int ostride, P0, par, NT; };
struct Seam { bf16x8 qr[12]; bf16x8 st_v0, st_v1, st_k0, st_k1, st_k2; };
#define VMW() asm volatile("s_waitcnt vmcnt(0)" ::: "memory")
#define VMWN(n) asm volatile("s_waitcnt vmcnt(%0)" :: "i"(n) : "memory")
#define SLOAD(R, k0) do { const unsigned so_ = (unsigned)(k0) * 256u, sp_ = (unsigned)(k0) * 128u; \
                          S.st_v0 = bload8(rV, lofs, so_); S.st_v1 = bload8(rV, lofs, so_ + 8192u); S.st_k0 = bload8(rK, lofs, so_); S.st_k1 = bload8(rK, lofs, so_ + 8192u); S.st_k2 = bload8(rP, lofp, sp_); } while (0)
#define SWRITE_K(bf) do { *(LAS bf16x8*)(K_lds + (bf) * SHM_K + kws) = S.st_k0; *(LAS bf16x8*)(K_lds + (bf) * SHM_K + kws + 32 * KROW) = S.st_k1; *(LAS bf16x8*)(K_lds + (bf) * SHM_K + kwp) = S.st_k2; } while (0)
#define SWRITE_V(bf) do { *(LAS bf16x8*)(V_lds + (bf) * SHM_V + vst0) = S.st_v0; *(LAS bf16x8*)(V_lds + (bf) * SHM_V + vst1) = S.st_v1; } while (0)
#define KBASE_OF(R, t) (((R).par + 2 * (t)) * KVBLK)
__device__ __forceinline__ void attn_block(const BlockRef& cur, LAS char* lds, int tid) {
    Seam S;
    const int wid = __builtin_amdgcn_readfirstlane(tid >> 6), lane = tid & 63, r32 = lane & 31, hi = lane >> 5;
    const int NT = cur.NT;
    const int qlo = cur.P0 + wid * QBLK, qm = qlo + r32 - 4 * hi;
    LAS char* V_lds = lds + LDS_V; LAS char* K_lds = lds + LDS_K;
    LAS float* wsc = (LAS float*)(lds + LDS_WS) + wid * 64; LAS float* li_l = wsc; LAS float* al_l = wsc + 32;
    float m_reg = -1e30f, l_reg = 0; f32x16 o[4] = {};
    const int sr = tid >> 4, sc = (tid & 15) * 8, vst0 = v_st(sr, sc), vst1 = v_st(32 + sr, sc), kws = sr * KROW + sc * 2, pr = tid >> 3, pc = (tid & 7) * 8, kwp = pr * KROW + 256 + pc * 2;
    const unsigned lofs = (unsigned)(sr * 128 + sc) * 2u, lofp = (unsigned)(pr * 64 + pc) * 2u;
    const __amdgpu_buffer_rsrc_t rV = __builtin_amdgcn_make_buffer_rsrc((void*)cur.V, 0, SEQ * 128 * 2, 0x00020000), rK = __builtin_amdgcn_make_buffer_rsrc((void*)cur.KN, 0, SEQ * 128 * 2, 0x00020000),
                                 rP = __builtin_amdgcn_make_buffer_rsrc((void*)cur.KP, 0, SEQ * ROPE * 2, 0x00020000);
    const int vb0 = (int)(unsigned)(size_t)V_lds + v_rd_base(lane);
#define RESC(a) do { if (__any((a) < 1.f)) { if (hi == 0) al_l[r32] = (a); asm volatile("s_waitcnt lgkmcnt(0)" ::: "memory");              \
                     for (int d_ = 0; d_ < 4; ++d_) for (int r = 0; r < 16; ++r) o[d_][r] *= al_l[crow(r, hi)]; } } while (0)
#define KBASE(t) KBASE_OF(cur, t)
#define MASKT(P0_, P1_, t) do { const int kb_ = KBASE(t); if (kb_ + KVBLK - 1 > qlo) mask_tile(P0_, P1_, qm - kb_); } while (0)
    f32x16 pA0, pA1, pB0, pB1; float mnA, mnB, alA, alB; bf16x8 pa0, pa1, pa2, pa3;
#pragma unroll
    for (int d0 = 0; d0 < 12; ++d0) S.qr[d0] = load8(cur.Q + (size_t)(wid * QBLK + r32) * DQK + d0 * 16 + hi * 8);
    SLOAD(cur, KBASE(0)); VMW(); SWRITE_K(0); SWRITE_V(0);
    __syncthreads();
    SLOAD(cur, KBASE(1));
    SBAR(); qkt<0>(pA0, pA1, K_lds, r32, hi, S.qr);
    MASKT(pA0, pA1, 0); partialSM(pA0, pA1, m_reg, mnA, alA);
    VMW(); SWRITE_V(1); SWRITE_K(1);
    __syncthreads();
#define HALF_STEP(PX0, PX1, mnX, alX, PY0, PY1, alY, t, KB, VB, SB) do {                                                      \
        SBAR(); qkt<KB>(PX0, PX1, K_lds, r32, hi, S.qr);                                                                      \
        finishSM(PY0, PY1, alY, l_reg, pa0, pa1, pa2, pa3); SBAR();                                                           \
        if ((t) + 1 < NT) { SLOAD(cur, KBASE((t) + 1)); SBAR(); }                                                             \
        pv_tile<VB>(o, vb0, pa0, pa1, pa2, pa3); MASKT(PX0, PX1, (t)); partialSM(PX0, PX1, m_reg, mnX, alX);                  \
        __syncthreads();                                                                                                      \
        if ((t) + 1 < NT) { VMW(); SWRITE_V(SB); SWRITE_K(SB); }                                                              \
        RESC(alX); __syncthreads(); } while (0)
    for (int t = 1; t + 1 < NT; t += 2) {
        HALF_STEP(pB0, pB1, mnB, alB, pA0, pA1, alA, t, 1, 0, 0);
        HALF_STEP(pA0, pA1, mnA, alA, pB0, pB1, alB, t + 1, 0, 1, 1);
    }
    SBAR(); qkt<1>(pB0, pB1, K_lds, r32, hi, S.qr); SBAR();
    finishSM(pA0, pA1, alA, l_reg, pa0, pa1, pa2, pa3); SBAR();
    pv_tile<0>(o, vb0, pa0, pa1, pa2, pa3);
    MASKT(pB0, pB1, NT - 1); partialSM(pB0, pB1, m_reg, mnB, alB); __syncthreads(); RESC(alB);
    finishSM(pB0, pB1, alB, l_reg, pa0, pa1, pa2, pa3); SBAR(); pv_tile<1>(o, vb0, pa0, pa1, pa2, pa3);
    if (hi == 0) { li_l[r32] = l_reg; *(float2*)(cur.ML + (size_t)(wid * QBLK + r32) * 2) = make_float2(m_reg, l_reg); }
    asm volatile("s_waitcnt lgkmcnt(0)" ::: "memory");
    float rli[16];
#pragma unroll
    for (int r = 0; r < 16; ++r) { const float lv = li_l[crow(r, hi)]; rli[r] = lv > 0.f ? __builtin_amdgcn_rcpf(lv) : 0.f; }
    bf16* Ow = cur.O + (size_t)(wid * QBLK) * cur.ostride;
#pragma unroll
    for (int r = 0; r < 16; ++r) { const int orow = crow(r, hi);
#pragma unroll
        for (int d0 = 0; d0 < 4; ++d0) { const float v = o[d0][r] * rli[r]; const float vn = __shfl_xor(v, 1);
            if ((r32 & 1) == 0) *(unsigned*)(Ow + (size_t)orow * cur.ostride + d0 * 32 + r32) = cvtpk(v, vn); } }
    __syncthreads();
#undef RESC
#undef KBASE
#undef MASKT
#undef HALF_STEP
}
#undef SLOAD
#undef SWRITE_K
#undef SWRITE_V
#undef VMW
#undef VMWN
struct Item { int bh, x, par; };
__device__ __forceinline__ Item decode(int L) { Item it; it.bh = L & 7; const int rest = L >> 3; it.x = rest >> 1; it.par = rest & 1; return it; }
__device__ __forceinline__ BlockRef make_ref(unsigned char* ws, const Item& it, int pass) {
    const int qb = pass ? (NQB - 1 - it.x) : it.x, bh = it.bh; BlockRef r;
    r.Q = (const bf16*)(ws + WS_Q) + ((size_t)bh * SEQ + (size_t)qb * QB) * DQK;
    r.KN = (const bf16*)(ws + WS_KN) + (size_t)bh * SEQ * 128; r.KP = (const bf16*)(ws + WS_KPE) + (size_t)(bh >> 2) * SEQ * ROPE; r.V = (const bf16*)(ws + WS_V) + (size_t)bh * SEQ * 128;
    if (it.par == 0) { r.O = (bf16*)(ws + WS_CC) + ((size_t)((bh >> 2) * SEQ + qb * QB)) * DM + (bh & 3) * 128; r.ostride = DM; }
    else { r.O = (bf16*)(ws + WS_AP2) + ((size_t)bh * SEQ + (size_t)qb * QB) * 128; r.ostride = 128; }
    r.ML = (float*)(ws + WS_AML) + ((size_t)(it.par * 8 + bh) * SEQ + (size_t)qb * QB) * 2;
    r.P0 = qb * QB; r.par = it.par; r.NT = 2 * (qb + 1);
    return r;
}
}
__device__ __forceinline__ void phase_attn_fast(const Ctx& X, unsigned char* ws) {
    constexpr int TOTAL = 2 * NH * (att::NQB / 2) * 2;
    int L = X.bid; if (L >= TOTAL) return;
    const int stride = X.nblk;
    LAS char* lds = (LAS char*)X.lds;
    for (; L < TOTAL; L += stride) {
        const att::Item it = att::decode(L);
#pragma nounroll
        for (int pass = 0; pass < 2; ++pass) { const att::BlockRef cur = att::make_ref(ws, it, pass); att::attn_block(cur, lds, X.tid); }
    }
}
__device__ __forceinline__ void phase_attn_combine(const Ctx& X, unsigned char* ws) {
    bf16* CC = (bf16*)(ws + WS_CC); const bf16* P2 = (const bf16*)(ws + WS_AP2); const float* ML = (const float*)(ws + WS_AML);
    const int gw = X.bid * NWAVES + X.wave, ngw = X.nblk * NWAVES, lane = X.lane, h = lane >> 4, dd = (lane & 15) * 8;
    for (int r0 = gw; r0 < T; r0 += 4 * ngw) {
        u32x4 a[4], q[4]; float2 s1[4], s2[4];
#pragma unroll
        for (int i = 0; i < 4; ++i) { const int row = (r0 + i * ngw < T) ? r0 + i * ngw : r0, b = row >> 13, sq = row & (SEQ - 1), bh = b * NH + h;
            a[i] = *(const u32x4*)(CC + (size_t)row * DM + h * 128 + dd); q[i] = *(const u32x4*)(P2 + ((size_t)bh * SEQ + sq) * 128 + dd);
            s1[i] = *(const float2*)(ML + ((size_t)bh * SEQ + sq) * 2); s2[i] = *(const float2*)(ML + ((size_t)(8 + bh) * SEQ + sq) * 2); }
#pragma unroll
        for (int i = 0; i < 4; ++i) { const int row = (r0 + i * ngw < T) ? r0 + i * ngw : r0;
            const float m = fmaxf(s1[i].x, s2[i].x), w1 = s1[i].y * fast_exp(s1[i].x - m), w2 = s2[i].y * fast_exp(s2[i].x - m), inv = __builtin_amdgcn_rcpf(w1 + w2), c1 = w1 * inv, c2 = w2 * inv;
            u32x4 o; o.x = pk2(c1 * bflo(a[i].x) + c2 * bflo(q[i].x), c1 * bfhi(a[i].x) + c2 * bfhi(q[i].x)); o.y = pk2(c1 * bflo(a[i].y) + c2 * bflo(q[i].y), c1 * bfhi(a[i].y) + c2 * bfhi(q[i].y));
            o.z = pk2(c1 * bflo(a[i].z) + c2 * bflo(q[i].z), c1 * bfhi(a[i].z) + c2 * bfhi(q[i].z)); o.w = pk2(c1 * bflo(a[i].w) + c2 * bflo(q[i].w), c1 * bfhi(a[i].w) + c2 * bfhi(q[i].w));
            *(u32x4*)(CC + (size_t)row * DM + h * 128 + dd) = o; }
    }
}

namespace hg {
using att::s16x4; using att::f32x16; using att::v_st; using att::v_rd_base; using att::v_rd_off; using att::crow; using att::cvtpk;
constexpr int CH = 64, NCH = SEQ / CH;
constexpr int KROW2 = 272;
constexpr int TILE_V = 16384, TILE_K2 = CH * KROW2;
constexpr size_t US_BH = (size_t)NCH * 16384;
#define TRRD2(dst, base, off) asm volatile("ds_read_b64_tr_b16 %0, %1 offset:%2" : "=&v"(dst) : "v"(base), "i"(off) : "memory")
__device__ __forceinline__ float ex(float x) { return __builtin_amdgcn_exp2f(x * 1.4426950408889634f); }
#if HG_V2
__device__ __forceinline__ void h1_unit(const Ctx& X, unsigned char* ws, int u, const float* lbl) {
    int tid_ = X.tid; asm volatile("" : "+v"(tid_));
    const int bb = u >> 7, c = u & 127, row0 = bb * SEQ + c * CH, tid = tid_, lane = tid & 63, wave = X.wave;
    const bf16* HZ = (const bf16*)(ws + WS_HK); const bf16* HQ = (const bf16*)(ws + WS_HQ); const bf16* HV = (const bf16*)(ws + WS_HV);
    bf16* KRB = (bf16*)(ws + WS_LF); bf16* QRB = (bf16*)(ws + WS_LF + 16 * MiB);
    float* Dd = (float*)(ws + WS_HD); float* Rr = (float*)(ws + WS_HR); bf16* US = (bf16*)(ws + WS_XB);
    LAS char* lds = (LAS char*)X.lds;
    {
        const int t0 = tid >> 4, c8 = (tid & 15) * 8; const size_t g0 = (size_t)(row0 + t0) * HGW + c8; const int vst0 = v_st(t0, c8);
        u32x4 vw[8];
#pragma unroll
        for (int j = 0; j < 8; ++j) vw[j] = *(const u32x4*)(HV + g0 + (size_t)((j & 1) * 32 * HGW + (j >> 1) * 128));
#pragma unroll
        for (int j = 0; j < 8; ++j) *(LAS u32x4*)(lds + 65536 + (j >> 1) * TILE_V + vst0 + (j & 1) * 8192) = vw[j];
    }
    {
        const int head = tid >> 7, d = tid & 127; const unsigned vo = (unsigned)tid * 2u; const size_t cb = (size_t)row0 * HGW * 2;
        const __amdgpu_buffer_rsrc_t rZ = __builtin_amdgcn_make_buffer_rsrc((void*)((const char*)HZ + cb), 0, CH * HGW * 2, 0x00020000), rQ = __builtin_amdgcn_make_buffer_rsrc((void*)((const char*)HQ + cb), 0, CH * HGW * 2, 0x00020000),
                                     rK = __builtin_amdgcn_make_buffer_rsrc((void*)((char*)KRB + cb), 0, CH * HGW * 2, 0x00020000), rR = __builtin_amdgcn_make_buffer_rsrc((void*)((char*)QRB + cb), 0, CH * HGW * 2, 0x00020000);
        float zl[CH], qv[CH];
#pragma unroll
        for (int t = 0; t < CH; ++t) { zl[t] = bf2f((unsigned short)__builtin_amdgcn_raw_buffer_load_b16(rZ, vo, t * HGW * 2, 0)); qv[t] = bf2f((unsigned short)__builtin_amdgcn_raw_buffer_load_b16(rQ, vo, t * HGW * 2, 0)); }
        const float lb = lbl[tid], om = 1.f - lb;
        float b = 0.f, r = 0.f;
#pragma unroll
        for (int t = 0; t < CH; ++t) { const float zc = fminf(fmaxf(zl[t], -60.f), 60.f), e = fast_exp(-zc), sg = __builtin_amdgcn_rcpf(1.f + e), f = lb + om * sg;
            const float lf = __builtin_amdgcn_logf(fmaxf(f, 1e-30f)) * 0.6931471805599453f; zl[t] = lf; b += lf; if (t == 31) r = b; }
        const float bl = b; r = fmaxf(r, -60.f);
        Dd[(size_t)u * HGW + tid] = ex(bl); Rr[(size_t)u * HGW + tid] = ex(r);
        b = 0.f;
        LAS char* kd = lds + head * TILE_V + ((d >> 5) * 512 + (d & 31) * 2);
#pragma unroll
        for (int t = 0; t < CH; ++t) { const float lf = zl[t]; b += lf; const float kk = 1.f - ex(lf);
            __builtin_amdgcn_raw_buffer_store_b16((short)pk2(kk * ex(fminf(r - b, 80.f)), 0.f), rK, vo, t * HGW * 2, 0);
            __builtin_amdgcn_raw_buffer_store_b16((short)pk2(qv[t] * ex(fminf(b - r, 80.f)), 0.f), rR, vo, t * HGW * 2, 0);
            constexpr int dummy = 0; (void)dummy;
            const int kk_t = (t & ~0xC) | ((t & 4) << 1) | ((t & 8) >> 1);
            *(LAS unsigned short*)(kd + (kk_t >> 3) * 4 * 512 + (kk_t & 7) * 64) = (unsigned short)pk2(kk * ex(bl - b), 0.f); }
    }
    __syncthreads();
#else
__device__ __forceinline__ void h1_unit(const Ctx& X, unsigned char* ws, int u) {
    const int bb = u >> 7, c = u & 127, row0 = bb * SEQ + c * CH, tid = X.tid, lane = X.lane, wave = X.wave;
    float* LFB = (float*)(ws + WS_LF); const bf16* HK = (const bf16*)(ws + WS_HK); const bf16* HV = (const bf16*)(ws + WS_HV);
    float* Dd = (float*)(ws + WS_HD); float* Rr = (float*)(ws + WS_HR); bf16* US = (bf16*)(ws + WS_XB);
    LAS char* lds = (LAS char*)X.lds; LAS float* bl = (LAS float*)(lds + 131072);
    {
        float* col = LFB + (size_t)row0 * HGW + tid; float b = 0.f, r = 0.f;
#pragma unroll 1
        for (int t0 = 0; t0 < CH; t0 += 8) { float x[8];
#pragma unroll
            for (int i = 0; i < 8; ++i) x[i] = col[(size_t)(t0 + i) * HGW];
#pragma unroll
            for (int i = 0; i < 8; ++i) { b += x[i]; col[(size_t)(t0 + i) * HGW] = b; if (t0 + i == 31) r = b; } }
        bl[tid] = b; r = fmaxf(r, -60.f);
        Dd[(size_t)u * HGW + tid] = ex(b); Rr[(size_t)u * HGW + tid] = ex(r);
    }
    asm volatile("s_waitcnt vmcnt(0)" ::: "memory");
    __syncthreads();
#pragma unroll 2
    for (int j = 0; j < 8; ++j) { const int i = tid + 512 * j, head = i >> 10, rem = i & 1023, t = rem >> 4, c8 = (rem & 15) * 8; const size_t g = (size_t)(row0 + t) * HGW + head * 128 + c8;
        const u32x4 kw = *(const u32x4*)(HK + g), vw = *(const u32x4*)(HV + g); const f32x4 b0 = *(const f32x4*)(LFB + g), b1 = *(const f32x4*)(LFB + g + 4);
        const f32x4 l0 = *(const LAS f32x4*)(bl + head * 128 + c8), l1 = *(const LAS f32x4*)(bl + head * 128 + c8 + 4);
        u32x4 o; o.x = pk2(bflo(kw.x) * ex(l0.x - b0.x), bfhi(kw.x) * ex(l0.y - b0.y)); o.y = pk2(bflo(kw.y) * ex(l0.z - b0.z), bfhi(kw.y) * ex(l0.w - b0.w));
        o.z = pk2(bflo(kw.z) * ex(l1.x - b1.x), bfhi(kw.z) * ex(l1.y - b1.y)); o.w = pk2(bflo(kw.w) * ex(l1.z - b1.z), bfhi(kw.w) * ex(l1.w - b1.w));
        *(LAS u32x4*)(lds + head * TILE_V + v_st(t, c8)) = o; *(LAS u32x4*)(lds + 65536 + head * TILE_V + v_st(t, c8)) = vw; }
    __syncthreads();
#endif
    {
        const int head = wave >> 1, db0 = (wave & 1) * 2, r32 = lane & 31, hiC = lane >> 5;
        const int ab = (int)(unsigned)(size_t)(lds + head * TILE_V) + v_rd_base(lane), vb = (int)(unsigned)(size_t)(lds + 65536 + head * TILE_V) + v_rd_base(lane);
        f32x16 acc[2][4];
#pragma unroll
        for (int a = 0; a < 2; ++a)
#pragma unroll
            for (int v = 0; v < 4; ++v) acc[a][v] = f32x16{};
#define FRAG(dst, base, d0, ks) do { s16x4 lo_, hi_; TRRD2(lo_, base, v_rd_off(d0, ks, 0)); TRRD2(hi_, base, v_rd_off(d0, ks, 1)); asm volatile("s_waitcnt lgkmcnt(0)" ::: "memory"); __builtin_amdgcn_sched_barrier(0); \
            dst = (bf16x8){lo_[0], lo_[1], lo_[2], lo_[3], hi_[0], hi_[1], hi_[2], hi_[3]}; } while (0)
#define U_KS(ks) do { bf16x8 a0, a1, b0, b1, b2, b3; \
            if (db0 == 0) { FRAG(a0, ab, 0, ks); FRAG(a1, ab, 1, ks); } else { FRAG(a0, ab, 2, ks); FRAG(a1, ab, 3, ks); } \
            FRAG(b0, vb, 0, ks); FRAG(b1, vb, 1, ks); FRAG(b2, vb, 2, ks); FRAG(b3, vb, 3, ks); \
            acc[0][0] = __builtin_amdgcn_mfma_f32_32x32x16_bf16(a0, b0, acc[0][0], 0, 0, 0); acc[0][1] = __builtin_amdgcn_mfma_f32_32x32x16_bf16(a0, b1, acc[0][1], 0, 0, 0); \
            acc[0][2] = __builtin_amdgcn_mfma_f32_32x32x16_bf16(a0, b2, acc[0][2], 0, 0, 0); acc[0][3] = __builtin_amdgcn_mfma_f32_32x32x16_bf16(a0, b3, acc[0][3], 0, 0, 0); \
            acc[1][0] = __builtin_amdgcn_mfma_f32_32x32x16_bf16(a1, b0, acc[1][0], 0, 0, 0); acc[1][1] = __builtin_amdgcn_mfma_f32_32x32x16_bf16(a1, b1, acc[1][1], 0, 0, 0); \
            acc[1][2] = __builtin_amdgcn_mfma_f32_32x32x16_bf16(a1, b2, acc[1][2], 0, 0, 0); acc[1][3] = __builtin_amdgcn_mfma_f32_32x32x16_bf16(a1, b3, acc[1][3], 0, 0, 0); } while (0)
        U_KS(0); U_KS(1); U_KS(2); U_KS(3);
#undef U_KS
        bf16* Ub = US + ((size_t)(bb * NH + head) * NCH + c) * 16384;
#pragma unroll
        for (int a = 0; a < 2; ++a)
#pragma unroll
            for (int v = 0; v < 4; ++v)
#pragma unroll
                for (int q4 = 0; q4 < 4; ++q4) { const int ks = 2 * (db0 + a) + (q4 >> 1), lanep = (q4 & 1) * 32 + r32;
                    u32x2 w; w.x = pk2(acc[a][v][4 * q4 + 0], acc[a][v][4 * q4 + 1]); w.y = pk2(acc[a][v][4 * q4 + 2], acc[a][v][4 * q4 + 3]);
                    *(u32x2*)(Ub + ((size_t)((ks * 4 + v) * 64 + lanep)) * 8 + 4 * hiC) = w; }
    }
    __syncthreads();
}
#if HG_V2
__device__ __forceinline__ void phase_h1(const Ctx& X, unsigned char* ws, int l) { const float* lbl = (const float*)(ws + WS_MISC + MISC_LB) + l * HGW; for (int u = X.bid; u < 2 * NCH; u += X.nblk) h1_unit(X, ws, u, lbl); }
#else
__device__ __forceinline__ void phase_h1(const Ctx& X, unsigned char* ws, int) { for (int u = X.bid; u < 2 * NCH; u += X.nblk) h1_unit(X, ws, u); }
#endif
__device__ __forceinline__ void phase_h2(const Ctx& X, unsigned char* ws) {
    bf16* US = (bf16*)(ws + WS_XB); const float* Dd = (const float*)(ws + WS_HD); const float* Rr = (const float*)(ws + WS_HR);
    for (int u = X.bid; u < 256; u += X.nblk) {
        if (X.tid < 256) {
            const int bh = u >> 5, slot = u & 31, ks = slot >> 2, bb = bh >> 2, h = bh & 3, lanep = X.tid >> 2, j = 2 * (X.tid & 3), d = 16 * ks + 8 * (lanep >> 5) + j;
            unsigned* p = (unsigned*)(US + (size_t)bh * US_BH + (size_t)slot * 512 + 2 * X.tid);
            const float* dp = Dd + (size_t)bb * NCH * HGW + h * 128 + d; const float* rp = Rr + (size_t)bb * NCH * HGW + h * 128 + d;
            float s0 = 0.f, s1 = 0.f;
#pragma unroll 1
            for (int c0 = 0; c0 < NCH; c0 += 8) { unsigned uw[8]; float2 dv[8], rv[8];
#pragma unroll
                for (int i = 0; i < 8; ++i) { uw[i] = p[(size_t)(c0 + i) * 8192]; dv[i] = *(const float2*)(dp + (size_t)(c0 + i) * HGW); rv[i] = *(const float2*)(rp + (size_t)(c0 + i) * HGW); }
#pragma unroll
                for (int i = 0; i < 8; ++i) { p[(size_t)(c0 + i) * 8192] = pk2(rv[i].x * s0, rv[i].y * s1); s0 = dv[i].x * s0 + bflo(uw[i]); s1 = dv[i].y * s1 + bfhi(uw[i]); } }
        }
    }
}
__device__ __forceinline__ void h3_unit(const Ctx& X, unsigned char* ws, const float* onorm, int u) {
    const int bb = u >> 7, c = u & 127, row0 = bb * SEQ + c * CH, tid = X.tid, lane = X.lane, wave = X.wave;
    const float* LFB = (const float*)(ws + WS_LF); const bf16* HQ = (const bf16*)(ws + WS_HQ); const bf16* HK = (const bf16*)(ws + WS_HK); const bf16* HV = (const bf16*)(ws + WS_HV); const bf16* HG = (const bf16*)(ws + WS_HG);
    const bf16* US = (const bf16*)(ws + WS_XB); bf16* CC = (bf16*)(ws + WS_CC);
    LAS char* lds = (LAS char*)X.lds;
#if HG_V2
    const bf16* KRB = (const bf16*)(ws + WS_LF); const bf16* QRB = (const bf16*)(ws + WS_LF + 16 * MiB);
    const int head = wave >> 1, th = wave & 1, r32 = lane & 31, hi = lane >> 5, trow = row0 + 32 * th + r32;
    bf16x8 qr[8];
    { const int t0 = tid >> 4, c8 = (tid & 15) * 8; const size_t g0 = (size_t)(row0 + t0) * HGW + c8; const int kst0 = t0 * KROW2 + c8 * 2, vst0 = 4 * TILE_K2 + v_st(t0, c8);
      u32x4 kw[8], vw[8];
#pragma unroll
      for (int j = 0; j < 8; ++j) { const size_t g = g0 + (size_t)((j & 1) * 32 * HGW + (j >> 1) * 128); kw[j] = *(const u32x4*)(KRB + g); vw[j] = *(const u32x4*)(HV + g); }
      const size_t gq = (size_t)trow * HGW + head * 128 + hi * 8;
#pragma unroll
      for (int d0 = 0; d0 < 8; ++d0) qr[d0] = *reinterpret_cast<const bf16x8*>(QRB + gq + d0 * 16);
#pragma unroll
      for (int j = 0; j < 8; ++j) { *(LAS u32x4*)(lds + kst0 + (j >> 1) * TILE_K2 + (j & 1) * 32 * KROW2) = kw[j]; *(LAS u32x4*)(lds + vst0 + (j >> 1) * TILE_V + (j & 1) * 8192) = vw[j]; } }
#else
#pragma unroll 2
    for (int j = 0; j < 8; ++j) { const int i = tid + 512 * j, head = i >> 10, rem = i & 1023, t = rem >> 4, c8 = (rem & 15) * 8; const size_t g = (size_t)(row0 + t) * HGW + head * 128 + c8, gr = (size_t)(row0 + 31) * HGW + head * 128 + c8;
        const u32x4 kw = *(const u32x4*)(HK + g), vw = *(const u32x4*)(HV + g); const f32x4 b0 = *(const f32x4*)(LFB + g), b1 = *(const f32x4*)(LFB + g + 4); f32x4 r0 = *(const f32x4*)(LFB + gr), r1 = *(const f32x4*)(LFB + gr + 4);
#define KE(rr, bv) ex(fminf(fmaxf((rr), -60.f) - (bv), 80.f))
        u32x4 o; o.x = pk2(bflo(kw.x) * KE(r0.x, b0.x), bfhi(kw.x) * KE(r0.y, b0.y)); o.y = pk2(bflo(kw.y) * KE(r0.z, b0.z), bfhi(kw.y) * KE(r0.w, b0.w));
        o.z = pk2(bflo(kw.z) * KE(r1.x, b1.x), bfhi(kw.z) * KE(r1.y, b1.y)); o.w = pk2(bflo(kw.w) * KE(r1.z, b1.z), bfhi(kw.w) * KE(r1.w, b1.w));
#undef KE
        *(LAS u32x4*)(lds + head * TILE_K2 + t * KROW2 + c8 * 2) = o; *(LAS u32x4*)(lds + 4 * TILE_K2 + head * TILE_V + v_st(t, c8)) = vw; }
    const int head = wave >> 1, th = wave & 1, r32 = lane & 31, hi = lane >> 5, trow = row0 + 32 * th + r32;
    bf16x8 qr[8];
    {
        const size_t g = (size_t)trow * HGW + head * 128 + hi * 8, gr = (size_t)(row0 + 31) * HGW + head * 128 + hi * 8;
#pragma unroll
        for (int d0 = 0; d0 < 8; ++d0) { const u32x4 qw = *(const u32x4*)(HQ + g + d0 * 16); const f32x4 b0 = *(const f32x4*)(LFB + g + d0 * 16), b1 = *(const f32x4*)(LFB + g + d0 * 16 + 4), r0 = *(const f32x4*)(LFB + gr + d0 * 16), r1 = *(const f32x4*)(LFB + gr + d0 * 16 + 4);
#define QE(bv, rr) ex(fminf((bv) - fmaxf((rr), -60.f), 80.f))
            u32x4 o; o.x = pk2(bflo(qw.x) * QE(b0.x, r0.x), bfhi(qw.x) * QE(b0.y, r0.y)); o.y = pk2(bflo(qw.y) * QE(b0.z, r0.z), bfhi(qw.y) * QE(b0.w, r0.w));
            o.z = pk2(bflo(qw.z) * QE(b1.x, r1.x), bfhi(qw.z) * QE(b1.y, r1.y)); o.w = pk2(bflo(qw.w) * QE(b1.z, r1.z), bfhi(qw.w) * QE(b1.w, r1.w));
#undef QE
            qr[d0] = __builtin_bit_cast(bf16x8, o); }
    }
#endif
    __syncthreads();
    f32x16 p0 = f32x16{}, p1 = f32x16{};
    { const LAS char* kb = lds + head * TILE_K2 + r32 * KROW2 + hi * 16;
#pragma unroll
      for (int d0 = 0; d0 < 8; ++d0) { const bf16x8 k0 = *reinterpret_cast<const LAS bf16x8*>(kb + d0 * 32); p0 = __builtin_amdgcn_mfma_f32_32x32x16_bf16(k0, qr[d0], p0, 0, 0, 0);
          if (th) { const bf16x8 k1 = *reinterpret_cast<const LAS bf16x8*>(kb + d0 * 32 + 32 * KROW2); p1 = __builtin_amdgcn_mfma_f32_32x32x16_bf16(k1, qr[d0], p1, 0, 0, 0); } } }
    { const int tq = 32 * th + r32 - 4 * hi;
#pragma unroll
      for (int r = 0; r < 16; ++r) { const int cr = (r & 3) + 8 * (r >> 2); if (tq - cr < 0) p0[r] = 0.f; if (tq - cr - 32 < 0) p1[r] = 0.f; } }
    bf16x8 pa0, pa1, pa2, pa3;
#define PK4(P, B_, OUT) do { unsigned a0 = cvtpk(P[B_+0], P[B_+1]), a1 = cvtpk(P[B_+2], P[B_+3]);                          \
        unsigned b0 = cvtpk(P[B_+4], P[B_+5]), b1 = cvtpk(P[B_+6], P[B_+7]);                                             \
        auto r0 = __builtin_amdgcn_permlane32_swap(a0, b0, false, false); auto r1 = __builtin_amdgcn_permlane32_swap(a1, b1, false, false); \
        u32x4 w = {r0[0], r1[0], r0[1], r1[1]}; OUT = *reinterpret_cast<bf16x8*>(&w); } while (0)
    PK4(p0, 0, pa0); PK4(p0, 8, pa1); PK4(p1, 0, pa2); PK4(p1, 8, pa3);
#undef PK4
    f32x16 o[4] = {};
    { const int vb = (int)(unsigned)(size_t)(lds + 4 * TILE_K2 + head * TILE_V) + v_rd_base(lane);
#define PV(d0) do { bf16x8 f0, f1, f2, f3; FRAG(f0, vb, d0, 0); FRAG(f1, vb, d0, 1); FRAG(f2, vb, d0, 2); FRAG(f3, vb, d0, 3); \
        o[d0] = __builtin_amdgcn_mfma_f32_32x32x16_bf16(pa0, f0, o[d0], 0, 0, 0); o[d0] = __builtin_amdgcn_mfma_f32_32x32x16_bf16(pa1, f1, o[d0], 0, 0, 0); \
        o[d0] = __builtin_amdgcn_mfma_f32_32x32x16_bf16(pa2, f2, o[d0], 0, 0, 0); o[d0] = __builtin_amdgcn_mfma_f32_32x32x16_bf16(pa3, f3, o[d0], 0, 0, 0); } while (0)
      PV(0); PV(1); PV(2); PV(3);
#undef PV
    }
    { const bf16* Sb = US + ((size_t)(bb * NH + head) * NCH + c) * 16384 + (size_t)lane * 8;
#pragma unroll
      for (int vb = 0; vb < 4; ++vb)
#pragma unroll
          for (int ks = 0; ks < 8; ++ks) { const bf16x8 sf = *reinterpret_cast<const bf16x8*>(Sb + (size_t)(ks * 4 + vb) * 512); o[vb] = __builtin_amdgcn_mfma_f32_32x32x16_bf16(qr[ks], sf, o[vb], 0, 0, 0); } }
    float rs[16];
#pragma unroll
    for (int r = 0; r < 16; ++r) { float q = o[0][r] * o[0][r] + o[1][r] * o[1][r] + o[2][r] * o[2][r] + o[3][r] * o[3][r];
        q += __shfl_xor(q, 1); q += __shfl_xor(q, 2); q += __shfl_xor(q, 4); q += __shfl_xor(q, 8); q += __shfl_xor(q, 16); rs[r] = rsqrtf(q * (1.f / 128.f) + EPS); }
#pragma unroll
    for (int vb = 0; vb < 4; ++vb) { const float gn = onorm[32 * vb + r32];
#pragma unroll
        for (int r = 0; r < 16; ++r) { const size_t row = (size_t)(row0 + 32 * th + crow(r, hi));
            const float g = bf2f(HG[row * HGW + head * 128 + 32 * vb + r32]); const float val = o[vb][r] * rs[r] * gn * siluf_(g); const float vn = __shfl_xor(val, 1);
            if ((r32 & 1) == 0) *(unsigned*)(CC + row * DM + 512 + head * 128 + 32 * vb + r32) = cvtpk(val, vn); } }
    __syncthreads();
}
#undef FRAG
#undef TRRD2
__device__ __forceinline__ void phase_h3(const Ctx& X, unsigned char* ws, const float* onorm) { for (int u = X.bid; u < 2 * NCH; u += X.nblk) h3_unit(X, ws, onorm, u); }
}

__device__ __forceinline__ void phase_hgrn_simple(const Ctx& X, const Params& p) {
    unsigned char* ws = p.ws;
    const bf16* HQ = (const bf16*)(ws + WS_HQ); const bf16* HK = (const bf16*)(ws + WS_HK); const bf16* HV = (const bf16*)(ws + WS_HV); const float* LF = (const float*)(ws + WS_LF);
    float* OB = (float*)(ws + WS_XB);
    for (int bh = X.bid; bh < 2 * NH; bh += X.nblk) {
        if (X.tid < 256) {
            const int v = X.tid >> 1, hf = X.tid & 1, b = bh >> 2, h = bh & 3;
            float S[64];
#pragma unroll
            for (int j = 0; j < 64; ++j) S[j] = 0.f;
            for (int t = 0; t < SEQ; ++t) {
                const size_t base = ((size_t)(b * SEQ + t)) * HGW + h * 128;
                const float vt = bf2f(HV[base + v]);
                float o = 0.f;
#pragma unroll
                for (int j8 = 0; j8 < 8; ++j8) {
                    const size_t bj = base + 64 * hf + 8 * j8;
                    const f32x4 f0 = *(const f32x4*)(LF + bj), f1 = *(const f32x4*)(LF + bj + 4);
                    const u32x4 kw = *(const u32x4*)(HK + bj), qw = *(const u32x4*)(HQ + bj);
#define HSTEP(J, lf, kk, qq) do { S[8 * j8 + J] = fast_exp(lf) * S[8 * j8 + J] + (kk) * vt; o += (qq) * S[8 * j8 + J]; } while (0)
                    HSTEP(0, f0.x, bflo(kw.x), bflo(qw.x)); HSTEP(1, f0.y, bfhi(kw.x), bfhi(qw.x)); HSTEP(2, f0.z, bflo(kw.y), bflo(qw.y)); HSTEP(3, f0.w, bfhi(kw.y), bfhi(qw.y));
                    HSTEP(4, f1.x, bflo(kw.z), bflo(qw.z)); HSTEP(5, f1.y, bfhi(kw.z), bfhi(qw.z)); HSTEP(6, f1.z, bflo(kw.w), bflo(qw.w)); HSTEP(7, f1.w, bfhi(kw.w), bfhi(qw.w));
#undef HSTEP
                }
                o += __shfl_xor(o, 1);
                if (hf == 0) OB[base + v] = o;
            }
        }
    }
}
__device__ __forceinline__ void phase_hgrn_out(const Ctx& X, const Params& p, int l) {
    unsigned char* ws = p.ws;
    const float* OB = (const float*)(ws + WS_XB); const bf16* HG = (const bf16*)(ws + WS_HG); bf16* CC = (bf16*)(ws + WS_CC); const float* on = p.in[I_HON] + l * 128;
    const int gw = X.bid * NWAVES + X.wave, ngw = X.nblk * NWAVES, lane = X.lane;
    for (int i = gw; i < T * NH; i += ngw) {
        const int row = i >> 2, h = i & 3; const size_t base = (size_t)row * HGW + h * 128 + 2 * lane;
        const float o0 = OB[base], o1 = OB[base + 1];
        const float rstd = rsqrtf(wave_sum(o0 * o0 + o1 * o1) * (1.f / 128.f) + EPS);
        const unsigned gw2 = *(const unsigned*)(HG + base);
        *(unsigned*)(CC + (size_t)row * DM + 512 + h * 128 + 2 * lane) = pk2(o0 * rstd * on[2 * lane] * siluf_(bflo(gw2)), o1 * rstd * on[2 * lane + 1] * siluf_(bfhi(gw2)));
    }
}

template <class TS>
__device__ __forceinline__ void phase_norm(const Ctx& X, const Params& p, const TS* src, const float* gain) { norm_all_rows(X, src, gain, (bf16*)(p.ws + WS_XB)); }
template <class TS>
__device__ __forceinline__ void phase_norm_route(const Ctx& X, const Params& p, const TS* src, const float* gain) {
    unsigned char* ws = p.ws;
    int* GCNT = (int*)(ws + WS_MISC + MISC_GCNT); int* TOPI = (int*)(ws + WS_MISC + MISC_TOPI); float* TOPG = (float*)(ws + WS_MISC + MISC_TOPG);
    const float* wr = p.in[I_ROUTER];
    LAS int* wcnt = (LAS int*)(X.lds);
    const int lane = X.lane, b5 = lane >> 5, b4 = (lane >> 4) & 1, b3 = (lane >> 3) & 1;
    f32x4 w0[4][4], w1[4][4], gn[4];
#pragma unroll
    for (int j = 0; j < 4; ++j) { gn[j] = *((const f32x4*)gain + lane + 64 * j);
#pragma unroll
        for (int q = 0; q < 4; ++q) { const float* wp = wr + (size_t)(4 * (lane + 64 * j) + q) * NE; w0[j][q] = *(const f32x4*)wp; w1[j][q] = *(const f32x4*)(wp + 4); } }
    for (int g = X.bid; g < T / 64; g += X.nblk) {
        int cn[NE];
#pragma unroll
        for (int e = 0; e < NE; ++e) cn[e] = 0;
#pragma unroll 1
        for (int bt = 0; bt < 4; ++bt) {
            const int rbase = g * 64 + X.wave * 8 + 2 * bt;
            f32x4 v[2][4];
#pragma unroll
            for (int i = 0; i < 2; ++i)
#pragma unroll
                for (int j = 0; j < 4; ++j) v[i][j] = ldrow4(src + (size_t)(rbase + i) * DM, lane + 64 * j);
#pragma unroll
            for (int i = 0; i < 2; ++i) { const int row = rbase + i; float s = 0.f;
#pragma unroll
                for (int j = 0; j < 4; ++j) s += (v[i][j].x * v[i][j].x + v[i][j].y * v[i][j].y) + (v[i][j].z * v[i][j].z + v[i][j].w * v[i][j].w);
                const float rstd = __builtin_amdgcn_rsqf(wave_sum(s) * (1.f / DM) + EPS);
                float lg[NE];
#pragma unroll
                for (int e = 0; e < NE; ++e) lg[e] = 0.f;
#pragma unroll
                for (int j = 0; j < 4; ++j) { const f32x4 y = v[i][j] * rstd * gn[j];
                    *((unsigned*)((unsigned char*)(ws + WS_XB) + (size_t)row * DM) + lane + 64 * j) = pk4_fp8(y.x, y.y, y.z, y.w);
#pragma unroll
                    for (int q = 0; q < 4; ++q) { const float yv = (q == 0) ? y.x : (q == 1) ? y.y : (q == 2) ? y.z : y.w;
                        lg[0] += yv * w0[j][q].x; lg[1] += yv * w0[j][q].y; lg[2] += yv * w0[j][q].z; lg[3] += yv * w0[j][q].w; lg[4] += yv * w1[j][q].x; lg[5] += yv * w1[j][q].y; lg[6] += yv * w1[j][q].z; lg[7] += yv * w1[j][q].w; } }
                float k4[4], k2[2], k1;
#pragma unroll
                for (int t = 0; t < 4; ++t) { const float keep = b5 ? lg[4 + t] : lg[t], send = b5 ? lg[t] : lg[4 + t]; k4[t] = keep + __shfl_xor(send, 32); }
#pragma unroll
                for (int t = 0; t < 2; ++t) { const float keep = b4 ? k4[2 + t] : k4[t], send = b4 ? k4[t] : k4[2 + t]; k2[t] = keep + __shfl_xor(send, 16); }
                { const float keep = b3 ? k2[1] : k2[0], send = b3 ? k2[0] : k2[1]; k1 = keep + __shfl_xor(send, 8); }
                k1 += __shfl_xor(k1, 4); k1 += __shfl_xor(k1, 2); k1 += __shfl_xor(k1, 1);
                float tl[NE];
#pragma unroll
                for (int e = 0; e < NE; ++e) tl[e] = __int_as_float(__builtin_amdgcn_readlane(__float_as_int(k1), (e >> 2) * 32 + ((e >> 1) & 1) * 16 + (e & 1) * 8));
                int e1 = 0; float l1 = tl[0];
#pragma unroll
                for (int e = 1; e < NE; ++e) if (tl[e] > l1) { l1 = tl[e]; e1 = e; }
                int e2 = -1; float l2 = -3.0e38f;
#pragma unroll
                for (int e = 0; e < NE; ++e) if (e != e1 && tl[e] > l2) { l2 = tl[e]; e2 = e; }
#pragma unroll
                for (int e = 0; e < NE; ++e) cn[e] += (e == e1) + (e == e2);
                if (lane == 0) { const float g1 = 1.f / (1.f + expf(l2 - l1)); TOPI[row * 2] = e1; TOPI[row * 2 + 1] = e2; TOPG[row * 2] = g1; TOPG[row * 2 + 1] = 1.f - g1; }
            }
        }
        if (lane == 0) {
#pragma unroll
            for (int e = 0; e < NE; ++e) wcnt[X.wave * NE + e] = cn[e]; }
        __syncthreads();
        if (X.tid < NE) { int t = 0;
#pragma unroll
            for (int w = 0; w < NWAVES; ++w) t += wcnt[w * NE + X.tid];
            GCNT[g * NE + X.tid] = t; }
        __syncthreads();
    }
}
__device__ __forceinline__ void phase_scatter(const Ctx& X, const Params& p) {
    unsigned char* ws = p.ws;
    const int* GCNT = (const int*)(ws + WS_MISC + MISC_GCNT); const int* TOPI = (const int*)(ws + WS_MISC + MISC_TOPI); int* POS = (int*)(ws + WS_MISC + MISC_POS);
    int* TILE_E = (int*)(ws + WS_MISC + MISC_TILE_E); int* NT = (int*)(ws + WS_MISC + MISC_NT);
    const unsigned char* XF = (const unsigned char*)(ws + WS_XB); unsigned char* XS = (unsigned char*)(ws + WS_XS);
    LAS int* gc = (LAS int*)(X.lds);
    LAS int* pstart = gc + 256 * NE;
    LAS int* ntot = pstart + 8;
    LAS int* basel = ntot + 8;
    LAS int* posl = basel + 8;
    for (int i = X.tid; i < 256 * NE; i += NTHREADS) gc[i] = GCNT[i];
    __syncthreads();
    { const int e = X.wave; int n = 0;
#pragma unroll
      for (int k = 0; k < 4; ++k) n += gc[(X.lane + 64 * k) * NE + e];
#pragma unroll
      for (int o = 1; o < 64; o <<= 1) n += __shfl_xor(n, o);
      if (X.lane == 0) ntot[e] = n; }
    __syncthreads();
    if (X.tid == 0) { int acc = 0;
        for (int e = 0; e < NE; ++e) { pstart[e] = acc; const int nt = (ntot[e] + 255) >> 8; if (X.bid == 0) for (int t = 0; t < nt; ++t) TILE_E[(acc >> 8) + t] = e; acc += nt * 256; }
        if (X.bid == 0) NT[0] = acc >> 8; }
    __syncthreads();
    for (int g = X.bid; g < T / 64; g += X.nblk) {
        { const int e = X.wave; int n = 0;
#pragma unroll
          for (int k = 0; k < 4; ++k) { const int gg = X.lane + 64 * k; n += (gg < g) ? gc[gg * NE + e] : 0; }
#pragma unroll
          for (int o = 1; o < 64; o <<= 1) n += __shfl_xor(n, o);
          if (X.lane == 0) basel[e] = pstart[e] + n; }
        __syncthreads();
        if (X.wave == 0) {
            const int row = g * 64 + X.lane; const int e1 = TOPI[row * 2], e2 = TOPI[row * 2 + 1];
            int p1 = 0, p2 = 0;
            const unsigned long long lt = (1ull << X.lane) - 1ull;
#pragma unroll
            for (int e = 0; e < NE; ++e) {
                const int base = basel[e];
                const unsigned long long m1 = __ballot(e1 == e), m2 = __ballot(e2 == e);
                if (e1 == e) p1 = base + __popcll(m1 & lt);
                if (e2 == e) p2 = base + __popcll(m1) + __popcll(m2 & lt);
            }
            POS[row * 2] = p1; POS[row * 2 + 1] = p2; posl[X.lane * 2] = p1; posl[X.lane * 2 + 1] = p2;
        }
        __syncthreads();
        { u32x4 a[8];
#pragma unroll
          for (int i = 0; i < 8; ++i) a[i] = ((const u32x4*)(XF + (size_t)(g * 64 + X.wave * 8 + i) * DM))[X.lane];
#pragma unroll
          for (int i = 0; i < 8; ++i) { const int r = X.wave * 8 + i; ((u32x4*)(XS + (size_t)posl[r * 2] * DM))[X.lane] = a[i]; ((u32x4*)(XS + (size_t)posl[r * 2 + 1] * DM))[X.lane] = a[i]; } }
        __syncthreads();
    }
}
template <class TS>
__device__ __forceinline__ void phase_combine(const Ctx& X, const Params& p, const TS* xr) {
    unsigned char* ws = p.ws;
    const int* POS = (const int*)(ws + WS_MISC + MISC_POS); const float* TOPG = (const float*)(ws + WS_MISC + MISC_TOPG); const bf16* YS = (const bf16*)(ws + WS_YS);
    const float* fn = p.in[I_FINN];
    const int gw = X.bid * NWAVES + X.wave, ngw = X.nblk * NWAVES, lane = X.lane;
    f32x4 gf[4];
#pragma unroll
    for (int j = 0; j < 4; ++j) gf[j] = *((const f32x4*)fn + lane + 64 * j);
    for (int r0 = gw; r0 < T; r0 += 2 * ngw) {
        int pp[2][2]; float gg[2][2]; f32x4 v[2][4]; u32x2 ya[2][4], yb[2][4];
#pragma unroll
        for (int i = 0; i < 2; ++i) { const int row = (r0 + i * ngw < T) ? r0 + i * ngw : r0; pp[i][0] = POS[row * 2]; pp[i][1] = POS[row * 2 + 1]; gg[i][0] = TOPG[row * 2]; gg[i][1] = TOPG[row * 2 + 1];
#pragma unroll
            for (int j = 0; j < 4; ++j) v[i][j] = ldrow4(xr + (size_t)row * DM, lane + 64 * j); }
#pragma unroll
        for (int i = 0; i < 2; ++i)
#pragma unroll
            for (int j = 0; j < 4; ++j) { ya[i][j] = *((const u32x2*)(YS + (size_t)pp[i][0] * DM) + lane + 64 * j); yb[i][j] = *((const u32x2*)(YS + (size_t)pp[i][1] * DM) + lane + 64 * j); }
#if DN_SPLITK
#pragma unroll
        for (int i = 0; i < 2; ++i)
#pragma unroll
            for (int k = 0; k < 2; ++k) { const int pos = pp[i][k];
                if (pos >= 128 * 256) { const float* sl = (const float*)(ws + WS_SLAB) + ((size_t)(((pos >> 8) - 128) * 4) * 7 * 256 + (pos & 255)) * 256 + 4 * lane;
#pragma unroll
                    for (int j = 0; j < 4; ++j) { f32x4 acc = *(const f32x4*)(sl + (size_t)(j * 7) * 65536);
#pragma unroll
                        for (int q = 1; q < 7; ++q) acc = acc + *(const f32x4*)(sl + (size_t)(j * 7 + q) * 65536);
                        u32x2 w; w.x = pk2(acc.x, acc.y); w.y = pk2(acc.z, acc.w); if (k == 0) ya[i][j] = w; else yb[i][j] = w; } } }
#endif
#pragma unroll
        for (int i = 0; i < 2; ++i) { const int row = (r0 + i * ngw < T) ? r0 + i * ngw : r0; const float g1 = gg[i][0], g2 = gg[i][1]; float s = 0.f;
#pragma unroll
            for (int j = 0; j < 4; ++j) { const u32x2 a = ya[i][j], b = yb[i][j]; f32x4& x = v[i][j];
                x.x += g1 * bflo(a.x) + g2 * bflo(b.x); x.y += g1 * bfhi(a.x) + g2 * bfhi(b.x); x.z += g1 * bflo(a.y) + g2 * bflo(b.y); x.w += g1 * bfhi(a.y) + g2 * bfhi(b.y);
                s += (x.x * x.x + x.y * x.y) + (x.z * x.z + x.w * x.w); }
            const float rstd = __builtin_amdgcn_rsqf(wave_sum(s) * (1.f / DM) + EPS);
#pragma unroll
            for (int j = 0; j < 4; ++j) *((f32x4*)(p.out + (size_t)row * DM) + lane + 64 * j) = v[i][j] * rstd * gf[j]; }
    }
}

__device__ __forceinline__ bool relaunder(Ctx& X, unsigned char*& ws, const Params& p) {
    int t = threadIdx.x; asm volatile("" : "+v"(t)); X.tid = t; X.lane = t & 63; X.wave = __builtin_amdgcn_readfirstlane(t >> 6);
    unsigned long long w = (unsigned long long)p.ws; asm volatile("" : "+s"(w)); ws = (unsigned char*)(GAS unsigned char*)w;
    return true;
}
constexpr int NPHASES = 26;
#define PHASE(k) relaunder(X, ws, p)
#define SEAM(k) xcd_barrier(bar)
template <int L>
__device__ __forceinline__ void run_layer(Ctx& X, const Params& p, const XcdBarrier& bar) {
    unsigned char* ws;
#if XR_BF16
    xr_t* XR = (xr_t*)(p.ws + WS_XRB);
#else
    xr_t* XR = p.out;
#endif
    PHASE(pb + 0); {
        EpiProj E{ws, L, (FUSE_NORM && L == 1) ? (int)MISC_SSXB : 0};
        gemm_dense(X, (FUSE_NORM && L == 1) ? (const bf16*)XR : (const bf16*)(ws + WS_XB), (const bf16*)(ws + WS_WT_IN) + (size_t)L * NPROJ_P * DM, NPROJ_P, DM, E);
#ifdef PROBE_INPROJ_NOEPI
        { EpiProbe EP{(float*)(ws + WS_CC)}; gemm_dense(X, (const bf16*)(ws + WS_XB), (const bf16*)(ws + WS_WT_IN) + (size_t)L * NPROJ_P * DM, NPROJ_P, DM, EP); }
#endif
    } SEAM(pb + 0);
    PHASE(pb + 1); {
        EpiQ EQ{ws}; EpiKV EK{ws};
        REP_X(REP_QKV, gemm_dense(X, (const bf16*)(ws + WS_CQ), (const bf16*)(ws + WS_WT_QB) + (size_t)L * (NH * DQK) * QR, NH * DQK, QR, EQ);
        gemm_dense(X, (const bf16*)(ws + WS_CKV), (const bf16*)(ws + WS_WT_KVB) + (size_t)L * 1024 * KVR, 1024, KVR, EK);)
#if FAST_HGRN
        hg::phase_h1(X, ws, L);
#endif
    } SEAM(pb + 1);
#if FAST_ATTN
    PHASE(pb + 2); {
#if FAST_HGRN
        hg::phase_h2(X, ws);
#endif
        REP_X(REP_ATTN, phase_attn_fast(X, ws);) } SEAM(pb + 2);
#else
    PHASE(pb + 2); { phase_attn_simple(X, p); } SEAM(pb + 2);
#endif
#if !FAST_HGRN
    PHASE(pb + 3); { phase_hgrn_simple(X, p); } SEAM(pb + 3);
#endif
#if FAST_ATTN
#if FAST_HGRN
    PHASE(pb + 4); { phase_attn_combine(X, ws); REP_X(REP_H3, hg::phase_h3(X, ws, p.in[I_HON] + L * 128);) } SEAM(pb + 4);
#else
    PHASE(pb + 4); { phase_attn_combine(X, ws); phase_hgrn_out(X, p, L); } SEAM(pb + 4);
#endif
#else
    PHASE(pb + 4); { phase_hgrn_out(X, p, L); } SEAM(pb + 4);
#endif
    PHASE(pb + 5); {
#if FUSE_NORM
        if (L == 0) { EpiResNormT<float> E{p.in[I_X], XR, (float*)(ws + WS_MISC + MISC_SSXA), 0.f, (LAS float*)(X.lds + 131072)}; gemm_dense(X, (const bf16*)(ws + WS_CC), (const bf16*)(ws + WS_WT_OUT) + (size_t)L * DM * DM, DM, DM, E); }
#else
        if (L == 0) { EpiResT<float, xr_t> E{p.in[I_X], XR}; gemm_dense(X, (const bf16*)(ws + WS_CC), (const bf16*)(ws + WS_WT_OUT) + (size_t)L * DM * DM, DM, DM, E); }
#endif
        else { EpiResT<xr_t, xr_t> E{XR, XR}; gemm_dense(X, (const bf16*)(ws + WS_CC), (const bf16*)(ws + WS_WT_OUT) + (size_t)L * DM * DM, DM, DM, E); }
    } SEAM(pb + 5);
#if FUSE_NORM
    if (L == 1) { PHASE(pb + 6); { phase_norm_route(X, p, XR, p.in[I_FFNN] + DM); } SEAM(pb + 6); }
    if (L == 0) {
        PHASE(8); { EpiSwiglu E{(bf16*)(ws + WS_HID), FF0, 0, (const float*)(ws + WS_MISC + MISC_SSXA)};
            gemm_dense(X, (const bf16*)XR, (const bf16*)(ws + WS_WT_GU), 2 * FF0, DM, E);
#ifdef PROBE_GU_NOEPI
            { EpiProbe EP{(float*)(ws + WS_CC)}; gemm_dense(X, (const bf16*)XR, (const bf16*)(ws + WS_WT_GU), 2 * FF0, DM, EP); }
#endif
            } SEAM(8);
        PHASE(9); { EpiResNormT<xr_t> E{XR, XR, (float*)(ws + WS_MISC + MISC_SSXB), 0.f, (LAS float*)(X.lds + 131072)};
            gemm_dense(X, (const bf16*)(ws + WS_HID), (const bf16*)(ws + WS_WT_DN), DM, FF0, E); } SEAM(9);
    }
#else
    PHASE(pb + 6); { if (L == 0) { phase_norm(X, p, XR, p.in[I_FFNN]); } else { phase_norm_route(X, p, XR, p.in[I_FFNN] + DM); } } SEAM(pb + 6);
    if (L == 0) {
        PHASE(8); { EpiSwiglu E{(bf16*)(ws + WS_HID), FF0, 0, nullptr};
            gemm_dense(X, (const bf16*)(ws + WS_XB), (const bf16*)(ws + WS_WT_GU), 2 * FF0, DM, E); } SEAM(8);
        PHASE(9); { EpiResT<xr_t, xr_t> E{XR, XR};
            gemm_dense(X, (const bf16*)(ws + WS_HID), (const bf16*)(ws + WS_WT_DN), DM, FF0, E); } SEAM(9);
        PHASE(10); { phase_norm(X, p, XR, p.in[I_MIXN] + DM); } SEAM(10);
    }
#endif
}

__global__ void __launch_bounds__(NTHREADS, 2) mega(Params p) {
    extern __shared__ __attribute__((aligned(16))) unsigned char lds_raw[];
    Ctx X; X.tid = threadIdx.x; X.lane = X.tid & 63; X.wave = __builtin_amdgcn_readfirstlane(X.tid >> 6); X.bid = blockIdx.x; X.nblk = gridDim.x; X.lds = (LAS unsigned char*)lds_raw;
    unsigned char* ws = p.ws;
    volatile LAS unsigned* MISC = (volatile LAS unsigned*)(X.lds + LDS_MISC_OFF);
    if (X.tid < 32) MISC[X.tid] = 0u;
    __syncthreads();
    const XcdBarrier bar = xcd_barrier_post((unsigned*)(ws + WS_CTL) + CW_BAR, MISC + 8);

    PHASE(0); { REP_X(REP_PRO, phase_prologue(X, p);) } SEAM(0);
    run_layer<0>(X, p, bar);
    run_layer<1>(X, p, bar);
    PHASE(18); { REP_X(REP_ROUTE, phase_scatter(X, p);) } SEAM(18);
#if MOE_FP8
    PHASE(19); { const int* NTp = (const int*)(ws + WS_MISC + MISC_NT); const int* TILE_E = (const int*)(ws + WS_MISC + MISC_TILE_E); const int nt = NTp[0];
        EpiSwiglu8 E{(unsigned char*)(ws + WS_HIDM), FFM, 0};
        REP_X(REP_MOEGU, gemm_moe(X, (const bf16*)(ws + WS_XS), (const bf16*)(ws + WS_WT_MGU), 0, nt, 2 * FFM, DM / 2, TILE_E, 0, 0x79797979, E);) } SEAM(19);
    PHASE(20); { const int* NTp = (const int*)(ws + WS_MISC + MISC_NT); const int* TILE_E = (const int*)(ws + WS_MISC + MISC_TILE_E); const int nt = NTp[0];
        EpiBf16Plain E{(bf16*)(ws + WS_YS), DM};
#if DN_SPLITK
        const int nfull = nt < 128 ? nt : 128;
        gemm_moe(X, (const bf16*)(ws + WS_HIDM), (const bf16*)(ws + WS_WT_MDN), 0, nfull, DM, FFM / 2, TILE_E, 0, 0x78787878, E);
        { const int nsub = (nt - nfull) * 4 * 7, sidx = (int)X.bid;
          pg8::OneUnit S1; S1.have = sidx < nsub;
          const int ks = sidx % 7, up = sidx / 7, pn = up & 3, pm = nfull + (up >> 2);
          S1.u.pm = pm; S1.u.pn = pn; S1.u.pa = pm; S1.u.pb = (S1.have ? __builtin_amdgcn_readfirstlane(TILE_E[pm]) : 0) * 4 + pn;
          pg8::Gemm g1{(const bf16*)(ws + WS_HIDM + (size_t)ks * 512), (const bf16*)(ws + WS_WT_MDN + (size_t)ks * 512), 256, DM, 256, 0x78787878, FFM / 2};
          EpiSlab E1{(float*)(ws + WS_SLAB), ks};
          pg8::gemm_phase<EpiSlab, pg8::OneUnit, true, true, true>(X.lds, g1, S1, E1); }
        } SEAM(20);
#else
        REP_X(REP_MOEDN, gemm_moe(X, (const bf16*)(ws + WS_HIDM), (const bf16*)(ws + WS_WT_MDN), 0, nt, DM, FFM / 2, TILE_E, 0, 0x78787878, E);) } SEAM(20);
#endif
#else
    for (int c = 0; c < 3; ++c) {
        PHASE(19 + 2 * c); { const int* NTp = (const int*)(ws + WS_MISC + MISC_NT); const int* TILE_E = (const int*)(ws + WS_MISC + MISC_TILE_E);
            const int nt = NTp[0], t0 = CHUNK_TILES * c, t1 = min(nt, t0 + CHUNK_TILES);
            if (t1 > t0) { EpiSwiglu E{(bf16*)(ws + WS_HIDM), FFM, t0 * 256, nullptr};
                REP_X(REP_MOEGU, gemm_moe(X, (const bf16*)(ws + WS_XS), (const bf16*)(ws + WS_WT_MGU), t0, t1, 2 * FFM, DM, TILE_E, 0, 0, E);) } } SEAM(19 + 2 * c);
        PHASE(20 + 2 * c); { const int* NTp = (const int*)(ws + WS_MISC + MISC_NT); const int* TILE_E = (const int*)(ws + WS_MISC + MISC_TILE_E);
            const int nt = NTp[0], t0 = CHUNK_TILES * c, t1 = min(nt, t0 + CHUNK_TILES);
            if (t1 > t0) { EpiBf16Plain E{(bf16*)(ws + WS_YS), DM};
                REP_X(REP_MOEDN, gemm_moe(X, (const bf16*)(ws + WS_HIDM), (const bf16*)(ws + WS_WT_MDN), t0, t1, DM, FFM, TILE_E, t0, 0, E);) } } SEAM(20 + 2 * c);
    }
#endif
#if XR_BF16
    PHASE(25); { phase_combine(X, p, (const xr_t*)(p.ws + WS_XRB)); }
#else
    PHASE(25); { phase_combine(X, p, (const xr_t*)p.out); }
#endif
}
#undef PHASE
#undef SEAM

extern "C" void kernel_launch(void* const* d_in, const int* in_sizes, int n_in, void* d_out, int out_size, void* d_ws, size_t ws_size, hipStream_t stream) {
    static int grid = 0;
    if (grid == 0) {
        if (n_in != 20 || out_size != T * DM || ws_size < WS_END) { fprintf(stderr, "kernel_launch: unexpected shapes (n_in %d out %d ws %zu)\n", n_in, out_size, ws_size); grid = -1; return; }
        int dev = 0, cus = 0;
        if (hipGetDevice(&dev) != hipSuccess || hipDeviceGetAttribute(&cus, hipDeviceAttributeMultiprocessorCount, dev) != hipSuccess) { grid = -1; return; }
        if (hipFuncSetAttribute((const void*)mega, hipFuncAttributeMaxDynamicSharedMemorySize, LDS_BYTES) != hipSuccess) { fprintf(stderr, "kernel_launch: hipFuncSetAttribute failed\n"); grid = -1; return; }
        int per_cu = 0; (void)hipOccupancyMaxActiveBlocksPerMultiprocessor(&per_cu, (const void*)mega, NTHREADS, LDS_BYTES); (void)hipGetLastError();
        grid = cus;
    }
    if (grid < 0) return;
    (void)hipMemsetAsync((char*)d_ws + WS_CTL, 0, CTL_BYTES, stream);
    Params p{};
    for (int i = 0; i < 20; ++i) p.in[i] = (const float*)d_in[i];
    p.out = (float*)d_out; p.ws = (unsigned char*)d_ws;
    p.ph_lo = 0; p.ph_hi = NPHASES;
    hipLaunchKernelGGL(mega, dim3(grid), dim3(NTHREADS), LDS_BYTES, stream, p);
}
```

```cpp
#include <hip/hip_runtime.h>
#include <cstdio>
#include <cstdint>

#ifndef N_LAUNCH_MODE
#define N_LAUNCH_MODE 1
#endif

#ifndef FAST_GEMM
#define FAST_GEMM 1
#endif
#ifndef REP_ATTN
#define REP_ATTN 1
#endif
#ifndef REP_INPROJ
#define REP_INPROJ 1
#endif
#ifndef REP_H3
#define REP_H3 1
#endif
#ifndef REP_PRO
#define REP_PRO 1
#endif
#ifndef REP_MOEGU
#define REP_MOEGU 1
#endif
#ifndef REP_MOEDN
#define REP_MOEDN 1
#endif
#ifndef REP_DGU
#define REP_DGU 1
#endif
#ifndef REP_NORM
#define REP_NORM 1
#endif
#ifndef REP_ROUTE
#define REP_ROUTE 1
#endif
#ifndef REP_OUT0
#define REP_OUT0 1
#endif
#ifndef REP_QKV
#define REP_QKV 1
#endif
#define REP_1(stmt) stmt
#define REP_2(stmt) stmt stmt
#define REP_CAT(a, b) a##b
#define REP_X(n, stmt) REP_CAT(REP_, n)(stmt)
#ifndef MOE_FP8
#define MOE_FP8 1
#endif
#ifndef DN_SPLITK
#define DN_SPLITK 1
#endif
#ifndef FUSE_NORM
#define FUSE_NORM 1
#endif
#ifndef XR_BF16
#define XR_BF16 1
#endif
#ifndef HG_V2
#define HG_V2 1
#endif
#ifndef FAST_ATTN
#define FAST_ATTN 1
#endif
#ifndef FAST_HGRN
#define FAST_HGRN 1
#endif
#define GAS __attribute__((address_space(1)))
#define LAS __attribute__((address_space(3)))
typedef unsigned short bf16;
typedef float f32x4 __attribute__((ext_vector_type(4)));
typedef short bf16x8 __attribute__((ext_vector_type(8)));
typedef unsigned u32x4 __attribute__((ext_vector_type(4)));
typedef unsigned u32x2 __attribute__((ext_vector_type(2)));

constexpr int T = 16384, SEQ = 8192, DM = 1024, NLAYER = 2;
constexpr int QR = 384, KVR = 256, ROPE = 64, NPROJ = 2752, NPROJ_P = 2816;
constexpr int NH = 4, DQK = 192, DNOPE = 128, DV = 128;
constexpr int HGW = 512;
constexpr int FF0 = 2816, FFM = 3584, NE = 8;
constexpr int MAXTILES = 136;
constexpr float EPS = 1e-6f;
constexpr int NWAVES = 8, NTHREADS = 512;

constexpr size_t MiB = 1u << 20;
constexpr size_t WS_CTL = 0, CTL_BYTES = 32768;
constexpr size_t WS_MISC = 1 * MiB;
constexpr size_t MISC_LB = 0, MISC_GCNT = 8192, MISC_TILE_E = 16384, MISC_NT = 17408, MISC_TOPI = 65536, MISC_TOPG = 196608, MISC_POS = 327680, MISC_SSXA = 458752, MISC_SSXB = 720896;
constexpr size_t WS_COS = 2 * MiB, WS_SIN = 4 * MiB;
constexpr size_t WS_WT_IN = 6 * MiB, WS_WT_QB = 17 * MiB, WS_WT_KVB = 19 * MiB, WS_WT_OUT = 20 * MiB, WS_WT_GU = 24 * MiB, WS_WT_DN = 35 * MiB, WS_WT_MGU = 41 * MiB, WS_WT_MDN = 153 * MiB;
constexpr size_t WS_XB = 209 * MiB;
constexpr size_t WS_CQ = 242 * MiB, WS_CKV = 254 * MiB, WS_KPE = 262 * MiB, WS_SSQ = 264 * MiB, WS_HQ = 266 * MiB, WS_HK = 282 * MiB, WS_LF = 298 * MiB, WS_HV = 330 * MiB, WS_HG = 346 * MiB;
constexpr size_t WS_Q = 362 * MiB, WS_KN = 386 * MiB, WS_V = 402 * MiB, WS_CC = 418 * MiB, WS_END = 464 * MiB;
constexpr size_t WS_HID = 242 * MiB;
#if MOE_FP8
constexpr size_t WS_XS = 242 * MiB;
constexpr size_t WS_YS = 276 * MiB;
constexpr size_t WS_HIDM = 344 * MiB;
constexpr int CHUNK_TILES = 136;
static_assert(WS_HIDM + (size_t)34816 * 3584 <= 464 * MiB, "MoE hidden fits below the guaranteed workspace size");
#else
constexpr size_t WS_XS = 242 * MiB;
constexpr size_t WS_YS = WS_XS;
constexpr size_t WS_HIDM = 310 * MiB;
constexpr int CHUNK_TILES = 64;
#endif
constexpr size_t WS_AP2 = WS_CQ;
constexpr size_t WS_AML = WS_SSQ;
constexpr size_t WS_HD = WS_XB + 32 * MiB, WS_HR = WS_HD + 512 * 1024;
constexpr size_t WS_XRB = 97 * MiB;
constexpr size_t WS_SLAB = 209 * MiB;
constexpr int CW_BAR = 4096;

constexpr int LDS_BYTES = 147456;
constexpr int LDS_MISC_OFF = 143360;

__device__ __forceinline__ unsigned f2bf(float f) { unsigned u = __float_as_uint(f); return (u + 0x7fffu + ((u >> 16) & 1u)) >> 16; }
typedef float pk2_f32x2 __attribute__((ext_vector_type(2)));
typedef __bf16 pk2_bf16x2 __attribute__((ext_vector_type(2)));
__device__ __forceinline__ unsigned pk2(float lo, float hi) { const pk2_f32x2 v = {lo, hi}; return __builtin_bit_cast(unsigned, __builtin_convertvector(v, pk2_bf16x2)); }
__device__ __forceinline__ float bf2f(unsigned short b) { return __uint_as_float(((unsigned)b) << 16); }
__device__ __forceinline__ float bflo(unsigned w) { return __uint_as_float(w << 16); }
__device__ __forceinline__ float bfhi(unsigned w) { return __uint_as_float(w & 0xffff0000u); }
__device__ __forceinline__ float clamp8(float x) { return __builtin_amdgcn_fmed3f(x, -448.f, 448.f); }
__device__ __forceinline__ unsigned pk4_fp8(float a, float b, float c, float d) {
    int w = __builtin_amdgcn_cvt_pk_fp8_f32(clamp8(a), clamp8(b), 0, false); w = __builtin_amdgcn_cvt_pk_fp8_f32(clamp8(c), clamp8(d), w, true); return (unsigned)w; }
__device__ __forceinline__ u32x4 pack8(f32x4 a, f32x4 b) { u32x4 w; w.x = pk2(a.x, a.y); w.y = pk2(a.z, a.w); w.z = pk2(b.x, b.y); w.w = pk2(b.z, b.w); return w; }
#if XR_BF16
typedef bf16 xr_t;
#else
typedef float xr_t;
#endif
__device__ __forceinline__ f32x4 ldrow4(const float* row, int idx) { return *((const f32x4*)row + idx); }
__device__ __forceinline__ f32x4 ldrow4(const bf16* row, int idx) { const u32x2 w = *((const u32x2*)row + idx); f32x4 r; r.x = __uint_as_float(w.x << 16); r.y = __uint_as_float(w.x & 0xffff0000u); r.z = __uint_as_float(w.y << 16); r.w = __uint_as_float(w.y & 0xffff0000u); return r; }
__device__ __forceinline__ float wave_sum(float v) {
#pragma unroll
    for (int o = 1; o < 64; o <<= 1) v += __shfl_xor(v, o);
    return v;
}
__device__ __forceinline__ float wave_max(float v) {
#pragma unroll
    for (int o = 1; o < 64; o <<= 1) v = fmaxf(v, __shfl_xor(v, o));
    return v;
}
__device__ __forceinline__ float fast_exp(float x) { return __builtin_amdgcn_exp2f(x * 1.4426950408889634f); }
__device__ __forceinline__ float sigmoidf_(float x) { return __builtin_amdgcn_rcpf(1.f + fast_exp(-x)); }
__device__ __forceinline__ float siluf_(float x) { return x * __builtin_amdgcn_rcpf(1.f + fast_exp(-x)); }
typedef float f32x2v __attribute__((ext_vector_type(2)));
__device__ __forceinline__ f32x2v silu_mul_pk(f32x2v g, f32x2v u) {
    const f32x2v t = g * (-1.4426950408889634f); f32x2v e; e.x = __builtin_amdgcn_exp2f(t.x); e.y = __builtin_amdgcn_exp2f(t.y);
    const f32x2v d = e + 1.0f; f32x2v r; r.x = __builtin_amdgcn_rcpf(d.x); r.y = __builtin_amdgcn_rcpf(d.y);
    return (g * u) * r;
}
__device__ __forceinline__ int perm32(int rho) { const int n = rho >> 4, i = rho & 15; return 8 * (i >> 2) + 4 * n + (i & 3); }

__device__ const double kInvRev[32] = {
    1.59154943091895346e-01, 1.19349370211248862e-01, 8.94994016088910133e-02, 6.71150830052272551e-02, 5.03292121044870353e-02, 3.77415847174197711e-02, 2.83021958306233987e-02, 2.12236527647776604e-02,
    1.59154943091895339e-02, 1.19349370211248862e-02, 8.94994016088910237e-03, 6.71150830052272534e-03, 5.03292121044870370e-03, 3.77415847174197719e-03, 2.83021958306233987e-03, 2.12236527647776622e-03,
    1.59154943091895356e-03, 1.19349370211248849e-03, 8.94994016088910237e-04, 6.71150830052272599e-04, 5.03292121044870326e-04, 3.77415847174197741e-04, 2.83021958306233954e-04, 2.12236527647776605e-04,
    1.59154943091895351e-04, 1.19349370211248862e-04, 8.94994016088910182e-05, 6.71150830052272545e-05, 5.03292121044870354e-05, 3.77415847174197768e-05, 2.83021958306233961e-05, 2.12236527647776592e-05};

#define XB_TMO      128
#define XB_XCNT(j)  (256  + 64 * (j))
#define XB_XSUB(j)  (1280 + 64 * (j))
#define XB_XGEN(j)  (2304 + 64 * (j))
#define XB_TOP      3328
#define XB_TOPGEN   3392
#define XCD_BAR_WORDS 3456
#define XB_SPIN_CAP (1u << 18)
__device__ __forceinline__ unsigned xb_ld(unsigned* p)              { return __hip_atomic_load(p, __ATOMIC_RELAXED, __HIP_MEMORY_SCOPE_AGENT); }
__device__ __forceinline__ unsigned xb_add(unsigned* p, unsigned v) { return __hip_atomic_fetch_add(p, v, __ATOMIC_RELAXED, __HIP_MEMORY_SCOPE_AGENT); }
__device__ __forceinline__ unsigned xb_xcc_id() { return (unsigned)__builtin_amdgcn_s_getreg((3 << 11) | 20) & 0xFu; }
#define XB_SPIN(cond, bar) do { unsigned _sp = 0; while (cond) { __builtin_amdgcn_s_sleep(1); \
    if ((++_sp & 255u) == 0u) { if (xb_ld(&(bar)[XB_TMO])) break; if (_sp > XB_SPIN_CAP) { atomicAdd(&(bar)[XB_TMO], 1u); break; } } } } while (0)
struct XcdBarrier { unsigned* bar; unsigned x; volatile LAS unsigned* st; };
__device__ __forceinline__ XcdBarrier xcd_barrier_post(unsigned* bar, volatile LAS unsigned* st) {
    XcdBarrier b; b.bar = bar; b.x = xb_xcc_id(); b.st = st;
    if (threadIdx.x == 0) (void)xb_add(&bar[XB_XCNT(b.x)], 1u);
    return b;
}
__device__ __forceinline__ void xcd_barrier_complete(unsigned* bar, unsigned x, unsigned& nloc, unsigned& nx) {
    const unsigned G = gridDim.x * gridDim.y * gridDim.z;
    unsigned sum, cnt, mine, sp = 0u;
    for (;;) {
        sum = 0u; cnt = 0u; mine = 0u;
#pragma unroll
        for (unsigned j = 0; j < 16; ++j) { const unsigned c = xb_ld(&bar[XB_XCNT(j)]); sum += c; cnt += (c > 0u) ? 1u : 0u; mine = (j == x) ? c : mine; }
        if (sum == G) break;
        __builtin_amdgcn_s_sleep(1);
        if ((++sp & 255u) == 0u) { if (xb_ld(&bar[XB_TMO])) break; if (sp > XB_SPIN_CAP) { atomicAdd(&bar[XB_TMO], 1u); break; } }
    }
    nloc = mine > 0u ? mine : 1u; nx = cnt > 0u ? cnt : 1u;
}
__device__ __forceinline__ void xcd_barrier(const XcdBarrier& b) {
    asm volatile("s_waitcnt vmcnt(0)" ::: "memory");
    __syncthreads();
    unsigned long long bar_ = (unsigned long long)b.bar; asm volatile("" : "+s"(bar_));
    if (threadIdx.x == 0) {
        unsigned* bar = (unsigned*)(GAS unsigned*)bar_;
        __builtin_amdgcn_s_waitcnt(0);
        unsigned nloc = b.st[0], nx = b.st[1];
        if (nloc == 0u) { xcd_barrier_complete(bar, b.x, nloc, nx); b.st[0] = nloc; b.st[1] = nx; }
        const unsigned old = xb_add(&bar[XB_XSUB(b.x)], 1u);
        const unsigned gen = old / nloc;
        if (old + 1u == (gen + 1u) * nloc) {
            __builtin_amdgcn_fence(__ATOMIC_RELEASE, "agent");
            asm volatile("s_waitcnt vmcnt(0)" ::: "memory");
            const unsigned og = xb_add(&bar[XB_TOP], 1u);
            const unsigned tg = og / nx;
            if (og + 1u == (tg + 1u) * nx) xb_add(&bar[XB_TOPGEN], 1u);
            else XB_SPIN(xb_ld(&bar[XB_TOPGEN]) == tg, bar);
            __builtin_amdgcn_fence(__ATOMIC_ACQUIRE, "agent");
            xb_add(&bar[XB_XGEN(b.x)], 1u);
            asm volatile("s_waitcnt vmcnt(0)" ::: "memory");
        } else {
            XB_SPIN(xb_ld(&bar[XB_XGEN(b.x)]) == gen, bar);
            __builtin_amdgcn_fence(__ATOMIC_ACQUIRE, "agent");
            asm volatile("s_waitcnt vmcnt(0)" ::: "memory");
        }
    }
    __syncthreads();
}

struct Params { const float* in[20]; float* out; unsigned char* ws; int ph_lo, ph_hi; };
enum { I_X = 0, I_POS, I_MIXN, I_WIN, I_QAN, I_WQB, I_KVAN, I_WKVB, I_HLB, I_HON, I_WOUT, I_FFNN, I_DWG, I_DWU, I_DWD, I_ROUTER, I_MWG, I_MWU, I_MWD, I_FINN };

struct Ctx {
    int tid, lane, wave, bid, nblk;
    LAS unsigned char* lds;
};

struct EpiProj {
    unsigned char* ws; int l; int ssx;
    __device__ __forceinline__ void launder() { unsigned long long w = (unsigned long long)ws; asm volatile("" : "+s"(w)); ws = (unsigned char*)(GAS unsigned char*)w;     }
    static constexpr int HAS_ROWSCALE = 1;
    __device__ __forceinline__ float rowscale(int row) const { if (!ssx) return 1.f; const float* sx = (const float*)(ws + WS_MISC + ssx) + row; return __builtin_amdgcn_rsqf(((sx[0] + sx[T]) + (sx[2 * T] + sx[3 * T])) * (1.f / DM) + EPS); }
    __device__ __forceinline__ void operator()(int row, int c, f32x4 a, f32x4 b) const {
        bf16* CQ = (bf16*)(ws + WS_CQ); bf16* CKV = (bf16*)(ws + WS_CKV); bf16* KPE = (bf16*)(ws + WS_KPE); bf16* HQ = (bf16*)(ws + WS_HQ); bf16* HK = (bf16*)(ws + WS_HK); bf16* HV = (bf16*)(ws + WS_HV); bf16* HG = (bf16*)(ws + WS_HG);
        float* LF = (float*)(ws + WS_LF); float* SSQ = (float*)(ws + WS_SSQ); const float* LB = (const float*)(ws + WS_MISC + MISC_LB) + l * HGW; const float* COS = (const float*)(ws + WS_COS); const float* SIN = (const float*)(ws + WS_SIN);
        if (c < 640) {
            float ss = (a.x * a.x + a.y * a.y) + (a.z * a.z + a.w * a.w) + (b.x * b.x + b.y * b.y) + (b.z * b.z + b.w * b.w);
            ss += __shfl_xor(ss, 16); ss += __shfl_xor(ss, 32);
            if ((threadIdx.x & 63) < 16) SSQ[(size_t)(c >> 5) * T + row] = ss;
            const u32x4 w = pack8(a, b);
            if (c < QR) *(u32x4*)(CQ + (size_t)row * QR + c) = w; else *(u32x4*)(CKV + (size_t)row * KVR + (c - QR)) = w;
        } else if (c < 704) {
            const int g = (c - 640) >> 3;
            const f32x4 cs = *(const f32x4*)(COS + (size_t)row * 32 + 4 * g), sn = *(const f32x4*)(SIN + (size_t)row * 32 + 4 * g);
            const f32x4 o1 = a * cs - b * sn, o2 = a * sn + b * cs;
            *(u32x4*)(KPE + (size_t)row * ROPE + 8 * g) = pack8(o1, o2);
        } else if (c < 1216) {
            f32x4 x, y; x.x = siluf_(a.x); x.y = siluf_(a.y); x.z = siluf_(a.z); x.w = siluf_(a.w); y.x = siluf_(b.x); y.y = siluf_(b.y); y.z = siluf_(b.z); y.w = siluf_(b.w);
            *(u32x4*)(HQ + (size_t)row * HGW + (c - 704)) = pack8(x, y);
#if HG_V2
        } else if (c < 1728) {
            *(u32x4*)(HK + (size_t)row * HGW + (c - 1216)) = pack8(a, b);
#else
        } else if (c < 1728) {
            const int d = c - 1216;
            const f32x4 l0 = *(const f32x4*)(LB + d), l1 = *(const f32x4*)(LB + d + 4);
            f32x4 k0, k1, f0, f1;
#define HGATE(z, lb, kk, lf) do { const float zc = fminf(fmaxf((z), -60.f), 60.f); const float e = fast_exp(-zc); const float sg = __builtin_amdgcn_rcpf(1.f + e); const float om = 1.f - (lb); \
                kk = om * (e * sg); const float f = (lb) + om * sg; lf = __builtin_amdgcn_logf(fmaxf(f, 1e-30f)) * 0.6931471805599453f; } while (0)
            HGATE(a.x, l0.x, k0.x, f0.x); HGATE(a.y, l0.y, k0.y, f0.y); HGATE(a.z, l0.z, k0.z, f0.z); HGATE(a.w, l0.w, k0.w, f0.w);
            HGATE(b.x, l1.x, k1.x, f1.x); HGATE(b.y, l1.y, k1.y, f1.y); HGATE(b.z, l1.z, k1.z, f1.z); HGATE(b.w, l1.w, k1.w, f1.w);
#undef HGATE
            *(u32x4*)(HK + (size_t)row * HGW + d) = pack8(k0, k1);
            *(f32x4*)(LF + (size_t)row * HGW + d) = f0; *(f32x4*)(LF + (size_t)row * HGW + d + 4) = f1;
#endif
        } else if (c < 2240) {
            *(u32x4*)(HV + (size_t)row * HGW + (c - 1728)) = pack8(a, b);
        } else if (c < 2752) {
            *(u32x4*)(HG + (size_t)row * HGW + (c - 2240)) = pack8(a, b);
        }
    }
};
struct EpiQ {
    unsigned char* ws;
    __device__ __forceinline__ void launder() { unsigned long long w = (unsigned long long)ws; asm volatile("" : "+s"(w)); ws = (unsigned char*)(GAS unsigned char*)w;     }
    __device__ __forceinline__ void operator()(int row, int c, f32x4 a, f32x4 b) const {
        bf16* Q = (bf16*)(ws + WS_Q); const float* SSQ = (const float*)(ws + WS_SSQ); const float* COS = (const float*)(ws + WS_COS); const float* SIN = (const float*)(ws + WS_SIN);
        float s = 0.f;
#pragma unroll
        for (int i = 0; i < 12; ++i) s += SSQ[(size_t)i * T + row];
        const float rstd = __builtin_amdgcn_rsqf(s * (1.f / QR) + EPS);
        a = a * rstd; b = b * rstd;
        const int h = c / DQK, cc = c - h * DQK, bb = row >> 13, sq = row & (SEQ - 1);
        bf16* dst = Q + ((size_t)((bb * NH + h) * SEQ + sq)) * DQK + cc;
        if (cc < DNOPE) { *(u32x4*)dst = pack8(a, b); }
        else { const int g = (cc - DNOPE) >> 3;
            const f32x4 cs = *(const f32x4*)(COS + (size_t)row * 32 + 4 * g), sn = *(const f32x4*)(SIN + (size_t)row * 32 + 4 * g);
            *(u32x4*)dst = pack8(a * cs - b * sn, a * sn + b * cs); }
    }
};
struct EpiKV {
    unsigned char* ws;
    __device__ __forceinline__ void launder() { unsigned long long w = (unsigned long long)ws; asm volatile("" : "+s"(w)); ws = (unsigned char*)(GAS unsigned char*)w;     }
    __device__ __forceinline__ void operator()(int row, int c, f32x4 a, f32x4 b) const {
        bf16* KN = (bf16*)(ws + WS_KN); bf16* V = (bf16*)(ws + WS_V); const float* SSQ = (const float*)(ws + WS_SSQ);
        float s = 0.f;
#pragma unroll
        for (int i = 12; i < 20; ++i) s += SSQ[(size_t)i * T + row];
        const float rstd = __builtin_amdgcn_rsqf(s * (1.f / KVR) + EPS);
        a = a * rstd; b = b * rstd;
        const int h = c >> 8, cc = c & 255, bb = row >> 13, sq = row & (SEQ - 1);
        const size_t r = ((size_t)((bb * NH + h) * SEQ + sq)) * 128;
        if (cc < 128) *(u32x4*)(KN + r + cc) = pack8(a, b); else *(u32x4*)(V + r + (cc - 128)) = pack8(a, b);
    }
};
template <class TS, class TD> struct EpiResT {
    const TS* SRC; TD* DST;
    __device__ __forceinline__ void launder() {}
    __device__ __forceinline__ void operator()(int row, int c, f32x4 a, f32x4 b) const {
        const size_t o = (size_t)row * DM + c;
        f32x4 s0, s1;
        if constexpr (sizeof(TS) == 4) { s0 = *(const f32x4*)((const float*)SRC + o); s1 = *(const f32x4*)((const float*)SRC + o + 4); }
        else { const u32x4 w = *(const u32x4*)((const bf16*)SRC + o); s0.x = bflo(w.x); s0.y = bfhi(w.x); s0.z = bflo(w.y); s0.w = bfhi(w.y); s1.x = bflo(w.z); s1.y = bfhi(w.z); s1.z = bflo(w.w); s1.w = bfhi(w.w); }
        s0 = s0 + a; s1 = s1 + b;
        if constexpr (sizeof(TD) == 4) { *(f32x4*)((float*)DST + o) = s0; *(f32x4*)((float*)DST + o + 4) = s1; }
        else *(u32x4*)((bf16*)DST + o) = pack8(s0, s1);
    }
};
template <class TS> struct EpiResNormT {
    static constexpr bool HAS_FINISH = true;
    const TS* SRC; bf16* DST; float* SSX; float ssb;
    __device__ __forceinline__ void launder() {}
    __device__ __forceinline__ void operator()(int row, int c, f32x4 a, f32x4 b) {
        const size_t o = (size_t)row * DM + c;
        f32x4 s0, s1;
        if constexpr (sizeof(TS) == 4) { s0 = *(const f32x4*)((const float*)SRC + o); s1 = *(const f32x4*)((const float*)SRC + o + 4); }
        else { const u32x4 w = *(const u32x4*)((const bf16*)SRC + o); s0.x = bflo(w.x); s0.y = bfhi(w.x); s0.z = bflo(w.y); s0.w = bfhi(w.y); s1.x = bflo(w.z); s1.y = bfhi(w.z); s1.z = bflo(w.w); s1.w = bfhi(w.w); }
        s0 = s0 + a; s1 = s1 + b;
        *(u32x4*)(DST + o) = pack8(s0, s1);
        float ss = (s0.x * s0.x + s0.y * s0.y) + (s0.z * s0.z + s0.w * s0.w) + (s1.x * s1.x + s1.y * s1.y) + (s1.z * s1.z + s1.w * s1.w);
        if ((c & 128) == 0) { ssb = ss; }
        else { ss += ssb; ss += __shfl_xor(ss, 16); ss += __shfl_xor(ss, 32);
            if ((threadIdx.x & 63) < 16) part[(row & 255) * 4 + ((c >> 5) & 3)] = ss; }
    }
    LAS float* part;
    __device__ __forceinline__ void finish(int pm, int pn, int tid) {
        asm volatile("s_waitcnt lgkmcnt(0)" ::: "memory"); __builtin_amdgcn_s_barrier(); asm volatile("" ::: "memory");
        if (tid < 256) { const LAS float* q = part + tid * 4; SSX[(size_t)pn * T + pm * 256 + tid] = (q[0] + q[1]) + (q[2] + q[3]); }
    }
};
struct EpiSwiglu {
    bf16* HID; int ff; int rowbase; const float* SSX;
    static constexpr int HAS_ROWSCALE = 1;
    __device__ __forceinline__ void launder() {}
    __device__ __forceinline__ float rowscale(int row) const { if (!SSX) return 1.f; const float* sx = SSX + row; return __builtin_amdgcn_rsqf(((sx[0] + sx[T]) + (sx[2 * T] + sx[3 * T])) * (1.f / DM) + EPS); }
    __device__ __forceinline__ void operator()(int row, int c, f32x4 a, f32x4 b) const {
        const f32x2v h0 = silu_mul_pk((f32x2v){a.x, a.y}, (f32x2v){b.x, b.y}), h1 = silu_mul_pk((f32x2v){a.z, a.w}, (f32x2v){b.z, b.w});
        u32x2 w; w.x = pk2(h0.x, h0.y); w.y = pk2(h1.x, h1.y);
        *(u32x2*)(HID + (size_t)(row - rowbase) * ff + (c >> 1)) = w;
    }
};
struct EpiSwiglu8 {
    unsigned char* HID; int ff; int rowbase;
    __device__ __forceinline__ void launder() {}
    __device__ __forceinline__ void operator()(int row, int c, f32x4 a, f32x4 b) const {
        const f32x2v h0 = silu_mul_pk((f32x2v){a.x, a.y}, (f32x2v){b.x, b.y}), h1 = silu_mul_pk((f32x2v){a.z, a.w}, (f32x2v){b.z, b.w});
        *(unsigned*)(HID + (size_t)(row - rowbase) * ff + (c >> 1)) = pk4_fp8(h0.x, h0.y, h1.x, h1.y);
    }
};
struct EpiProbe {
    float* sink;
    __device__ __forceinline__ void launder() {}
    __device__ __forceinline__ void operator()(int row, int c, f32x4 a, f32x4 b) const { if (a.x == 123456.789f && b.w == -98765.4321f) sink[row * 8 + (c & 7)] = a.y; }
};
struct EpiBf16Plain {
    bf16* O; int ld;
    __device__ __forceinline__ void launder() {}
    __device__ __forceinline__ void operator()(int row, int c, f32x4 a, f32x4 b) const { *(u32x4*)(O + (size_t)row * ld + c) = pack8(a, b); }
};

namespace pg8 {
#define PG8_LAS __attribute__((address_space(3)))
typedef unsigned short bf16_t;
typedef short bf16x8 __attribute__((ext_vector_type(8)));
typedef float f32x4 __attribute__((ext_vector_type(4)));
typedef unsigned u32x4 __attribute__((ext_vector_type(4)));
typedef int v4i_t __attribute__((ext_vector_type(4)));
typedef int v8i_t __attribute__((ext_vector_type(8)));
constexpr int BM = 256, BK = 64, HALF = 128, HTB = HALF * BK * 2  , STAGE_BYTES = 8 * HTB, NXCD = 8, WGM = 8;

__host__ __device__ __forceinline__ int lds_byte(int r, int c) { const int st = (r >> 4) * 2 + (c >> 5), rr = r & 15, cc = c & 31, ob = rr * 64 + cc * 2; return st * 1024 + (ob ^ (((ob >> 9) & 1) << 5)); }
__host__ __device__ __forceinline__ void stage_rc(int b, int& R, int& C) { const int st = b / 1024, sb = b % 1024, swz = sb ^ (((sb >> 9) & 1) << 5); R = (st >> 1) * 16 + swz / 64; C = (st & 1) * 32 + (swz % 64) / 2; }
__host__ __device__ __forceinline__ int perm32(int rho) { const int n = rho >> 4, i = rho & 15; return 8 * (i >> 2) + 4 * n + (i & 3); }

template <class E, class = void> struct has_finish { static constexpr bool value = false; };
template <class E> struct has_finish<E, decltype((void)E::HAS_FINISH)> { static constexpr bool value = true; };
template <class E, class = void> struct has_rowscale { static constexpr bool value = false; };
template <class E> struct has_rowscale<E, decltype((void)E::HAS_ROWSCALE)> { static constexpr bool value = true; };
struct Unit { int pm, pn, pa, pb; };
struct Gemm { const bf16_t* A; const bf16_t* Bt; int M, N, K; int wscale; int ld; };

struct StaticOrder {
    int nM, nN, nwg, G, c;
    __host__ __device__ void init(int M, int N, int G_, int c_) { nM = M / BM; nN = N / BM; nwg = nM * nN; G = G_; c = c_; }
    __host__ __device__ bool next(int i, Unit& u) const {
        const long L = (long)i * G + c; if (L >= nwg) return false;
        int wgid = (int)L; { const int q = nwg / NXCD, r = nwg % NXCD, xcd = wgid % NXCD, off = wgid / NXCD; wgid = (xcd < r ? xcd * (q + 1) : r * (q + 1) + (xcd - r) * q) + off; }
        const int nig = WGM * nN, gid = wgid / nig, fm = gid * WGM, gsz = (nM - fm) < WGM ? (nM - fm) : WGM;
        u.pm = fm + ((wgid % nig) % gsz); u.pn = (wgid % nig) / gsz; u.pa = u.pm; u.pb = u.pn; return true;
    }
    __device__ __forceinline__ void a_ready(const Unit&) const {}
    __device__ __forceinline__ void done(const Unit&) const {}
};
template <class Epi, class Sched, bool ALIGN_EPI = false, bool SP2 = false, bool FP8 = false>
__device__ __forceinline__ void gemm_phase(PG8_LAS unsigned char* lds, const Gemm g, const Sched& S, const Epi& E) {
    int tid_ = threadIdx.x; asm volatile("" : "+v"(tid_));
    const int tid = tid_, wid = __builtin_amdgcn_readfirstlane(tid >> 6), lane = tid & 63, wr = wid >> 2, wc = wid & 3, fr = lane & 15, fq = lane >> 4;
    const int K = g.ld ? g.ld : g.K, nt = g.K / BK;
    unsigned voffA[2], voffB[2];
#pragma unroll
    for (int i = 0; i < 2; ++i) { int R, C; stage_rc(tid * 16 + i * 8192, R, C); const int Rb = (R & ~31) + perm32(R & 31);
        voffA[i] = (unsigned)(R * K + C) * 2u; voffB[i] = (unsigned)(Rb * K + C) * 2u; }
    const size_t kstep = (size_t)(BK * 2);
    const size_t hstep = (size_t)HALF * K * 2;
    const size_t tstep = 2 * hstep;
    const unsigned ldsw = (unsigned)wid * 1024u;
    const int aoff = lds_byte(wr * 64 + fr, fq * 8), boff = lds_byte(wc * 32 + fr, fq * 8);
#define PG8_SA(b, h) (((b) * 2 + (h)) * HTB)
#define PG8_SB(b, h) ((4 + (b) * 2 + (h)) * HTB)
#define PG8_STAGE(bufoff, gbase, voff) do { _Pragma("unroll") for (int _i = 0; _i < 2; ++_i) \
        __builtin_amdgcn_global_load_lds((const unsigned*)((const char*)(gbase) + (voff)[_i]), (PG8_LAS unsigned*)(lds + (bufoff) + ldsw + _i * 8192), 16, 0, 0); } while (0)
#define PG8_RD(off) (*(const PG8_LAS bf16x8*)(lds + (off)))
#define PG8_CAT(lo, hi) __builtin_shufflevector(__builtin_bit_cast(v4i_t, lo), __builtin_bit_cast(v4i_t, hi), 0, 1, 2, 3, 4, 5, 6, 7)
#define PG8_LDA(dst, b, h) do { _Pragma("unroll") for (int m = 0; m < 4; ++m) { if constexpr (FP8) dst##8[m] = PG8_CAT(PG8_RD(PG8_SA(b, h) + aoff + m * 2048), PG8_RD(PG8_SA(b, h) + aoff + m * 2048 + 1024)); \
        else { dst[m][0] = PG8_RD(PG8_SA(b, h) + aoff + m * 2048); dst[m][1] = PG8_RD(PG8_SA(b, h) + aoff + m * 2048 + 1024); } } } while (0)
#define PG8_LDB(dst, b, h) do { _Pragma("unroll") for (int n = 0; n < 2; ++n) { if constexpr (FP8) dst##8[n] = PG8_CAT(PG8_RD(PG8_SB(b, h) + boff + n * 2048), PG8_RD(PG8_SB(b, h) + boff + n * 2048 + 1024)); \
        else { dst[n][0] = PG8_RD(PG8_SB(b, h) + boff + n * 2048); dst[n][1] = PG8_RD(PG8_SB(b, h) + boff + n * 2048 + 1024); } } } while (0)
#define PG8_MMA(ai, bj, At, Bt) do { __builtin_amdgcn_s_setprio(1); if constexpr (FP8) { _Pragma("unroll") for (int m = 0; m < 4; ++m) _Pragma("unroll") for (int n = 0; n < 2; ++n) \
        asm volatile("v_mfma_scale_f32_16x16x128_f8f6f4 %0, %1, %2, %0, %3, %4 op_sel_hi:[0,0,0]" : "+v"(acc[ai][bj][m][n]) : "v"(Bt##8[n]), "v"(At##8[m]), "v"(sc_w), "v"(sc_1)); } \
        else { _Pragma("unroll") for (int m = 0; m < 4; ++m) _Pragma("unroll") for (int n = 0; n < 2; ++n) _Pragma("unroll") for (int k = 0; k < 2; ++k) \
        acc[ai][bj][m][n] = __builtin_amdgcn_mfma_f32_16x16x32_bf16(Bt[n][k], At[m][k], acc[ai][bj][m][n], 0, 0, 0); } __builtin_amdgcn_s_setprio(0); } while (0)
#define PG8_WAIT_V(n) asm volatile("s_waitcnt vmcnt(" #n ")" ::: "memory")
#define PG8_WAIT_L(n) asm volatile("s_waitcnt lgkmcnt(" #n ")" ::: "memory")
#define PG8_BAR __builtin_amdgcn_s_barrier()
#define PG8_SCHED __builtin_amdgcn_sched_barrier(0)
    Unit cur, nxt; int ui = 0;
    if (!S.next(0, cur)) return;
    f32x4 acc[2][2][4][2];
#pragma unroll
    for (int a = 0; a < 2; ++a)
#pragma unroll
        for (int b = 0; b < 2; ++b)
#pragma unroll
            for (int m = 0; m < 4; ++m)
#pragma unroll
                for (int n = 0; n < 2; ++n) acc[a][b][m][n] = (f32x4){0.f, 0.f, 0.f, 0.f};
    const int sc_w = g.wscale, sc_1 = 0x7F7F7F7F;
    bf16x8 At[4][2], B0[2][2], B1[2][2]; v8i_t At8[4], B08[2], B18[2];
    const char* cA = (const char*)g.A + (size_t)cur.pa * tstep; const char* cB = (const char*)g.Bt + (size_t)cur.pb * tstep;
    S.a_ready(cur);
    if constexpr (SP2) {
        PG8_STAGE(PG8_SB(0, 0), cB, voffB); PG8_STAGE(PG8_SB(0, 1), cB + hstep, voffB); PG8_STAGE(PG8_SA(0, 0), cA, voffA); PG8_STAGE(PG8_SA(0, 1), cA + hstep, voffA);
        if (wr == 1) PG8_BAR;
        PG8_WAIT_V(2); PG8_BAR;
        PG8_STAGE(PG8_SB(1, 0), cB + kstep, voffB); PG8_STAGE(PG8_SA(1, 0), cA + kstep, voffA); PG8_STAGE(PG8_SB(1, 1), cB + hstep + kstep, voffB);
        PG8_WAIT_V(6); PG8_BAR;
    } else {
        PG8_STAGE(PG8_SB(0, 0), cB, voffB); PG8_STAGE(PG8_SA(0, 0), cA, voffA); PG8_STAGE(PG8_SB(0, 1), cB + hstep, voffB); PG8_STAGE(PG8_SA(0, 1), cA + hstep, voffA);
        if (wr == 1) PG8_BAR;
        PG8_WAIT_V(4); PG8_BAR;
        PG8_STAGE(PG8_SB(1, 0), cB + kstep, voffB); PG8_STAGE(PG8_SA(1, 0), cA + kstep, voffA); PG8_STAGE(PG8_SB(1, 1), cB + hstep + kstep, voffB);
        PG8_WAIT_V(6); PG8_BAR;
    }
    for (;;) {
        const bool has_next = S.next(ui + 1, nxt);
        const char* nA = has_next ? (const char*)g.A + (size_t)nxt.pa * tstep : cA; const char* nB = has_next ? (const char*)g.Bt + (size_t)nxt.pb * tstep : cB;
#pragma nounroll
        for (int t = 0; t < nt; t += 2) {
            const bool last = (t == nt - 2);
            const char* a1 = cA + (size_t)(t + 1) * kstep;
            const char* a2 = last ? nA : cA + (size_t)(t + 2) * kstep; const char* b2 = last ? nB : cB + (size_t)(t + 2) * kstep;
            const char* a3 = a2 + kstep; const char* b3 = b2 + kstep;
            if (last && has_next) S.a_ready(nxt);
            if constexpr (SP2) {
            PG8_LDB(B0, 0, 0); PG8_LDB(B1, 0, 1); PG8_SCHED; PG8_LDA(At, 0, 0); PG8_STAGE(PG8_SA(1, 1), a1 + hstep, voffA);
            PG8_WAIT_V(8); PG8_WAIT_L(0); PG8_BAR; PG8_MMA(0, 0, At, B0); PG8_MMA(0, 1, At, B1); PG8_BAR; PG8_SCHED;
            PG8_LDA(At, 0, 1); PG8_STAGE(PG8_SB(0, 0), b2, voffB); PG8_STAGE(PG8_SB(0, 1), b2 + hstep, voffB); PG8_STAGE(PG8_SA(0, 0), a2, voffA);
            PG8_WAIT_V(8); PG8_WAIT_L(0); PG8_BAR; PG8_MMA(1, 0, At, B0); PG8_MMA(1, 1, At, B1); PG8_BAR; PG8_SCHED;
            PG8_LDB(B0, 1, 0); PG8_LDB(B1, 1, 1); PG8_SCHED; PG8_LDA(At, 1, 0); PG8_STAGE(PG8_SA(0, 1), a2 + hstep, voffA);
            PG8_WAIT_V(8); PG8_WAIT_L(0); PG8_BAR; PG8_MMA(0, 0, At, B0); PG8_MMA(0, 1, At, B1); PG8_BAR; PG8_SCHED;
            PG8_LDA(At, 1, 1); PG8_STAGE(PG8_SB(1, 0), b3, voffB); PG8_STAGE(PG8_SB(1, 1), b3 + hstep, voffB); PG8_STAGE(PG8_SA(1, 0), a3, voffA);
            PG8_WAIT_V(8); PG8_WAIT_L(0); PG8_BAR; PG8_MMA(1, 0, At, B0); PG8_MMA(1, 1, At, B1); PG8_BAR; PG8_SCHED;
            } else {
            PG8_LDB(B0, 0, 0); PG8_SCHED; PG8_LDA(At, 0, 0); PG8_STAGE(PG8_SA(1, 1), a1 + hstep, voffA);
            PG8_WAIT_L(8); PG8_BAR; PG8_WAIT_L(0); PG8_MMA(0, 0, At, B0); PG8_BAR; PG8_SCHED;
            PG8_LDB(B1, 0, 1); PG8_STAGE(PG8_SB(0, 0), b2, voffB);
            PG8_BAR; PG8_WAIT_L(0); PG8_MMA(0, 1, At, B1); PG8_BAR;
            PG8_LDA(At, 0, 1); PG8_STAGE(PG8_SA(0, 0), a2, voffA);
            PG8_BAR; PG8_WAIT_L(0); PG8_MMA(1, 0, At, B0); PG8_BAR; PG8_SCHED;
            PG8_STAGE(PG8_SB(0, 1), b2 + hstep, voffB);
            PG8_WAIT_V(6); PG8_BAR; PG8_MMA(1, 1, At, B1); PG8_BAR;
            PG8_LDB(B0, 1, 0); PG8_SCHED; PG8_LDA(At, 1, 0); PG8_STAGE(PG8_SA(0, 1), a2 + hstep, voffA);
            PG8_WAIT_L(8); PG8_BAR; PG8_WAIT_L(0); PG8_MMA(0, 0, At, B0); PG8_BAR; PG8_SCHED;
            PG8_LDB(B1, 1, 1); PG8_STAGE(PG8_SB(1, 0), b3, voffB);
            PG8_BAR; PG8_WAIT_L(0); PG8_MMA(0, 1, At, B1); PG8_BAR;
            PG8_LDA(At, 1, 1); PG8_STAGE(PG8_SA(1, 0), a3, voffA);
            PG8_BAR; PG8_WAIT_L(0); PG8_MMA(1, 0, At, B0); PG8_BAR; PG8_SCHED;
            PG8_STAGE(PG8_SB(1, 1), b3 + hstep, voffB);
            PG8_WAIT_V(6); PG8_BAR; PG8_MMA(1, 1, At, B1); PG8_BAR;
            }
        }
        if constexpr (ALIGN_EPI) { if (wr == 0) PG8_BAR; }
        if constexpr (FP8) asm volatile("s_nop 15\n\ts_nop 15" ::: "memory");
        {
            int fr_ = fr, fq_ = fq; asm volatile("" : "+v"(fr_), "+v"(fq_));
            const int row0 = cur.pm * BM + wr * 64 + fr_, col0 = cur.pn * BM + wc * 32 + 8 * fq_;
            Epi E2 = E; E2.launder();
            if constexpr (has_rowscale<Epi>::value) {
                float rs[2][4];
#pragma unroll
                for (int ai = 0; ai < 2; ++ai)
#pragma unroll
                    for (int m = 0; m < 4; ++m) rs[ai][m] = E2.rowscale(row0 + ai * HALF + m * 16);
#pragma unroll
                for (int ai = 0; ai < 2; ++ai)
#pragma unroll
                    for (int m = 0; m < 4; ++m)
#pragma unroll
                        for (int bj = 0; bj < 2; ++bj) E2(row0 + ai * HALF + m * 16, col0 + bj * HALF, acc[ai][bj][m][0] * rs[ai][m], acc[ai][bj][m][1] * rs[ai][m]);
            } else {
#pragma unroll
            for (int ai = 0; ai < 2; ++ai)
#pragma unroll
                for (int m = 0; m < 4; ++m)
#pragma unroll
                    for (int bj = 0; bj < 2; ++bj) E2(row0 + ai * HALF + m * 16, col0 + bj * HALF, acc[ai][bj][m][0], acc[ai][bj][m][1]);
            }
            if constexpr (has_finish<Epi>::value) E2.finish(cur.pm, cur.pn, tid);
            S.done(cur);
        }
        if (!has_next) break;
#pragma unroll
        for (int a = 0; a < 2; ++a)
#pragma unroll
            for (int b = 0; b < 2; ++b)
#pragma unroll
                for (int m = 0; m < 4; ++m)
#pragma unroll
                    for (int n = 0; n < 2; ++n) acc[a][b][m][n] = (f32x4){0.f, 0.f, 0.f, 0.f};
        cur = nxt; cA = nA; cB = nB; ++ui;
        if constexpr (ALIGN_EPI) { if (wr == 1) PG8_BAR; }
    }
    PG8_WAIT_V(0);
    if constexpr (!ALIGN_EPI) { if (wr == 0) PG8_BAR; }
    PG8_BAR;
#undef PG8_SA
#undef PG8_SB
#undef PG8_STAGE
#undef PG8_LDA
#undef PG8_RD
#undef PG8_LDB
#undef PG8_MMA
#undef PG8_CAT
#undef PG8_WAIT_V
#undef PG8_WAIT_L
#undef PG8_BAR
#undef PG8_SCHED
}

struct MoeOrder {
    StaticOrder so; int t0, abase, nN; const int* tile_e;
    __device__ void init(int t0_, int t1_, int N, int G_, int c_, const int* te, int abase_) { so.init((t1_ - t0_) * BM, N, G_, c_); t0 = t0_; abase = abase_; nN = N / BM; tile_e = te; }
    __device__ bool next(int i, Unit& u) const { if (!so.next(i, u)) return false; u.pm += t0; u.pa = u.pm - abase; u.pb = __builtin_amdgcn_readfirstlane(tile_e[u.pm]) * nN + u.pn; return true; }
    __device__ __forceinline__ void a_ready(const Unit&) const {}
    __device__ __forceinline__ void done(const Unit&) const {}
};
}

template <class Epi>
__device__ __forceinline__ void simple_gemm(const Ctx& X, const bf16* A, const bf16* Bt, int row_lo, int nrows, int N, int K, const int* tile_e, size_t expert_stride, int a_rowbase, const Epi& E) {
    const int fr = X.lane & 15, fq = X.lane >> 4;
    const int ncb = N / 32, ntile = (nrows / 16) * ncb;
    const int gw = X.bid * NWAVES + X.wave, ngw = X.nblk * NWAVES;
    for (int t = gw; t < ntile; t += ngw) {
        const int tm = t / ncb, tn = t - tm * ncb, r0 = row_lo + tm * 16, c0 = tn * 32;
        const bf16* Bb = Bt; if (tile_e) Bb += (size_t)tile_e[r0 >> 8] * expert_stride;
        const bf16* arow = A + (size_t)(r0 - a_rowbase + fr) * K + 8 * fq;
        const bf16* b0 = Bb + (size_t)(c0 + perm32(fr)) * K + 8 * fq;
        const bf16* b1 = Bb + (size_t)(c0 + perm32(16 + fr)) * K + 8 * fq;
        f32x4 acc0 = {0.f, 0.f, 0.f, 0.f}, acc1 = {0.f, 0.f, 0.f, 0.f};
        for (int k = 0; k < K; k += 32) {
            const bf16x8 a = *(const bf16x8*)(arow + k), w0 = *(const bf16x8*)(b0 + k), w1 = *(const bf16x8*)(b1 + k);
            acc0 = __builtin_amdgcn_mfma_f32_16x16x32_bf16(w0, a, acc0, 0, 0, 0);
            acc1 = __builtin_amdgcn_mfma_f32_16x16x32_bf16(w1, a, acc1, 0, 0, 0);
        }
        E(r0 + fr, c0 + 8 * fq, acc0, acc1);
    }
}


namespace pg8 { struct OneUnit { Unit u; bool have;
    __device__ bool next(int i, Unit& o) const { if (i != 0 || !have) return false; o = u; return true; }
    __device__ __forceinline__ void a_ready(const Unit&) const {}
    __device__ __forceinline__ void done(const Unit&) const {} }; }
struct EpiSlab {
    float* slab; int ks;
    __device__ __forceinline__ void launder() {}
    __device__ __forceinline__ void operator()(int row, int c, f32x4 a, f32x4 b) const {
        float* d = slab + ((size_t)((((row >> 8) - 128) * 4 + (c >> 8)) * 7 + ks) * 256 + (row & 255)) * 256 + (c & 255);
        *(f32x4*)d = a; *(f32x4*)(d + 4) = b; }
};
template <class Epi>
__device__ __forceinline__ void gemm_dense(const Ctx& X, const bf16* A, const bf16* Bt, int N, int K, const Epi& E) {
#if FAST_GEMM
    pg8::Gemm g{A, Bt, T, N, K, 0}; pg8::StaticOrder S; S.init(T, N, X.nblk, X.bid);
    pg8::gemm_phase<Epi, pg8::StaticOrder, true, true>(X.lds, g, S, E);
#else
    simple_gemm(X, A, Bt, 0, T, N, K, nullptr, 0, 0, E);
#endif
}
template <class Epi>
__device__ __forceinline__ void gemm_moe(const Ctx& X, const bf16* A, const bf16* Bt, int t0, int t1, int N, int K, const int* tile_e, int abase, int wscale, const Epi& E) {
#if FAST_GEMM
    pg8::Gemm g{A, Bt, (t1 - t0) * 256, N, K, wscale, 0}; pg8::MoeOrder S; S.init(t0, t1, N, X.nblk, X.bid, tile_e, abase);
    pg8::gemm_phase<Epi, pg8::MoeOrder, true, true, MOE_FP8 != 0>(X.lds, g, S, E);
#else
    simple_gemm(X, A, Bt, t0 * 256, (t1 - t0) * 256, N, K, tile_e, (size_t)N * K, abase * 256, E);
#endif
}

struct SrcPlain { const float* W; int N; __device__ __forceinline__ f32x4 load4(int k, int n4) const { return *(const f32x4*)(W + (size_t)k * N + n4); } };
struct SrcScaled { const float* W; int N; const float* rs; __device__ __forceinline__ f32x4 load4(int k, int n4) const { return *(const f32x4*)(W + (size_t)k * N + n4) * rs[k]; } };
__device__ __forceinline__ int rope_src(int j) { const int g = j >> 3, jj = j & 7; return (jj < 4) ? (4 * g + jj) : (32 + 4 * g + (jj - 4)); }
struct SrcIn { const float* W; const float* rs;
    __device__ __forceinline__ f32x4 load4(int k, int n4) const { if (n4 >= NPROJ) return (f32x4){0.f, 0.f, 0.f, 0.f}; int m = n4; if (n4 >= 640 && n4 < 704) m = 640 + rope_src(n4 - 640); const f32x4 v = *(const f32x4*)(W + (size_t)k * NPROJ + m); return rs ? v * rs[k] : v; } };
struct SrcQB { const float* W; const float* gain;
    __device__ __forceinline__ f32x4 load4(int k, int n4) const { const int h = n4 / DQK; int c = n4 - h * DQK; if (c >= DNOPE) c = DNOPE + rope_src(c - DNOPE);
        return *(const f32x4*)(W + (size_t)k * (NH * DQK) + h * DQK + c) * (gain[k] * 0.07216878364870322f); } };
struct SrcGU { const float* Wg; const float* Wu; int FF; const float* rs;
    __device__ __forceinline__ f32x4 load4(int k, int n4) const { const int g = n4 >> 3; const long long d = (n4 & 4) ? (long long)(Wu - Wg) : 0ll; const f32x4 v = *(const f32x4*)(Wg + d + (long long)k * FF + 4 * g); return rs ? v * rs[k] : v; } };

template <class Src>
__device__ __forceinline__ void transpose_item(const Src& S, int K, int nblk, bf16* WT, LAS float* scr, int item, int lane) {
    const int kb = item / nblk, nb = item - kb * nblk, k0 = 64 * kb, n0 = 32 * nb;
    const int kk0 = lane >> 3, qd = lane & 7;
    f32x4 v[8];
#pragma unroll
    for (int i = 0; i < 8; ++i) v[i] = S.load4(k0 + 8 * i + kk0, n0 + 4 * qd);
#pragma unroll
    for (int i = 0; i < 8; ++i) { LAS float* d = scr + (8 * i + kk0) * 33 + 4 * qd; d[0] = v[i].x; d[1] = v[i].y; d[2] = v[i].z; d[3] = v[i].w; }
    asm volatile("s_waitcnt lgkmcnt(0)" ::: "memory");
    const int c = lane & 7;
#pragma unroll
    for (int j = 0; j < 4; ++j) { const int n = (lane >> 3) + 8 * j; const LAS float* s = scr + (8 * c) * 33 + n;
        u32x4 o; o.x = pk2(s[0 * 33], s[1 * 33]); o.y = pk2(s[2 * 33], s[3 * 33]); o.z = pk2(s[4 * 33], s[5 * 33]); o.w = pk2(s[6 * 33], s[7 * 33]);
        *(u32x4*)(WT + (size_t)(n0 + n) * K + k0 + 8 * c) = o; }
    asm volatile("s_waitcnt lgkmcnt(0)" ::: "memory");
}

template <class Src>
__device__ __forceinline__ void transpose_item_fp8(const Src& S, int K, int nblk, unsigned char* WT, LAS float* scr, int item, int lane, float scale) {
    const int kb = item / nblk, nb = item - kb * nblk, k0 = 64 * kb, n0 = 32 * nb;
    const int kk0 = lane >> 3, qd = lane & 7;
    f32x4 v[8];
#pragma unroll
    for (int i = 0; i < 8; ++i) v[i] = S.load4(k0 + 8 * i + kk0, n0 + 4 * qd);
#pragma unroll
    for (int i = 0; i < 8; ++i) { LAS float* d = scr + (8 * i + kk0) * 33 + 4 * qd; d[0] = v[i].x * scale; d[1] = v[i].y * scale; d[2] = v[i].z * scale; d[3] = v[i].w * scale; }
    asm volatile("s_waitcnt lgkmcnt(0)" ::: "memory");
    const int c = lane & 3;
#pragma unroll
    for (int j = 0; j < 2; ++j) { const int n = (lane >> 2) + 16 * j; const LAS float* s = scr + (16 * c) * 33 + n;
        u32x4 o; o.x = pk4_fp8(s[0 * 33], s[1 * 33], s[2 * 33], s[3 * 33]); o.y = pk4_fp8(s[4 * 33], s[5 * 33], s[6 * 33], s[7 * 33]);
        o.z = pk4_fp8(s[8 * 33], s[9 * 33], s[10 * 33], s[11 * 33]); o.w = pk4_fp8(s[12 * 33], s[13 * 33], s[14 * 33], s[15 * 33]);
        *(u32x4*)(WT + (size_t)(n0 + n) * K + k0 + 16 * c) = o; }
    asm volatile("s_waitcnt lgkmcnt(0)" ::: "memory");
}

template <int NR, class TS>
__device__ __forceinline__ void norm_rows_bf16(const TS* src, const float* gain, bf16* dst, int row0, int rstep, int lane) {
    f32x4 v[NR][4];
#pragma unroll
    for (int i = 0; i < NR; ++i)
#pragma unroll
        for (int j = 0; j < 4; ++j) v[i][j] = ldrow4(src + (size_t)(row0 + i * rstep) * DM, lane + 64 * j);
    f32x4 g[4];
#pragma unroll
    for (int j = 0; j < 4; ++j) g[j] = *((const f32x4*)gain + lane + 64 * j);
#pragma unroll
    for (int i = 0; i < NR; ++i) { float s = 0.f;
#pragma unroll
        for (int j = 0; j < 4; ++j) s += (v[i][j].x * v[i][j].x + v[i][j].y * v[i][j].y) + (v[i][j].z * v[i][j].z + v[i][j].w * v[i][j].w);
        const float rstd = __builtin_amdgcn_rsqf(wave_sum(s) * (1.f / DM) + EPS);
#pragma unroll
        for (int j = 0; j < 4; ++j) { const f32x4 y = v[i][j] * rstd * g[j]; u32x2 w; w.x = pk2(y.x, y.y); w.y = pk2(y.z, y.w); *((u32x2*)(dst + (size_t)(row0 + i * rstep) * DM) + lane + 64 * j) = w; } }
}
template <class TS>
__device__ __forceinline__ void norm_all_rows(const Ctx& X, const TS* src, const float* gain, bf16* dst) {
    const int gw = X.bid * NWAVES + X.wave, ngw = X.nblk * NWAVES;
    int m = gw;
    for (; m + 3 * ngw < T; m += 4 * ngw) norm_rows_bf16<4, TS>(src, gain, dst, m, ngw, X.lane);
    for (; m < T; m += ngw) norm_rows_bf16<1, TS>(src, gain, dst, m, ngw, X.lane);
}

__device__ __forceinline__ void phase_prologue(const Ctx& X, const Params& p) {
    unsigned char* ws = p.ws;
    LAS float* scr = (LAS float*)(X.lds + X.wave * 16384);
    const int gw = X.bid * NWAVES + X.wave, ngw = X.nblk * NWAVES;
    constexpr int I_IN = 16 * 88, I_QB = 6 * 24, I_KVB = 4 * 32, I_OUT = 16 * 32, I_GU = 16 * 176, I_DN = 44 * 32, I_MGU = 16 * 224, I_MDN = 56 * 32;
    constexpr int I_LAYER = I_IN + I_QB + I_KVB + I_OUT;
    constexpr int NITEMS = 2 * I_LAYER + I_GU + I_DN + NE * (I_MGU + I_MDN);
    for (int it = gw; it < NITEMS; it += ngw) {
        int r = it;
        if (r < 2 * I_LAYER) {
            const int l = r / I_LAYER; r -= l * I_LAYER;
            if (r < I_IN) { SrcIn S{p.in[I_WIN] + (size_t)l * DM * NPROJ, (FUSE_NORM && l == 1) ? p.in[I_MIXN] + DM : nullptr}; transpose_item(S, DM, NPROJ_P / 32, (bf16*)(ws + WS_WT_IN) + (size_t)l * NPROJ_P * DM, scr, r, X.lane); continue; } r -= I_IN;
            if (r < I_QB) { SrcQB S{p.in[I_WQB] + (size_t)l * QR * (NH * DQK), p.in[I_QAN] + l * QR}; transpose_item(S, QR, (NH * DQK) / 32, (bf16*)(ws + WS_WT_QB) + (size_t)l * (NH * DQK) * QR, scr, r, X.lane); continue; } r -= I_QB;
            if (r < I_KVB) { SrcScaled S{p.in[I_WKVB] + (size_t)l * KVR * 1024, 1024, p.in[I_KVAN] + l * KVR}; transpose_item(S, KVR, 1024 / 32, (bf16*)(ws + WS_WT_KVB) + (size_t)l * 1024 * KVR, scr, r, X.lane); continue; } r -= I_KVB;
            { SrcPlain S{p.in[I_WOUT] + (size_t)l * DM * DM, DM}; transpose_item(S, DM, DM / 32, (bf16*)(ws + WS_WT_OUT) + (size_t)l * DM * DM, scr, r, X.lane); continue; }
        }
        r -= 2 * I_LAYER;
        if (r < I_GU) { SrcGU S{p.in[I_DWG], p.in[I_DWU], FF0, FUSE_NORM ? p.in[I_FFNN] : nullptr}; transpose_item(S, DM, (2 * FF0) / 32, (bf16*)(ws + WS_WT_GU), scr, r, X.lane); continue; } r -= I_GU;
        if (r < I_DN) { SrcPlain S{p.in[I_DWD], DM}; transpose_item(S, FF0, DM / 32, (bf16*)(ws + WS_WT_DN), scr, r, X.lane); continue; } r -= I_DN;
        if (r < NE * I_MGU) { const int e = r / I_MGU; r -= e * I_MGU; SrcGU S{p.in[I_MWG] + (size_t)e * DM * FFM, p.in[I_MWU] + (size_t)e * DM * FFM, FFM, nullptr};
#if MOE_FP8
            transpose_item_fp8(S, DM, (2 * FFM) / 32, (unsigned char*)(ws + WS_WT_MGU) + (size_t)e * (2 * FFM) * DM, scr, r, X.lane, 64.f); continue; } r -= NE * I_MGU;
        { const int e = r / I_MDN; r -= e * I_MDN; SrcPlain S{p.in[I_MWD] + (size_t)e * FFM * DM, DM};
            transpose_item_fp8(S, FFM, DM / 32, (unsigned char*)(ws + WS_WT_MDN) + (size_t)e * DM * FFM, scr, r, X.lane, 128.f); }
#else
            transpose_item(S, DM, (2 * FFM) / 32, (bf16*)(ws + WS_WT_MGU) + (size_t)e * (2 * FFM) * DM, scr, r, X.lane); continue; } r -= NE * I_MGU;
        { const int e = r / I_MDN; r -= e * I_MDN; SrcPlain S{p.in[I_MWD] + (size_t)e * FFM * DM, DM};
            transpose_item(S, FFM, DM / 32, (bf16*)(ws + WS_WT_MDN) + (size_t)e * DM * FFM, scr, r, X.lane); }
#endif
    }
    { const int* pos = (const int*)p.in[I_POS]; float* COS = (float*)(ws + WS_COS); float* SIN = (float*)(ws + WS_SIN);
      for (int i = X.bid * NTHREADS + X.tid; i < T * 32; i += X.nblk * NTHREADS) {
          const int row = i >> 5, f = i & 31; const double a = (double)pos[row] * kInvRev[f]; const float rev = (float)(a - floor(a));
          COS[i] = __builtin_amdgcn_cosf(rev); SIN[i] = __builtin_amdgcn_sinf(rev); } }
    if (X.bid == 0) { float* LB = (float*)(ws + WS_MISC + MISC_LB); const float* h = p.in[I_HLB];
        for (int i = X.tid; i < HGW; i += NTHREADS) { LB[i] = 0.f; LB[HGW + i] = 1.f / (1.f + expf(h[i] - h[HGW + i])); } }
    norm_all_rows(X, p.in[I_X], p.in[I_MIXN], (bf16*)(ws + WS_XB));
}

__device__ __forceinline__ void phase_attn_simple(const Ctx& X, const Params& p) {
    unsigned char* ws = p.ws;
    const bf16* Q = (const bf16*)(ws + WS_Q); const bf16* KN = (const bf16*)(ws + WS_KN); const bf16* KPE = (const bf16*)(ws + WS_KPE); const bf16* V = (const bf16*)(ws + WS_V);
    bf16* CC = (bf16*)(ws + WS_CC);
    LAS float* ql = (LAS float*)(X.lds + X.wave * 1024);
    const int gw = X.bid * NWAVES + X.wave, ngw = X.nblk * NWAVES, lane = X.lane;
    for (int idx = gw; idx < 2 * NH * SEQ; idx += ngw) {
        const int bh = idx & 7, q = SEQ - 1 - (idx >> 3), b = bh >> 2, h = bh & 3;
        const bf16* qrow = Q + ((size_t)bh * SEQ + q) * DQK;
        ql[lane] = bf2f(qrow[lane]); ql[64 + lane] = bf2f(qrow[64 + lane]); ql[128 + lane] = bf2f(qrow[128 + lane]);
        asm volatile("s_waitcnt lgkmcnt(0)" ::: "memory");
        float m = -1e30f, l = 0.f, o0 = 0.f, o1 = 0.f;
        for (int k0 = 0; k0 <= q; k0 += 64) {
            const int key = k0 + lane; const bool valid = key <= q;
            float s = 0.f;
            const bf16* kr = KN + ((size_t)bh * SEQ + key) * 128; const bf16* kp = KPE + ((size_t)b * SEQ + key) * ROPE;
#pragma unroll 4
            for (int c = 0; c < 16; ++c) { const u32x4 w = *(const u32x4*)(kr + 8 * c); const LAS float* qq = ql + 8 * c;
                s += bflo(w.x) * qq[0] + bfhi(w.x) * qq[1] + bflo(w.y) * qq[2] + bfhi(w.y) * qq[3] + bflo(w.z) * qq[4] + bfhi(w.z) * qq[5] + bflo(w.w) * qq[6] + bfhi(w.w) * qq[7]; }
#pragma unroll 4
            for (int c = 0; c < 8; ++c) { const u32x4 w = *(const u32x4*)(kp + 8 * c); const LAS float* qq = ql + 128 + 8 * c;
                s += bflo(w.x) * qq[0] + bfhi(w.x) * qq[1] + bflo(w.y) * qq[2] + bfhi(w.y) * qq[3] + bflo(w.z) * qq[4] + bfhi(w.z) * qq[5] + bflo(w.w) * qq[6] + bfhi(w.w) * qq[7]; }
            if (!valid) s = -1e30f;
            const float mx = wave_max(s), mn = fmaxf(m, mx), alpha = fast_exp(m - mn);
            const float pr = valid ? fast_exp(s - mn) : 0.f;
            l = l * alpha + wave_sum(pr); o0 *= alpha; o1 *= alpha; m = mn;
            const bf16* vb = V + ((size_t)bh * SEQ + k0) * 128 + 2 * lane;
            for (int j = 0; j < 64; ++j) { const float pj = __shfl(pr, j); const unsigned w = *(const unsigned*)(vb + (size_t)j * 128); o0 += pj * bflo(w); o1 += pj * bfhi(w); }
        }
        const float inv = 1.f / l;
        *(unsigned*)(CC + ((size_t)(b * SEQ + q)) * DM + h * 128 + 2 * lane) = pk2(o0 * inv, o1 * inv);
    }
}


namespace att {
typedef short s16x4 __attribute__((ext_vector_type(4)));
typedef float f32x16 __attribute__((ext_vector_type(16)));
constexpr int NW = 8, QBLK = 32, KVBLK = 64, QB = 256, NQB = SEQ / QB;
constexpr int KROW = 400, SHM_V = KVBLK * 128 * 2, SHM_K = KVBLK * KROW;
constexpr int LDS_V = 0, LDS_K = 2 * SHM_V, LDS_WS = LDS_K + 2 * SHM_K, LDS_TOTAL = LDS_WS + NW * 64 * 4;
constexpr float THR = 8.f;
#define SBAR() __builtin_amdgcn_sched_barrier(0)
__device__ __forceinline__ int v_st(int k, int c) { const int kk = (k & ~0xC) | ((k & 4) << 1) | ((k & 8) >> 1); return ((kk >> 3) * 4 + (c >> 5)) * 512 + ((kk & 7) * 32 + (c & 31)) * 2; }
__device__ __forceinline__ int v_rd_base(int lane) { return ((lane & 3) << 3) | (((lane >> 2) & 3) << 6) | (((lane >> 4) & 1) << 5) | (((lane >> 5) & 1) << 8); }
constexpr int v_rd_off(int d0, int ks, int half) { return d0 * 512 + ks * 4096 + half * 2048; }
__device__ __forceinline__ int crow(int r, int hi) { return (r & 3) + 8 * (r >> 2) + 4 * hi; }
__device__ __forceinline__ unsigned cvtpk(float lo, float hi) { unsigned r; asm volatile("v_cvt_pk_bf16_f32 %0, %1, %2" : "=v"(r) : "v"(lo), "v"(hi)); return r; }
__device__ __forceinline__ bf16x8 load8(const bf16* p) { return *reinterpret_cast<const bf16x8*>(p); }
__device__ __forceinline__ bf16x8 bload8(__amdgpu_buffer_rsrc_t r, unsigned voff, unsigned soff) { const u32x4 x = __builtin_amdgcn_raw_buffer_load_b128(r, voff, soff, 0); return __builtin_bit_cast(bf16x8, x); }
__device__ __forceinline__ void mask_tile(f32x16& p0, f32x16& p1, int dq) {
    const float NEG = -__builtin_inff();
#pragma unroll
    for (int r = 0; r < 16; ++r) { const int c = (r & 3) + 8 * (r >> 2); if (dq - c < 0) p0[r] = NEG; if (dq - c - 32 < 0) p1[r] = NEG; }
}
__device__ __forceinline__ void partialSM(f32x16& p0, f32x16& p1, float& m_reg, float& mn, float& alpha) {
    float pmax = p0[0]; for (int r = 1; r < 16; ++r) pmax = fmaxf(pmax, p0[r]); for (int r = 0; r < 16; ++r) pmax = fmaxf(pmax, p1[r]);
    { auto rr = __builtin_amdgcn_permlane32_swap(__float_as_uint(pmax), __float_as_uint(pmax), false, false);
      pmax = fmaxf(__uint_as_float(rr[0]), __uint_as_float(rr[1])); }
    constexpr float C2 = 1.4426950408889634f;
    if (__builtin_expect(__all((pmax - m_reg) <= THR), 1)) { mn = m_reg; alpha = 1.f; }
    else { mn = fmaxf(m_reg, pmax); alpha = __builtin_amdgcn_exp2f((m_reg - mn) * C2); m_reg = mn; }
    const float mnL = -mn * C2;
    for (int r = 0; r < 16; ++r) p0[r] = fmaf(p0[r], C2, mnL); for (int r = 0; r < 16; ++r) p1[r] = fmaf(p1[r], C2, mnL);
    for (int r = 0; r < 16; ++r) p0[r] = __builtin_amdgcn_exp2f(p0[r]);
}
__device__ __forceinline__ void finishSM(f32x16& p0, f32x16& p1, float alpha, float& l_reg, bf16x8& pa0, bf16x8& pa1, bf16x8& pa2, bf16x8& pa3) {
    for (int r = 0; r < 16; ++r) p1[r] = __builtin_amdgcn_exp2f(p1[r]);
    float ps = 0; for (int r = 0; r < 16; ++r) ps += p0[r]; for (int r = 0; r < 16; ++r) ps += p1[r];
    { auto rr = __builtin_amdgcn_permlane32_swap(__float_as_uint(ps), __float_as_uint(ps), false, false);
      ps = __uint_as_float(rr[0]) + __uint_as_float(rr[1]); }
    l_reg = l_reg * alpha + ps;
#define PK4(P, B_, OUT) do { unsigned a0 = cvtpk(P[B_+0], P[B_+1]), a1 = cvtpk(P[B_+2], P[B_+3]);                          \
        unsigned b0 = cvtpk(P[B_+4], P[B_+5]), b1 = cvtpk(P[B_+6], P[B_+7]);                                             \
        auto r0 = __builtin_amdgcn_permlane32_swap(a0, b0, false, false); auto r1 = __builtin_amdgcn_permlane32_swap(a1, b1, false, false); \
        u32x4 w = {r0[0], r1[0], r0[1], r1[1]}; OUT = *reinterpret_cast<bf16x8*>(&w); } while (0)
    PK4(p0, 0, pa0); PK4(p0, 8, pa1); PK4(p1, 0, pa2); PK4(p1, 8, pa3);
#undef PK4
}
template <int KB>
__device__ __forceinline__ void qkt(f32x16& p0, f32x16& p1, const LAS char* K_lds, int r32, int hi, const bf16x8* qr) {
    p0 = f32x16{}; p1 = f32x16{};
    const LAS char* kb = K_lds + KB * SHM_K + r32 * KROW + hi * 16;
#pragma unroll
    for (int d0 = 0; d0 < 12; ++d0) {
        const bf16x8 b0 = *reinterpret_cast<const LAS bf16x8*>(kb + d0 * 32);
        const bf16x8 b1 = *reinterpret_cast<const LAS bf16x8*>(kb + d0 * 32 + 32 * KROW);
        p0 = __builtin_amdgcn_mfma_f32_32x32x16_bf16(b0, qr[d0], p0, 0, 0, 0);
        p1 = __builtin_amdgcn_mfma_f32_32x32x16_bf16(b1, qr[d0], p1, 0, 0, 0); }
}
template <int VB>
__device__ __forceinline__ void pv_tile(f32x16* o, int vb0, bf16x8 pa0, bf16x8 pa1, bf16x8 pa2, bf16x8 pa3) {
#define TRRD(dst, off) asm volatile("ds_read_b64_tr_b16 %0, %1 offset:%2" : "=&v"(dst) : "v"(vb0), "i"(off) : "memory")
#define PV_D0(d0) do { s16x4 l0, l1, l2, l3, h0, h1, h2, h3; constexpr int b_ = VB * SHM_V + v_rd_off(d0, 0, 0); \
        TRRD(l0, b_); TRRD(h0, b_ + 2048); TRRD(l1, b_ + 4096); TRRD(h1, b_ + 6144); TRRD(l2, b_ + 8192); TRRD(h2, b_ + 10240); TRRD(l3, b_ + 12288); TRRD(h3, b_ + 14336); \
        asm volatile("s_waitcnt lgkmcnt(0)" ::: "memory"); SBAR();   \
        o[d0] = __builtin_amdgcn_mfma_f32_32x32x16_bf16(pa0, (bf16x8){l0[0], l0[1], l0[2], l0[3], h0[0], h0[1], h0[2], h0[3]}, o[d0], 0, 0, 0);   \
        o[d0] = __builtin_amdgcn_mfma_f32_32x32x16_bf16(pa1, (bf16x8){l1[0], l1[1], l1[2], l1[3], h1[0], h1[1], h1[2], h1[3]}, o[d0], 0, 0, 0);   \
        o[d0] = __builtin_amdgcn_mfma_f32_32x32x16_bf16(pa2, (bf16x8){l2[0], l2[1], l2[2], l2[3], h2[0], h2[1], h2[2], h2[3]}, o[d0], 0, 0, 0);   \
        o[d0] = __builtin_amdgcn_mfma_f32_32x32x16_bf16(pa3, (bf16x8){l3[0], l3[1], l3[2], l3[3], h3[0], h3[1], h3[2], h3[3]}, o[d0], 0, 0, 0); } while (0)
    PV_D0(0); PV_D0(1); PV_D0(2); PV_D0(3);
#undef PV_D0
#undef TRRD
}
struct BlockRef { const bf16* Q; const bf16* KN; const bf16* KP; const bf16* V; bf16* O; float* ML; int ostride, P0, par, NT; };
struct Seam { bf16x8 qr[12]; bf16x8 st_v0, st_v1, st_k0, st_k1, st_k2; };
#define VMW() asm volatile("s_waitcnt vmcnt(0)" ::: "memory")
#define VMWN(n) asm volatile("s_waitcnt vmcnt(%0)" :: "i"(n) : "memory")
#define SLOAD(R, k0) do { const unsigned so_ = (unsigned)(k0) * 256u, sp_ = (unsigned)(k0) * 128u; \
                          S.st_v0 = bload8(rV, lofs, so_); S.st_v1 = bload8(rV, lofs, so_ + 8192u); S.st_k0 = bload8(rK, lofs, so_); S.st_k1 = bload8(rK, lofs, so_ + 8192u); S.st_k2 = bload8(rP, lofp, sp_); } while (0)
#define SWRITE_K(bf) do { *(LAS bf16x8*)(K_lds + (bf) * SHM_K + kws) = S.st_k0; *(LAS bf16x8*)(K_lds + (bf) * SHM_K + kws + 32 * KROW) = S.st_k1; *(LAS bf16x8*)(K_lds + (bf) * SHM_K + kwp) = S.st_k2; } while (0)
#define SWRITE_V(bf) do { *(LAS bf16x8*)(V_lds + (bf) * SHM_V + vst0) = S.st_v0; *(LAS bf16x8*)(V_lds + (bf) * SHM_V + vst1) = S.st_v1; } while (0)
#define KBASE_OF(R, t) (((R).par + 2 * (t)) * KVBLK)
__device__ __forceinline__ void attn_block(const BlockRef& cur, LAS char* lds, int tid) {
    Seam S;
    const int wid = __builtin_amdgcn_readfirstlane(tid >> 6), lane = tid & 63, r32 = lane & 31, hi = lane >> 5;
    const int NT = cur.NT;
    const int qlo = cur.P0 + wid * QBLK, qm = qlo + r32 - 4 * hi;
    LAS char* V_lds = lds + LDS_V; LAS char* K_lds = lds + LDS_K;
    LAS float* wsc = (LAS float*)(lds + LDS_WS) + wid * 64; LAS float* li_l = wsc; LAS float* al_l = wsc + 32;
    float m_reg = -1e30f, l_reg = 0; f32x16 o[4] = {};
    const int sr = tid >> 4, sc = (tid & 15) * 8, vst0 = v_st(sr, sc), vst1 = v_st(32 + sr, sc), kws = sr * KROW + sc * 2, pr = tid >> 3, pc = (tid & 7) * 8, kwp = pr * KROW + 256 + pc * 2;
    const unsigned lofs = (unsigned)(sr * 128 + sc) * 2u, lofp = (unsigned)(pr * 64 + pc) * 2u;
    const __amdgpu_buffer_rsrc_t rV = __builtin_amdgcn_make_buffer_rsrc((void*)cur.V, 0, SEQ * 128 * 2, 0x00020000), rK = __builtin_amdgcn_make_buffer_rsrc((void*)cur.KN, 0, SEQ * 128 * 2, 0x00020000),
                                 rP = __builtin_amdgcn_make_buffer_rsrc((void*)cur.KP, 0, SEQ * ROPE * 2, 0x00020000);
    const int vb0 = (int)(unsigned)(size_t)V_lds + v_rd_base(lane);
#define RESC(a) do { if (__any((a) < 1.f)) { if (hi == 0) al_l[r32] = (a); asm volatile("s_waitcnt lgkmcnt(0)" ::: "memory");              \
                     for (int d_ = 0; d_ < 4; ++d_) for (int r = 0; r < 16; ++r) o[d_][r] *= al_l[crow(r, hi)]; } } while (0)
#define KBASE(t) KBASE_OF(cur, t)
#define MASKT(P0_, P1_, t) do { const int kb_ = KBASE(t); if (kb_ + KVBLK - 1 > qlo) mask_tile(P0_, P1_, qm - kb_); } while (0)
    f32x16 pA0, pA1, pB0, pB1; float mnA, mnB, alA, alB; bf16x8 pa0, pa1, pa2, pa3;
#pragma unroll
    for (int d0 = 0; d0 < 12; ++d0) S.qr[d0] = load8(cur.Q + (size_t)(wid * QBLK + r32) * DQK + d0 * 16 + hi * 8);
    SLOAD(cur, KBASE(0)); VMW(); SWRITE_K(0); SWRITE_V(0);
    __syncthreads();
    SLOAD(cur, KBASE(1));
    SBAR(); qkt<0>(pA0, pA1, K_lds, r32, hi, S.qr);
    MASKT(pA0, pA1, 0); partialSM(pA0, pA1, m_reg, mnA, alA);
    VMW(); SWRITE_V(1); SWRITE_K(1);
    __syncthreads();
#define HALF_STEP(PX0, PX1, mnX, alX, PY0, PY1, alY, t, KB, VB, SB) do {                                                      \
        SBAR(); qkt<KB>(PX0, PX1, K_lds, r32, hi, S.qr);                                                                      \
        finishSM(PY0, PY1, alY, l_reg, pa0, pa1, pa2, pa3); SBAR();                                                           \
        if ((t) + 1 < NT) { SLOAD(cur, KBASE((t) + 1)); SBAR(); }                                                             \
        pv_tile<VB>(o, vb0, pa0, pa1, pa2, pa3); MASKT(PX0, PX1, (t)); partialSM(PX0, PX1, m_reg, mnX, alX);                  \
        __syncthreads();                                                                                                      \
        if ((t) + 1 < NT) { VMW(); SWRITE_V(SB); SWRITE_K(SB); }                                                              \
        RESC(alX); __syncthreads(); } while (0)
    for (int t = 1; t + 1 < NT; t += 2) {
        HALF_STEP(pB0, pB1, mnB, alB, pA0, pA1, alA, t, 1, 0, 0);
        HALF_STEP(pA0, pA1, mnA, alA, pB0, pB1, alB, t + 1, 0, 1, 1);
    }
    SBAR(); qkt<1>(pB0, pB1, K_lds, r32, hi, S.qr); SBAR();
    finishSM(pA0, pA1, alA, l_reg, pa0, pa1, pa2, pa3); SBAR();
    pv_tile<0>(o, vb0, pa0, pa1, pa2, pa3);
    MASKT(pB0, pB1, NT - 1); partialSM(pB0, pB1, m_reg, mnB, alB); __syncthreads(); RESC(alB);
    finishSM(pB0, pB1, alB, l_reg, pa0, pa1, pa2, pa3); SBAR(); pv_tile<1>(o, vb0, pa0, pa1, pa2, pa3);
    if (hi == 0) { li_l[r32] = l_reg; *(float2*)(cur.ML + (size_t)(wid * QBLK + r32) * 2) = make_float2(m_reg, l_reg); }
    asm volatile("s_waitcnt lgkmcnt(0)" ::: "memory");
    float rli[16];
#pragma unroll
    for (int r = 0; r < 16; ++r) { const float lv = li_l[crow(r, hi)]; rli[r] = lv > 0.f ? __builtin_amdgcn_rcpf(lv) : 0.f; }
    bf16* Ow = cur.O + (size_t)(wid * QBLK) * cur.ostride;
#pragma unroll
    for (int r = 0; r < 16; ++r) { const int orow = crow(r, hi);
#pragma unroll
        for (int d0 = 0; d0 < 4; ++d0) { const float v = o[d0][r] * rli[r]; const float vn = __shfl_xor(v, 1);
            if ((r32 & 1) == 0) *(unsigned*)(Ow + (size_t)orow * cur.ostride + d0 * 32 + r32) = cvtpk(v, vn); } }
    __syncthreads();
#undef RESC
#undef KBASE
#undef MASKT
#undef HALF_STEP
}
#undef SLOAD
#undef SWRITE_K
#undef SWRITE_V
#undef VMW
#undef VMWN
struct Item { int bh, x, par; };
__device__ __forceinline__ Item decode(int L) { Item it; it.bh = L & 7; const int rest = L >> 3; it.x = rest >> 1; it.par = rest & 1; return it; }
__device__ __forceinline__ BlockRef make_ref(unsigned char* ws, const Item& it, int pass) {
    const int qb = pass ? (NQB - 1 - it.x) : it.x, bh = it.bh; BlockRef r;
    r.Q = (const bf16*)(ws + WS_Q) + ((size_t)bh * SEQ + (size_t)qb * QB) * DQK;
    r.KN = (const bf16*)(ws + WS_KN) + (size_t)bh * SEQ * 128; r.KP = (const bf16*)(ws + WS_KPE) + (size_t)(bh >> 2) * SEQ * ROPE; r.V = (const bf16*)(ws + WS_V) + (size_t)bh * SEQ * 128;
    if (it.par == 0) { r.O = (bf16*)(ws + WS_CC) + ((size_t)((bh >> 2) * SEQ + qb * QB)) * DM + (bh & 3) * 128; r.ostride = DM; }
    else { r.O = (bf16*)(ws + WS_AP2) + ((size_t)bh * SEQ + (size_t)qb * QB) * 128; r.ostride = 128; }
    r.ML = (float*)(ws + WS_AML) + ((size_t)(it.par * 8 + bh) * SEQ + (size_t)qb * QB) * 2;
    r.P0 = qb * QB; r.par = it.par; r.NT = 2 * (qb + 1);
    return r;
}
}
__device__ __forceinline__ void phase_attn_fast(const Ctx& X, unsigned char* ws) {
    constexpr int TOTAL = 2 * NH * (att::NQB / 2) * 2;
    int L = X.bid; if (L >= TOTAL) return;
    const int stride = X.nblk;
    LAS char* lds = (LAS char*)X.lds;
    for (; L < TOTAL; L += stride) {
        const att::Item it = att::decode(L);
#pragma nounroll
        for (int pass = 0; pass < 2; ++pass) { const att::BlockRef cur = att::make_ref(ws, it, pass); att::attn_block(cur, lds, X.tid); }
    }
}
__device__ __forceinline__ void phase_attn_combine(const Ctx& X, unsigned char* ws) {
    bf16* CC = (bf16*)(ws + WS_CC); const bf16* P2 = (const bf16*)(ws + WS_AP2); const float* ML = (const float*)(ws + WS_AML);
    const int gw = X.bid * NWAVES + X.wave, ngw = X.nblk * NWAVES, lane = X.lane, h = lane >> 4, dd = (lane & 15) * 8;
    for (int r0 = gw; r0 < T; r0 += 4 * ngw) {
        u32x4 a[4], q[4]; float2 s1[4], s2[4];
#pragma unroll
        for (int i = 0; i < 4; ++i) { const int row = (r0 + i * ngw < T) ? r0 + i * ngw : r0, b = row >> 13, sq = row & (SEQ - 1), bh = b * NH + h;
            a[i] = *(const u32x4*)(CC + (size_t)row * DM + h * 128 + dd); q[i] = *(const u32x4*)(P2 + ((size_t)bh * SEQ + sq) * 128 + dd);
            s1[i] = *(const float2*)(ML + ((size_t)bh * SEQ + sq) * 2); s2[i] = *(const float2*)(ML + ((size_t)(8 + bh) * SEQ + sq) * 2); }
#pragma unroll
        for (int i = 0; i < 4; ++i) { const int row = (r0 + i * ngw < T) ? r0 + i * ngw : r0;
            const float m = fmaxf(s1[i].x, s2[i].x), w1 = s1[i].y * fast_exp(s1[i].x - m), w2 = s2[i].y * fast_exp(s2[i].x - m), inv = __builtin_amdgcn_rcpf(w1 + w2), c1 = w1 * inv, c2 = w2 * inv;
            u32x4 o; o.x = pk2(c1 * bflo(a[i].x) + c2 * bflo(q[i].x), c1 * bfhi(a[i].x) + c2 * bfhi(q[i].x)); o.y = pk2(c1 * bflo(a[i].y) + c2 * bflo(q[i].y), c1 * bfhi(a[i].y) + c2 * bfhi(q[i].y));
            o.z = pk2(c1 * bflo(a[i].z) + c2 * bflo(q[i].z), c1 * bfhi(a[i].z) + c2 * bfhi(q[i].z)); o.w = pk2(c1 * bflo(a[i].w) + c2 * bflo(q[i].w), c1 * bfhi(a[i].w) + c2 * bfhi(q[i].w));
            *(u32x4*)(CC + (size_t)row * DM + h * 128 + dd) = o; }
    }
}

namespace hg {
using att::s16x4; using att::f32x16; using att::v_st; using att::v_rd_base; using att::v_rd_off; using att::crow; using att::cvtpk;
constexpr int CH = 64, NCH = SEQ / CH;
constexpr int KROW2 = 272;
constexpr int TILE_V = 16384, TILE_K2 = CH * KROW2;
constexpr size_t US_BH = (size_t)NCH * 16384;
#define TRRD2(dst, base, off) asm volatile("ds_read_b64_tr_b16 %0, %1 offset:%2" : "=&v"(dst) : "v"(base), "i"(off) : "memory")
__device__ __forceinline__ float ex(float x) { return __builtin_amdgcn_exp2f(x * 1.4426950408889634f); }
#if HG_V2
__device__ __forceinline__ void h1_unit(const Ctx& X, unsigned char* ws, int u, const float* lbl) {
    int tid_ = X.tid; asm volatile("" : "+v"(tid_));
    const int bb = u >> 7, c = u & 127, row0 = bb * SEQ + c * CH, tid = tid_, lane = tid & 63, wave = X.wave;
    const bf16* HZ = (const bf16*)(ws + WS_HK); const bf16* HQ = (const bf16*)(ws + WS_HQ); const bf16* HV = (const bf16*)(ws + WS_HV);
    bf16* KRB = (bf16*)(ws + WS_LF); bf16* QRB = (bf16*)(ws + WS_LF + 16 * MiB);
    float* Dd = (float*)(ws + WS_HD); float* Rr = (float*)(ws + WS_HR); bf16* US = (bf16*)(ws + WS_XB);
    LAS char* lds = (LAS char*)X.lds;
    {
        const int t0 = tid >> 4, c8 = (tid & 15) * 8; const size_t g0 = (size_t)(row0 + t0) * HGW + c8; const int vst0 = v_st(t0, c8);
        u32x4 vw[8];
#pragma unroll
        for (int j = 0; j < 8; ++j) vw[j] = *(const u32x4*)(HV + g0 + (size_t)((j & 1) * 32 * HGW + (j >> 1) * 128));
#pragma unroll
        for (int j = 0; j < 8; ++j) *(LAS u32x4*)(lds + 65536 + (j >> 1) * TILE_V + vst0 + (j & 1) * 8192) = vw[j];
    }
    {
        const int head = tid >> 7, d = tid & 127; const unsigned vo = (unsigned)tid * 2u; const size_t cb = (size_t)row0 * HGW * 2;
        const __amdgpu_buffer_rsrc_t rZ = __builtin_amdgcn_make_buffer_rsrc((void*)((const char*)HZ + cb), 0, CH * HGW * 2, 0x00020000), rQ = __builtin_amdgcn_make_buffer_rsrc((void*)((const char*)HQ + cb), 0, CH * HGW * 2, 0x00020000),
                                     rK = __builtin_amdgcn_make_buffer_rsrc((void*)((char*)KRB + cb), 0, CH * HGW * 2, 0x00020000), rR = __builtin_amdgcn_make_buffer_rsrc((void*)((char*)QRB + cb), 0, CH * HGW * 2, 0x00020000);
        float zl[CH], qv[CH];
#pragma unroll
        for (int t = 0; t < CH; ++t) { zl[t] = bf2f((unsigned short)__builtin_amdgcn_raw_buffer_load_b16(rZ, vo, t * HGW * 2, 0)); qv[t] = bf2f((unsigned short)__builtin_amdgcn_raw_buffer_load_b16(rQ, vo, t * HGW * 2, 0)); }
        const float lb = lbl[tid], om = 1.f - lb;
        float b = 0.f, r = 0.f;
#pragma unroll
        for (int t = 0; t < CH; ++t) { const float zc = fminf(fmaxf(zl[t], -60.f), 60.f), e = fast_exp(-zc), sg = __builtin_amdgcn_rcpf(1.f + e), f = lb + om * sg;
            const float lf = __builtin_amdgcn_logf(fmaxf(f, 1e-30f)) * 0.6931471805599453f; zl[t] = lf; b += lf; if (t == 31) r = b; }
        const float bl = b; r = fmaxf(r, -60.f);
        Dd[(size_t)u * HGW + tid] = ex(bl); Rr[(size_t)u * HGW + tid] = ex(r);
        b = 0.f;
        LAS char* kd = lds + head * TILE_V + ((d >> 5) * 512 + (d & 31) * 2);
#pragma unroll
        for (int t = 0; t < CH; ++t) { const float lf = zl[t]; b += lf; const float kk = 1.f - ex(lf);
            __builtin_amdgcn_raw_buffer_store_b16((short)pk2(kk * ex(fminf(r - b, 80.f)), 0.f), rK, vo, t * HGW * 2, 0);
            __builtin_amdgcn_raw_buffer_store_b16((short)pk2(qv[t] * ex(fminf(b - r, 80.f)), 0.f), rR, vo, t * HGW * 2, 0);
            constexpr int dummy = 0; (void)dummy;
            const int kk_t = (t & ~0xC) | ((t & 4) << 1) | ((t & 8) >> 1);
            *(LAS unsigned short*)(kd + (kk_t >> 3) * 4 * 512 + (kk_t & 7) * 64) = (unsigned short)pk2(kk * ex(bl - b), 0.f); }
    }
    __syncthreads();
#else
__device__ __forceinline__ void h1_unit(const Ctx& X, unsigned char* ws, int u) {
    const int bb = u >> 7, c = u & 127, row0 = bb * SEQ + c * CH, tid = X.tid, lane = X.lane, wave = X.wave;
    float* LFB = (float*)(ws + WS_LF); const bf16* HK = (const bf16*)(ws + WS_HK); const bf16* HV = (const bf16*)(ws + WS_HV);
    float* Dd = (float*)(ws + WS_HD); float* Rr = (float*)(ws + WS_HR); bf16* US = (bf16*)(ws + WS_XB);
    LAS char* lds = (LAS char*)X.lds; LAS float* bl = (LAS float*)(lds + 131072);
    {
        float* col = LFB + (size_t)row0 * HGW + tid; float b = 0.f, r = 0.f;
#pragma unroll 1
        for (int t0 = 0; t0 < CH; t0 += 8) { float x[8];
#pragma unroll
            for (int i = 0; i < 8; ++i) x[i] = col[(size_t)(t0 + i) * HGW];
#pragma unroll
            for (int i = 0; i < 8; ++i) { b += x[i]; col[(size_t)(t0 + i) * HGW] = b; if (t0 + i == 31) r = b; } }
        bl[tid] = b; r = fmaxf(r, -60.f);
        Dd[(size_t)u * HGW + tid] = ex(b); Rr[(size_t)u * HGW + tid] = ex(r);
    }
    asm volatile("s_waitcnt vmcnt(0)" ::: "memory");
    __syncthreads();
#pragma unroll 2
    for (int j = 0; j < 8; ++j) { const int i = tid + 512 * j, head = i >> 10, rem = i & 1023, t = rem >> 4, c8 = (rem & 15) * 8; const size_t g = (size_t)(row0 + t) * HGW + head * 128 + c8;
        const u32x4 kw = *(const u32x4*)(HK + g), vw = *(const u32x4*)(HV + g); const f32x4 b0 = *(const f32x4*)(LFB + g), b1 = *(const f32x4*)(LFB + g + 4);
        const f32x4 l0 = *(const LAS f32x4*)(bl + head * 128 + c8), l1 = *(const LAS f32x4*)(bl + head * 128 + c8 + 4);
        u32x4 o; o.x = pk2(bflo(kw.x) * ex(l0.x - b0.x), bfhi(kw.x) * ex(l0.y - b0.y)); o.y = pk2(bflo(kw.y) * ex(l0.z - b0.z), bfhi(kw.y) * ex(l0.w - b0.w));
        o.z = pk2(bflo(kw.z) * ex(l1.x - b1.x), bfhi(kw.z) * ex(l1.y - b1.y)); o.w = pk2(bflo(kw.w) * ex(l1.z - b1.z), bfhi(kw.w) * ex(l1.w - b1.w));
        *(LAS u32x4*)(lds + head * TILE_V + v_st(t, c8)) = o; *(LAS u32x4*)(lds + 65536 + head * TILE_V + v_st(t, c8)) = vw; }
    __syncthreads();
#endif
    {
        const int head = wave >> 1, db0 = (wave & 1) * 2, r32 = lane & 31, hiC = lane >> 5;
        const int ab = (int)(unsigned)(size_t)(lds + head * TILE_V) + v_rd_base(lane), vb = (int)(unsigned)(size_t)(lds + 65536 + head * TILE_V) + v_rd_base(lane);
        f32x16 acc[2][4];
#pragma unroll
        for (int a = 0; a < 2; ++a)
#pragma unroll
            for (int v = 0; v < 4; ++v) acc[a][v] = f32x16{};
#define FRAG(dst, base, d0, ks) do { s16x4 lo_, hi_; TRRD2(lo_, base, v_rd_off(d0, ks, 0)); TRRD2(hi_, base, v_rd_off(d0, ks, 1)); asm volatile("s_waitcnt lgkmcnt(0)" ::: "memory"); __builtin_amdgcn_sched_barrier(0); \
            dst = (bf16x8){lo_[0], lo_[1], lo_[2], lo_[3], hi_[0], hi_[1], hi_[2], hi_[3]}; } while (0)
#define U_KS(ks) do { bf16x8 a0, a1, b0, b1, b2, b3; \
            if (db0 == 0) { FRAG(a0, ab, 0, ks); FRAG(a1, ab, 1, ks); } else { FRAG(a0, ab, 2, ks); FRAG(a1, ab, 3, ks); } \
            FRAG(b0, vb, 0, ks); FRAG(b1, vb, 1, ks); FRAG(b2, vb, 2, ks); FRAG(b3, vb, 3, ks); \
            acc[0][0] = __builtin_amdgcn_mfma_f32_32x32x16_bf16(a0, b0, acc[0][0], 0, 0, 0); acc[0][1] = __builtin_amdgcn_mfma_f32_32x32x16_bf16(a0, b1, acc[0][1], 0, 0, 0); \
            acc[0][2] = __builtin_amdgcn_mfma_f32_32x32x16_bf16(a0, b2, acc[0][2], 0, 0, 0); acc[0][3] = __builtin_amdgcn_mfma_f32_32x32x16_bf16(a0, b3, acc[0][3], 0, 0, 0); \
            acc[1][0] = __builtin_amdgcn_mfma_f32_32x32x16_bf16(a1, b0, acc[1][0], 0, 0, 0); acc[1][1] = __builtin_amdgcn_mfma_f32_32x32x16_bf16(a1, b1, acc[1][1], 0, 0, 0); \
            acc[1][2] = __builtin_amdgcn_mfma_f32_32x32x16_bf16(a1, b2, acc[1][2], 0, 0, 0); acc[1][3] = __builtin_amdgcn_mfma_f32_32x32x16_bf16(a1, b3, acc[1][3], 0, 0, 0); } while (0)
        U_KS(0); U_KS(1); U_KS(2); U_KS(3);
#undef U_KS
        bf16* Ub = US + ((size_t)(bb * NH + head) * NCH + c) * 16384;
#pragma unroll
        for (int a = 0; a < 2; ++a)
#pragma unroll
            for (int v = 0; v < 4; ++v)
#pragma unroll
                for (int q4 = 0; q4 < 4; ++q4) { const int ks = 2 * (db0 + a) + (q4 >> 1), lanep = (q4 & 1) * 32 + r32;
                    u32x2 w; w.x = pk2(acc[a][v][4 * q4 + 0], acc[a][v][4 * q4 + 1]); w.y = pk2(acc[a][v][4 * q4 + 2], acc[a][v][4 * q4 + 3]);
                    *(u32x2*)(Ub + ((size_t)((ks * 4 + v) * 64 + lanep)) * 8 + 4 * hiC) = w; }
    }
    __syncthreads();
}
#if HG_V2
__device__ __forceinline__ void phase_h1(const Ctx& X, unsigned char* ws, int l) { const float* lbl = (const float*)(ws + WS_MISC + MISC_LB) + l * HGW; for (int u = X.bid; u < 2 * NCH; u += X.nblk) h1_unit(X, ws, u, lbl); }
#else
__device__ __forceinline__ void phase_h1(const Ctx& X, unsigned char* ws, int) { for (int u = X.bid; u < 2 * NCH; u += X.nblk) h1_unit(X, ws, u); }
#endif
__device__ __forceinline__ void phase_h2(const Ctx& X, unsigned char* ws) {
    bf16* US = (bf16*)(ws + WS_XB); const float* Dd = (const float*)(ws + WS_HD); const float* Rr = (const float*)(ws + WS_HR);
    for (int u = X.bid; u < 256; u += X.nblk) {
        if (X.tid < 256) {
            const int bh = u >> 5, slot = u & 31, ks = slot >> 2, bb = bh >> 2, h = bh & 3, lanep = X.tid >> 2, j = 2 * (X.tid & 3), d = 16 * ks + 8 * (lanep >> 5) + j;
            unsigned* p = (unsigned*)(US + (size_t)bh * US_BH + (size_t)slot * 512 + 2 * X.tid);
            const float* dp = Dd + (size_t)bb * NCH * HGW + h * 128 + d; const float* rp = Rr + (size_t)bb * NCH * HGW + h * 128 + d;
            float s0 = 0.f, s1 = 0.f;
#pragma unroll 1
            for (int c0 = 0; c0 < NCH; c0 += 8) { unsigned uw[8]; float2 dv[8], rv[8];
#pragma unroll
                for (int i = 0; i < 8; ++i) { uw[i] = p[(size_t)(c0 + i) * 8192]; dv[i] = *(const float2*)(dp + (size_t)(c0 + i) * HGW); rv[i] = *(const float2*)(rp + (size_t)(c0 + i) * HGW); }
#pragma unroll
                for (int i = 0; i < 8; ++i) { p[(size_t)(c0 + i) * 8192] = pk2(rv[i].x * s0, rv[i].y * s1); s0 = dv[i].x * s0 + bflo(uw[i]); s1 = dv[i].y * s1 + bfhi(uw[i]); } }
        }
    }
}
__device__ __forceinline__ void h3_unit(const Ctx& X, unsigned char* ws, const float* onorm, int u) {
    const int bb = u >> 7, c = u & 127, row0 = bb * SEQ + c * CH, tid = X.tid, lane = X.lane, wave = X.wave;
    const float* LFB = (const float*)(ws + WS_LF); const bf16* HQ = (const bf16*)(ws + WS_HQ); const bf16* HK = (const bf16*)(ws + WS_HK); const bf16* HV = (const bf16*)(ws + WS_HV); const bf16* HG = (const bf16*)(ws + WS_HG);
    const bf16* US = (const bf16*)(ws + WS_XB); bf16* CC = (bf16*)(ws + WS_CC);
    LAS char* lds = (LAS char*)X.lds;
#if HG_V2
    const bf16* KRB = (const bf16*)(ws + WS_LF); const bf16* QRB = (const bf16*)(ws + WS_LF + 16 * MiB);
    const int head = wave >> 1, th = wave & 1, r32 = lane & 31, hi = lane >> 5, trow = row0 + 32 * th + r32;
    bf16x8 qr[8];
    { const int t0 = tid >> 4, c8 = (tid & 15) * 8; const size_t g0 = (size_t)(row0 + t0) * HGW + c8; const int kst0 = t0 * KROW2 + c8 * 2, vst0 = 4 * TILE_K2 + v_st(t0, c8);
      u32x4 kw[8], vw[8];
#pragma unroll
      for (int j = 0; j < 8; ++j) { const size_t g = g0 + (size_t)((j & 1) * 32 * HGW + (j >> 1) * 128); kw[j] = *(const u32x4*)(KRB + g); vw[j] = *(const u32x4*)(HV + g); }
      const size_t gq = (size_t)trow * HGW + head * 128 + hi * 8;
#pragma unroll
      for (int d0 = 0; d0 < 8; ++d0) qr[d0] = *reinterpret_cast<const bf16x8*>(QRB + gq + d0 * 16);
#pragma unroll
      for (int j = 0; j < 8; ++j) { *(LAS u32x4*)(lds + kst0 + (j >> 1) * TILE_K2 + (j & 1) * 32 * KROW2) = kw[j]; *(LAS u32x4*)(lds + vst0 + (j >> 1) * TILE_V + (j & 1) * 8192) = vw[j]; } }
#else
#pragma unroll 2
    for (int j = 0; j < 8; ++j) { const int i = tid + 512 * j, head = i >> 10, rem = i & 1023, t = rem >> 4, c8 = (rem & 15) * 8; const size_t g = (size_t)(row0 + t) * HGW + head * 128 + c8, gr = (size_t)(row0 + 31) * HGW + head * 128 + c8;
        const u32x4 kw = *(const u32x4*)(HK + g), vw = *(const u32x4*)(HV + g); const f32x4 b0 = *(const f32x4*)(LFB + g), b1 = *(const f32x4*)(LFB + g + 4); f32x4 r0 = *(const f32x4*)(LFB + gr), r1 = *(const f32x4*)(LFB + gr + 4);
#define KE(rr, bv) ex(fminf(fmaxf((rr), -60.f) - (bv), 80.f))
        u32x4 o; o.x = pk2(bflo(kw.x) * KE(r0.x, b0.x), bfhi(kw.x) * KE(r0.y, b0.y)); o.y = pk2(bflo(kw.y) * KE(r0.z, b0.z), bfhi(kw.y) * KE(r0.w, b0.w));
        o.z = pk2(bflo(kw.z) * KE(r1.x, b1.x), bfhi(kw.z) * KE(r1.y, b1.y)); o.w = pk2(bflo(kw.w) * KE(r1.z, b1.z), bfhi(kw.w) * KE(r1.w, b1.w));
#undef KE
        *(LAS u32x4*)(lds + head * TILE_K2 + t * KROW2 + c8 * 2) = o; *(LAS u32x4*)(lds + 4 * TILE_K2 + head * TILE_V + v_st(t, c8)) = vw; }
    const int head = wave >> 1, th = wave & 1, r32 = lane & 31, hi = lane >> 5, trow = row0 + 32 * th + r32;
    bf16x8 qr[8];
    {
        const size_t g = (size_t)trow * HGW + head * 128 + hi * 8, gr = (size_t)(row0 + 31) * HGW + head * 128 + hi * 8;
#pragma unroll
        for (int d0 = 0; d0 < 8; ++d0) { const u32x4 qw = *(const u32x4*)(HQ + g + d0 * 16); const f32x4 b0 = *(const f32x4*)(LFB + g + d0 * 16), b1 = *(const f32x4*)(LFB + g + d0 * 16 + 4), r0 = *(const f32x4*)(LFB + gr + d0 * 16), r1 = *(const f32x4*)(LFB + gr + d0 * 16 + 4);
#define QE(bv, rr) ex(fminf((bv) - fmaxf((rr), -60.f), 80.f))
            u32x4 o; o.x = pk2(bflo(qw.x) * QE(b0.x, r0.x), bfhi(qw.x) * QE(b0.y, r0.y)); o.y = pk2(bflo(qw.y) * QE(b0.z, r0.z), bfhi(qw.y) * QE(b0.w, r0.w));
            o.z = pk2(bflo(qw.z) * QE(b1.x, r1.x), bfhi(qw.z) * QE(b1.y, r1.y)); o.w = pk2(bflo(qw.w) * QE(b1.z, r1.z), bfhi(qw.w) * QE(b1.w, r1.w));
#undef QE
            qr[d0] = __builtin_bit_cast(bf16x8, o); }
    }
#endif
    __syncthreads();
    f32x16 p0 = f32x16{}, p1 = f32x16{};
    { const LAS char* kb = lds + head * TILE_K2 + r32 * KROW2 + hi * 16;
#pragma unroll
      for (int d0 = 0; d0 < 8; ++d0) { const bf16x8 k0 = *reinterpret_cast<const LAS bf16x8*>(kb + d0 * 32); p0 = __builtin_amdgcn_mfma_f32_32x32x16_bf16(k0, qr[d0], p0, 0, 0, 0);
          if (th) { const bf16x8 k1 = *reinterpret_cast<const LAS bf16x8*>(kb + d0 * 32 + 32 * KROW2); p1 = __builtin_amdgcn_mfma_f32_32x32x16_bf16(k1, qr[d0], p1, 0, 0, 0); } } }
    { const int tq = 32 * th + r32 - 4 * hi;
#pragma unroll
      for (int r = 0; r < 16; ++r) { const int cr = (r & 3) + 8 * (r >> 2); if (tq - cr < 0) p0[r] = 0.f; if (tq - cr - 32 < 0) p1[r] = 0.f; } }
    bf16x8 pa0, pa1, pa2, pa3;
#define PK4(P, B_, OUT) do { unsigned a0 = cvtpk(P[B_+0], P[B_+1]), a1 = cvtpk(P[B_+2], P[B_+3]);                          \
        unsigned b0 = cvtpk(P[B_+4], P[B_+5]), b1 = cvtpk(P[B_+6], P[B_+7]);                                             \
        auto r0 = __builtin_amdgcn_permlane32_swap(a0, b0, false, false); auto r1 = __builtin_amdgcn_permlane32_swap(a1, b1, false, false); \
        u32x4 w = {r0[0], r1[0], r0[1], r1[1]}; OUT = *reinterpret_cast<bf16x8*>(&w); } while (0)
    PK4(p0, 0, pa0); PK4(p0, 8, pa1); PK4(p1, 0, pa2); PK4(p1, 8, pa3);
#undef PK4
    f32x16 o[4] = {};
    { const int vb = (int)(unsigned)(size_t)(lds + 4 * TILE_K2 + head * TILE_V) + v_rd_base(lane);
#define PV(d0) do { bf16x8 f0, f1, f2, f3; FRAG(f0, vb, d0, 0); FRAG(f1, vb, d0, 1); FRAG(f2, vb, d0, 2); FRAG(f3, vb, d0, 3); \
        o[d0] = __builtin_amdgcn_mfma_f32_32x32x16_bf16(pa0, f0, o[d0], 0, 0, 0); o[d0] = __builtin_amdgcn_mfma_f32_32x32x16_bf16(pa1, f1, o[d0], 0, 0, 0); \
        o[d0] = __builtin_amdgcn_mfma_f32_32x32x16_bf16(pa2, f2, o[d0], 0, 0, 0); o[d0] = __builtin_amdgcn_mfma_f32_32x32x16_bf16(pa3, f3, o[d0], 0, 0, 0); } while (0)
      PV(0); PV(1); PV(2); PV(3);
#undef PV
    }
    { const bf16* Sb = US + ((size_t)(bb * NH + head) * NCH + c) * 16384 + (size_t)lane * 8;
#pragma unroll
      for (int vb = 0; vb < 4; ++vb)
#pragma unroll
          for (int ks = 0; ks < 8; ++ks) { const bf16x8 sf = *reinterpret_cast<const bf16x8*>(Sb + (size_t)(ks * 4 + vb) * 512); o[vb] = __builtin_amdgcn_mfma_f32_32x32x16_bf16(qr[ks], sf, o[vb], 0, 0, 0); } }
    float rs[16];
#pragma unroll
    for (int r = 0; r < 16; ++r) { float q = o[0][r] * o[0][r] + o[1][r] * o[1][r] + o[2][r] * o[2][r] + o[3][r] * o[3][r];
        q += __shfl_xor(q, 1); q += __shfl_xor(q, 2); q += __shfl_xor(q, 4); q += __shfl_xor(q, 8); q += __shfl_xor(q, 16); rs[r] = rsqrtf(q * (1.f / 128.f) + EPS); }
#pragma unroll
    for (int vb = 0; vb < 4; ++vb) { const float gn = onorm[32 * vb + r32];
#pragma unroll
        for (int r = 0; r < 16; ++r) { const size_t row = (size_t)(row0 + 32 * th + crow(r, hi));
            const float g = bf2f(HG[row * HGW + head * 128 + 32 * vb + r32]); const float val = o[vb][r] * rs[r] * gn * siluf_(g); const float vn = __shfl_xor(val, 1);
            if ((r32 & 1) == 0) *(unsigned*)(CC + row * DM + 512 + head * 128 + 32 * vb + r32) = cvtpk(val, vn); } }
    __syncthreads();
}
#undef FRAG
#undef TRRD2
__device__ __forceinline__ void phase_h3(const Ctx& X, unsigned char* ws, const float* onorm) { for (int u = X.bid; u < 2 * NCH; u += X.nblk) h3_unit(X, ws, onorm, u); }
}

__device__ __forceinline__ void phase_hgrn_simple(const Ctx& X, const Params& p) {
    unsigned char* ws = p.ws;
    const bf16* HQ = (const bf16*)(ws + WS_HQ); const bf16* HK = (const bf16*)(ws + WS_HK); const bf16* HV = (const bf16*)(ws + WS_HV); const float* LF = (const float*)(ws + WS_LF);
    float* OB = (float*)(ws + WS_XB);
    for (int bh = X.bid; bh < 2 * NH; bh += X.nblk) {
        if (X.tid < 256) {
            const int v = X.tid >> 1, hf = X.tid & 1, b = bh >> 2, h = bh & 3;
            float S[64];
#pragma unroll
            for (int j = 0; j < 64; ++j) S[j] = 0.f;
            for (int t = 0; t < SEQ; ++t) {
                const size_t base = ((size_t)(b * SEQ + t)) * HGW + h * 128;
                const float vt = bf2f(HV[base + v]);
                float o = 0.f;
#pragma unroll
                for (int j8 = 0; j8 < 8; ++j8) {
                    const size_t bj = base + 64 * hf + 8 * j8;
                    const f32x4 f0 = *(const f32x4*)(LF + bj), f1 = *(const f32x4*)(LF + bj + 4);
                    const u32x4 kw = *(const u32x4*)(HK + bj), qw = *(const u32x4*)(HQ + bj);
#define HSTEP(J, lf, kk, qq) do { S[8 * j8 + J] = fast_exp(lf) * S[8 * j8 + J] + (kk) * vt; o += (qq) * S[8 * j8 + J]; } while (0)
                    HSTEP(0, f0.x, bflo(kw.x), bflo(qw.x)); HSTEP(1, f0.y, bfhi(kw.x), bfhi(qw.x)); HSTEP(2, f0.z, bflo(kw.y), bflo(qw.y)); HSTEP(3, f0.w, bfhi(kw.y), bfhi(qw.y));
                    HSTEP(4, f1.x, bflo(kw.z), bflo(qw.z)); HSTEP(5, f1.y, bfhi(kw.z), bfhi(qw.z)); HSTEP(6, f1.z, bflo(kw.w), bflo(qw.w)); HSTEP(7, f1.w, bfhi(kw.w), bfhi(qw.w));
#undef HSTEP
                }
                o += __shfl_xor(o, 1);
                if (hf == 0) OB[base + v] = o;
            }
        }
    }
}
__device__ __forceinline__ void phase_hgrn_out(const Ctx& X, const Params& p, int l) {
    unsigned char* ws = p.ws;
    const float* OB = (const float*)(ws + WS_XB); const bf16* HG = (const bf16*)(ws + WS_HG); bf16* CC = (bf16*)(ws + WS_CC); const float* on = p.in[I_HON] + l * 128;
    const int gw = X.bid * NWAVES + X.wave, ngw = X.nblk * NWAVES, lane = X.lane;
    for (int i = gw; i < T * NH; i += ngw) {
        const int row = i >> 2, h = i & 3; const size_t base = (size_t)row * HGW + h * 128 + 2 * lane;
        const float o0 = OB[base], o1 = OB[base + 1];
        const float rstd = rsqrtf(wave_sum(o0 * o0 + o1 * o1) * (1.f / 128.f) + EPS);
        const unsigned gw2 = *(const unsigned*)(HG + base);
        *(unsigned*)(CC + (size_t)row * DM + 512 + h * 128 + 2 * lane) = pk2(o0 * rstd * on[2 * lane] * siluf_(bflo(gw2)), o1 * rstd * on[2 * lane + 1] * siluf_(bfhi(gw2)));
    }
}

template <class TS>
__device__ __forceinline__ void phase_norm(const Ctx& X, const Params& p, const TS* src, const float* gain) { norm_all_rows(X, src, gain, (bf16*)(p.ws + WS_XB)); }
template <class TS>
__device__ __forceinline__ void phase_norm_route(const Ctx& X, const Params& p, const TS* src, const float* gain) {
    unsigned char* ws = p.ws;
    int* GCNT = (int*)(ws + WS_MISC + MISC_GCNT); int* TOPI = (int*)(ws + WS_MISC + MISC_TOPI); float* TOPG = (float*)(ws + WS_MISC + MISC_TOPG);
    const float* wr = p.in[I_ROUTER];
    LAS int* wcnt = (LAS int*)(X.lds);
    const int lane = X.lane, b5 = lane >> 5, b4 = (lane >> 4) & 1, b3 = (lane >> 3) & 1;
    f32x4 w0[4][4], w1[4][4], gn[4];
#pragma unroll
    for (int j = 0; j < 4; ++j) { gn[j] = *((const f32x4*)gain + lane + 64 * j);
#pragma unroll
        for (int q = 0; q < 4; ++q) { const float* wp = wr + (size_t)(4 * (lane + 64 * j) + q) * NE; w0[j][q] = *(const f32x4*)wp; w1[j][q] = *(const f32x4*)(wp + 4); } }
    for (int g = X.bid; g < T / 64; g += X.nblk) {
        int cn[NE];
#pragma unroll
        for (int e = 0; e < NE; ++e) cn[e] = 0;
#pragma unroll 1
        for (int bt = 0; bt < 4; ++bt) {
            const int rbase = g * 64 + X.wave * 8 + 2 * bt;
            f32x4 v[2][4];
#pragma unroll
            for (int i = 0; i < 2; ++i)
#pragma unroll
                for (int j = 0; j < 4; ++j) v[i][j] = ldrow4(src + (size_t)(rbase + i) * DM, lane + 64 * j);
#pragma unroll
            for (int i = 0; i < 2; ++i) { const int row = rbase + i; float s = 0.f;
#pragma unroll
                for (int j = 0; j < 4; ++j) s += (v[i][j].x * v[i][j].x + v[i][j].y * v[i][j].y) + (v[i][j].z * v[i][j].z + v[i][j].w * v[i][j].w);
                const float rstd = __builtin_amdgcn_rsqf(wave_sum(s) * (1.f / DM) + EPS);
                float lg[NE];
#pragma unroll
                for (int e = 0; e < NE; ++e) lg[e] = 0.f;
#pragma unroll
                for (int j = 0; j < 4; ++j) { const f32x4 y = v[i][j] * rstd * gn[j];
                    *((unsigned*)((unsigned char*)(ws + WS_XB) + (size_t)row * DM) + lane + 64 * j) = pk4_fp8(y.x, y.y, y.z, y.w);
#pragma unroll
                    for (int q = 0; q < 4; ++q) { const float yv = (q == 0) ? y.x : (q == 1) ? y.y : (q == 2) ? y.z : y.w;
                        lg[0] += yv * w0[j][q].x; lg[1] += yv * w0[j][q].y; lg[2] += yv * w0[j][q].z; lg[3] += yv * w0[j][q].w; lg[4] += yv * w1[j][q].x; lg[5] += yv * w1[j][q].y; lg[6] += yv * w1[j][q].z; lg[7] += yv * w1[j][q].w; } }
                float k4[4], k2[2], k1;
#pragma unroll
                for (int t = 0; t < 4; ++t) { const float keep = b5 ? lg[4 + t] : lg[t], send = b5 ? lg[t] : lg[4 + t]; k4[t] = keep + __shfl_xor(send, 32); }
#pragma unroll
                for (int t = 0; t < 2; ++t) { const float keep = b4 ? k4[2 + t] : k4[t], send = b4 ? k4[t] : k4[2 + t]; k2[t] = keep + __shfl_xor(send, 16); }
                { const float keep = b3 ? k2[1] : k2[0], send = b3 ? k2[0] : k2[1]; k1 = keep + __shfl_xor(send, 8); }
                k1 += __shfl_xor(k1, 4); k1 += __shfl_xor(k1, 2); k1 += __shfl_xor(k1, 1);
                float tl[NE];
#pragma unroll
                for (int e = 0; e < NE; ++e) tl[e] = __int_as_float(__builtin_amdgcn_readlane(__float_as_int(k1), (e >> 2) * 32 + ((e >> 1) & 1) * 16 + (e & 1) * 8));
                int e1 = 0; float l1 = tl[0];
#pragma unroll
                for (int e = 1; e < NE; ++e) if (tl[e] > l1) { l1 = tl[e]; e1 = e; }
                int e2 = -1; float l2 = -3.0e38f;
#pragma unroll
                for (int e = 0; e < NE; ++e) if (e != e1 && tl[e] > l2) { l2 = tl[e]; e2 = e; }
#pragma unroll
                for (int e = 0; e < NE; ++e) cn[e] += (e == e1) + (e == e2);
                if (lane == 0) { const float g1 = 1.f / (1.f + expf(l2 - l1)); TOPI[row * 2] = e1; TOPI[row * 2 + 1] = e2; TOPG[row * 2] = g1; TOPG[row * 2 + 1] = 1.f - g1; }
            }
        }
        if (lane == 0) {
#pragma unroll
            for (int e = 0; e < NE; ++e) wcnt[X.wave * NE + e] = cn[e]; }
        __syncthreads();
        if (X.tid < NE) { int t = 0;
#pragma unroll
            for (int w = 0; w < NWAVES; ++w) t += wcnt[w * NE + X.tid];
            GCNT[g * NE + X.tid] = t; }
        __syncthreads();
    }
}
__device__ __forceinline__ void phase_scatter(const Ctx& X, const Params& p) {
    unsigned char* ws = p.ws;
    const int* GCNT = (const int*)(ws + WS_MISC + MISC_GCNT); const int* TOPI = (const int*)(ws + WS_MISC + MISC_TOPI); int* POS = (int*)(ws + WS_MISC + MISC_POS);
    int* TILE_E = (int*)(ws + WS_MISC + MISC_TILE_E); int* NT = (int*)(ws + WS_MISC + MISC_NT);
    const unsigned char* XF = (const unsigned char*)(ws + WS_XB); unsigned char* XS = (unsigned char*)(ws + WS_XS);
    LAS int* gc = (LAS int*)(X.lds);
    LAS int* pstart = gc + 256 * NE;
    LAS int* ntot = pstart + 8;
    LAS int* basel = ntot + 8;
    LAS int* posl = basel + 8;
    for (int i = X.tid; i < 256 * NE; i += NTHREADS) gc[i] = GCNT[i];
    __syncthreads();
    { const int e = X.wave; int n = 0;
#pragma unroll
      for (int k = 0; k < 4; ++k) n += gc[(X.lane + 64 * k) * NE + e];
#pragma unroll
      for (int o = 1; o < 64; o <<= 1) n += __shfl_xor(n, o);
      if (X.lane == 0) ntot[e] = n; }
    __syncthreads();
    if (X.tid == 0) { int acc = 0;
        for (int e = 0; e < NE; ++e) { pstart[e] = acc; const int nt = (ntot[e] + 255) >> 8; if (X.bid == 0) for (int t = 0; t < nt; ++t) TILE_E[(acc >> 8) + t] = e; acc += nt * 256; }
        if (X.bid == 0) NT[0] = acc >> 8; }
    __syncthreads();
    for (int g = X.bid; g < T / 64; g += X.nblk) {
        { const int e = X.wave; int n = 0;
#pragma unroll
          for (int k = 0; k < 4; ++k) { const int gg = X.lane + 64 * k; n += (gg < g) ? gc[gg * NE + e] : 0; }
#pragma unroll
          for (int o = 1; o < 64; o <<= 1) n += __shfl_xor(n, o);
          if (X.lane == 0) basel[e] = pstart[e] + n; }
        __syncthreads();
        if (X.wave == 0) {
            const int row = g * 64 + X.lane; const int e1 = TOPI[row * 2], e2 = TOPI[row * 2 + 1];
            int p1 = 0, p2 = 0;
            const unsigned long long lt = (1ull << X.lane) - 1ull;
#pragma unroll
            for (int e = 0; e < NE; ++e) {
                const int base = basel[e];
                const unsigned long long m1 = __ballot(e1 == e), m2 = __ballot(e2 == e);
                if (e1 == e) p1 = base + __popcll(m1 & lt);
                if (e2 == e) p2 = base + __popcll(m1) + __popcll(m2 & lt);
            }
            POS[row * 2] = p1; POS[row * 2 + 1] = p2; posl[X.lane * 2] = p1; posl[X.lane * 2 + 1] = p2;
        }
        __syncthreads();
        { u32x4 a[8];
#pragma unroll
          for (int i = 0; i < 8; ++i) a[i] = ((const u32x4*)(XF + (size_t)(g * 64 + X.wave * 8 + i) * DM))[X.lane];
#pragma unroll
          for (int i = 0; i < 8; ++i) { const int r = X.wave * 8 + i; ((u32x4*)(XS + (size_t)posl[r * 2] * DM))[X.lane] = a[i]; ((u32x4*)(XS + (size_t)posl[r * 2 + 1] * DM))[X.lane] = a[i]; } }
        __syncthreads();
    }
}
template <class TS>
__device__ __forceinline__ void phase_combine(const Ctx& X, const Params& p, const TS* xr) {
    unsigned char* ws = p.ws;
    const int* POS = (const int*)(ws + WS_MISC + MISC_POS); const float* TOPG = (const float*)(ws + WS_MISC + MISC_TOPG); const bf16* YS = (const bf16*)(ws + WS_YS);
    const float* fn = p.in[I_FINN];
    const int gw = X.bid * NWAVES + X.wave, ngw = X.nblk * NWAVES, lane = X.lane;
    f32x4 gf[4];
#pragma unroll
    for (int j = 0; j < 4; ++j) gf[j] = *((const f32x4*)fn + lane + 64 * j);
    for (int r0 = gw; r0 < T; r0 += 2 * ngw) {
        int pp[2][2]; float gg[2][2]; f32x4 v[2][4]; u32x2 ya[2][4], yb[2][4];
#pragma unroll
        for (int i = 0; i < 2; ++i) { const int row = (r0 + i * ngw < T) ? r0 + i * ngw : r0; pp[i][0] = POS[row * 2]; pp[i][1] = POS[row * 2 + 1]; gg[i][0] = TOPG[row * 2]; gg[i][1] = TOPG[row * 2 + 1];
#pragma unroll
            for (int j = 0; j < 4; ++j) v[i][j] = ldrow4(xr + (size_t)row * DM, lane + 64 * j); }
#pragma unroll
        for (int i = 0; i < 2; ++i)
#pragma unroll
            for (int j = 0; j < 4; ++j) { ya[i][j] = *((const u32x2*)(YS + (size_t)pp[i][0] * DM) + lane + 64 * j); yb[i][j] = *((const u32x2*)(YS + (size_t)pp[i][1] * DM) + lane + 64 * j); }
#if DN_SPLITK
#pragma unroll
        for (int i = 0; i < 2; ++i)
#pragma unroll
            for (int k = 0; k < 2; ++k) { const int pos = pp[i][k];
                if (pos >= 128 * 256) { const float* sl = (const float*)(ws + WS_SLAB) + ((size_t)(((pos >> 8) - 128) * 4) * 7 * 256 + (pos & 255)) * 256 + 4 * lane;
#pragma unroll
                    for (int j = 0; j < 4; ++j) { f32x4 acc = *(const f32x4*)(sl + (size_t)(j * 7) * 65536);
#pragma unroll
                        for (int q = 1; q < 7; ++q) acc = acc + *(const f32x4*)(sl + (size_t)(j * 7 + q) * 65536);
                        u32x2 w; w.x = pk2(acc.x, acc.y); w.y = pk2(acc.z, acc.w); if (k == 0) ya[i][j] = w; else yb[i][j] = w; } } }
#endif
#pragma unroll
        for (int i = 0; i < 2; ++i) { const int row = (r0 + i * ngw < T) ? r0 + i * ngw : r0; const float g1 = gg[i][0], g2 = gg[i][1]; float s = 0.f;
#pragma unroll
            for (int j = 0; j < 4; ++j) { const u32x2 a = ya[i][j], b = yb[i][j]; f32x4& x = v[i][j];
                x.x += g1 * bflo(a.x) + g2 * bflo(b.x); x.y += g1 * bfhi(a.x) + g2 * bfhi(b.x); x.z += g1 * bflo(a.y) + g2 * bflo(b.y); x.w += g1 * bfhi(a.y) + g2 * bfhi(b.y);
                s += (x.x * x.x + x.y * x.y) + (x.z * x.z + x.w * x.w); }
            const float rstd = __builtin_amdgcn_rsqf(wave_sum(s) * (1.f / DM) + EPS);
#pragma unroll
            for (int j = 0; j < 4; ++j) *((f32x4*)(p.out + (size_t)row * DM) + lane + 64 * j) = v[i][j] * rstd * gf[j]; }
    }
}

__device__ __forceinline__ bool relaunder(Ctx& X, unsigned char*& ws, const Params& p) {
    int t = threadIdx.x; asm volatile("" : "+v"(t)); X.tid = t; X.lane = t & 63; X.wave = __builtin_amdgcn_readfirstlane(t >> 6);
    unsigned long long w = (unsigned long long)p.ws; asm volatile("" : "+s"(w)); ws = (unsigned char*)(GAS unsigned char*)w;
    return true;
}
constexpr int NPHASES = 26;
#define PHASE(k) relaunder(X, ws, p)
#define SEAM(k) xcd_barrier(bar)
template <int L>
__device__ __forceinline__ void run_layer(Ctx& X, const Params& p, const XcdBarrier& bar) {
    unsigned char* ws;
#if XR_BF16
    xr_t* XR = (xr_t*)(p.ws + WS_XRB);
#else
    xr_t* XR = p.out;
#endif
    PHASE(pb + 0); {
        EpiProj E{ws, L, (FUSE_NORM && L == 1) ? (int)MISC_SSXB : 0};
        gemm_dense(X, (FUSE_NORM && L == 1) ? (const bf16*)XR : (const bf16*)(ws + WS_XB), (const bf16*)(ws + WS_WT_IN) + (size_t)L * NPROJ_P * DM, NPROJ_P, DM, E);
#ifdef PROBE_INPROJ_NOEPI
        { EpiProbe EP{(float*)(ws + WS_CC)}; gemm_dense(X, (const bf16*)(ws + WS_XB), (const bf16*)(ws + WS_WT_IN) + (size_t)L * NPROJ_P * DM, NPROJ_P, DM, EP); }
#endif
    } SEAM(pb + 0);
    PHASE(pb + 1); {
        EpiQ EQ{ws}; EpiKV EK{ws};
        REP_X(REP_QKV, gemm_dense(X, (const bf16*)(ws + WS_CQ), (const bf16*)(ws + WS_WT_QB) + (size_t)L * (NH * DQK) * QR, NH * DQK, QR, EQ);
        gemm_dense(X, (const bf16*)(ws + WS_CKV), (const bf16*)(ws + WS_WT_KVB) + (size_t)L * 1024 * KVR, 1024, KVR, EK);)
#if FAST_HGRN
        hg::phase_h1(X, ws, L);
#endif
    } SEAM(pb + 1);
#if FAST_ATTN
    PHASE(pb + 2); {
#if FAST_HGRN
        hg::phase_h2(X, ws);
#endif
        REP_X(REP_ATTN, phase_attn_fast(X, ws);) } SEAM(pb + 2);
#else
    PHASE(pb + 2); { phase_attn_simple(X, p); } SEAM(pb + 2);
#endif
#if !FAST_HGRN
    PHASE(pb + 3); { phase_hgrn_simple(X, p); } SEAM(pb + 3);
#endif
#if FAST_ATTN
#if FAST_HGRN
    PHASE(pb + 4); { phase_attn_combine(X, ws); REP_X(REP_H3, hg::phase_h3(X, ws, p.in[I_HON] + L * 128);) } SEAM(pb + 4);
#else
    PHASE(pb + 4); { phase_attn_combine(X, ws); phase_hgrn_out(X, p, L); } SEAM(pb + 4);
#endif
#else
    PHASE(pb + 4); { phase_hgrn_out(X, p, L); } SEAM(pb + 4);
#endif
    PHASE(pb + 5); {
#if FUSE_NORM
        if (L == 0) { EpiResNormT<float> E{p.in[I_X], XR, (float*)(ws + WS_MISC + MISC_SSXA), 0.f, (LAS float*)(X.lds + 131072)}; gemm_dense(X, (const bf16*)(ws + WS_CC), (const bf16*)(ws + WS_WT_OUT) + (size_t)L * DM * DM, DM, DM, E); }
#else
        if (L == 0) { EpiResT<float, xr_t> E{p.in[I_X], XR}; gemm_dense(X, (const bf16*)(ws + WS_CC), (const bf16*)(ws + WS_WT_OUT) + (size_t)L * DM * DM, DM, DM, E); }
#endif
        else { EpiResT<xr_t, xr_t> E{XR, XR}; gemm_dense(X, (const bf16*)(ws + WS_CC), (const bf16*)(ws + WS_WT_OUT) + (size_t)L * DM * DM, DM, DM, E); }
    } SEAM(pb + 5);
#if FUSE_NORM
    if (L == 1) { PHASE(pb + 6); { phase_norm_route(X, p, XR, p.in[I_FFNN] + DM); } SEAM(pb + 6); }
    if (L == 0) {
        PHASE(8); { EpiSwiglu E{(bf16*)(ws + WS_HID), FF0, 0, (const float*)(ws + WS_MISC + MISC_SSXA)};
            gemm_dense(X, (const bf16*)XR, (const bf16*)(ws + WS_WT_GU), 2 * FF0, DM, E);
#ifdef PROBE_GU_NOEPI
            { EpiProbe EP{(float*)(ws + WS_CC)}; gemm_dense(X, (const bf16*)XR, (const bf16*)(ws + WS_WT_GU), 2 * FF0, DM, EP); }
#endif
            } SEAM(8);
        PHASE(9); { EpiResNormT<xr_t> E{XR, XR, (float*)(ws + WS_MISC + MISC_SSXB), 0.f, (LAS float*)(X.lds + 131072)};
            gemm_dense(X, (const bf16*)(ws + WS_HID), (const bf16*)(ws + WS_WT_DN), DM, FF0, E); } SEAM(9);
    }
#else
    PHASE(pb + 6); { if (L == 0) { phase_norm(X, p, XR, p.in[I_FFNN]); } else { phase_norm_route(X, p, XR, p.in[I_FFNN] + DM); } } SEAM(pb + 6);
    if (L == 0) {
        PHASE(8); { EpiSwiglu E{(bf16*)(ws + WS_HID), FF0, 0, nullptr};
            gemm_dense(X, (const bf16*)(ws + WS_XB), (const bf16*)(ws + WS_WT_GU), 2 * FF0, DM, E); } SEAM(8);
        PHASE(9); { EpiResT<xr_t, xr_t> E{XR, XR};
            gemm_dense(X, (const bf16*)(ws + WS_HID), (const bf16*)(ws + WS_WT_DN), DM, FF0, E); } SEAM(9);
        PHASE(10); { phase_norm(X, p, XR, p.in[I_MIXN] + DM); } SEAM(10);
    }
#endif
}

__global__ void __launch_bounds__(NTHREADS, 2) mega(Params p) {
    extern __shared__ __attribute__((aligned(16))) unsigned char lds_raw[];
    Ctx X; X.tid = threadIdx.x; X.lane = X.tid & 63; X.wave = __builtin_amdgcn_readfirstlane(X.tid >> 6); X.bid = blockIdx.x; X.nblk = gridDim.x; X.lds = (LAS unsigned char*)lds_raw;
    unsigned char* ws = p.ws;
    volatile LAS unsigned* MISC = (volatile LAS unsigned*)(X.lds + LDS_MISC_OFF);
    if (X.tid < 32) MISC[X.tid] = 0u;
    __syncthreads();
    const XcdBarrier bar = xcd_barrier_post((unsigned*)(ws + WS_CTL) + CW_BAR, MISC + 8);

    PHASE(0); { REP_X(REP_PRO, phase_prologue(X, p);) } SEAM(0);
    run_layer<0>(X, p, bar);
    run_layer<1>(X, p, bar);
    PHASE(18); { REP_X(REP_ROUTE, phase_scatter(X, p);) } SEAM(18);
#if MOE_FP8
    PHASE(19); { const int* NTp = (const int*)(ws + WS_MISC + MISC_NT); const int* TILE_E = (const int*)(ws + WS_MISC + MISC_TILE_E); const int nt = NTp[0];
        EpiSwiglu8 E{(unsigned char*)(ws + WS_HIDM), FFM, 0};
        REP_X(REP_MOEGU, gemm_moe(X, (const bf16*)(ws + WS_XS), (const bf16*)(ws + WS_WT_MGU), 0, nt, 2 * FFM, DM / 2, TILE_E, 0, 0x79797979, E);) } SEAM(19);
    PHASE(20); { const int* NTp = (const int*)(ws + WS_MISC + MISC_NT); const int* TILE_E = (const int*)(ws + WS_MISC + MISC_TILE_E); const int nt = NTp[0];
        EpiBf16Plain E{(bf16*)(ws + WS_YS), DM};
#if DN_SPLITK
        const int nfull = nt < 128 ? nt : 128;
        gemm_moe(X, (const bf16*)(ws + WS_HIDM), (const bf16*)(ws + WS_WT_MDN), 0, nfull, DM, FFM / 2, TILE_E, 0, 0x78787878, E);
        { const int nsub = (nt - nfull) * 4 * 7, sidx = (int)X.bid;
          pg8::OneUnit S1; S1.have = sidx < nsub;
          const int ks = sidx % 7, up = sidx / 7, pn = up & 3, pm = nfull + (up >> 2);
          S1.u.pm = pm; S1.u.pn = pn; S1.u.pa = pm; S1.u.pb = (S1.have ? __builtin_amdgcn_readfirstlane(TILE_E[pm]) : 0) * 4 + pn;
          pg8::Gemm g1{(const bf16*)(ws + WS_HIDM + (size_t)ks * 512), (const bf16*)(ws + WS_WT_MDN + (size_t)ks * 512), 256, DM, 256, 0x78787878, FFM / 2};
          EpiSlab E1{(float*)(ws + WS_SLAB), ks};
          pg8::gemm_phase<EpiSlab, pg8::OneUnit, true, true, true>(X.lds, g1, S1, E1); }
        } SEAM(20);
#else
        REP_X(REP_MOEDN, gemm_moe(X, (const bf16*)(ws + WS_HIDM), (const bf16*)(ws + WS_WT_MDN), 0, nt, DM, FFM / 2, TILE_E, 0, 0x78787878, E);) } SEAM(20);
#endif
#else
    for (int c = 0; c < 3; ++c) {
        PHASE(19 + 2 * c); { const int* NTp = (const int*)(ws + WS_MISC + MISC_NT); const int* TILE_E = (const int*)(ws + WS_MISC + MISC_TILE_E);
            const int nt = NTp[0], t0 = CHUNK_TILES * c, t1 = min(nt, t0 + CHUNK_TILES);
            if (t1 > t0) { EpiSwiglu E{(bf16*)(ws + WS_HIDM), FFM, t0 * 256, nullptr};
                REP_X(REP_MOEGU, gemm_moe(X, (const bf16*)(ws + WS_XS), (const bf16*)(ws + WS_WT_MGU), t0, t1, 2 * FFM, DM, TILE_E, 0, 0, E);) } } SEAM(19 + 2 * c);
        PHASE(20 + 2 * c); { const int* NTp = (const int*)(ws + WS_MISC + MISC_NT); const int* TILE_E = (const int*)(ws + WS_MISC + MISC_TILE_E);
            const int nt = NTp[0], t0 = CHUNK_TILES * c, t1 = min(nt, t0 + CHUNK_TILES);
            if (t1 > t0) { EpiBf16Plain E{(bf16*)(ws + WS_YS), DM};
                REP_X(REP_MOEDN, gemm_moe(X, (const bf16*)(ws + WS_HIDM), (const bf16*)(ws + WS_WT_MDN), t0, t1, DM, FFM, TILE_E, t0, 0, E);) } } SEAM(20 + 2 * c);
    }
#endif
#if XR_BF16
    PHASE(25); { phase_combine(X, p, (const xr_t*)(p.ws + WS_XRB)); }
#else
    PHASE(25); { phase_combine(X, p, (const xr_t*)p.out); }
#endif
}
#undef PHASE
#undef SEAM

extern "C" void kernel_launch(void* const* d_in, const int* in_sizes, int n_in, void* d_out, int out_size, void* d_ws, size_t ws_size, hipStream_t stream) {
    static int grid = 0;
    if (grid == 0) {
        if (n_in != 20 || out_size != T * DM || ws_size < WS_END) { fprintf(stderr, "kernel_launch: unexpected shapes (n_in %d out %d ws %zu)\n", n_in, out_size, ws_size); grid = -1; return; }
        int dev = 0, cus = 0;
        if (hipGetDevice(&dev) != hipSuccess || hipDeviceGetAttribute(&cus, hipDeviceAttributeMultiprocessorCount, dev) != hipSuccess) { grid = -1; return; }
        if (hipFuncSetAttribute((const void*)mega, hipFuncAttributeMaxDynamicSharedMemorySize, LDS_BYTES) != hipSuccess) { fprintf(stderr, "kernel_launch: hipFuncSetAttribute failed\n"); grid = -1; return; }
        int per_cu = 0; (void)hipOccupancyMaxActiveBlocksPerMultiprocessor(&per_cu, (const void*)mega, NTHREADS, LDS_BYTES); (void)hipGetLastError();
        grid = cus;
    }
    if (grid < 0) return;
    (void)hipMemsetAsync((char*)d_ws + WS_CTL, 0, CTL_BYTES, stream);
    Params p{};
    for (int i = 0; i < 20; ++i) p.in[i] = (const float*)d_in[i];
    p.out = (float*)d_out; p.ws = (unsigned char*)d_ws;
    p.ph_lo = 0; p.ph_hi = NPHASES;
    hipLaunchKernelGGL(mega, dim3(grid), dim3(NTHREADS), LDS_BYTES, stream, p);
}
```

```cpp
#include <hip/hip_runtime.h>
#include <cstdio>
#include <cstdint>

#ifndef N_LAUNCH_MODE
#define N_LAUNCH_MODE 1
#endif

#ifndef FAST_GEMM
#define FAST_GEMM 1
#endif
#ifndef REP_ATTN
#define REP_ATTN 1
#endif
#ifndef REP_INPROJ
#define REP_INPROJ 1
#endif
#ifndef REP_H3
#define REP_H3 1
#endif
#ifndef REP_PRO
#define REP_PRO 1
#endif
#ifndef REP_MOEGU
#define REP_MOEGU 1
#endif
#ifndef REP_MOEDN
#define REP_MOEDN 1
#endif
#ifndef REP_DGU
#define REP_DGU 1
#endif
#ifndef REP_NORM
#define REP_NORM 1
#endif
#ifndef REP_ROUTE
#define REP_ROUTE 1
#endif
#ifndef REP_OUT0
#define REP_OUT0 1
#endif
#ifndef REP_QKV
#define REP_QKV 1
#endif
#define REP_1(stmt) stmt
#define REP_2(stmt) stmt stmt
#define REP_CAT(a, b) a##b
#define REP_X(n, stmt) REP_CAT(REP_, n)(stmt)
#ifndef MOE_FP8
#define MOE_FP8 1
#endif
#ifndef DN_SPLITK
#define DN_SPLITK 1
#endif
#ifndef FUSE_NORM
#define FUSE_NORM 1
#endif
#ifndef XR_BF16
#define XR_BF16 1
#endif
#ifndef HG_V2
#define HG_V2 1
#endif
#ifndef FAST_ATTN
#define FAST_ATTN 1
#endif
#ifndef TAILFILL
#define TAILFILL 1
#endif
#ifndef TAILFILL_A
#define TAILFILL_A 8
#endif
#ifndef TAILFILL_B
#define TAILFILL_B 3
#endif
#ifndef TAILFILL_C
#define TAILFILL_C 8
#endif
#ifndef H1_WIDE
#define H1_WIDE 1
#endif
#ifndef H3_STAGED_EPI
#define H3_STAGED_EPI 1
#endif
#ifndef ATTN_STAGED_EPI
#define ATTN_STAGED_EPI 1
#endif
#ifndef FAST_HGRN
#define FAST_HGRN 1
#endif
#define GAS __attribute__((address_space(1)))
#define LAS __attribute__((address_space(3)))
typedef unsigned short bf16;
typedef float f32x4 __attribute__((ext_vector_type(4)));
typedef short bf16x8 __attribute__((ext_vector_type(8)));
typedef unsigned u32x4 __attribute__((ext_vector_type(4)));
typedef unsigned u32x2 __attribute__((ext_vector_type(2)));

constexpr int T = 16384, SEQ = 8192, DM = 1024, NLAYER = 2;
constexpr int QR = 384, KVR = 256, ROPE = 64, NPROJ = 2752, NPROJ_P = 2816;
constexpr int NH = 4, DQK = 192, DNOPE = 128, DV = 128;
constexpr int HGW = 512;
constexpr int FF0 = 2816, FFM = 3584, NE = 8;
constexpr int MAXTILES = 136;
constexpr float EPS = 1e-6f;
constexpr int NWAVES = 8, NTHREADS = 512;

constexpr size_t MiB = 1u << 20;
constexpr size_t WS_CTL = 0, CTL_BYTES = 32768;
constexpr size_t WS_MISC = 1 * MiB;
constexpr size_t MISC_LB = 0, MISC_GCNT = 8192, MISC_TILE_E = 16384, MISC_NT = 17408, MISC_TOPI = 65536, MISC_TOPG = 196608, MISC_POS = 327680, MISC_SSXA = 458752, MISC_SSXB = 720896;
constexpr size_t WS_COS = 2 * MiB, WS_SIN = 4 * MiB;
constexpr size_t WS_WT_IN = 6 * MiB, WS_WT_QB = 17 * MiB, WS_WT_KVB = 19 * MiB, WS_WT_OUT = 20 * MiB, WS_WT_GU = 24 * MiB, WS_WT_DN = 35 * MiB, WS_WT_MGU = 41 * MiB, WS_WT_MDN = 153 * MiB;
constexpr size_t WS_XB = 209 * MiB;
constexpr size_t WS_CQ = 242 * MiB, WS_CKV = 254 * MiB, WS_KPE = 262 * MiB, WS_SSQ = 264 * MiB, WS_HQ = 266 * MiB, WS_HK = 282 * MiB, WS_LF = 298 * MiB, WS_HV = 330 * MiB, WS_HG = 346 * MiB;
constexpr size_t WS_Q = 362 * MiB, WS_KN = 386 * MiB, WS_V = 402 * MiB, WS_CC = 418 * MiB, WS_END = 464 * MiB;
constexpr size_t WS_HID = 242 * MiB;
#if MOE_FP8
constexpr size_t WS_XS = 242 * MiB;
constexpr size_t WS_YS = 276 * MiB;
constexpr size_t WS_HIDM = 344 * MiB;
constexpr int CHUNK_TILES = 136;
static_assert(WS_HIDM + (size_t)34816 * 3584 <= 464 * MiB, "MoE hidden fits below the guaranteed workspace size");
#else
constexpr size_t WS_XS = 242 * MiB;
constexpr size_t WS_YS = WS_XS;
constexpr size_t WS_HIDM = 310 * MiB;
constexpr int CHUNK_TILES = 64;
#endif
constexpr size_t WS_AP2 = WS_CQ;
constexpr size_t WS_AML = WS_SSQ;
constexpr size_t WS_HD = WS_XB + 32 * MiB, WS_HR = WS_HD + 512 * 1024;
constexpr size_t WS_XRB = 97 * MiB;
constexpr size_t WS_SLAB = 209 * MiB;
constexpr int CW_BAR = 4096;

constexpr int LDS_BYTES = 147456;
constexpr int LDS_MISC_OFF = 143360;

__device__ __forceinline__ unsigned f2bf(float f) { unsigned u = __float_as_uint(f); return (u + 0x7fffu + ((u >> 16) & 1u)) >> 16; }
typedef float pk2_f32x2 __attribute__((ext_vector_type(2)));
typedef __bf16 pk2_bf16x2 __attribute__((ext_vector_type(2)));
__device__ __forceinline__ unsigned pk2(float lo, float hi) { const pk2_f32x2 v = {lo, hi}; return __builtin_bit_cast(unsigned, __builtin_convertvector(v, pk2_bf16x2)); }
__device__ __forceinline__ float bf2f(unsigned short b) { return __uint_as_float(((unsigned)b) << 16); }
__device__ __forceinline__ float bflo(unsigned w) { return __uint_as_float(w << 16); }
__device__ __forceinline__ float bfhi(unsigned w) { return __uint_as_float(w & 0xffff0000u); }
__device__ __forceinline__ float clamp8(float x) { return __builtin_amdgcn_fmed3f(x, -448.f, 448.f); }
__device__ __forceinline__ unsigned pk4_fp8(float a, float b, float c, float d) {
    int w = __builtin_amdgcn_cvt_pk_fp8_f32(clamp8(a), clamp8(b), 0, false); w = __builtin_amdgcn_cvt_pk_fp8_f32(clamp8(c), clamp8(d), w, true); return (unsigned)w; }
__device__ __forceinline__ u32x4 pack8(f32x4 a, f32x4 b) { u32x4 w; w.x = pk2(a.x, a.y); w.y = pk2(a.z, a.w); w.z = pk2(b.x, b.y); w.w = pk2(b.z, b.w); return w; }
#if XR_BF16
typedef bf16 xr_t;
#else
typedef float xr_t;
#endif
__device__ __forceinline__ f32x4 ldrow4(const float* row, int idx) { return *((const f32x4*)row + idx); }
__device__ __forceinline__ f32x4 ldrow4(const bf16* row, int idx) { const u32x2 w = *((const u32x2*)row + idx); f32x4 r; r.x = __uint_as_float(w.x << 16); r.y = __uint_as_float(w.x & 0xffff0000u); r.z = __uint_as_float(w.y << 16); r.w = __uint_as_float(w.y & 0xffff0000u); return r; }
#define DPP_F(v, ctrl) __int_as_float(__builtin_amdgcn_update_dpp(0, __float_as_int(v), (ctrl), 0xf, 0xf, true))
#define DPP_I(v, ctrl) __builtin_amdgcn_update_dpp(0, (v), (ctrl), 0xf, 0xf, true)
__device__ __forceinline__ float xsum16(float v) { const auto r = __builtin_amdgcn_permlane16_swap(__float_as_uint(v), __float_as_uint(v), false, false); return __uint_as_float(r[0]) + __uint_as_float(r[1]); }
__device__ __forceinline__ float xsum32(float v) { const auto r = __builtin_amdgcn_permlane32_swap(__float_as_uint(v), __float_as_uint(v), false, false); return __uint_as_float(r[0]) + __uint_as_float(r[1]); }
__device__ __forceinline__ float xget16(float v, int odd_row) { const auto r = __builtin_amdgcn_permlane16_swap(__float_as_uint(v), __float_as_uint(v), false, false); return __uint_as_float(odd_row ? r[0] : r[1]); }
__device__ __forceinline__ float xget32(float v, int upper) { const auto r = __builtin_amdgcn_permlane32_swap(__float_as_uint(v), __float_as_uint(v), false, false); return __uint_as_float(upper ? r[0] : r[1]); }
__device__ __forceinline__ float wave_sum(float v) {
    v += DPP_F(v, 0xB1); v += DPP_F(v, 0x4E); v += DPP_F(v, 0x124); v += DPP_F(v, 0x128); v = xsum16(v); v = xsum32(v);
    return v;
}
__device__ __forceinline__ float wave_max(float v) {
    v = fmaxf(v, DPP_F(v, 0xB1)); v = fmaxf(v, DPP_F(v, 0x4E)); v = fmaxf(v, DPP_F(v, 0x124)); v = fmaxf(v, DPP_F(v, 0x128));
    { const auto r = __builtin_amdgcn_permlane16_swap(__float_as_uint(v), __float_as_uint(v), false, false); v = fmaxf(__uint_as_float(r[0]), __uint_as_float(r[1])); }
    { const auto r = __builtin_amdgcn_permlane32_swap(__float_as_uint(v), __float_as_uint(v), false, false); v = fmaxf(__uint_as_float(r[0]), __uint_as_float(r[1])); }
    return v;
}
__device__ __forceinline__ float fast_exp(float x) { return __builtin_amdgcn_exp2f(x * 1.4426950408889634f); }
__device__ __forceinline__ float sigmoidf_(float x) { return __builtin_amdgcn_rcpf(1.f + fast_exp(-x)); }
__device__ __forceinline__ float siluf_(float x) { return x * __builtin_amdgcn_rcpf(1.f + fast_exp(-x)); }
typedef float f32x2v __attribute__((ext_vector_type(2)));
__device__ __forceinline__ f32x2v silu_mul_pk(f32x2v g, f32x2v u) {
    const f32x2v t = g * (-1.4426950408889634f); f32x2v e; e.x = __builtin_amdgcn_exp2f(t.x); e.y = __builtin_amdgcn_exp2f(t.y);
    const f32x2v d = e + 1.0f; f32x2v r; r.x = __builtin_amdgcn_rcpf(d.x); r.y = __builtin_amdgcn_rcpf(d.y);
    return (g * u) * r;
}
__device__ __forceinline__ int perm32(int rho) { const int n = rho >> 4, i = rho & 15; return 8 * (i >> 2) + 4 * n + (i & 3); }

__device__ const double kInvRev[32] = {
    1.59154943091895346e-01, 1.19349370211248862e-01, 8.94994016088910133e-02, 6.71150830052272551e-02, 5.03292121044870353e-02, 3.77415847174197711e-02, 2.83021958306233987e-02, 2.12236527647776604e-02,
    1.59154943091895339e-02, 1.19349370211248862e-02, 8.94994016088910237e-03, 6.71150830052272534e-03, 5.03292121044870370e-03, 3.77415847174197719e-03, 2.83021958306233987e-03, 2.12236527647776622e-03,
    1.59154943091895356e-03, 1.19349370211248849e-03, 8.94994016088910237e-04, 6.71150830052272599e-04, 5.03292121044870326e-04, 3.77415847174197741e-04, 2.83021958306233954e-04, 2.12236527647776605e-04,
    1.59154943091895351e-04, 1.19349370211248862e-04, 8.94994016088910182e-05, 6.71150830052272545e-05, 5.03292121044870354e-05, 3.77415847174197768e-05, 2.83021958306233961e-05, 2.12236527647776592e-05};

#define XB_TMO      128
#define XB_XCNT(j)  (256  + 64 * (j))
#define XB_XSUB(j)  (1280 + 64 * (j))
#define XB_XGEN(j)  (2304 + 64 * (j))
#define XB_TOP      3328
#define XB_TOPGEN   3392
#define XCD_BAR_WORDS 3456
#define XB_SPIN_CAP (1u << 18)
__device__ __forceinline__ unsigned xb_ld(unsigned* p)              { return __hip_atomic_load(p, __ATOMIC_RELAXED, __HIP_MEMORY_SCOPE_AGENT); }
__device__ __forceinline__ unsigned xb_add(unsigned* p, unsigned v) { return __hip_atomic_fetch_add(p, v, __ATOMIC_RELAXED, __HIP_MEMORY_SCOPE_AGENT); }
__device__ __forceinline__ unsigned xb_xcc_id() { return (unsigned)__builtin_amdgcn_s_getreg((3 << 11) | 20) & 0xFu; }
#define XB_SPIN(cond, bar) do { unsigned _sp = 0; while (cond) { __builtin_amdgcn_s_sleep(1); \
    if ((++_sp & 255u) == 0u) { if (xb_ld(&(bar)[XB_TMO])) break; if (_sp > XB_SPIN_CAP) { atomicAdd(&(bar)[XB_TMO], 1u); break; } } } } while (0)
struct XcdBarrier { unsigned* bar; unsigned x; volatile LAS unsigned* st; };
__device__ __forceinline__ XcdBarrier xcd_barrier_post(unsigned* bar, volatile LAS unsigned* st) {
    XcdBarrier b; b.bar = bar; b.x = xb_xcc_id(); b.st = st;
    if (threadIdx.x == 0) (void)xb_add(&bar[XB_XCNT(b.x)], 1u);
    return b;
}
__device__ __forceinline__ void xcd_barrier_complete(unsigned* bar, unsigned x, unsigned& nloc, unsigned& nx) {
    const unsigned G = gridDim.x * gridDim.y * gridDim.z;
    unsigned sum, cnt, mine, sp = 0u;
    for (;;) {
        sum = 0u; cnt = 0u; mine = 0u;
#pragma unroll
        for (unsigned j = 0; j < 16; ++j) { const unsigned c = xb_ld(&bar[XB_XCNT(j)]); sum += c; cnt += (c > 0u) ? 1u : 0u; mine = (j == x) ? c : mine; }
        if (sum == G) break;
        __builtin_amdgcn_s_sleep(1);
        if ((++sp & 255u) == 0u) { if (xb_ld(&bar[XB_TMO])) break; if (sp > XB_SPIN_CAP) { atomicAdd(&bar[XB_TMO], 1u); break; } }
    }
    nloc = mine > 0u ? mine : 1u; nx = cnt > 0u ? cnt : 1u;
}
__device__ __forceinline__ void xcd_barrier(const XcdBarrier& b) {
    asm volatile("s_waitcnt vmcnt(0)" ::: "memory");
    __syncthreads();
    unsigned long long bar_ = (unsigned long long)b.bar; asm volatile("" : "+s"(bar_));
    if (threadIdx.x == 0) {
        unsigned* bar = (unsigned*)(GAS unsigned*)bar_;
        __builtin_amdgcn_s_waitcnt(0);
        unsigned nloc = b.st[0], nx = b.st[1];
        if (nloc == 0u) { xcd_barrier_complete(bar, b.x, nloc, nx); b.st[0] = nloc; b.st[1] = nx; }
        const unsigned old = xb_add(&bar[XB_XSUB(b.x)], 1u);
        const unsigned gen = old / nloc;
        if (old + 1u == (gen + 1u) * nloc) {
            __builtin_amdgcn_fence(__ATOMIC_RELEASE, "agent");
            asm volatile("s_waitcnt vmcnt(0)" ::: "memory");
            const unsigned og = xb_add(&bar[XB_TOP], 1u);
            const unsigned tg = og / nx;
            if (og + 1u == (tg + 1u) * nx) xb_add(&bar[XB_TOPGEN], 1u);
            else XB_SPIN(xb_ld(&bar[XB_TOPGEN]) == tg, bar);
            __builtin_amdgcn_fence(__ATOMIC_ACQUIRE, "agent");
            xb_add(&bar[XB_XGEN(b.x)], 1u);
            asm volatile("s_waitcnt vmcnt(0)" ::: "memory");
        } else {
            XB_SPIN(xb_ld(&bar[XB_XGEN(b.x)]) == gen, bar);
            __builtin_amdgcn_fence(__ATOMIC_ACQUIRE, "agent");
            asm volatile("s_waitcnt vmcnt(0)" ::: "memory");
        }
    }
    __syncthreads();
}

struct Params { const float* in[20]; float* out; unsigned char* ws; int ph_lo, ph_hi; };
enum { I_X = 0, I_POS, I_MIXN, I_WIN, I_QAN, I_WQB, I_KVAN, I_WKVB, I_HLB, I_HON, I_WOUT, I_FFNN, I_DWG, I_DWU, I_DWD, I_ROUTER, I_MWG, I_MWU, I_MWD, I_FINN };

struct Ctx {
    int tid, lane, wave, bid, nblk;
    LAS unsigned char* lds;
};

struct EpiProj {
    unsigned char* ws; int l; int ssx;
    __device__ __forceinline__ void launder() { unsigned long long w = (unsigned long long)ws; asm volatile("" : "+s"(w)); ws = (unsigned char*)(GAS unsigned char*)w;     }
    static constexpr int HAS_ROWSCALE = 1;
    __device__ __forceinline__ float rowscale(int row) const { if (!ssx) return 1.f; const float* sx = (const float*)(ws + WS_MISC + ssx) + row; return __builtin_amdgcn_rsqf(((sx[0] + sx[T]) + (sx[2 * T] + sx[3 * T])) * (1.f / DM) + EPS); }
    __device__ __forceinline__ void operator()(int row, int c, f32x4 a, f32x4 b) const {
        bf16* CQ = (bf16*)(ws + WS_CQ); bf16* CKV = (bf16*)(ws + WS_CKV); bf16* KPE = (bf16*)(ws + WS_KPE); bf16* HQ = (bf16*)(ws + WS_HQ); bf16* HK = (bf16*)(ws + WS_HK); bf16* HV = (bf16*)(ws + WS_HV); bf16* HG = (bf16*)(ws + WS_HG);
        float* LF = (float*)(ws + WS_LF); float* SSQ = (float*)(ws + WS_SSQ); const float* LB = (const float*)(ws + WS_MISC + MISC_LB) + l * HGW; const float* COS = (const float*)(ws + WS_COS); const float* SIN = (const float*)(ws + WS_SIN);
        if (c < 640) {
            float ss = (a.x * a.x + a.y * a.y) + (a.z * a.z + a.w * a.w) + (b.x * b.x + b.y * b.y) + (b.z * b.z + b.w * b.w);
            { const auto r = __builtin_amdgcn_permlane16_swap(__float_as_uint(ss), __float_as_uint(ss), false, false); ss = __uint_as_float(r[0]) + __uint_as_float(r[1]); }
            { const auto r = __builtin_amdgcn_permlane32_swap(__float_as_uint(ss), __float_as_uint(ss), false, false); ss = __uint_as_float(r[0]) + __uint_as_float(r[1]); }
            if ((threadIdx.x & 63) < 16) SSQ[(size_t)(c >> 5) * T + row] = ss;
            const u32x4 w = pack8(a, b);
            if (c < QR) *(u32x4*)(CQ + (size_t)row * QR + c) = w; else *(u32x4*)(CKV + (size_t)row * KVR + (c - QR)) = w;
        } else if (c < 704) {
            const int g = (c - 640) >> 3;
            const f32x4 cs = *(const f32x4*)(COS + (size_t)row * 32 + 4 * g), sn = *(const f32x4*)(SIN + (size_t)row * 32 + 4 * g);
            const f32x4 o1 = a * cs - b * sn, o2 = a * sn + b * cs;
            *(u32x4*)(KPE + (size_t)row * ROPE + 8 * g) = pack8(o1, o2);
        } else if (c < 1216) {
            f32x4 x, y; x.x = siluf_(a.x); x.y = siluf_(a.y); x.z = siluf_(a.z); x.w = siluf_(a.w); y.x = siluf_(b.x); y.y = siluf_(b.y); y.z = siluf_(b.z); y.w = siluf_(b.w);
            *(u32x4*)(HQ + (size_t)row * HGW + (c - 704)) = pack8(x, y);
#if HG_V2
        } else if (c < 1728) {
            *(u32x4*)(HK + (size_t)row * HGW + (c - 1216)) = pack8(a, b);
#else
        } else if (c < 1728) {
            const int d = c - 1216;
            const f32x4 l0 = *(const f32x4*)(LB + d), l1 = *(const f32x4*)(LB + d + 4);
            f32x4 k0, k1, f0, f1;
#define HGATE(z, lb, kk, lf) do { const float zc = fminf(fmaxf((z), -60.f), 60.f); const float e = fast_exp(-zc); const float sg = __builtin_amdgcn_rcpf(1.f + e); const float om = 1.f - (lb); \
                kk = om * (e * sg); const float f = (lb) + om * sg; lf = __builtin_amdgcn_logf(fmaxf(f, 1e-30f)) * 0.6931471805599453f; } while (0)
            HGATE(a.x, l0.x, k0.x, f0.x); HGATE(a.y, l0.y, k0.y, f0.y); HGATE(a.z, l0.z, k0.z, f0.z); HGATE(a.w, l0.w, k0.w, f0.w);
            HGATE(b.x, l1.x, k1.x, f1.x); HGATE(b.y, l1.y, k1.y, f1.y); HGATE(b.z, l1.z, k1.z, f1.z); HGATE(b.w, l1.w, k1.w, f1.w);
#undef HGATE
            *(u32x4*)(HK + (size_t)row * HGW + d) = pack8(k0, k1);
            *(f32x4*)(LF + (size_t)row * HGW + d) = f0; *(f32x4*)(LF + (size_t)row * HGW + d + 4) = f1;
#endif
        } else if (c < 2240) {
            *(u32x4*)(HV + (size_t)row * HGW + (c - 1728)) = pack8(a, b);
        } else if (c < 2752) {
            *(u32x4*)(HG + (size_t)row * HGW + (c - 2240)) = pack8(a, b);
        }
    }
};
struct EpiQ {
    unsigned char* ws;
    __device__ __forceinline__ void launder() { unsigned long long w = (unsigned long long)ws; asm volatile("" : "+s"(w)); ws = (unsigned char*)(GAS unsigned char*)w;     }
    static constexpr int HAS_ROWSCALE = 1;
    __device__ __forceinline__ float rowscale(int row) const { const float* SSQ = (const float*)(ws + WS_SSQ); float s = 0.f;
#pragma unroll
        for (int i = 0; i < 12; ++i) s += SSQ[(size_t)i * T + row];
        return __builtin_amdgcn_rsqf(s * (1.f / QR) + EPS); }
    __device__ __forceinline__ void operator()(int row, int c, f32x4 a, f32x4 b) const {
        bf16* Q = (bf16*)(ws + WS_Q); const float* COS = (const float*)(ws + WS_COS); const float* SIN = (const float*)(ws + WS_SIN);
        const int h = c / DQK, cc = c - h * DQK, bb = row >> 13, sq = row & (SEQ - 1);
        bf16* dst = Q + ((size_t)((bb * NH + h) * SEQ + sq)) * DQK + cc;
        if (cc < DNOPE) { *(u32x4*)dst = pack8(a, b); }
        else { const int g = (cc - DNOPE) >> 3;
            const f32x4 cs = *(const f32x4*)(COS + (size_t)row * 32 + 4 * g), sn = *(const f32x4*)(SIN + (size_t)row * 32 + 4 * g);
            *(u32x4*)dst = pack8(a * cs - b * sn, a * sn + b * cs); }
    }
};
struct EpiKV {
    unsigned char* ws;
    __device__ __forceinline__ void launder() { unsigned long long w = (unsigned long long)ws; asm volatile("" : "+s"(w)); ws = (unsigned char*)(GAS unsigned char*)w;     }
    static constexpr int HAS_ROWSCALE = 1;
    __device__ __forceinline__ float rowscale(int row) const { const float* SSQ = (const float*)(ws + WS_SSQ); float s = 0.f;
#pragma unroll
        for (int i = 12; i < 20; ++i) s += SSQ[(size_t)i * T + row];
        return __builtin_amdgcn_rsqf(s * (1.f / KVR) + EPS); }
    __device__ __forceinline__ void operator()(int row, int c, f32x4 a, f32x4 b) const {
        bf16* KN = (bf16*)(ws + WS_KN); bf16* V = (bf16*)(ws + WS_V);
        const int h = c >> 8, cc = c & 255, bb = row >> 13, sq = row & (SEQ - 1);
        const size_t r = ((size_t)((bb * NH + h) * SEQ + sq)) * 128;
        if (cc < 128) *(u32x4*)(KN + r + cc) = pack8(a, b); else *(u32x4*)(V + r + (cc - 128)) = pack8(a, b);
    }
};
template <class TS, class TD> struct EpiResT {
    static constexpr int HAS_PAIR = 1;
    __device__ __forceinline__ void pair(int row, int c, f32x4 a0, f32x4 b0, f32x4 a1, f32x4 b1) const {
        const size_t o = (size_t)row * DM + c;
        f32x4 s0, s1, t0, t1;
        if constexpr (sizeof(TS) == 4) { s0 = *(const f32x4*)((const float*)SRC + o); s1 = *(const f32x4*)((const float*)SRC + o + 4); t0 = *(const f32x4*)((const float*)SRC + o + 128); t1 = *(const f32x4*)((const float*)SRC + o + 132); }
        else { const u32x4 w = *(const u32x4*)((const bf16*)SRC + o), v = *(const u32x4*)((const bf16*)SRC + o + 128);
            s0.x = bflo(w.x); s0.y = bfhi(w.x); s0.z = bflo(w.y); s0.w = bfhi(w.y); s1.x = bflo(w.z); s1.y = bfhi(w.z); s1.z = bflo(w.w); s1.w = bfhi(w.w);
            t0.x = bflo(v.x); t0.y = bfhi(v.x); t0.z = bflo(v.y); t0.w = bfhi(v.y); t1.x = bflo(v.z); t1.y = bfhi(v.z); t1.z = bflo(v.w); t1.w = bfhi(v.w); }
        s0 = s0 + a0; s1 = s1 + b0; t0 = t0 + a1; t1 = t1 + b1;
        if constexpr (sizeof(TD) == 4) { *(f32x4*)((float*)DST + o) = s0; *(f32x4*)((float*)DST + o + 4) = s1; *(f32x4*)((float*)DST + o + 128) = t0; *(f32x4*)((float*)DST + o + 132) = t1; }
        else { *(u32x4*)((bf16*)DST + o) = pack8(s0, s1); *(u32x4*)((bf16*)DST + o + 128) = pack8(t0, t1); }
    }
    const TS* SRC; TD* DST;
    __device__ __forceinline__ void launder() {}
    __device__ __forceinline__ void operator()(int row, int c, f32x4 a, f32x4 b) const {
        const size_t o = (size_t)row * DM + c;
        f32x4 s0, s1;
        if constexpr (sizeof(TS) == 4) { s0 = *(const f32x4*)((const float*)SRC + o); s1 = *(const f32x4*)((const float*)SRC + o + 4); }
        else { const u32x4 w = *(const u32x4*)((const bf16*)SRC + o); s0.x = bflo(w.x); s0.y = bfhi(w.x); s0.z = bflo(w.y); s0.w = bfhi(w.y); s1.x = bflo(w.z); s1.y = bfhi(w.z); s1.z = bflo(w.w); s1.w = bfhi(w.w); }
        s0 = s0 + a; s1 = s1 + b;
        if constexpr (sizeof(TD) == 4) { *(f32x4*)((float*)DST + o) = s0; *(f32x4*)((float*)DST + o + 4) = s1; }
        else *(u32x4*)((bf16*)DST + o) = pack8(s0, s1);
    }
};
template <class TS> struct EpiResNormT {
    static constexpr bool HAS_FINISH = true;
    const TS* SRC; bf16* DST; float* SSX; float ssb;
    __device__ __forceinline__ void launder() {}
    __device__ __forceinline__ void operator()(int row, int c, f32x4 a, f32x4 b) {
        const size_t o = (size_t)row * DM + c;
        f32x4 s0, s1;
        if constexpr (sizeof(TS) == 4) { s0 = *(const f32x4*)((const float*)SRC + o); s1 = *(const f32x4*)((const float*)SRC + o + 4); }
        else { const u32x4 w = *(const u32x4*)((const bf16*)SRC + o); s0.x = bflo(w.x); s0.y = bfhi(w.x); s0.z = bflo(w.y); s0.w = bfhi(w.y); s1.x = bflo(w.z); s1.y = bfhi(w.z); s1.z = bflo(w.w); s1.w = bfhi(w.w); }
        s0 = s0 + a; s1 = s1 + b;
        *(u32x4*)(DST + o) = pack8(s0, s1);
        float ss = (s0.x * s0.x + s0.y * s0.y) + (s0.z * s0.z + s0.w * s0.w) + (s1.x * s1.x + s1.y * s1.y) + (s1.z * s1.z + s1.w * s1.w);
        if ((c & 128) == 0) { ssb = ss; }
        else { ss += ssb; ss += __shfl_xor(ss, 16); ss += __shfl_xor(ss, 32);
            if ((threadIdx.x & 63) < 16) part[(row & 255) * 4 + ((c >> 5) & 3)] = ss; }
    }
    static constexpr int HAS_PAIR = 1;
    __device__ __forceinline__ void pair(int row, int c, f32x4 a0, f32x4 b0, f32x4 a1, f32x4 b1) const {
        const size_t o = (size_t)row * DM + c;
        f32x4 s0, s1, t0, t1;
        if constexpr (sizeof(TS) == 4) { s0 = *(const f32x4*)((const float*)SRC + o); s1 = *(const f32x4*)((const float*)SRC + o + 4); t0 = *(const f32x4*)((const float*)SRC + o + 128); t1 = *(const f32x4*)((const float*)SRC + o + 132); }
        else { const u32x4 w = *(const u32x4*)((const bf16*)SRC + o), v = *(const u32x4*)((const bf16*)SRC + o + 128);
            s0.x = bflo(w.x); s0.y = bfhi(w.x); s0.z = bflo(w.y); s0.w = bfhi(w.y); s1.x = bflo(w.z); s1.y = bfhi(w.z); s1.z = bflo(w.w); s1.w = bfhi(w.w);
            t0.x = bflo(v.x); t0.y = bfhi(v.x); t0.z = bflo(v.y); t0.w = bfhi(v.y); t1.x = bflo(v.z); t1.y = bfhi(v.z); t1.z = bflo(v.w); t1.w = bfhi(v.w); }
        s0 = s0 + a0; s1 = s1 + b0; t0 = t0 + a1; t1 = t1 + b1;
        *(u32x4*)(DST + o) = pack8(s0, s1); *(u32x4*)(DST + o + 128) = pack8(t0, t1);
        const f32x4 q = s0 * s0 + s1 * s1 + (t0 * t0 + t1 * t1);
        float ss = (q.x + q.y) + (q.z + q.w);
        { const auto r = __builtin_amdgcn_permlane16_swap(__float_as_uint(ss), __float_as_uint(ss), false, false); ss = __uint_as_float(r[0]) + __uint_as_float(r[1]); }
        { const auto r = __builtin_amdgcn_permlane32_swap(__float_as_uint(ss), __float_as_uint(ss), false, false); ss = __uint_as_float(r[0]) + __uint_as_float(r[1]); }
        if ((threadIdx.x & 63) < 16) part[(row & 255) * 4 + (__builtin_amdgcn_readfirstlane(c) >> 5 & 3)] = ss;
    }
    LAS float* part;
    __device__ __forceinline__ void finish(int pm, int pn, int tid) {
        asm volatile("s_waitcnt lgkmcnt(0)" ::: "memory"); __builtin_amdgcn_s_barrier(); asm volatile("" ::: "memory");
        if (tid < 256) { const LAS float* q = part + tid * 4; SSX[(size_t)pn * T + pm * 256 + tid] = (q[0] + q[1]) + (q[2] + q[3]); }
    }
};
struct EpiSwiglu {
    bf16* HID; int ff; int rowbase; const float* SSX;
    static constexpr int HAS_ROWSCALE = 1;
    __device__ __forceinline__ void launder() {}
    __device__ __forceinline__ float rowscale(int row) const { if (!SSX) return 1.f; const float* sx = SSX + row; return __builtin_amdgcn_rsqf(((sx[0] + sx[T]) + (sx[2 * T] + sx[3 * T])) * (1.f / DM) + EPS); }
    __device__ __forceinline__ void operator()(int row, int c, f32x4 a, f32x4 b) const {
        const f32x2v h0 = silu_mul_pk((f32x2v){a.x, a.y}, (f32x2v){b.x, b.y}), h1 = silu_mul_pk((f32x2v){a.z, a.w}, (f32x2v){b.z, b.w});
        u32x2 w; w.x = pk2(h0.x, h0.y); w.y = pk2(h1.x, h1.y);
        *(u32x2*)(HID + (size_t)(row - rowbase) * ff + (c >> 1)) = w;
    }
    static constexpr int HAS_QUAD = 1;
    __device__ __forceinline__ void quad(int rowA, int c, int fq, const f32x4 (&A)[4][2], const float (&rs)[4]) const {
#pragma unroll
        for (int mp = 0; mp < 4; mp += 2) {
            u32x2 X, Y;
            { const f32x4 a = A[mp][0] * rs[mp], b = A[mp][1] * rs[mp]; const f32x2v h0 = silu_mul_pk((f32x2v){a.x, a.y}, (f32x2v){b.x, b.y}), h1 = silu_mul_pk((f32x2v){a.z, a.w}, (f32x2v){b.z, b.w}); X.x = pk2(h0.x, h0.y); X.y = pk2(h1.x, h1.y); }
            { const f32x4 a = A[mp + 1][0] * rs[mp + 1], b = A[mp + 1][1] * rs[mp + 1]; const f32x2v h0 = silu_mul_pk((f32x2v){a.x, a.y}, (f32x2v){b.x, b.y}), h1 = silu_mul_pk((f32x2v){a.z, a.w}, (f32x2v){b.z, b.w}); Y.x = pk2(h0.x, h0.y); Y.y = pk2(h1.x, h1.y); }
            const auto sx = __builtin_amdgcn_permlane16_swap(X.x, Y.x, false, false), sy = __builtin_amdgcn_permlane16_swap(X.y, Y.y, false, false);
            u32x4 w; w.x = sx[0]; w.y = sy[0]; w.z = sx[1]; w.w = sy[1];
            const int odd = fq & 1;
            *(u32x4*)(HID + (size_t)(rowA + 16 * (mp + odd) - rowbase) * ff + ((c - 8 * odd) >> 1)) = w;
        }
    }
};
struct EpiSwiglu8 {
    unsigned char* HID; int ff; int rowbase;
    __device__ __forceinline__ void launder() {}
    __device__ __forceinline__ void operator()(int row, int c, f32x4 a, f32x4 b) const {
        const f32x2v h0 = silu_mul_pk((f32x2v){a.x, a.y}, (f32x2v){b.x, b.y}), h1 = silu_mul_pk((f32x2v){a.z, a.w}, (f32x2v){b.z, b.w});
        *(unsigned*)(HID + (size_t)(row - rowbase) * ff + (c >> 1)) = pk4_fp8(h0.x, h0.y, h1.x, h1.y);
    }
    static constexpr int HAS_QUAD = 1;
    __device__ __forceinline__ float rowscale(int) const { return 1.f; }
    __device__ __forceinline__ void quad(int rowA, int c, int fq, const f32x4 (&A)[4][2], const float (&)[4]) const {
        unsigned d[4];
#pragma unroll
        for (int m = 0; m < 4; ++m) { const f32x4 a = A[m][0], b = A[m][1]; const f32x2v h0 = silu_mul_pk((f32x2v){a.x, a.y}, (f32x2v){b.x, b.y}), h1 = silu_mul_pk((f32x2v){a.z, a.w}, (f32x2v){b.z, b.w}); d[m] = pk4_fp8(h0.x, h0.y, h1.x, h1.y); }
        const auto r02 = __builtin_amdgcn_permlane32_swap(d[0], d[2], false, false), r13 = __builtin_amdgcn_permlane32_swap(d[1], d[3], false, false);
        const auto s01 = __builtin_amdgcn_permlane16_swap(r02[0], r13[0], false, false), s23 = __builtin_amdgcn_permlane16_swap(r02[1], r13[1], false, false);
        u32x4 w; w.x = s01[0]; w.y = s01[1]; w.z = s23[0]; w.w = s23[1];
        *(u32x4*)(HID + (size_t)(rowA + 16 * fq - rowbase) * ff + ((c - 8 * fq) >> 1)) = w;
    }
};
struct EpiProbe {
    float* sink;
    __device__ __forceinline__ void launder() {}
    __device__ __forceinline__ void operator()(int row, int c, f32x4 a, f32x4 b) const { if (a.x == 123456.789f && b.w == -98765.4321f) sink[row * 8 + (c & 7)] = a.y; }
};
struct EpiBf16Plain {
    bf16* O; int ld;
    __device__ __forceinline__ void launder() {}
    __device__ __forceinline__ void operator()(int row, int c, f32x4 a, f32x4 b) const { *(u32x4*)(O + (size_t)row * ld + c) = pack8(a, b); }
};

namespace pg8 {
#define PG8_LAS __attribute__((address_space(3)))
typedef unsigned short bf16_t;
typedef short bf16x8 __attribute__((ext_vector_type(8)));
typedef float f32x4 __attribute__((ext_vector_type(4)));
typedef unsigned u32x4 __attribute__((ext_vector_type(4)));
typedef int v4i_t __attribute__((ext_vector_type(4)));
typedef int v8i_t __attribute__((ext_vector_type(8)));
constexpr int BM = 256, BK = 64, HALF = 128, HTB = HALF * BK * 2  , STAGE_BYTES = 8 * HTB, NXCD = 8, WGM = 8;

__host__ __device__ __forceinline__ int lds_byte(int r, int c) { const int st = (r >> 4) * 2 + (c >> 5), rr = r & 15, cc = c & 31, ob = rr * 64 + cc * 2; return st * 1024 + (ob ^ (((ob >> 9) & 1) << 5)); }
__host__ __device__ __forceinline__ void stage_rc(int b, int& R, int& C) { const int st = b / 1024, sb = b % 1024, swz = sb ^ (((sb >> 9) & 1) << 5); R = (st >> 1) * 16 + swz / 64; C = (st & 1) * 32 + (swz % 64) / 2; }
__host__ __device__ __forceinline__ int perm32(int rho) { const int n = rho >> 4, i = rho & 15; return 8 * (i >> 2) + 4 * n + (i & 3); }

template <class E, class = void> struct has_finish { static constexpr bool value = false; };
template <class E> struct has_finish<E, decltype((void)E::HAS_FINISH)> { static constexpr bool value = true; };
template <class E, class = void> struct has_pair { static constexpr bool value = false; };
template <class E> struct has_pair<E, decltype((void)E::HAS_PAIR)> { static constexpr bool value = true; };
template <class E, class = void> struct has_quad { static constexpr bool value = false; };
template <class E> struct has_quad<E, decltype((void)E::HAS_QUAD)> { static constexpr bool value = true; };
template <class E, class = void> struct has_rowscale { static constexpr bool value = false; };
template <class E> struct has_rowscale<E, decltype((void)E::HAS_ROWSCALE)> { static constexpr bool value = true; };
struct Unit { int pm, pn, pa, pb; };
struct Gemm { const bf16_t* A; const bf16_t* Bt; int M, N, K; int wscale; int ld; };

struct StaticOrder {
    int nM, nN, nwg, G, c;
    __host__ __device__ void init(int M, int N, int G_, int c_) { nM = M / BM; nN = N / BM; nwg = nM * nN; G = G_; c = c_; }
    __host__ __device__ bool next(int i, Unit& u) const {
        const long L = (long)i * G + c; if (L >= nwg) return false;
        int wgid = (int)L; { const int q = nwg / NXCD, r = nwg % NXCD, xcd = wgid % NXCD, off = wgid / NXCD; wgid = (xcd < r ? xcd * (q + 1) : r * (q + 1) + (xcd - r) * q) + off; }
        const int nig = WGM * nN, gid = wgid / nig, fm = gid * WGM, gsz = (nM - fm) < WGM ? (nM - fm) : WGM;
        u.pm = fm + ((wgid % nig) % gsz); u.pn = (wgid % nig) / gsz; u.pa = u.pm; u.pb = u.pn; return true;
    }
    __device__ __forceinline__ void a_ready(const Unit&) const {}
    __device__ __forceinline__ void done(const Unit&) const {}
};
template <class Epi, class Sched, bool ALIGN_EPI = false, bool SP2 = false, bool FP8 = false>
__device__ __forceinline__ void gemm_phase(PG8_LAS unsigned char* lds, const Gemm g, const Sched& S, const Epi& E) {
    int tid_ = threadIdx.x; asm volatile("" : "+v"(tid_));
    const int tid = tid_, wid = __builtin_amdgcn_readfirstlane(tid >> 6), lane = tid & 63, wr = wid >> 2, wc = wid & 3, fr = lane & 15, fq = lane >> 4;
    const int K = g.ld ? g.ld : g.K, nt = g.K / BK;
    unsigned voffA[2], voffB[2];
#pragma unroll
    for (int i = 0; i < 2; ++i) { int R, C; stage_rc(tid * 16 + i * 8192, R, C); const int Rb = (R & ~31) + perm32(R & 31);
        voffA[i] = (unsigned)(R * K + C) * 2u; voffB[i] = (unsigned)(Rb * K + C) * 2u; }
    const size_t kstep = (size_t)(BK * 2);
    const size_t hstep = (size_t)HALF * K * 2;
    const size_t tstep = 2 * hstep;
    const unsigned ldsw = (unsigned)wid * 1024u;
    const int aoff = lds_byte(wr * 64 + fr, fq * 8), boff = lds_byte(wc * 32 + fr, fq * 8);
#define PG8_SA(b, h) (((b) * 2 + (h)) * HTB)
#define PG8_SB(b, h) ((4 + (b) * 2 + (h)) * HTB)
#define PG8_STAGE(bufoff, gbase, voff) do { _Pragma("unroll") for (int _i = 0; _i < 2; ++_i) \
        __builtin_amdgcn_global_load_lds((const unsigned*)((const char*)(gbase) + (voff)[_i]), (PG8_LAS unsigned*)(lds + (bufoff) + ldsw + _i * 8192), 16, 0, 0); } while (0)
#define PG8_RD(off) (*(const PG8_LAS bf16x8*)(lds + (off)))
#define PG8_CAT(lo, hi) __builtin_shufflevector(__builtin_bit_cast(v4i_t, lo), __builtin_bit_cast(v4i_t, hi), 0, 1, 2, 3, 4, 5, 6, 7)
#define PG8_LDA(dst, b, h) do { _Pragma("unroll") for (int m = 0; m < 4; ++m) { if constexpr (FP8) dst##8[m] = PG8_CAT(PG8_RD(PG8_SA(b, h) + aoff + m * 2048), PG8_RD(PG8_SA(b, h) + aoff + m * 2048 + 1024)); \
        else { dst[m][0] = PG8_RD(PG8_SA(b, h) + aoff + m * 2048); dst[m][1] = PG8_RD(PG8_SA(b, h) + aoff + m * 2048 + 1024); } } } while (0)
#define PG8_LDB(dst, b, h) do { _Pragma("unroll") for (int n = 0; n < 2; ++n) { if constexpr (FP8) dst##8[n] = PG8_CAT(PG8_RD(PG8_SB(b, h) + boff + n * 2048), PG8_RD(PG8_SB(b, h) + boff + n * 2048 + 1024)); \
        else { dst[n][0] = PG8_RD(PG8_SB(b, h) + boff + n * 2048); dst[n][1] = PG8_RD(PG8_SB(b, h) + boff + n * 2048 + 1024); } } } while (0)
#define PG8_MMA(ai, bj, At, Bt) do { __builtin_amdgcn_s_setprio(1); if constexpr (FP8) { _Pragma("unroll") for (int m = 0; m < 4; ++m) _Pragma("unroll") for (int n = 0; n < 2; ++n) \
        asm volatile("v_mfma_scale_f32_16x16x128_f8f6f4 %0, %1, %2, %0, %3, %4 op_sel_hi:[0,0,0]" : "+v"(acc[ai][bj][m][n]) : "v"(Bt##8[n]), "v"(At##8[m]), "v"(sc_w), "v"(sc_1)); } \
        else { _Pragma("unroll") for (int m = 0; m < 4; ++m) _Pragma("unroll") for (int n = 0; n < 2; ++n) _Pragma("unroll") for (int k = 0; k < 2; ++k) \
        acc[ai][bj][m][n] = __builtin_amdgcn_mfma_f32_16x16x32_bf16(Bt[n][k], At[m][k], acc[ai][bj][m][n], 0, 0, 0); } __builtin_amdgcn_s_setprio(0); } while (0)
#define PG8_WAIT_V(n) asm volatile("s_waitcnt vmcnt(" #n ")" ::: "memory")
#define PG8_WAIT_L(n) asm volatile("s_waitcnt lgkmcnt(" #n ")" ::: "memory")
#define PG8_BAR __builtin_amdgcn_s_barrier()
#define PG8_SCHED __builtin_amdgcn_sched_barrier(0)
    Unit cur, nxt; int ui = 0;
    if (!S.next(0, cur)) return;
    f32x4 acc[2][2][4][2];
#pragma unroll
    for (int a = 0; a < 2; ++a)
#pragma unroll
        for (int b = 0; b < 2; ++b)
#pragma unroll
            for (int m = 0; m < 4; ++m)
#pragma unroll
                for (int n = 0; n < 2; ++n) acc[a][b][m][n] = (f32x4){0.f, 0.f, 0.f, 0.f};
    const int sc_w = g.wscale, sc_1 = 0x7F7F7F7F;
    bf16x8 At[4][2], B0[2][2], B1[2][2]; v8i_t At8[4], B08[2], B18[2];
    const char* cA = (const char*)g.A + (size_t)cur.pa * tstep; const char* cB = (const char*)g.Bt + (size_t)cur.pb * tstep;
    S.a_ready(cur);
    if constexpr (SP2) {
        PG8_STAGE(PG8_SB(0, 0), cB, voffB); PG8_STAGE(PG8_SB(0, 1), cB + hstep, voffB); PG8_STAGE(PG8_SA(0, 0), cA, voffA); PG8_STAGE(PG8_SA(0, 1), cA + hstep, voffA);
        if (wr == 1) PG8_BAR;
        PG8_WAIT_V(2); PG8_BAR;
        PG8_STAGE(PG8_SB(1, 0), cB + kstep, voffB); PG8_STAGE(PG8_SA(1, 0), cA + kstep, voffA); PG8_STAGE(PG8_SB(1, 1), cB + hstep + kstep, voffB);
        PG8_WAIT_V(6); PG8_BAR;
    } else {
        PG8_STAGE(PG8_SB(0, 0), cB, voffB); PG8_STAGE(PG8_SA(0, 0), cA, voffA); PG8_STAGE(PG8_SB(0, 1), cB + hstep, voffB); PG8_STAGE(PG8_SA(0, 1), cA + hstep, voffA);
        if (wr == 1) PG8_BAR;
        PG8_WAIT_V(4); PG8_BAR;
        PG8_STAGE(PG8_SB(1, 0), cB + kstep, voffB); PG8_STAGE(PG8_SA(1, 0), cA + kstep, voffA); PG8_STAGE(PG8_SB(1, 1), cB + hstep + kstep, voffB);
        PG8_WAIT_V(6); PG8_BAR;
    }
    for (;;) {
        const bool has_next = S.next(ui + 1, nxt);
        const char* nA = has_next ? (const char*)g.A + (size_t)nxt.pa * tstep : cA; const char* nB = has_next ? (const char*)g.Bt + (size_t)nxt.pb * tstep : cB;
#pragma nounroll
        for (int t = 0; t < nt; t += 2) {
            const bool last = (t == nt - 2);
            const char* a1 = cA + (size_t)(t + 1) * kstep;
            const char* a2 = last ? nA : cA + (size_t)(t + 2) * kstep; const char* b2 = last ? nB : cB + (size_t)(t + 2) * kstep;
            const char* a3 = a2 + kstep; const char* b3 = b2 + kstep;
            if (last && has_next) S.a_ready(nxt);
            if constexpr (SP2) {
            PG8_LDB(B0, 0, 0); PG8_LDB(B1, 0, 1); PG8_SCHED; PG8_LDA(At, 0, 0); PG8_STAGE(PG8_SA(1, 1), a1 + hstep, voffA);
            PG8_WAIT_V(8); PG8_WAIT_L(0); PG8_BAR; PG8_MMA(0, 0, At, B0); PG8_MMA(0, 1, At, B1); PG8_BAR; PG8_SCHED;
            PG8_LDA(At, 0, 1); PG8_STAGE(PG8_SB(0, 0), b2, voffB); PG8_STAGE(PG8_SB(0, 1), b2 + hstep, voffB); PG8_STAGE(PG8_SA(0, 0), a2, voffA);
            PG8_WAIT_V(8); PG8_WAIT_L(0); PG8_BAR; PG8_MMA(1, 0, At, B0); PG8_MMA(1, 1, At, B1); PG8_BAR; PG8_SCHED;
            PG8_LDB(B0, 1, 0); PG8_LDB(B1, 1, 1); PG8_SCHED; PG8_LDA(At, 1, 0); PG8_STAGE(PG8_SA(0, 1), a2 + hstep, voffA);
            PG8_WAIT_V(8); PG8_WAIT_L(0); PG8_BAR; PG8_MMA(0, 0, At, B0); PG8_MMA(0, 1, At, B1); PG8_BAR; PG8_SCHED;
            PG8_LDA(At, 1, 1); PG8_STAGE(PG8_SB(1, 0), b3, voffB); PG8_STAGE(PG8_SB(1, 1), b3 + hstep, voffB); PG8_STAGE(PG8_SA(1, 0), a3, voffA);
            PG8_WAIT_V(8); PG8_WAIT_L(0); PG8_BAR; PG8_MMA(1, 0, At, B0); PG8_MMA(1, 1, At, B1); PG8_BAR; PG8_SCHED;
            } else {
            PG8_LDB(B0, 0, 0); PG8_SCHED; PG8_LDA(At, 0, 0); PG8_STAGE(PG8_SA(1, 1), a1 + hstep, voffA);
            PG8_WAIT_L(8); PG8_BAR; PG8_WAIT_L(0); PG8_MMA(0, 0, At, B0); PG8_BAR; PG8_SCHED;
            PG8_LDB(B1, 0, 1); PG8_STAGE(PG8_SB(0, 0), b2, voffB);
            PG8_BAR; PG8_WAIT_L(0); PG8_MMA(0, 1, At, B1); PG8_BAR;
            PG8_LDA(At, 0, 1); PG8_STAGE(PG8_SA(0, 0), a2, voffA);
            PG8_BAR; PG8_WAIT_L(0); PG8_MMA(1, 0, At, B0); PG8_BAR; PG8_SCHED;
            PG8_STAGE(PG8_SB(0, 1), b2 + hstep, voffB);
            PG8_WAIT_V(6); PG8_BAR; PG8_MMA(1, 1, At, B1); PG8_BAR;
            PG8_LDB(B0, 1, 0); PG8_SCHED; PG8_LDA(At, 1, 0); PG8_STAGE(PG8_SA(0, 1), a2 + hstep, voffA);
            PG8_WAIT_L(8); PG8_BAR; PG8_WAIT_L(0); PG8_MMA(0, 0, At, B0); PG8_BAR; PG8_SCHED;
            PG8_LDB(B1, 1, 1); PG8_STAGE(PG8_SB(1, 0), b3, voffB);
            PG8_BAR; PG8_WAIT_L(0); PG8_MMA(0, 1, At, B1); PG8_BAR;
            PG8_LDA(At, 1, 1); PG8_STAGE(PG8_SA(1, 0), a3, voffA);
            PG8_BAR; PG8_WAIT_L(0); PG8_MMA(1, 0, At, B0); PG8_BAR; PG8_SCHED;
            PG8_STAGE(PG8_SB(1, 1), b3 + hstep, voffB);
            PG8_WAIT_V(6); PG8_BAR; PG8_MMA(1, 1, At, B1); PG8_BAR;
            }
        }
        if constexpr (ALIGN_EPI) { if (wr == 0) PG8_BAR; }
        if constexpr (FP8) asm volatile("s_nop 15\n\ts_nop 15" ::: "memory");
        {
            int fr_ = fr, fq_ = fq; asm volatile("" : "+v"(fr_), "+v"(fq_));
            const int row0 = cur.pm * BM + wr * 64 + fr_, col0 = cur.pn * BM + wc * 32 + 8 * fq_;
            Epi E2 = E; E2.launder();
            if constexpr (has_quad<Epi>::value) {
                float rs[2][4];
#pragma unroll
                for (int ai = 0; ai < 2; ++ai)
#pragma unroll
                    for (int m = 0; m < 4; ++m) rs[ai][m] = E2.rowscale(row0 + ai * HALF + m * 16);
#pragma unroll
                for (int ai = 0; ai < 2; ++ai)
#pragma unroll
                    for (int bj = 0; bj < 2; ++bj) E2.quad(row0 + ai * HALF, col0 + bj * HALF, fq_, acc[ai][bj], rs[ai]);
            } else if constexpr (has_pair<Epi>::value) {
#pragma unroll
                for (int ai = 0; ai < 2; ++ai)
#pragma unroll
                    for (int m = 0; m < 4; ++m) E2.pair(row0 + ai * HALF + m * 16, col0, acc[ai][0][m][0], acc[ai][0][m][1], acc[ai][1][m][0], acc[ai][1][m][1]);
            } else if constexpr (has_rowscale<Epi>::value) {
#pragma unroll
                for (int ai = 0; ai < 2; ++ai) {
                    float rs[4];
#pragma unroll
                    for (int m = 0; m < 4; ++m) rs[m] = E2.rowscale(row0 + ai * HALF + m * 16);
                    asm volatile("" ::: "memory");
#pragma unroll
                    for (int m = 0; m < 4; ++m)
#pragma unroll
                        for (int bj = 0; bj < 2; ++bj) E2(row0 + ai * HALF + m * 16, col0 + bj * HALF, acc[ai][bj][m][0] * rs[m], acc[ai][bj][m][1] * rs[m]);
                    asm volatile("" ::: "memory");
                }
            } else {
#pragma unroll
            for (int ai = 0; ai < 2; ++ai)
#pragma unroll
                for (int m = 0; m < 4; ++m)
#pragma unroll
                    for (int bj = 0; bj < 2; ++bj) E2(row0 + ai * HALF + m * 16, col0 + bj * HALF, acc[ai][bj][m][0], acc[ai][bj][m][1]);
            }
            if constexpr (has_finish<Epi>::value) E2.finish(cur.pm, cur.pn, tid);
            S.done(cur);
        }
        if (!has_next) break;
#pragma unroll
        for (int a = 0; a < 2; ++a)
#pragma unroll
            for (int b = 0; b < 2; ++b)
#pragma unroll
                for (int m = 0; m < 4; ++m)
#pragma unroll
                    for (int n = 0; n < 2; ++n) acc[a][b][m][n] = (f32x4){0.f, 0.f, 0.f, 0.f};
        cur = nxt; cA = nA; cB = nB; ++ui;
        if constexpr (ALIGN_EPI) { if (wr == 1) PG8_BAR; }
    }
    PG8_WAIT_V(0);
    if constexpr (!ALIGN_EPI) { if (wr == 0) PG8_BAR; }
    PG8_BAR;
#undef PG8_SA
#undef PG8_SB
#undef PG8_STAGE
#undef PG8_LDA
#undef PG8_RD
#undef PG8_LDB
#undef PG8_MMA
#undef PG8_CAT
#undef PG8_WAIT_V
#undef PG8_WAIT_L
#undef PG8_BAR
#undef PG8_SCHED
}

struct MoeOrder {
    StaticOrder so; int t0, abase, nN; const int* tile_e;
    __device__ void init(int t0_, int t1_, int N, int G_, int c_, const int* te, int abase_) { so.init((t1_ - t0_) * BM, N, G_, c_); t0 = t0_; abase = abase_; nN = N / BM; tile_e = te; }
    __device__ bool next(int i, Unit& u) const { if (!so.next(i, u)) return false; u.pm += t0; u.pa = u.pm - abase; u.pb = __builtin_amdgcn_readfirstlane(tile_e[u.pm]) * nN + u.pn; return true; }
    __device__ __forceinline__ void a_ready(const Unit&) const {}
    __device__ __forceinline__ void done(const Unit&) const {}
};
}

template <class Epi>
__device__ __forceinline__ void simple_gemm(const Ctx& X, const bf16* A, const bf16* Bt, int row_lo, int nrows, int N, int K, const int* tile_e, size_t expert_stride, int a_rowbase, const Epi& E) {
    const int fr = X.lane & 15, fq = X.lane >> 4;
    const int ncb = N / 32, ntile = (nrows / 16) * ncb;
    const int gw = X.bid * NWAVES + X.wave, ngw = X.nblk * NWAVES;
    for (int t = gw; t < ntile; t += ngw) {
        const int tm = t / ncb, tn = t - tm * ncb, r0 = row_lo + tm * 16, c0 = tn * 32;
        const bf16* Bb = Bt; if (tile_e) Bb += (size_t)tile_e[r0 >> 8] * expert_stride;
        const bf16* arow = A + (size_t)(r0 - a_rowbase + fr) * K + 8 * fq;
        const bf16* b0 = Bb + (size_t)(c0 + perm32(fr)) * K + 8 * fq;
        const bf16* b1 = Bb + (size_t)(c0 + perm32(16 + fr)) * K + 8 * fq;
        f32x4 acc0 = {0.f, 0.f, 0.f, 0.f}, acc1 = {0.f, 0.f, 0.f, 0.f};
        for (int k = 0; k < K; k += 32) {
            const bf16x8 a = *(const bf16x8*)(arow + k), w0 = *(const bf16x8*)(b0 + k), w1 = *(const bf16x8*)(b1 + k);
            acc0 = __builtin_amdgcn_mfma_f32_16x16x32_bf16(w0, a, acc0, 0, 0, 0);
            acc1 = __builtin_amdgcn_mfma_f32_16x16x32_bf16(w1, a, acc1, 0, 0, 0);
        }
        E(r0 + fr, c0 + 8 * fq, acc0, acc1);
    }
}


namespace pg8 { struct OneUnit { Unit u; bool have;
    __device__ bool next(int i, Unit& o) const { if (i != 0 || !have) return false; o = u; return true; }
    __device__ __forceinline__ void a_ready(const Unit&) const {}
    __device__ __forceinline__ void done(const Unit&) const {} }; }
struct EpiSlab {
    float* slab; int ks;
    __device__ __forceinline__ void launder() {}
    __device__ __forceinline__ void operator()(int row, int c, f32x4 a, f32x4 b) const {
        float* d = slab + ((size_t)((((row >> 8) - 128) * 4 + (c >> 8)) * 7 + ks) * 256 + (row & 255)) * 256 + (c & 255);
        *(f32x4*)d = a; *(f32x4*)(d + 4) = b; }
};
template <class Epi>
__device__ __forceinline__ void gemm_dense(const Ctx& X, const bf16* A, const bf16* Bt, int N, int K, const Epi& E) {
#if FAST_GEMM
    pg8::Gemm g{A, Bt, T, N, K, 0}; pg8::StaticOrder S; S.init(T, N, X.nblk, X.bid);
    pg8::gemm_phase<Epi, pg8::StaticOrder, true, true>(X.lds, g, S, E);
#else
    simple_gemm(X, A, Bt, 0, T, N, K, nullptr, 0, 0, E);
#endif
}
template <class Epi>
__device__ __forceinline__ void gemm_moe(const Ctx& X, const bf16* A, const bf16* Bt, int t0, int t1, int N, int K, const int* tile_e, int abase, int wscale, const Epi& E) {
#if FAST_GEMM
    pg8::Gemm g{A, Bt, (t1 - t0) * 256, N, K, wscale, 0}; pg8::MoeOrder S; S.init(t0, t1, N, X.nblk, X.bid, tile_e, abase);
    pg8::gemm_phase<Epi, pg8::MoeOrder, true, true, MOE_FP8 != 0>(X.lds, g, S, E);
#else
    simple_gemm(X, A, Bt, t0 * 256, (t1 - t0) * 256, N, K, tile_e, (size_t)N * K, abase * 256, E);
#endif
}

struct SrcPlain { const float* W; int N; __device__ __forceinline__ f32x4 load4(int k, int n4) const { return *(const f32x4*)(W + (size_t)k * N + n4); } };
struct SrcScaled { const float* W; int N; const float* rs; __device__ __forceinline__ f32x4 load4(int k, int n4) const { return *(const f32x4*)(W + (size_t)k * N + n4) * rs[k]; } };
__device__ __forceinline__ int rope_src(int j) { const int g = j >> 3, jj = j & 7; return (jj < 4) ? (4 * g + jj) : (32 + 4 * g + (jj - 4)); }
struct SrcIn { const float* W; const float* rs;
    __device__ __forceinline__ f32x4 load4(int k, int n4) const { if (n4 >= NPROJ) return (f32x4){0.f, 0.f, 0.f, 0.f}; int m = n4; if (n4 >= 640 && n4 < 704) m = 640 + rope_src(n4 - 640); const f32x4 v = *(const f32x4*)(W + (size_t)k * NPROJ + m); return rs ? v * rs[k] : v; } };
struct SrcQB { const float* W; const float* gain;
    __device__ __forceinline__ f32x4 load4(int k, int n4) const { const int h = n4 / DQK; int c = n4 - h * DQK; if (c >= DNOPE) c = DNOPE + rope_src(c - DNOPE);
        return *(const f32x4*)(W + (size_t)k * (NH * DQK) + h * DQK + c) * (gain[k] * 0.07216878364870322f); } };
struct SrcGU { const float* Wg; const float* Wu; int FF; const float* rs;
    __device__ __forceinline__ f32x4 load4(int k, int n4) const { const int g = n4 >> 3; const long long d = (n4 & 4) ? (long long)(Wu - Wg) : 0ll; const f32x4 v = *(const f32x4*)(Wg + d + (long long)k * FF + 4 * g); return rs ? v * rs[k] : v; } };

template <class Src>
__device__ __forceinline__ void transpose_item(const Src& S, int K, int nblk, bf16* WT, LAS float* scr, int item, int lane) {
    const int kb = item / nblk, nb = item - kb * nblk, k0 = 64 * kb, n0 = 32 * nb;
    const int kk0 = lane >> 3, qd = lane & 7;
    f32x4 v[8];
#pragma unroll
    for (int i = 0; i < 8; ++i) v[i] = S.load4(k0 + 8 * i + kk0, n0 + 4 * qd);
#pragma unroll
    for (int i = 0; i < 8; ++i) { LAS float* d = scr + (8 * i + kk0) * 33 + 4 * qd; d[0] = v[i].x; d[1] = v[i].y; d[2] = v[i].z; d[3] = v[i].w; }
    asm volatile("s_waitcnt lgkmcnt(0)" ::: "memory");
    const int c = lane & 7;
#pragma unroll
    for (int j = 0; j < 4; ++j) { const int n = (lane >> 3) + 8 * j; const LAS float* s = scr + (8 * c) * 33 + n;
        u32x4 o; o.x = pk2(s[0 * 33], s[1 * 33]); o.y = pk2(s[2 * 33], s[3 * 33]); o.z = pk2(s[4 * 33], s[5 * 33]); o.w = pk2(s[6 * 33], s[7 * 33]);
        *(u32x4*)(WT + (size_t)(n0 + n) * K + k0 + 8 * c) = o; }
    asm volatile("s_waitcnt lgkmcnt(0)" ::: "memory");
}

template <class Src>
__device__ __forceinline__ void transpose_item_fp8(const Src& S, int K, int nblk, unsigned char* WT, LAS float* scr, int item, int lane, float scale) {
    const int kb = item / nblk, nb = item - kb * nblk, k0 = 64 * kb, n0 = 32 * nb;
    const int kk0 = lane >> 3, qd = lane & 7;
    f32x4 v[8];
#pragma unroll
    for (int i = 0; i < 8; ++i) v[i] = S.load4(k0 + 8 * i + kk0, n0 + 4 * qd);
#pragma unroll
    for (int i = 0; i < 8; ++i) { LAS float* d = scr + (8 * i + kk0) * 33 + 4 * qd; d[0] = v[i].x * scale; d[1] = v[i].y * scale; d[2] = v[i].z * scale; d[3] = v[i].w * scale; }
    asm volatile("s_waitcnt lgkmcnt(0)" ::: "memory");
    const int c = lane & 3;
#pragma unroll
    for (int j = 0; j < 2; ++j) { const int n = (lane >> 2) + 16 * j; const LAS float* s = scr + (16 * c) * 33 + n;
        u32x4 o; o.x = pk4_fp8(s[0 * 33], s[1 * 33], s[2 * 33], s[3 * 33]); o.y = pk4_fp8(s[4 * 33], s[5 * 33], s[6 * 33], s[7 * 33]);
        o.z = pk4_fp8(s[8 * 33], s[9 * 33], s[10 * 33], s[11 * 33]); o.w = pk4_fp8(s[12 * 33], s[13 * 33], s[14 * 33], s[15 * 33]);
        *(u32x4*)(WT + (size_t)(n0 + n) * K + k0 + 16 * c) = o; }
    asm volatile("s_waitcnt lgkmcnt(0)" ::: "memory");
}

template <int NR, class TS>
__device__ __forceinline__ void norm_rows_bf16(const TS* src, const float* gain, bf16* dst, int row0, int rstep, int lane) {
    f32x4 v[NR][4];
#pragma unroll
    for (int i = 0; i < NR; ++i)
#pragma unroll
        for (int j = 0; j < 4; ++j) v[i][j] = ldrow4(src + (size_t)(row0 + i * rstep) * DM, lane + 64 * j);
    f32x4 g[4];
#pragma unroll
    for (int j = 0; j < 4; ++j) g[j] = *((const f32x4*)gain + lane + 64 * j);
#pragma unroll
    for (int i = 0; i < NR; ++i) { float s = 0.f;
#pragma unroll
        for (int j = 0; j < 4; ++j) s += (v[i][j].x * v[i][j].x + v[i][j].y * v[i][j].y) + (v[i][j].z * v[i][j].z + v[i][j].w * v[i][j].w);
        const float rstd = __builtin_amdgcn_rsqf(wave_sum(s) * (1.f / DM) + EPS);
#pragma unroll
        for (int j = 0; j < 4; ++j) { const f32x4 y = v[i][j] * rstd * g[j]; u32x2 w; w.x = pk2(y.x, y.y); w.y = pk2(y.z, y.w); *((u32x2*)(dst + (size_t)(row0 + i * rstep) * DM) + lane + 64 * j) = w; } }
}
template <class TS>
__device__ __forceinline__ void norm_all_rows(const Ctx& X, const TS* src, const float* gain, bf16* dst) {
    const int gw = X.bid * NWAVES + X.wave, ngw = X.nblk * NWAVES;
    int m = gw;
    for (; m + 3 * ngw < T; m += 4 * ngw) norm_rows_bf16<4, TS>(src, gain, dst, m, ngw, X.lane);
    for (; m < T; m += ngw) norm_rows_bf16<1, TS>(src, gain, dst, m, ngw, X.lane);
}

constexpr int TAIL_A = 64 * 8 * TAILFILL_A, TAIL_B = 64 * 8 * TAILFILL_B, TAIL_C = 128 * 8 * TAILFILL_C;
constexpr int TAIL_ITEMS = TAILFILL ? (2 * TAIL_A + 2 * TAIL_B + TAIL_C) : 0;
constexpr int MDN_ITEMS = NE * 56 * 32;
constexpr int MGU_ITEMS = NE * 16 * 224;
static_assert(TAIL_ITEMS <= MDN_ITEMS + MGU_ITEMS, "tail slices exceed the expert weight copy items");
__device__ __forceinline__ void tail_fill(const Ctx& X, const Params& p, int slice_first, int per_wave, int rank, int nranks) {
    unsigned char* ws = p.ws; LAS float* scr = (LAS float*)(X.lds + X.wave * 16384);
    constexpr int I_MDN = 56 * 32, I_MGU = 16 * 224;
#pragma unroll 1
    for (int k = 0; k < per_wave; ++k) { const int idx = (MGU_ITEMS + MDN_ITEMS - TAIL_ITEMS) + slice_first + (k * nranks + rank) * NWAVES + X.wave;
        if (idx < MGU_ITEMS) { const int e = idx / I_MGU, r = idx - e * I_MGU; SrcGU S{p.in[I_MWG] + (size_t)e * DM * FFM, p.in[I_MWU] + (size_t)e * DM * FFM, FFM, nullptr};
            transpose_item_fp8(S, DM, (2 * FFM) / 32, (unsigned char*)(ws + WS_WT_MGU) + (size_t)e * (2 * FFM) * DM, scr, r, X.lane, 64.f); }
        else { const int i2 = idx - MGU_ITEMS, e = i2 / I_MDN, r = i2 - e * I_MDN; SrcPlain S{p.in[I_MWD] + (size_t)e * FFM * DM, DM};
            transpose_item_fp8(S, FFM, DM / 32, (unsigned char*)(ws + WS_WT_MDN) + (size_t)e * DM * FFM, scr, r, X.lane, 128.f); } }
}
__device__ __forceinline__ void phase_prologue(const Ctx& X, const Params& p) {
    unsigned char* ws = p.ws;
    LAS float* scr = (LAS float*)(X.lds + X.wave * 16384);
    const int gw = X.bid * NWAVES + X.wave, ngw = X.nblk * NWAVES;
    constexpr int I_IN = 16 * 88, I_QB = 6 * 24, I_KVB = 4 * 32, I_OUT = 16 * 32, I_GU = 16 * 176, I_DN = 44 * 32, I_MGU = 16 * 224, I_MDN = 56 * 32;
    constexpr int I_LAYER = I_IN + I_QB + I_KVB + I_OUT;
    constexpr int NITEMS = 2 * I_LAYER + I_GU + I_DN + NE * (I_MGU + I_MDN);
    const int nitems = (X.nblk == 256) ? NITEMS - TAIL_ITEMS : NITEMS;
    for (int it = gw; it < nitems; it += ngw) {
        int r = it;
        if (r < 2 * I_LAYER) {
            const int l = r / I_LAYER; r -= l * I_LAYER;
            if (r < I_IN) { SrcIn S{p.in[I_WIN] + (size_t)l * DM * NPROJ, (FUSE_NORM && l == 1) ? p.in[I_MIXN] + DM : nullptr}; transpose_item(S, DM, NPROJ_P / 32, (bf16*)(ws + WS_WT_IN) + (size_t)l * NPROJ_P * DM, scr, r, X.lane); continue; } r -= I_IN;
            if (r < I_QB) { SrcQB S{p.in[I_WQB] + (size_t)l * QR * (NH * DQK), p.in[I_QAN] + l * QR}; transpose_item(S, QR, (NH * DQK) / 32, (bf16*)(ws + WS_WT_QB) + (size_t)l * (NH * DQK) * QR, scr, r, X.lane); continue; } r -= I_QB;
            if (r < I_KVB) { SrcScaled S{p.in[I_WKVB] + (size_t)l * KVR * 1024, 1024, p.in[I_KVAN] + l * KVR}; transpose_item(S, KVR, 1024 / 32, (bf16*)(ws + WS_WT_KVB) + (size_t)l * 1024 * KVR, scr, r, X.lane); continue; } r -= I_KVB;
            { SrcPlain S{p.in[I_WOUT] + (size_t)l * DM * DM, DM}; transpose_item(S, DM, DM / 32, (bf16*)(ws + WS_WT_OUT) + (size_t)l * DM * DM, scr, r, X.lane); continue; }
        }
        r -= 2 * I_LAYER;
        if (r < I_GU) { SrcGU S{p.in[I_DWG], p.in[I_DWU], FF0, FUSE_NORM ? p.in[I_FFNN] : nullptr}; transpose_item(S, DM, (2 * FF0) / 32, (bf16*)(ws + WS_WT_GU), scr, r, X.lane); continue; } r -= I_GU;
        if (r < I_DN) { SrcPlain S{p.in[I_DWD], DM}; transpose_item(S, FF0, DM / 32, (bf16*)(ws + WS_WT_DN), scr, r, X.lane); continue; } r -= I_DN;
        if (r < NE * I_MGU) { const int e = r / I_MGU; r -= e * I_MGU; SrcGU S{p.in[I_MWG] + (size_t)e * DM * FFM, p.in[I_MWU] + (size_t)e * DM * FFM, FFM, nullptr};
#if MOE_FP8
            transpose_item_fp8(S, DM, (2 * FFM) / 32, (unsigned char*)(ws + WS_WT_MGU) + (size_t)e * (2 * FFM) * DM, scr, r, X.lane, 64.f); continue; } r -= NE * I_MGU;
        { const int e = r / I_MDN; r -= e * I_MDN; SrcPlain S{p.in[I_MWD] + (size_t)e * FFM * DM, DM};
            transpose_item_fp8(S, FFM, DM / 32, (unsigned char*)(ws + WS_WT_MDN) + (size_t)e * DM * FFM, scr, r, X.lane, 128.f); }
#else
            transpose_item(S, DM, (2 * FFM) / 32, (bf16*)(ws + WS_WT_MGU) + (size_t)e * (2 * FFM) * DM, scr, r, X.lane); continue; } r -= NE * I_MGU;
        { const int e = r / I_MDN; r -= e * I_MDN; SrcPlain S{p.in[I_MWD] + (size_t)e * FFM * DM, DM};
            transpose_item(S, FFM, DM / 32, (bf16*)(ws + WS_WT_MDN) + (size_t)e * DM * FFM, scr, r, X.lane); }
#endif
    }
    { const int* pos = (const int*)p.in[I_POS]; float* COS = (float*)(ws + WS_COS); float* SIN = (float*)(ws + WS_SIN);
      for (int i = X.bid * NTHREADS + X.tid; i < T * 32; i += X.nblk * NTHREADS) {
          const int row = i >> 5, f = i & 31; const double a = (double)pos[row] * kInvRev[f]; const float rev = (float)(a - floor(a));
          COS[i] = __builtin_amdgcn_cosf(rev); SIN[i] = __builtin_amdgcn_sinf(rev); } }
    if (X.bid == 0) { float* LB = (float*)(ws + WS_MISC + MISC_LB); const float* h = p.in[I_HLB];
        for (int i = X.tid; i < HGW; i += NTHREADS) { LB[i] = 0.f; LB[HGW + i] = 1.f / (1.f + expf(h[i] - h[HGW + i])); } }
    norm_all_rows(X, p.in[I_X], p.in[I_MIXN], (bf16*)(ws + WS_XB));
}

__device__ __forceinline__ void phase_attn_simple(const Ctx& X, const Params& p) {
    unsigned char* ws = p.ws;
    const bf16* Q = (const bf16*)(ws + WS_Q); const bf16* KN = (const bf16*)(ws + WS_KN); const bf16* KPE = (const bf16*)(ws + WS_KPE); const bf16* V = (const bf16*)(ws + WS_V);
    bf16* CC = (bf16*)(ws + WS_CC);
    LAS float* ql = (LAS float*)(X.lds + X.wave * 1024);
    const int gw = X.bid * NWAVES + X.wave, ngw = X.nblk * NWAVES, lane = X.lane;
    for (int idx = gw; idx < 2 * NH * SEQ; idx += ngw) {
        const int bh = idx & 7, q = SEQ - 1 - (idx >> 3), b = bh >> 2, h = bh & 3;
        const bf16* qrow = Q + ((size_t)bh * SEQ + q) * DQK;
        ql[lane] = bf2f(qrow[lane]); ql[64 + lane] = bf2f(qrow[64 + lane]); ql[128 + lane] = bf2f(qrow[128 + lane]);
        asm volatile("s_waitcnt lgkmcnt(0)" ::: "memory");
        float m = -1e30f, l = 0.f, o0 = 0.f, o1 = 0.f;
        for (int k0 = 0; k0 <= q; k0 += 64) {
            const int key = k0 + lane; const bool valid = key <= q;
            float s = 0.f;
            const bf16* kr = KN + ((size_t)bh * SEQ + key) * 128; const bf16* kp = KPE + ((size_t)b * SEQ + key) * ROPE;
#pragma unroll 4
            for (int c = 0; c < 16; ++c) { const u32x4 w = *(const u32x4*)(kr + 8 * c); const LAS float* qq = ql + 8 * c;
                s += bflo(w.x) * qq[0] + bfhi(w.x) * qq[1] + bflo(w.y) * qq[2] + bfhi(w.y) * qq[3] + bflo(w.z) * qq[4] + bfhi(w.z) * qq[5] + bflo(w.w) * qq[6] + bfhi(w.w) * qq[7]; }
#pragma unroll 4
            for (int c = 0; c < 8; ++c) { const u32x4 w = *(const u32x4*)(kp + 8 * c); const LAS float* qq = ql + 128 + 8 * c;
                s += bflo(w.x) * qq[0] + bfhi(w.x) * qq[1] + bflo(w.y) * qq[2] + bfhi(w.y) * qq[3] + bflo(w.z) * qq[4] + bfhi(w.z) * qq[5] + bflo(w.w) * qq[6] + bfhi(w.w) * qq[7]; }
            if (!valid) s = -1e30f;
            const float mx = wave_max(s), mn = fmaxf(m, mx), alpha = fast_exp(m - mn);
            const float pr = valid ? fast_exp(s - mn) : 0.f;
            l = l * alpha + wave_sum(pr); o0 *= alpha; o1 *= alpha; m = mn;
            const bf16* vb = V + ((size_t)bh * SEQ + k0) * 128 + 2 * lane;
            for (int j = 0; j < 64; ++j) { const float pj = __shfl(pr, j); const unsigned w = *(const unsigned*)(vb + (size_t)j * 128); o0 += pj * bflo(w); o1 += pj * bfhi(w); }
        }
        const float inv = 1.f / l;
        *(unsigned*)(CC + ((size_t)(b * SEQ + q)) * DM + h * 128 + 2 * lane) = pk2(o0 * inv, o1 * inv);
    }
}


namespace att {
typedef short s16x4 __attribute__((ext_vector_type(4)));
typedef float f32x16 __attribute__((ext_vector_type(16)));
constexpr int NW = 8, QBLK = 32, KVBLK = 64, QB = 256, NQB = SEQ / QB;
constexpr int KROW = 400, SHM_V = KVBLK * 128 * 2, SHM_K = KVBLK * KROW;
constexpr int LDS_V = 0, LDS_K = 2 * SHM_V, LDS_WS = LDS_K + 2 * SHM_K, LDS_TOTAL = LDS_WS + NW * 64 * 4;
constexpr float THR = 8.f;
constexpr int LDS_STAGE = LDS_TOTAL, STAGE_P = 144, STAGE_W = 32 * STAGE_P;
static_assert(LDS_STAGE + NW * STAGE_W <= LDS_MISC_OFF, "attention staging overlaps the barrier words");
#define SBAR() __builtin_amdgcn_sched_barrier(0)
__device__ __forceinline__ int v_st(int k, int c) { const int kk = (k & ~0xC) | ((k & 4) << 1) | ((k & 8) >> 1); return ((kk >> 3) * 4 + (c >> 5)) * 512 + ((kk & 7) * 32 + (c & 31)) * 2; }
__device__ __forceinline__ int v_rd_base(int lane) { return ((lane & 3) << 3) | (((lane >> 2) & 3) << 6) | (((lane >> 4) & 1) << 5) | (((lane >> 5) & 1) << 8); }
constexpr int v_rd_off(int d0, int ks, int half) { return d0 * 512 + ks * 4096 + half * 2048; }
__device__ __forceinline__ int crow(int r, int hi) { return (r & 3) + 8 * (r >> 2) + 4 * hi; }
__device__ __forceinline__ unsigned cvtpk(float lo, float hi) { unsigned r; asm volatile("v_cvt_pk_bf16_f32 %0, %1, %2" : "=v"(r) : "v"(lo), "v"(hi)); return r; }
__device__ __forceinline__ bf16x8 load8(const bf16* p) { return *reinterpret_cast<const bf16x8*>(p); }
__device__ __forceinline__ bf16x8 bload8(__amdgpu_buffer_rsrc_t r, unsigned voff, unsigned soff) { const u32x4 x = __builtin_amdgcn_raw_buffer_load_b128(r, voff, soff, 0); return __builtin_bit_cast(bf16x8, x); }
__device__ __forceinline__ void mask_tile(f32x16& p0, f32x16& p1, int dq) {
    const float NEG = -__builtin_inff();
#pragma unroll
    for (int r = 0; r < 16; ++r) { const int c = (r & 3) + 8 * (r >> 2); if (dq - c < 0) p0[r] = NEG; if (dq - c - 32 < 0) p1[r] = NEG; }
}
__device__ __forceinline__ void partialSM(f32x16& p0, f32x16& p1, float& m_reg, float& mn, float& alpha) {
    float pmax = p0[0]; for (int r = 1; r < 16; ++r) pmax = fmaxf(pmax, p0[r]); for (int r = 0; r < 16; ++r) pmax = fmaxf(pmax, p1[r]);
    { auto rr = __builtin_amdgcn_permlane32_swap(__float_as_uint(pmax), __float_as_uint(pmax), false, false);
      pmax = fmaxf(__uint_as_float(rr[0]), __uint_as_float(rr[1])); }
    constexpr float C2 = 1.4426950408889634f;
    if (__builtin_expect(__all((pmax - m_reg) <= THR), 1)) { mn = m_reg; alpha = 1.f; }
    else { mn = fmaxf(m_reg, pmax); alpha = __builtin_amdgcn_exp2f((m_reg - mn) * C2); m_reg = mn; }
    const float mnL = -mn * C2;
    for (int r = 0; r < 16; ++r) p0[r] = fmaf(p0[r], C2, mnL); for (int r = 0; r < 16; ++r) p1[r] = fmaf(p1[r], C2, mnL);
    for (int r = 0; r < 16; ++r) p0[r] = __builtin_amdgcn_exp2f(p0[r]);
}
__device__ __forceinline__ void finishSM(f32x16& p0, f32x16& p1, float alpha, float& l_reg, bf16x8& pa0, bf16x8& pa1, bf16x8& pa2, bf16x8& pa3) {
    for (int r = 0; r < 16; ++r) p1[r] = __builtin_amdgcn_exp2f(p1[r]);
    float ps = 0; for (int r = 0; r < 16; ++r) ps += p0[r]; for (int r = 0; r < 16; ++r) ps += p1[r];
    { auto rr = __builtin_amdgcn_permlane32_swap(__float_as_uint(ps), __float_as_uint(ps), false, false);
      ps = __uint_as_float(rr[0]) + __uint_as_float(rr[1]); }
    l_reg = l_reg * alpha + ps;
#define PK4(P, B_, OUT) do { unsigned a0 = cvtpk(P[B_+0], P[B_+1]), a1 = cvtpk(P[B_+2], P[B_+3]);                          \
        unsigned b0 = cvtpk(P[B_+4], P[B_+5]), b1 = cvtpk(P[B_+6], P[B_+7]);                                             \
        auto r0 = __builtin_amdgcn_permlane32_swap(a0, b0, false, false); auto r1 = __builtin_amdgcn_permlane32_swap(a1, b1, false, false); \
        u32x4 w = {r0[0], r1[0], r0[1], r1[1]}; OUT = *reinterpret_cast<bf16x8*>(&w); } while (0)
    PK4(p0, 0, pa0); PK4(p0, 8, pa1); PK4(p1, 0, pa2); PK4(p1, 8, pa3);
#undef PK4
}
template <int KB>
__device__ __forceinline__ void qkt(f32x16& p0, f32x16& p1, const LAS char* K_lds, int r32, int hi, const bf16x8* qr) {
    p0 = f32x16{}; p1 = f32x16{};
    const LAS char* kb = K_lds + KB * SHM_K + r32 * KROW + hi * 16;
#pragma unroll
    for (int d0 = 0; d0 < 12; ++d0) {
        const bf16x8 b0 = *reinterpret_cast<const LAS bf16x8*>(kb + d0 * 32);
        const bf16x8 b1 = *reinterpret_cast<const LAS bf16x8*>(kb + d0 * 32 + 32 * KROW);
        p0 = __builtin_amdgcn_mfma_f32_32x32x16_bf16(b0, qr[d0], p0, 0, 0, 0);
        p1 = __builtin_amdgcn_mfma_f32_32x32x16_bf16(b1, qr[d0], p1, 0, 0, 0); }
}
template <int VB>
__device__ __forceinline__ void pv_tile(f32x16* o, int vb0, bf16x8 pa0, bf16x8 pa1, bf16x8 pa2, bf16x8 pa3) {
#define TRRD(dst, off) asm volatile("ds_read_b64_tr_b16 %0, %1 offset:%2" : "=&v"(dst) : "v"(vb0), "i"(off) : "memory")
#define PV_D0(d0) do { s16x4 l0, l1, l2, l3, h0, h1, h2, h3; constexpr int b_ = VB * SHM_V + v_rd_off(d0, 0, 0); \
        TRRD(l0, b_); TRRD(h0, b_ + 2048); TRRD(l1, b_ + 4096); TRRD(h1, b_ + 6144); TRRD(l2, b_ + 8192); TRRD(h2, b_ + 10240); TRRD(l3, b_ + 12288); TRRD(h3, b_ + 14336); \
        asm volatile("s_waitcnt lgkmcnt(0)" ::: "memory"); SBAR();   \
        o[d0] = __builtin_amdgcn_mfma_f32_32x32x16_bf16(pa0, (bf16x8){l0[0], l0[1], l0[2], l0[3], h0[0], h0[1], h0[2], h0[3]}, o[d0], 0, 0, 0);   \
        o[d0] = __builtin_amdgcn_mfma_f32_32x32x16_bf16(pa1, (bf16x8){l1[0], l1[1], l1[2], l1[3], h1[0], h1[1], h1[2], h1[3]}, o[d0], 0, 0, 0);   \
        o[d0] = __builtin_amdgcn_mfma_f32_32x32x16_bf16(pa2, (bf16x8){l2[0], l2[1], l2[2], l2[3], h2[0], h2[1], h2[2], h2[3]}, o[d0], 0, 0, 0);   \
        o[d0] = __builtin_amdgcn_mfma_f32_32x32x16_bf16(pa3, (bf16x8){l3[0], l3[1], l3[2], l3[3], h3[0], h3[1], h3[2], h3[3]}, o[d0], 0, 0, 0); } while (0)
    PV_D0(0); PV_D0(1); PV_D0(2); PV_D0(3);
#undef PV_D0
#undef TRRD
}
struct BlockRef { const bf16* Q; const bf16* KN; const bf16* KP; const bf16* V; bf16* O; float* ML; int ostride, P0, par, NT; };
struct Seam { bf16x8 qr[12]; bf16x8 st_v0, st_v1, st_k0, st_k1, st_k2; };
#define VMW() asm volatile("s_waitcnt vmcnt(0)" ::: "memory")
#define VMWN(n) asm volatile("s_waitcnt vmcnt(%0)" :: "i"(n) : "memory")
#define SLOAD(R, k0) do { const unsigned so_ = (unsigned)(k0) * 256u, sp_ = (unsigned)(k0) * 128u; \
                          S.st_v0 = bload8(rV, lofs, so_); S.st_v1 = bload8(rV, lofs, so_ + 8192u); S.st_k0 = bload8(rK, lofs, so_); S.st_k1 = bload8(rK, lofs, so_ + 8192u); S.st_k2 = bload8(rP, lofp, sp_); } while (0)
#define SWRITE_K(bf) do { *(LAS bf16x8*)(K_lds + (bf) * SHM_K + kws) = S.st_k0; *(LAS bf16x8*)(K_lds + (bf) * SHM_K + kws + 32 * KROW) = S.st_k1; *(LAS bf16x8*)(K_lds + (bf) * SHM_K + kwp) = S.st_k2; } while (0)
#define SWRITE_V(bf) do { *(LAS bf16x8*)(V_lds + (bf) * SHM_V + vst0) = S.st_v0; *(LAS bf16x8*)(V_lds + (bf) * SHM_V + vst1) = S.st_v1; } while (0)
#define KBASE_OF(R, t) (((R).par + 2 * (t)) * KVBLK)
__device__ __forceinline__ void attn_block(const BlockRef& cur, LAS char* lds, int tid) {
    Seam S;
    const int wid = __builtin_amdgcn_readfirstlane(tid >> 6), lane = tid & 63, r32 = lane & 31, hi = lane >> 5;
    const int NT = cur.NT;
    const int qlo = cur.P0 + wid * QBLK, qm = qlo + r32 - 4 * hi;
    LAS char* V_lds = lds + LDS_V; LAS char* K_lds = lds + LDS_K;
    LAS float* wsc = (LAS float*)(lds + LDS_WS) + wid * 64; LAS float* li_l = wsc; LAS float* al_l = wsc + 32;
    float m_reg = -1e30f, l_reg = 0; f32x16 o[4] = {};
    const int sr = tid >> 4, sc = (tid & 15) * 8, vst0 = v_st(sr, sc), vst1 = v_st(32 + sr, sc), kws = sr * KROW + sc * 2, pr = tid >> 3, pc = (tid & 7) * 8, kwp = pr * KROW + 256 + pc * 2;
    const unsigned lofs = (unsigned)(sr * 128 + sc) * 2u, lofp = (unsigned)(pr * 64 + pc) * 2u;
    const __amdgpu_buffer_rsrc_t rV = __builtin_amdgcn_make_buffer_rsrc((void*)cur.V, 0, SEQ * 128 * 2, 0x00020000), rK = __builtin_amdgcn_make_buffer_rsrc((void*)cur.KN, 0, SEQ * 128 * 2, 0x00020000),
                                 rP = __builtin_amdgcn_make_buffer_rsrc((void*)cur.KP, 0, SEQ * ROPE * 2, 0x00020000);
    const int vb0 = (int)(unsigned)(size_t)V_lds + v_rd_base(lane);
#define RESC(a) do { if (__any((a) < 1.f)) { if (hi == 0) al_l[r32] = (a); asm volatile("s_waitcnt lgkmcnt(0)" ::: "memory");              \
                     for (int d_ = 0; d_ < 4; ++d_) for (int r = 0; r < 16; ++r) o[d_][r] *= al_l[crow(r, hi)]; } } while (0)
#define KBASE(t) KBASE_OF(cur, t)
#define MASKT(P0_, P1_, t) do { const int kb_ = KBASE(t); if (kb_ + KVBLK - 1 > qlo) mask_tile(P0_, P1_, qm - kb_); } while (0)
    f32x16 pA0, pA1, pB0, pB1; float mnA, mnB, alA, alB; bf16x8 pa0, pa1, pa2, pa3;
#pragma unroll
    for (int d0 = 0; d0 < 12; ++d0) S.qr[d0] = load8(cur.Q + (size_t)(wid * QBLK + r32) * DQK + d0 * 16 + hi * 8);
    SLOAD(cur, KBASE(0)); VMW(); SWRITE_K(0); SWRITE_V(0);
    __syncthreads();
    SLOAD(cur, KBASE(1));
    SBAR(); qkt<0>(pA0, pA1, K_lds, r32, hi, S.qr);
    MASKT(pA0, pA1, 0); partialSM(pA0, pA1, m_reg, mnA, alA);
    VMW(); SWRITE_V(1); SWRITE_K(1);
    __syncthreads();
#define HALF_STEP(PX0, PX1, mnX, alX, PY0, PY1, alY, t, KB, VB, SB) do {                                                      \
        SBAR(); qkt<KB>(PX0, PX1, K_lds, r32, hi, S.qr);                                                                      \
        finishSM(PY0, PY1, alY, l_reg, pa0, pa1, pa2, pa3); SBAR();                                                           \
        if ((t) + 1 < NT) { SLOAD(cur, KBASE((t) + 1)); SBAR(); }                                                             \
        pv_tile<VB>(o, vb0, pa0, pa1, pa2, pa3); MASKT(PX0, PX1, (t)); partialSM(PX0, PX1, m_reg, mnX, alX);                  \
        __syncthreads();                                                                                                      \
        if ((t) + 1 < NT) { VMW(); SWRITE_V(SB); SWRITE_K(SB); }                                                              \
        RESC(alX); __syncthreads(); } while (0)
    for (int t = 1; t + 1 < NT; t += 2) {
        HALF_STEP(pB0, pB1, mnB, alB, pA0, pA1, alA, t, 1, 0, 0);
        HALF_STEP(pA0, pA1, mnA, alA, pB0, pB1, alB, t + 1, 0, 1, 1);
    }
    SBAR(); qkt<1>(pB0, pB1, K_lds, r32, hi, S.qr); SBAR();
    finishSM(pA0, pA1, alA, l_reg, pa0, pa1, pa2, pa3); SBAR();
    pv_tile<0>(o, vb0, pa0, pa1, pa2, pa3);
    MASKT(pB0, pB1, NT - 1); partialSM(pB0, pB1, m_reg, mnB, alB); __syncthreads(); RESC(alB);
    finishSM(pB0, pB1, alB, l_reg, pa0, pa1, pa2, pa3); SBAR(); pv_tile<1>(o, vb0, pa0, pa1, pa2, pa3);
    if (hi == 0) { li_l[r32] = l_reg; *(float2*)(cur.ML + (size_t)(wid * QBLK + r32) * 2) = make_float2(m_reg, l_reg); }
    asm volatile("s_waitcnt lgkmcnt(0)" ::: "memory");
    float rli[16];
#pragma unroll
    for (int r = 0; r < 16; ++r) { const float lv = li_l[crow(r, hi)]; rli[r] = lv > 0.f ? __builtin_amdgcn_rcpf(lv) : 0.f; }
    bf16* Ow = cur.O + (size_t)(wid * QBLK) * cur.ostride;
#if ATTN_STAGED_EPI
    {   LAS char* stg = lds + LDS_STAGE + wid * STAGE_W;
        const int wbase = hi * (4 * STAGE_P) + r32 * 2, rrow = lane >> 3, rchunk = lane & 7;
#pragma unroll
        for (int ps = 0; ps < 2; ++ps) {
#pragma unroll
            for (int r = 0; r < 16; r += 2)
#pragma unroll
                for (int dd = 0; dd < 2; ++dd) { const unsigned w = cvtpk(o[2 * ps + dd][r] * rli[r], o[2 * ps + dd][r + 1] * rli[r + 1]);
                    *(LAS unsigned short*)(stg + wbase + ((r & 3) + 8 * (r >> 2)) * STAGE_P + dd * 64) = (unsigned short)w;
                    *(LAS unsigned short*)(stg + wbase + ((r & 3) + 1 + 8 * (r >> 2)) * STAGE_P + dd * 64) = (unsigned short)(w >> 16); }
            u32x4 t[4];
#pragma unroll
            for (int j = 0; j < 4; ++j) t[j] = *(const LAS u32x4*)(stg + (rrow + 8 * j) * STAGE_P + rchunk * 16);
#pragma unroll
            for (int j = 0; j < 4; ++j) *(u32x4*)(Ow + (size_t)(rrow + 8 * j) * cur.ostride + ps * 64 + rchunk * 8) = t[j];
        }
    }
#else
#pragma unroll
    for (int r = 0; r < 16; ++r) { const int orow = crow(r, hi);
#pragma unroll
        for (int d0 = 0; d0 < 4; ++d0) { const float v = o[d0][r] * rli[r]; const float vn = __shfl_xor(v, 1);
            if ((r32 & 1) == 0) *(unsigned*)(Ow + (size_t)orow * cur.ostride + d0 * 32 + r32) = cvtpk(v, vn); } }
#endif
    __syncthreads();
#undef RESC
#undef KBASE
#undef MASKT
#undef HALF_STEP
}
#undef SLOAD
#undef SWRITE_K
#undef SWRITE_V
#undef VMW
#undef VMWN
struct Item { int bh, x, par; };
__device__ __forceinline__ Item decode(int L) { Item it; it.bh = L & 7; const int rest = L >> 3; it.x = rest >> 1; it.par = rest & 1; return it; }
__device__ __forceinline__ BlockRef make_ref(unsigned char* ws, const Item& it, int pass) {
    const int qb = pass ? (NQB - 1 - it.x) : it.x, bh = it.bh; BlockRef r;
    r.Q = (const bf16*)(ws + WS_Q) + ((size_t)bh * SEQ + (size_t)qb * QB) * DQK;
    r.KN = (const bf16*)(ws + WS_KN) + (size_t)bh * SEQ * 128; r.KP = (const bf16*)(ws + WS_KPE) + (size_t)(bh >> 2) * SEQ * ROPE; r.V = (const bf16*)(ws + WS_V) + (size_t)bh * SEQ * 128;
    if (it.par == 0) { r.O = (bf16*)(ws + WS_CC) + ((size_t)((bh >> 2) * SEQ + qb * QB)) * DM + (bh & 3) * 128; r.ostride = DM; }
    else { r.O = (bf16*)(ws + WS_AP2) + ((size_t)bh * SEQ + (size_t)qb * QB) * 128; r.ostride = 128; }
    r.ML = (float*)(ws + WS_AML) + ((size_t)(it.par * 8 + bh) * SEQ + (size_t)qb * QB) * 2;
    r.P0 = qb * QB; r.par = it.par; r.NT = 2 * (qb + 1);
    return r;
}
}
__device__ __forceinline__ void phase_attn_fast(const Ctx& X, unsigned char* ws) {
    constexpr int TOTAL = 2 * NH * (att::NQB / 2) * 2;
    int L = X.bid; if (L >= TOTAL) return;
    const int stride = X.nblk;
    LAS char* lds = (LAS char*)X.lds;
    if (X.wave >= 4) __builtin_amdgcn_s_setprio(1);
    for (; L < TOTAL; L += stride) {
        const att::Item it = att::decode(L);
#pragma nounroll
        for (int pass = 0; pass < 2; ++pass) { const att::BlockRef cur = att::make_ref(ws, it, pass); att::attn_block(cur, lds, X.tid); }
    }
    __builtin_amdgcn_s_setprio(0);
}
__device__ __forceinline__ void phase_attn_combine(const Ctx& X, unsigned char* ws) {
    bf16* CC = (bf16*)(ws + WS_CC); const bf16* P2 = (const bf16*)(ws + WS_AP2); const float* ML = (const float*)(ws + WS_AML);
    const int gw = X.bid * NWAVES + X.wave, ngw = X.nblk * NWAVES, lane = X.lane, h = lane >> 4, dd = (lane & 15) * 8;
    for (int r0 = gw; r0 < T; r0 += 4 * ngw) {
        u32x4 a[4], q[4]; float2 s1[4], s2[4];
#pragma unroll
        for (int i = 0; i < 4; ++i) { const int row = (r0 + i * ngw < T) ? r0 + i * ngw : r0, b = row >> 13, sq = row & (SEQ - 1), bh = b * NH + h;
            a[i] = *(const u32x4*)(CC + (size_t)row * DM + h * 128 + dd); q[i] = *(const u32x4*)(P2 + ((size_t)bh * SEQ + sq) * 128 + dd);
            s1[i] = *(const float2*)(ML + ((size_t)bh * SEQ + sq) * 2); s2[i] = *(const float2*)(ML + ((size_t)(8 + bh) * SEQ + sq) * 2); }
#pragma unroll
        for (int i = 0; i < 4; ++i) { const int row = (r0 + i * ngw < T) ? r0 + i * ngw : r0;
            const float m = fmaxf(s1[i].x, s2[i].x), w1 = s1[i].y * fast_exp(s1[i].x - m), w2 = s2[i].y * fast_exp(s2[i].x - m), inv = __builtin_amdgcn_rcpf(w1 + w2), c1 = w1 * inv, c2 = w2 * inv;
            u32x4 o; o.x = pk2(c1 * bflo(a[i].x) + c2 * bflo(q[i].x), c1 * bfhi(a[i].x) + c2 * bfhi(q[i].x)); o.y = pk2(c1 * bflo(a[i].y) + c2 * bflo(q[i].y), c1 * bfhi(a[i].y) + c2 * bfhi(q[i].y));
            o.z = pk2(c1 * bflo(a[i].z) + c2 * bflo(q[i].z), c1 * bfhi(a[i].z) + c2 * bfhi(q[i].z)); o.w = pk2(c1 * bflo(a[i].w) + c2 * bflo(q[i].w), c1 * bfhi(a[i].w) + c2 * bfhi(q[i].w));
            *(u32x4*)(CC + (size_t)row * DM + h * 128 + dd) = o; }
    }
}

namespace hg {
using att::s16x4; using att::f32x16; using att::v_st; using att::v_rd_base; using att::v_rd_off; using att::crow; using att::cvtpk;
constexpr int CH = 64, NCH = SEQ / CH;
constexpr int KROW2 = 272;
constexpr int TILE_V = 16384, TILE_K2 = CH * KROW2;
constexpr size_t US_BH = (size_t)NCH * 16384;
#define TRRD2(dst, base, off) asm volatile("ds_read_b64_tr_b16 %0, %1 offset:%2" : "=&v"(dst) : "v"(base), "i"(off) : "memory")
__device__ __forceinline__ float ex(float x) { return __builtin_amdgcn_exp2f(x * 1.4426950408889634f); }
#if HG_V2
__device__ __forceinline__ void h1_unit(const Ctx& X, unsigned char* ws, int u, const float* lbl) {
    int tid_ = X.tid; asm volatile("" : "+v"(tid_));
    const int bb = u >> 7, c = u & 127, row0 = bb * SEQ + c * CH, tid = tid_, lane = tid & 63, wave = X.wave;
    const bf16* HZ = (const bf16*)(ws + WS_HK); const bf16* HQ = (const bf16*)(ws + WS_HQ); const bf16* HV = (const bf16*)(ws + WS_HV);
    bf16* KRB = (bf16*)(ws + WS_LF); bf16* QRB = (bf16*)(ws + WS_LF + 16 * MiB);
    float* Dd = (float*)(ws + WS_HD); float* Rr = (float*)(ws + WS_HR); bf16* US = (bf16*)(ws + WS_XB);
    LAS char* lds = (LAS char*)X.lds;
    {
        const int t0 = tid >> 4, c8 = (tid & 15) * 8; const size_t g0 = (size_t)(row0 + t0) * HGW + c8; const int vst0 = v_st(t0, c8);
        u32x4 vw[8];
#pragma unroll
        for (int j = 0; j < 8; ++j) vw[j] = *(const u32x4*)(HV + g0 + (size_t)((j & 1) * 32 * HGW + (j >> 1) * 128));
#pragma unroll
        for (int j = 0; j < 8; ++j) *(LAS u32x4*)(lds + 65536 + (j >> 1) * TILE_V + vst0 + (j & 1) * 8192) = vw[j];
    }
#if H1_WIDE
    {
        const int tg = wave, cg = lane, col = 8 * cg, head = cg >> 4, dcol = col & 127;
        const size_t cb = (size_t)row0 * HGW * 2; const unsigned vo = (unsigned)((8 * tg * HGW + col) * 2);
        const __amdgpu_buffer_rsrc_t rZ = __builtin_amdgcn_make_buffer_rsrc((void*)((const char*)HZ + cb), 0, CH * HGW * 2, 0x00020000), rQ = __builtin_amdgcn_make_buffer_rsrc((void*)((const char*)HQ + cb), 0, CH * HGW * 2, 0x00020000),
                                     rK = __builtin_amdgcn_make_buffer_rsrc((void*)((char*)KRB + cb), 0, CH * HGW * 2, 0x00020000), rR = __builtin_amdgcn_make_buffer_rsrc((void*)((char*)QRB + cb), 0, CH * HGW * 2, 0x00020000);
        u32x4 zw[8], qw[8];
#pragma unroll
        for (int jj = 0; jj < 8; ++jj) zw[jj] = __builtin_amdgcn_raw_buffer_load_b128(rZ, vo, jj * HGW * 2, 0);
        const f32x4 lb0 = *(const f32x4*)(lbl + col), lb1 = *(const f32x4*)(lbl + col + 4);
        const float lbv[8] = {lb0.x, lb0.y, lb0.z, lb0.w, lb1.x, lb1.y, lb1.z, lb1.w};
        float bq[8][8];
#pragma unroll
        for (int jj = 0; jj < 8; ++jj) { const unsigned zz[4] = {zw[jj].x, zw[jj].y, zw[jj].z, zw[jj].w};
#pragma unroll
            for (int cc = 0; cc < 8; ++cc) { const float z = (cc & 1) ? bfhi(zz[cc >> 1]) : bflo(zz[cc >> 1]);
                const float zc = fminf(fmaxf(z, -60.f), 60.f), e = fast_exp(-zc), sg = __builtin_amdgcn_rcpf(1.f + e), f = lbv[cc] + (1.f - lbv[cc]) * sg;
                const float ff = fmaxf(f, 1e-30f); bq[jj][cc] = __builtin_amdgcn_logf(ff) * 0.6931471805599453f; }
            __builtin_amdgcn_sched_barrier(0); }
#pragma unroll
        for (int jj = 1; jj < 8; ++jj)
#pragma unroll
            for (int cc = 0; cc < 8; ++cc) bq[jj][cc] += bq[jj - 1][cc];
        LAS float* tot = (LAS float*)lds;
        *(LAS f32x4*)(tot + tg * HGW + col) = (f32x4){bq[7][0], bq[7][1], bq[7][2], bq[7][3]}; *(LAS f32x4*)(tot + tg * HGW + col + 4) = (f32x4){bq[7][4], bq[7][5], bq[7][6], bq[7][7]};
        __syncthreads();
        float off[8], rr[8], bl[8];
        { float run[8] = {0.f, 0.f, 0.f, 0.f, 0.f, 0.f, 0.f, 0.f};
#pragma unroll
          for (int cc = 0; cc < 8; ++cc) off[cc] = 0.f;
#pragma unroll
          for (int g = 0; g < 8; ++g) { const f32x4 t0 = *(const LAS f32x4*)(tot + g * HGW + col), t1 = *(const LAS f32x4*)(tot + g * HGW + col + 4); const float tv[8] = {t0.x, t0.y, t0.z, t0.w, t1.x, t1.y, t1.z, t1.w};
#pragma unroll
              for (int cc = 0; cc < 8; ++cc) { run[cc] += tv[cc]; if (g + 1 == tg) off[cc] = run[cc]; if (g == 3) rr[cc] = fmaxf(run[cc], -60.f); } }
#pragma unroll
          for (int cc = 0; cc < 8; ++cc) bl[cc] = run[cc]; }
        __syncthreads();
#pragma unroll
        for (int jj = 0; jj < 8; ++jj) qw[jj] = __builtin_amdgcn_raw_buffer_load_b128(rQ, vo, jj * HGW * 2, 0);
#pragma unroll
        for (int jj = 0; jj < 8; ++jj)
#pragma unroll
            for (int cc = 0; cc < 8; ++cc) bq[jj][cc] += off[cc];
        if (tg == 0) { float* dp = Dd + (size_t)u * HGW + col; float* rp = Rr + (size_t)u * HGW + col;
            *(f32x4*)dp = (f32x4){ex(bl[0]), ex(bl[1]), ex(bl[2]), ex(bl[3])}; *(f32x4*)(dp + 4) = (f32x4){ex(bl[4]), ex(bl[5]), ex(bl[6]), ex(bl[7])};
            *(f32x4*)rp = (f32x4){ex(rr[0]), ex(rr[1]), ex(rr[2]), ex(rr[3])}; *(f32x4*)(rp + 4) = (f32x4){ex(rr[4]), ex(rr[5]), ex(rr[6]), ex(rr[7])}; }
#pragma unroll
        for (int jj = 0; jj < 8; ++jj) { const unsigned qq[4] = {qw[jj].x, qw[jj].y, qw[jj].z, qw[jj].w}; float kr[8], qr_[8], kd[8];
#pragma unroll
            for (int cc = 0; cc < 8; ++cc) { const float b = bq[jj][cc], kk = 1.f - ex(b - (jj ? bq[jj ? jj - 1 : 0][cc] : off[cc])), qv = (cc & 1) ? bfhi(qq[cc >> 1]) : bflo(qq[cc >> 1]);
                kr[cc] = kk * ex(fminf(rr[cc] - b, 80.f)); qr_[cc] = qv * ex(fminf(b - rr[cc], 80.f)); kd[cc] = kk * ex(bl[cc] - b); }
            u32x4 ko, qo, dk; ko.x = pk2(kr[0], kr[1]); ko.y = pk2(kr[2], kr[3]); ko.z = pk2(kr[4], kr[5]); ko.w = pk2(kr[6], kr[7]);
            qo.x = pk2(qr_[0], qr_[1]); qo.y = pk2(qr_[2], qr_[3]); qo.z = pk2(qr_[4], qr_[5]); qo.w = pk2(qr_[6], qr_[7]);
            dk.x = pk2(kd[0], kd[1]); dk.y = pk2(kd[2], kd[3]); dk.z = pk2(kd[4], kd[5]); dk.w = pk2(kd[6], kd[7]);
            __builtin_amdgcn_raw_buffer_store_b128(ko, rK, vo, jj * HGW * 2, 0); __builtin_amdgcn_raw_buffer_store_b128(qo, rR, vo, jj * HGW * 2, 0);
            *(LAS u32x4*)(lds + head * TILE_V + v_st(8 * tg + jj, dcol)) = dk; __builtin_amdgcn_sched_barrier(0); }
    }
#else
    {
        const int head = tid >> 7, d = tid & 127; const unsigned vo = (unsigned)tid * 2u; const size_t cb = (size_t)row0 * HGW * 2;
        const __amdgpu_buffer_rsrc_t rZ = __builtin_amdgcn_make_buffer_rsrc((void*)((const char*)HZ + cb), 0, CH * HGW * 2, 0x00020000), rQ = __builtin_amdgcn_make_buffer_rsrc((void*)((const char*)HQ + cb), 0, CH * HGW * 2, 0x00020000),
                                     rK = __builtin_amdgcn_make_buffer_rsrc((void*)((char*)KRB + cb), 0, CH * HGW * 2, 0x00020000), rR = __builtin_amdgcn_make_buffer_rsrc((void*)((char*)QRB + cb), 0, CH * HGW * 2, 0x00020000);
        float zl[CH], qv[CH];
#pragma unroll
        for (int t = 0; t < CH; ++t) { zl[t] = bf2f((unsigned short)__builtin_amdgcn_raw_buffer_load_b16(rZ, vo, t * HGW * 2, 0)); qv[t] = bf2f((unsigned short)__builtin_amdgcn_raw_buffer_load_b16(rQ, vo, t * HGW * 2, 0)); }
        const float lb = lbl[tid], om = 1.f - lb;
        float b = 0.f, r = 0.f;
#pragma unroll
        for (int t = 0; t < CH; ++t) { const float zc = fminf(fmaxf(zl[t], -60.f), 60.f), e = fast_exp(-zc), sg = __builtin_amdgcn_rcpf(1.f + e), f = lb + om * sg;
            const float lf = __builtin_amdgcn_logf(fmaxf(f, 1e-30f)) * 0.6931471805599453f; zl[t] = lf; b += lf; if (t == 31) r = b; }
        const float bl = b; r = fmaxf(r, -60.f);
        Dd[(size_t)u * HGW + tid] = ex(bl); Rr[(size_t)u * HGW + tid] = ex(r);
        b = 0.f;
        LAS char* kd = lds + head * TILE_V + ((d >> 5) * 512 + (d & 31) * 2);
#pragma unroll
        for (int t = 0; t < CH; ++t) { const float lf = zl[t]; b += lf; const float kk = 1.f - ex(lf);
            __builtin_amdgcn_raw_buffer_store_b16((short)pk2(kk * ex(fminf(r - b, 80.f)), 0.f), rK, vo, t * HGW * 2, 0);
            __builtin_amdgcn_raw_buffer_store_b16((short)pk2(qv[t] * ex(fminf(b - r, 80.f)), 0.f), rR, vo, t * HGW * 2, 0);
            constexpr int dummy = 0; (void)dummy;
            const int kk_t = (t & ~0xC) | ((t & 4) << 1) | ((t & 8) >> 1);
            *(LAS unsigned short*)(kd + (kk_t >> 3) * 4 * 512 + (kk_t & 7) * 64) = (unsigned short)pk2(kk * ex(bl - b), 0.f); }
    }
#endif
    __syncthreads();
#else
__device__ __forceinline__ void h1_unit(const Ctx& X, unsigned char* ws, int u) {
    const int bb = u >> 7, c = u & 127, row0 = bb * SEQ + c * CH, tid = X.tid, lane = X.lane, wave = X.wave;
    float* LFB = (float*)(ws + WS_LF); const bf16* HK = (const bf16*)(ws + WS_HK); const bf16* HV = (const bf16*)(ws + WS_HV);
    float* Dd = (float*)(ws + WS_HD); float* Rr = (float*)(ws + WS_HR); bf16* US = (bf16*)(ws + WS_XB);
    LAS char* lds = (LAS char*)X.lds; LAS float* bl = (LAS float*)(lds + 131072);
    {
        float* col = LFB + (size_t)row0 * HGW + tid; float b = 0.f, r = 0.f;
#pragma unroll 1
        for (int t0 = 0; t0 < CH; t0 += 8) { float x[8];
#pragma unroll
            for (int i = 0; i < 8; ++i) x[i] = col[(size_t)(t0 + i) * HGW];
#pragma unroll
            for (int i = 0; i < 8; ++i) { b += x[i]; col[(size_t)(t0 + i) * HGW] = b; if (t0 + i == 31) r = b; } }
        bl[tid] = b; r = fmaxf(r, -60.f);
        Dd[(size_t)u * HGW + tid] = ex(b); Rr[(size_t)u * HGW + tid] = ex(r);
    }
    asm volatile("s_waitcnt vmcnt(0)" ::: "memory");
    __syncthreads();
#pragma unroll 2
    for (int j = 0; j < 8; ++j) { const int i = tid + 512 * j, head = i >> 10, rem = i & 1023, t = rem >> 4, c8 = (rem & 15) * 8; const size_t g = (size_t)(row0 + t) * HGW + head * 128 + c8;
        const u32x4 kw = *(const u32x4*)(HK + g), vw = *(const u32x4*)(HV + g); const f32x4 b0 = *(const f32x4*)(LFB + g), b1 = *(const f32x4*)(LFB + g + 4);
        const f32x4 l0 = *(const LAS f32x4*)(bl + head * 128 + c8), l1 = *(const LAS f32x4*)(bl + head * 128 + c8 + 4);
        u32x4 o; o.x = pk2(bflo(kw.x) * ex(l0.x - b0.x), bfhi(kw.x) * ex(l0.y - b0.y)); o.y = pk2(bflo(kw.y) * ex(l0.z - b0.z), bfhi(kw.y) * ex(l0.w - b0.w));
        o.z = pk2(bflo(kw.z) * ex(l1.x - b1.x), bfhi(kw.z) * ex(l1.y - b1.y)); o.w = pk2(bflo(kw.w) * ex(l1.z - b1.z), bfhi(kw.w) * ex(l1.w - b1.w));
        *(LAS u32x4*)(lds + head * TILE_V + v_st(t, c8)) = o; *(LAS u32x4*)(lds + 65536 + head * TILE_V + v_st(t, c8)) = vw; }
    __syncthreads();
#endif
    {
        const int head = wave >> 1, db0 = (wave & 1) * 2, r32 = lane & 31, hiC = lane >> 5;
        const int ab = (int)(unsigned)(size_t)(lds + head * TILE_V) + v_rd_base(lane), vb = (int)(unsigned)(size_t)(lds + 65536 + head * TILE_V) + v_rd_base(lane);
        f32x16 acc[2][4];
#pragma unroll
        for (int a = 0; a < 2; ++a)
#pragma unroll
            for (int v = 0; v < 4; ++v) acc[a][v] = f32x16{};
#define FRAG(dst, base, d0, ks) do { s16x4 lo_, hi_; TRRD2(lo_, base, v_rd_off(d0, ks, 0)); TRRD2(hi_, base, v_rd_off(d0, ks, 1)); asm volatile("s_waitcnt lgkmcnt(0)" ::: "memory"); __builtin_amdgcn_sched_barrier(0); \
            dst = (bf16x8){lo_[0], lo_[1], lo_[2], lo_[3], hi_[0], hi_[1], hi_[2], hi_[3]}; } while (0)
#define U_KS(ks) do { bf16x8 a0, a1, b0, b1, b2, b3; \
            if (db0 == 0) { FRAG(a0, ab, 0, ks); FRAG(a1, ab, 1, ks); } else { FRAG(a0, ab, 2, ks); FRAG(a1, ab, 3, ks); } \
            FRAG(b0, vb, 0, ks); FRAG(b1, vb, 1, ks); FRAG(b2, vb, 2, ks); FRAG(b3, vb, 3, ks); \
            acc[0][0] = __builtin_amdgcn_mfma_f32_32x32x16_bf16(a0, b0, acc[0][0], 0, 0, 0); acc[0][1] = __builtin_amdgcn_mfma_f32_32x32x16_bf16(a0, b1, acc[0][1], 0, 0, 0); \
            acc[0][2] = __builtin_amdgcn_mfma_f32_32x32x16_bf16(a0, b2, acc[0][2], 0, 0, 0); acc[0][3] = __builtin_amdgcn_mfma_f32_32x32x16_bf16(a0, b3, acc[0][3], 0, 0, 0); \
            acc[1][0] = __builtin_amdgcn_mfma_f32_32x32x16_bf16(a1, b0, acc[1][0], 0, 0, 0); acc[1][1] = __builtin_amdgcn_mfma_f32_32x32x16_bf16(a1, b1, acc[1][1], 0, 0, 0); \
            acc[1][2] = __builtin_amdgcn_mfma_f32_32x32x16_bf16(a1, b2, acc[1][2], 0, 0, 0); acc[1][3] = __builtin_amdgcn_mfma_f32_32x32x16_bf16(a1, b3, acc[1][3], 0, 0, 0); } while (0)
        U_KS(0); U_KS(1); U_KS(2); U_KS(3);
#undef U_KS
        bf16* Ub = US + ((size_t)(bb * NH + head) * NCH + c) * 16384;
#pragma unroll
        for (int a = 0; a < 2; ++a)
#pragma unroll
            for (int v = 0; v < 4; ++v)
#pragma unroll
                for (int q4 = 0; q4 < 4; ++q4) { const int ks = 2 * (db0 + a) + (q4 >> 1), lanep = (q4 & 1) * 32 + r32;
                    u32x2 w; w.x = pk2(acc[a][v][4 * q4 + 0], acc[a][v][4 * q4 + 1]); w.y = pk2(acc[a][v][4 * q4 + 2], acc[a][v][4 * q4 + 3]);
                    *(u32x2*)(Ub + ((size_t)((ks * 4 + v) * 64 + lanep)) * 8 + 4 * hiC) = w; }
    }
    __syncthreads();
}
#if HG_V2
__device__ __forceinline__ void phase_h1(const Ctx& X, unsigned char* ws, int l) { const float* lbl = (const float*)(ws + WS_MISC + MISC_LB) + l * HGW; if (X.wave >= 4) __builtin_amdgcn_s_setprio(1); for (int u = X.bid; u < 2 * NCH; u += X.nblk) h1_unit(X, ws, u, lbl); __builtin_amdgcn_s_setprio(0); }
#else
__device__ __forceinline__ void phase_h1(const Ctx& X, unsigned char* ws, int) { for (int u = X.bid; u < 2 * NCH; u += X.nblk) h1_unit(X, ws, u); }
#endif
__device__ __forceinline__ void phase_h2(const Ctx& X, unsigned char* ws) {
    bf16* US = (bf16*)(ws + WS_XB); const float* Dd = (const float*)(ws + WS_HD); const float* Rr = (const float*)(ws + WS_HR);
    for (int u = X.bid; u < 256; u += X.nblk) {
        if (X.tid < 256) {
            const int bh = u >> 5, slot = u & 31, ks = slot >> 2, bb = bh >> 2, h = bh & 3, lanep = X.tid >> 2, j = 2 * (X.tid & 3), d = 16 * ks + 8 * (lanep >> 5) + j;
            unsigned* p = (unsigned*)(US + (size_t)bh * US_BH + (size_t)slot * 512 + 2 * X.tid);
            const float* dp = Dd + (size_t)bb * NCH * HGW + h * 128 + d; const float* rp = Rr + (size_t)bb * NCH * HGW + h * 128 + d;
            float s0 = 0.f, s1 = 0.f;
#pragma unroll 1
            for (int c0 = 0; c0 < NCH; c0 += 8) { unsigned uw[8]; float2 dv[8], rv[8];
#pragma unroll
                for (int i = 0; i < 8; ++i) { uw[i] = p[(size_t)(c0 + i) * 8192]; dv[i] = *(const float2*)(dp + (size_t)(c0 + i) * HGW); rv[i] = *(const float2*)(rp + (size_t)(c0 + i) * HGW); }
#pragma unroll
                for (int i = 0; i < 8; ++i) { p[(size_t)(c0 + i) * 8192] = pk2(rv[i].x * s0, rv[i].y * s1); s0 = dv[i].x * s0 + bflo(uw[i]); s1 = dv[i].y * s1 + bfhi(uw[i]); } }
        }
    }
}
__device__ __forceinline__ void h3_unit(const Ctx& X, unsigned char* ws, const float* onorm, int u) {
    const int bb = u >> 7, c = u & 127, row0 = bb * SEQ + c * CH, tid = X.tid, lane = X.lane, wave = X.wave;
    const float* LFB = (const float*)(ws + WS_LF); const bf16* HQ = (const bf16*)(ws + WS_HQ); const bf16* HK = (const bf16*)(ws + WS_HK); const bf16* HV = (const bf16*)(ws + WS_HV); const bf16* HG = (const bf16*)(ws + WS_HG);
    const bf16* US = (const bf16*)(ws + WS_XB); bf16* CC = (bf16*)(ws + WS_CC);
    LAS char* lds = (LAS char*)X.lds;
#if HG_V2
    const bf16* KRB = (const bf16*)(ws + WS_LF); const bf16* QRB = (const bf16*)(ws + WS_LF + 16 * MiB);
    const int head = wave >> 1, th = wave & 1, r32 = lane & 31, hi = lane >> 5, trow = row0 + 32 * th + r32;
    bf16x8 qr[8];
    { const int t0 = tid >> 4, c8 = (tid & 15) * 8; const size_t g0 = (size_t)(row0 + t0) * HGW + c8; const int kst0 = t0 * KROW2 + c8 * 2, vst0 = 4 * TILE_K2 + v_st(t0, c8);
      u32x4 kw[8], vw[8];
#pragma unroll
      for (int j = 0; j < 8; ++j) { const size_t g = g0 + (size_t)((j & 1) * 32 * HGW + (j >> 1) * 128); kw[j] = *(const u32x4*)(KRB + g); vw[j] = *(const u32x4*)(HV + g); }
      const size_t gq = (size_t)trow * HGW + head * 128 + hi * 8;
#pragma unroll
      for (int d0 = 0; d0 < 8; ++d0) qr[d0] = *reinterpret_cast<const bf16x8*>(QRB + gq + d0 * 16);
#pragma unroll
      for (int j = 0; j < 8; ++j) { *(LAS u32x4*)(lds + kst0 + (j >> 1) * TILE_K2 + (j & 1) * 32 * KROW2) = kw[j]; *(LAS u32x4*)(lds + vst0 + (j >> 1) * TILE_V + (j & 1) * 8192) = vw[j]; } }
#else
#pragma unroll 2
    for (int j = 0; j < 8; ++j) { const int i = tid + 512 * j, head = i >> 10, rem = i & 1023, t = rem >> 4, c8 = (rem & 15) * 8; const size_t g = (size_t)(row0 + t) * HGW + head * 128 + c8, gr = (size_t)(row0 + 31) * HGW + head * 128 + c8;
        const u32x4 kw = *(const u32x4*)(HK + g), vw = *(const u32x4*)(HV + g); const f32x4 b0 = *(const f32x4*)(LFB + g), b1 = *(const f32x4*)(LFB + g + 4); f32x4 r0 = *(const f32x4*)(LFB + gr), r1 = *(const f32x4*)(LFB + gr + 4);
#define KE(rr, bv) ex(fminf(fmaxf((rr), -60.f) - (bv), 80.f))
        u32x4 o; o.x = pk2(bflo(kw.x) * KE(r0.x, b0.x), bfhi(kw.x) * KE(r0.y, b0.y)); o.y = pk2(bflo(kw.y) * KE(r0.z, b0.z), bfhi(kw.y) * KE(r0.w, b0.w));
        o.z = pk2(bflo(kw.z) * KE(r1.x, b1.x), bfhi(kw.z) * KE(r1.y, b1.y)); o.w = pk2(bflo(kw.w) * KE(r1.z, b1.z), bfhi(kw.w) * KE(r1.w, b1.w));
#undef KE
        *(LAS u32x4*)(lds + head * TILE_K2 + t * KROW2 + c8 * 2) = o; *(LAS u32x4*)(lds + 4 * TILE_K2 + head * TILE_V + v_st(t, c8)) = vw; }
    const int head = wave >> 1, th = wave & 1, r32 = lane & 31, hi = lane >> 5, trow = row0 + 32 * th + r32;
    bf16x8 qr[8];
    {
        const size_t g = (size_t)trow * HGW + head * 128 + hi * 8, gr = (size_t)(row0 + 31) * HGW + head * 128 + hi * 8;
#pragma unroll
        for (int d0 = 0; d0 < 8; ++d0) { const u32x4 qw = *(const u32x4*)(HQ + g + d0 * 16); const f32x4 b0 = *(const f32x4*)(LFB + g + d0 * 16), b1 = *(const f32x4*)(LFB + g + d0 * 16 + 4), r0 = *(const f32x4*)(LFB + gr + d0 * 16), r1 = *(const f32x4*)(LFB + gr + d0 * 16 + 4);
#define QE(bv, rr) ex(fminf((bv) - fmaxf((rr), -60.f), 80.f))
            u32x4 o; o.x = pk2(bflo(qw.x) * QE(b0.x, r0.x), bfhi(qw.x) * QE(b0.y, r0.y)); o.y = pk2(bflo(qw.y) * QE(b0.z, r0.z), bfhi(qw.y) * QE(b0.w, r0.w));
            o.z = pk2(bflo(qw.z) * QE(b1.x, r1.x), bfhi(qw.z) * QE(b1.y, r1.y)); o.w = pk2(bflo(qw.w) * QE(b1.z, r1.z), bfhi(qw.w) * QE(b1.w, r1.w));
#undef QE
            qr[d0] = __builtin_bit_cast(bf16x8, o); }
    }
#endif
    __syncthreads();
    f32x16 p0 = f32x16{}, p1 = f32x16{};
    { const LAS char* kb = lds + head * TILE_K2 + r32 * KROW2 + hi * 16;
#pragma unroll
      for (int d0 = 0; d0 < 8; ++d0) { const bf16x8 k0 = *reinterpret_cast<const LAS bf16x8*>(kb + d0 * 32); p0 = __builtin_amdgcn_mfma_f32_32x32x16_bf16(k0, qr[d0], p0, 0, 0, 0);
          if (th) { const bf16x8 k1 = *reinterpret_cast<const LAS bf16x8*>(kb + d0 * 32 + 32 * KROW2); p1 = __builtin_amdgcn_mfma_f32_32x32x16_bf16(k1, qr[d0], p1, 0, 0, 0); } } }
    { const int tq = 32 * th + r32 - 4 * hi;
#pragma unroll
      for (int r = 0; r < 16; ++r) { const int cr = (r & 3) + 8 * (r >> 2); if (tq - cr < 0) p0[r] = 0.f; if (tq - cr - 32 < 0) p1[r] = 0.f; } }
    bf16x8 pa0, pa1, pa2, pa3;
#define PK4(P, B_, OUT) do { unsigned a0 = cvtpk(P[B_+0], P[B_+1]), a1 = cvtpk(P[B_+2], P[B_+3]);                          \
        unsigned b0 = cvtpk(P[B_+4], P[B_+5]), b1 = cvtpk(P[B_+6], P[B_+7]);                                             \
        auto r0 = __builtin_amdgcn_permlane32_swap(a0, b0, false, false); auto r1 = __builtin_amdgcn_permlane32_swap(a1, b1, false, false); \
        u32x4 w = {r0[0], r1[0], r0[1], r1[1]}; OUT = *reinterpret_cast<bf16x8*>(&w); } while (0)
    PK4(p0, 0, pa0); PK4(p0, 8, pa1); PK4(p1, 0, pa2); PK4(p1, 8, pa3);
#undef PK4
    f32x16 o[4] = {};
    { const int vb = (int)(unsigned)(size_t)(lds + 4 * TILE_K2 + head * TILE_V) + v_rd_base(lane);
#define PV(d0) do { bf16x8 f0, f1, f2, f3; FRAG(f0, vb, d0, 0); FRAG(f1, vb, d0, 1); FRAG(f2, vb, d0, 2); FRAG(f3, vb, d0, 3); \
        o[d0] = __builtin_amdgcn_mfma_f32_32x32x16_bf16(pa0, f0, o[d0], 0, 0, 0); o[d0] = __builtin_amdgcn_mfma_f32_32x32x16_bf16(pa1, f1, o[d0], 0, 0, 0); \
        o[d0] = __builtin_amdgcn_mfma_f32_32x32x16_bf16(pa2, f2, o[d0], 0, 0, 0); o[d0] = __builtin_amdgcn_mfma_f32_32x32x16_bf16(pa3, f3, o[d0], 0, 0, 0); } while (0)
      PV(0); PV(1); PV(2); PV(3);
#undef PV
    }
    { const bf16* Sb = US + ((size_t)(bb * NH + head) * NCH + c) * 16384 + (size_t)lane * 8;
#pragma unroll
      for (int vb = 0; vb < 4; ++vb)
#pragma unroll
          for (int ks = 0; ks < 8; ++ks) { const bf16x8 sf = *reinterpret_cast<const bf16x8*>(Sb + (size_t)(ks * 4 + vb) * 512); o[vb] = __builtin_amdgcn_mfma_f32_32x32x16_bf16(qr[ks], sf, o[vb], 0, 0, 0); } }
    float rs[16];
#if H3_STAGED_EPI
#define DPP_ADD(v, ctrl) ((v) + __int_as_float(__builtin_amdgcn_update_dpp(0, __float_as_int(v), (ctrl), 0xf, 0xf, true)))
#pragma unroll
    for (int r = 0; r < 16; ++r) { float q = o[0][r] * o[0][r] + o[1][r] * o[1][r] + o[2][r] * o[2][r] + o[3][r] * o[3][r];
        q = DPP_ADD(q, 0xB1); q = DPP_ADD(q, 0x4E); q = DPP_ADD(q, 0x124); q = DPP_ADD(q, 0x128);
        { const auto rr = __builtin_amdgcn_permlane16_swap(__float_as_uint(q), __float_as_uint(q), false, false); q = __uint_as_float(rr[0]) + __uint_as_float(rr[1]); }
        rs[r] = __builtin_amdgcn_rsqf(q * (1.f / 128.f) + EPS); }
#undef DPP_ADD
    __syncthreads();
    {   LAS char* stg = lds + wave * (TILE_K2 / 2);
        const int wbase = hi * (4 * KROW2) + r32 * 2;
#pragma unroll
        for (int vb = 0; vb < 4; ++vb) { const float gn = onorm[32 * vb + r32];
#pragma unroll
            for (int r = 0; r < 16; r += 2) { const unsigned w = cvtpk(o[vb][r] * rs[r] * gn, o[vb][r + 1] * rs[r + 1] * gn);
                *(LAS unsigned short*)(stg + wbase + ((r & 3) + 8 * (r >> 2)) * KROW2 + vb * 64) = (unsigned short)w;
                *(LAS unsigned short*)(stg + wbase + ((r & 3) + 1 + 8 * (r >> 2)) * KROW2 + vb * 64) = (unsigned short)(w >> 16); } }
        const int rrow = lane >> 4, rchunk = lane & 15;
#pragma unroll
        for (int jh = 0; jh < 2; ++jh) { u32x4 t[4], g[4];
#pragma unroll
            for (int j = 0; j < 4; ++j) { const int lr = rrow + 4 * (jh * 4 + j); t[j] = *(const LAS u32x4*)(stg + lr * KROW2 + rchunk * 16);
                g[j] = *(const u32x4*)(HG + (size_t)(row0 + 32 * th + lr) * HGW + head * 128 + rchunk * 8); }
#pragma unroll
            for (int j = 0; j < 4; ++j) { const int lr = rrow + 4 * (jh * 4 + j); u32x4 w;
                w.x = pk2(bflo(t[j].x) * siluf_(bflo(g[j].x)), bfhi(t[j].x) * siluf_(bfhi(g[j].x))); w.y = pk2(bflo(t[j].y) * siluf_(bflo(g[j].y)), bfhi(t[j].y) * siluf_(bfhi(g[j].y)));
                w.z = pk2(bflo(t[j].z) * siluf_(bflo(g[j].z)), bfhi(t[j].z) * siluf_(bfhi(g[j].z))); w.w = pk2(bflo(t[j].w) * siluf_(bflo(g[j].w)), bfhi(t[j].w) * siluf_(bfhi(g[j].w)));
                *(u32x4*)(CC + (size_t)(row0 + 32 * th + lr) * DM + 512 + head * 128 + rchunk * 8) = w; } }
    }
#else
#pragma unroll
    for (int r = 0; r < 16; ++r) { float q = o[0][r] * o[0][r] + o[1][r] * o[1][r] + o[2][r] * o[2][r] + o[3][r] * o[3][r];
        q += __shfl_xor(q, 1); q += __shfl_xor(q, 2); q += __shfl_xor(q, 4); q += __shfl_xor(q, 8); q += __shfl_xor(q, 16); rs[r] = rsqrtf(q * (1.f / 128.f) + EPS); }
#pragma unroll
    for (int vb = 0; vb < 4; ++vb) { const float gn = onorm[32 * vb + r32];
#pragma unroll
        for (int r = 0; r < 16; ++r) { const size_t row = (size_t)(row0 + 32 * th + crow(r, hi));
            const float g = bf2f(HG[row * HGW + head * 128 + 32 * vb + r32]); const float val = o[vb][r] * rs[r] * gn * siluf_(g); const float vn = __shfl_xor(val, 1);
            if ((r32 & 1) == 0) *(unsigned*)(CC + row * DM + 512 + head * 128 + 32 * vb + r32) = cvtpk(val, vn); } }
#endif
    __syncthreads();
}
#undef FRAG
#undef TRRD2
__device__ __forceinline__ void phase_h3(const Ctx& X, unsigned char* ws, const float* onorm) { if (X.wave >= 4) __builtin_amdgcn_s_setprio(1); for (int u = X.bid; u < 2 * NCH; u += X.nblk) h3_unit(X, ws, onorm, u); __builtin_amdgcn_s_setprio(0); }
}

__device__ __forceinline__ void phase_hgrn_simple(const Ctx& X, const Params& p) {
    unsigned char* ws = p.ws;
    const bf16* HQ = (const bf16*)(ws + WS_HQ); const bf16* HK = (const bf16*)(ws + WS_HK); const bf16* HV = (const bf16*)(ws + WS_HV); const float* LF = (const float*)(ws + WS_LF);
    float* OB = (float*)(ws + WS_XB);
    for (int bh = X.bid; bh < 2 * NH; bh += X.nblk) {
        if (X.tid < 256) {
            const int v = X.tid >> 1, hf = X.tid & 1, b = bh >> 2, h = bh & 3;
            float S[64];
#pragma unroll
            for (int j = 0; j < 64; ++j) S[j] = 0.f;
            for (int t = 0; t < SEQ; ++t) {
                const size_t base = ((size_t)(b * SEQ + t)) * HGW + h * 128;
                const float vt = bf2f(HV[base + v]);
                float o = 0.f;
#pragma unroll
                for (int j8 = 0; j8 < 8; ++j8) {
                    const size_t bj = base + 64 * hf + 8 * j8;
                    const f32x4 f0 = *(const f32x4*)(LF + bj), f1 = *(const f32x4*)(LF + bj + 4);
                    const u32x4 kw = *(const u32x4*)(HK + bj), qw = *(const u32x4*)(HQ + bj);
#define HSTEP(J, lf, kk, qq) do { S[8 * j8 + J] = fast_exp(lf) * S[8 * j8 + J] + (kk) * vt; o += (qq) * S[8 * j8 + J]; } while (0)
                    HSTEP(0, f0.x, bflo(kw.x), bflo(qw.x)); HSTEP(1, f0.y, bfhi(kw.x), bfhi(qw.x)); HSTEP(2, f0.z, bflo(kw.y), bflo(qw.y)); HSTEP(3, f0.w, bfhi(kw.y), bfhi(qw.y));
                    HSTEP(4, f1.x, bflo(kw.z), bflo(qw.z)); HSTEP(5, f1.y, bfhi(kw.z), bfhi(qw.z)); HSTEP(6, f1.z, bflo(kw.w), bflo(qw.w)); HSTEP(7, f1.w, bfhi(kw.w), bfhi(qw.w));
#undef HSTEP
                }
                o += __shfl_xor(o, 1);
                if (hf == 0) OB[base + v] = o;
            }
        }
    }
}
__device__ __forceinline__ void phase_hgrn_out(const Ctx& X, const Params& p, int l) {
    unsigned char* ws = p.ws;
    const float* OB = (const float*)(ws + WS_XB); const bf16* HG = (const bf16*)(ws + WS_HG); bf16* CC = (bf16*)(ws + WS_CC); const float* on = p.in[I_HON] + l * 128;
    const int gw = X.bid * NWAVES + X.wave, ngw = X.nblk * NWAVES, lane = X.lane;
    for (int i = gw; i < T * NH; i += ngw) {
        const int row = i >> 2, h = i & 3; const size_t base = (size_t)row * HGW + h * 128 + 2 * lane;
        const float o0 = OB[base], o1 = OB[base + 1];
        const float rstd = rsqrtf(wave_sum(o0 * o0 + o1 * o1) * (1.f / 128.f) + EPS);
        const unsigned gw2 = *(const unsigned*)(HG + base);
        *(unsigned*)(CC + (size_t)row * DM + 512 + h * 128 + 2 * lane) = pk2(o0 * rstd * on[2 * lane] * siluf_(bflo(gw2)), o1 * rstd * on[2 * lane + 1] * siluf_(bfhi(gw2)));
    }
}

template <class TS>
__device__ __forceinline__ void phase_norm(const Ctx& X, const Params& p, const TS* src, const float* gain) { norm_all_rows(X, src, gain, (bf16*)(p.ws + WS_XB)); }
template <class TS>
__device__ __forceinline__ void phase_norm_route(const Ctx& X, const Params& p, const TS* src, const float* gain) {
    unsigned char* ws = p.ws;
    int* GCNT = (int*)(ws + WS_MISC + MISC_GCNT); int* TOPI = (int*)(ws + WS_MISC + MISC_TOPI); float* TOPG = (float*)(ws + WS_MISC + MISC_TOPG);
    const float* wr = p.in[I_ROUTER];
    LAS int* wcnt = (LAS int*)(X.lds);
    const int lane = X.lane, b5 = lane >> 5, b4 = (lane >> 4) & 1, b3 = (lane >> 3) & 1;
    f32x4 w0[4][4], w1[4][4], gn[4];
#pragma unroll
    for (int j = 0; j < 4; ++j) { gn[j] = *((const f32x4*)gain + lane + 64 * j);
#pragma unroll
        for (int q = 0; q < 4; ++q) { const float* wp = wr + (size_t)(4 * (lane + 64 * j) + q) * NE; w0[j][q] = *(const f32x4*)wp; w1[j][q] = *(const f32x4*)(wp + 4); } }
    for (int g = X.bid; g < T / 64; g += X.nblk) {
        int cn[NE];
#pragma unroll
        for (int e = 0; e < NE; ++e) cn[e] = 0;
#pragma unroll 1
        for (int bt = 0; bt < 4; ++bt) {
            const int rbase = g * 64 + X.wave * 8 + 2 * bt;
            f32x4 v[2][4];
#pragma unroll
            for (int i = 0; i < 2; ++i)
#pragma unroll
                for (int j = 0; j < 4; ++j) v[i][j] = ldrow4(src + (size_t)(rbase + i) * DM, lane + 64 * j);
#pragma unroll
            for (int i = 0; i < 2; ++i) { const int row = rbase + i; float s = 0.f;
#pragma unroll
                for (int j = 0; j < 4; ++j) s += (v[i][j].x * v[i][j].x + v[i][j].y * v[i][j].y) + (v[i][j].z * v[i][j].z + v[i][j].w * v[i][j].w);
                const float rstd = __builtin_amdgcn_rsqf(wave_sum(s) * (1.f / DM) + EPS);
                float lg[NE];
#pragma unroll
                for (int e = 0; e < NE; ++e) lg[e] = 0.f;
#pragma unroll
                for (int j = 0; j < 4; ++j) { const f32x4 y = v[i][j] * rstd * gn[j];
                    *((unsigned*)((unsigned char*)(ws + WS_XB) + (size_t)row * DM) + lane + 64 * j) = pk4_fp8(y.x, y.y, y.z, y.w);
#pragma unroll
                    for (int q = 0; q < 4; ++q) { const float yv = (q == 0) ? y.x : (q == 1) ? y.y : (q == 2) ? y.z : y.w;
                        lg[0] += yv * w0[j][q].x; lg[1] += yv * w0[j][q].y; lg[2] += yv * w0[j][q].z; lg[3] += yv * w0[j][q].w; lg[4] += yv * w1[j][q].x; lg[5] += yv * w1[j][q].y; lg[6] += yv * w1[j][q].z; lg[7] += yv * w1[j][q].w; } }
                float k4[4], k2[2], k1;
#pragma unroll
                for (int t = 0; t < 4; ++t) { const float keep = b5 ? lg[4 + t] : lg[t], send = b5 ? lg[t] : lg[4 + t]; k4[t] = keep + xget32(send, b5); }
#pragma unroll
                for (int t = 0; t < 2; ++t) { const float keep = b4 ? k4[2 + t] : k4[t], send = b4 ? k4[t] : k4[2 + t]; k2[t] = keep + xget16(send, b4); }
                { const float keep = b3 ? k2[1] : k2[0], send = b3 ? k2[0] : k2[1]; k1 = keep + DPP_F(send, 0x128); }
                k1 += DPP_F(k1, 0xB1); k1 += DPP_F(k1, 0x4E); k1 += DPP_F(k1, 0x141);
                float tl[NE];
#pragma unroll
                for (int e = 0; e < NE; ++e) tl[e] = __int_as_float(__builtin_amdgcn_readlane(__float_as_int(k1), (e >> 2) * 32 + ((e >> 1) & 1) * 16 + (e & 1) * 8));
                int e1 = 0; float l1 = tl[0];
#pragma unroll
                for (int e = 1; e < NE; ++e) if (tl[e] > l1) { l1 = tl[e]; e1 = e; }
                int e2 = -1; float l2 = -3.0e38f;
#pragma unroll
                for (int e = 0; e < NE; ++e) if (e != e1 && tl[e] > l2) { l2 = tl[e]; e2 = e; }
#pragma unroll
                for (int e = 0; e < NE; ++e) cn[e] += (e == e1) + (e == e2);
                if (lane == 0) { const float g1 = 1.f / (1.f + expf(l2 - l1)); TOPI[row * 2] = e1; TOPI[row * 2 + 1] = e2; TOPG[row * 2] = g1; TOPG[row * 2 + 1] = 1.f - g1; }
            }
        }
        if (lane == 0) {
#pragma unroll
            for (int e = 0; e < NE; ++e) wcnt[X.wave * NE + e] = cn[e]; }
        __syncthreads();
        if (X.tid < NE) { int t = 0;
#pragma unroll
            for (int w = 0; w < NWAVES; ++w) t += wcnt[w * NE + X.tid];
            GCNT[g * NE + X.tid] = t; }
        __syncthreads();
    }
}
__device__ __forceinline__ void phase_scatter(const Ctx& X, const Params& p) {
    unsigned char* ws = p.ws;
    const int* GCNT = (const int*)(ws + WS_MISC + MISC_GCNT); const int* TOPI = (const int*)(ws + WS_MISC + MISC_TOPI); int* POS = (int*)(ws + WS_MISC + MISC_POS);
    int* TILE_E = (int*)(ws + WS_MISC + MISC_TILE_E); int* NT = (int*)(ws + WS_MISC + MISC_NT);
    const unsigned char* XF = (const unsigned char*)(ws + WS_XB); unsigned char* XS = (unsigned char*)(ws + WS_XS);
    LAS int* gc = (LAS int*)(X.lds);
    LAS int* pstart = gc + 256 * NE;
    LAS int* ntot = pstart + 8;
    LAS int* basel = ntot + 8;
    LAS int* posl = basel + 8;
    for (int i = X.tid; i < 256 * NE; i += NTHREADS) gc[i] = GCNT[i];
    __syncthreads();
    { const int e = X.wave; int n = 0;
#pragma unroll
      for (int k = 0; k < 4; ++k) n += gc[(X.lane + 64 * k) * NE + e];
      n += DPP_I(n, 0xB1); n += DPP_I(n, 0x4E); n += DPP_I(n, 0x124); n += DPP_I(n, 0x128); { const auto r = __builtin_amdgcn_permlane16_swap((unsigned)n, (unsigned)n, false, false); n = (int)(r[0] + r[1]); } { const auto r = __builtin_amdgcn_permlane32_swap((unsigned)n, (unsigned)n, false, false); n = (int)(r[0] + r[1]); }
      if (X.lane == 0) ntot[e] = n; }
    __syncthreads();
    if (X.tid == 0) { int acc = 0;
        for (int e = 0; e < NE; ++e) { pstart[e] = acc; const int nt = (ntot[e] + 255) >> 8; if (X.bid == 0) for (int t = 0; t < nt; ++t) TILE_E[(acc >> 8) + t] = e; acc += nt * 256; }
        if (X.bid == 0) NT[0] = acc >> 8; }
    __syncthreads();
    for (int g = X.bid; g < T / 64; g += X.nblk) {
        { const int e = X.wave; int n = 0;
#pragma unroll
          for (int k = 0; k < 4; ++k) { const int gg = X.lane + 64 * k; n += (gg < g) ? gc[gg * NE + e] : 0; }
          n += DPP_I(n, 0xB1); n += DPP_I(n, 0x4E); n += DPP_I(n, 0x124); n += DPP_I(n, 0x128); { const auto r = __builtin_amdgcn_permlane16_swap((unsigned)n, (unsigned)n, false, false); n = (int)(r[0] + r[1]); } { const auto r = __builtin_amdgcn_permlane32_swap((unsigned)n, (unsigned)n, false, false); n = (int)(r[0] + r[1]); }
          if (X.lane == 0) basel[e] = pstart[e] + n; }
        __syncthreads();
        if (X.wave == 0) {
            const int row = g * 64 + X.lane; const int e1 = TOPI[row * 2], e2 = TOPI[row * 2 + 1];
            int p1 = 0, p2 = 0;
            const unsigned long long lt = (1ull << X.lane) - 1ull;
#pragma unroll
            for (int e = 0; e < NE; ++e) {
                const int base = basel[e];
                const unsigned long long m1 = __ballot(e1 == e), m2 = __ballot(e2 == e);
                if (e1 == e) p1 = base + __popcll(m1 & lt);
                if (e2 == e) p2 = base + __popcll(m1) + __popcll(m2 & lt);
            }
            POS[row * 2] = p1; POS[row * 2 + 1] = p2; posl[X.lane * 2] = p1; posl[X.lane * 2 + 1] = p2;
        }
        __syncthreads();
        { u32x4 a[8];
#pragma unroll
          for (int i = 0; i < 8; ++i) a[i] = ((const u32x4*)(XF + (size_t)(g * 64 + X.wave * 8 + i) * DM))[X.lane];
#pragma unroll
          for (int i = 0; i < 8; ++i) { const int r = X.wave * 8 + i; ((u32x4*)(XS + (size_t)posl[r * 2] * DM))[X.lane] = a[i]; ((u32x4*)(XS + (size_t)posl[r * 2 + 1] * DM))[X.lane] = a[i]; } }
        __syncthreads();
    }
}
template <class TS>
__device__ __forceinline__ void phase_combine(const Ctx& X, const Params& p, const TS* xr) {
    unsigned char* ws = p.ws;
    const int* POS = (const int*)(ws + WS_MISC + MISC_POS); const float* TOPG = (const float*)(ws + WS_MISC + MISC_TOPG); const bf16* YS = (const bf16*)(ws + WS_YS);
    const float* fn = p.in[I_FINN];
    const int gw = X.bid * NWAVES + X.wave, ngw = X.nblk * NWAVES, lane = X.lane;
    f32x4 gf[4];
#pragma unroll
    for (int j = 0; j < 4; ++j) gf[j] = *((const f32x4*)fn + lane + 64 * j);
    for (int r0 = gw; r0 < T; r0 += 2 * ngw) {
        int pp[2][2]; float gg[2][2]; f32x4 v[2][4]; u32x2 ya[2][4], yb[2][4];
#pragma unroll
        for (int i = 0; i < 2; ++i) { const int row = (r0 + i * ngw < T) ? r0 + i * ngw : r0; pp[i][0] = POS[row * 2]; pp[i][1] = POS[row * 2 + 1]; gg[i][0] = TOPG[row * 2]; gg[i][1] = TOPG[row * 2 + 1];
#pragma unroll
            for (int j = 0; j < 4; ++j) v[i][j] = ldrow4(xr + (size_t)row * DM, lane + 64 * j); }
#pragma unroll
        for (int i = 0; i < 2; ++i)
#pragma unroll
            for (int j = 0; j < 4; ++j) { ya[i][j] = *((const u32x2*)(YS + (size_t)pp[i][0] * DM) + lane + 64 * j); yb[i][j] = *((const u32x2*)(YS + (size_t)pp[i][1] * DM) + lane + 64 * j); }
#if DN_SPLITK
#pragma unroll
        for (int i = 0; i < 2; ++i)
#pragma unroll
            for (int k = 0; k < 2; ++k) { const int pos = pp[i][k];
                if (pos >= 128 * 256) { const float* sl = (const float*)(ws + WS_SLAB) + ((size_t)(((pos >> 8) - 128) * 4) * 7 * 256 + (pos & 255)) * 256 + 4 * lane;
#pragma unroll
                    for (int j = 0; j < 4; ++j) { f32x4 acc = *(const f32x4*)(sl + (size_t)(j * 7) * 65536);
#pragma unroll
                        for (int q = 1; q < 7; ++q) acc = acc + *(const f32x4*)(sl + (size_t)(j * 7 + q) * 65536);
                        u32x2 w; w.x = pk2(acc.x, acc.y); w.y = pk2(acc.z, acc.w); if (k == 0) ya[i][j] = w; else yb[i][j] = w; } } }
#endif
#pragma unroll
        for (int i = 0; i < 2; ++i) { const int row = (r0 + i * ngw < T) ? r0 + i * ngw : r0; const float g1 = gg[i][0], g2 = gg[i][1]; float s = 0.f;
#pragma unroll
            for (int j = 0; j < 4; ++j) { const u32x2 a = ya[i][j], b = yb[i][j]; f32x4& x = v[i][j];
                x.x += g1 * bflo(a.x) + g2 * bflo(b.x); x.y += g1 * bfhi(a.x) + g2 * bfhi(b.x); x.z += g1 * bflo(a.y) + g2 * bflo(b.y); x.w += g1 * bfhi(a.y) + g2 * bfhi(b.y);
                s += (x.x * x.x + x.y * x.y) + (x.z * x.z + x.w * x.w); }
            const float rstd = __builtin_amdgcn_rsqf(wave_sum(s) * (1.f / DM) + EPS);
#pragma unroll
            for (int j = 0; j < 4; ++j) *((f32x4*)(p.out + (size_t)row * DM) + lane + 64 * j) = v[i][j] * rstd * gf[j]; }
    }
}

__device__ __forceinline__ bool relaunder(Ctx& X, unsigned char*& ws, const Params& p) {
    int t = threadIdx.x; asm volatile("" : "+v"(t)); X.tid = t; X.lane = t & 63; X.wave = __builtin_amdgcn_readfirstlane(t >> 6);
    unsigned long long w = (unsigned long long)p.ws; asm volatile("" : "+s"(w)); ws = (unsigned char*)(GAS unsigned char*)w;
    return true;
}
constexpr int NPHASES = 26;
#define PHASE(k) relaunder(X, ws, p)
#define SEAM(k) xcd_barrier(bar)
template <int L>
__device__ __forceinline__ void run_layer(Ctx& X, const Params& p, const XcdBarrier& bar) {
    unsigned char* ws;
#if XR_BF16
    xr_t* XR = (xr_t*)(p.ws + WS_XRB);
#else
    xr_t* XR = p.out;
#endif
    PHASE(pb + 0); {
        EpiProj E{ws, L, (FUSE_NORM && L == 1) ? (int)MISC_SSXB : 0};
        gemm_dense(X, (FUSE_NORM && L == 1) ? (const bf16*)XR : (const bf16*)(ws + WS_XB), (const bf16*)(ws + WS_WT_IN) + (size_t)L * NPROJ_P * DM, NPROJ_P, DM, E);
#if TAILFILL && MOE_FP8
        if (X.nblk == 256 && X.bid >= 192) tail_fill(X, p, L == 0 ? 0 : TAIL_A + TAIL_B + TAIL_C, TAILFILL_A, X.bid - 192, 64);
#endif
#ifdef PROBE_INPROJ_NOEPI
        { EpiProbe EP{(float*)(ws + WS_CC)}; gemm_dense(X, (const bf16*)(ws + WS_XB), (const bf16*)(ws + WS_WT_IN) + (size_t)L * NPROJ_P * DM, NPROJ_P, DM, EP); }
#endif
    } SEAM(pb + 0);
    PHASE(pb + 1); {
        EpiQ EQ{ws}; EpiKV EK{ws};
        REP_X(REP_QKV, gemm_dense(X, (const bf16*)(ws + WS_CQ), (const bf16*)(ws + WS_WT_QB) + (size_t)L * (NH * DQK) * QR, NH * DQK, QR, EQ);
        gemm_dense(X, (const bf16*)(ws + WS_CKV), (const bf16*)(ws + WS_WT_KVB) + (size_t)L * 1024 * KVR, 1024, KVR, EK);)
#if FAST_HGRN
        hg::phase_h1(X, ws, L);
#endif
#if TAILFILL && MOE_FP8
        if (X.nblk == 256 && X.bid >= 192) tail_fill(X, p, (L == 0 ? 0 : TAIL_A + TAIL_B + TAIL_C) + TAIL_A, TAILFILL_B, X.bid - 192, 64);
#endif
    } SEAM(pb + 1);
#if FAST_ATTN
    PHASE(pb + 2); {
#if FAST_HGRN
        hg::phase_h2(X, ws);
#endif
        REP_X(REP_ATTN, phase_attn_fast(X, ws);) } SEAM(pb + 2);
#else
    PHASE(pb + 2); { phase_attn_simple(X, p); } SEAM(pb + 2);
#endif
#if !FAST_HGRN
    PHASE(pb + 3); { phase_hgrn_simple(X, p); } SEAM(pb + 3);
#endif
#if FAST_ATTN
#if FAST_HGRN
    PHASE(pb + 4); { phase_attn_combine(X, ws); REP_X(REP_H3, hg::phase_h3(X, ws, p.in[I_HON] + L * 128);) } SEAM(pb + 4);
#else
    PHASE(pb + 4); { phase_attn_combine(X, ws); phase_hgrn_out(X, p, L); } SEAM(pb + 4);
#endif
#else
    PHASE(pb + 4); { phase_hgrn_out(X, p, L); } SEAM(pb + 4);
#endif
    PHASE(pb + 5); {
#if FUSE_NORM
        if (L == 0) { EpiResNormT<float> E{p.in[I_X], XR, (float*)(ws + WS_MISC + MISC_SSXA), 0.f, (LAS float*)(X.lds + 131072)}; gemm_dense(X, (const bf16*)(ws + WS_CC), (const bf16*)(ws + WS_WT_OUT) + (size_t)L * DM * DM, DM, DM, E); }
#else
        if (L == 0) { EpiResT<float, xr_t> E{p.in[I_X], XR}; gemm_dense(X, (const bf16*)(ws + WS_CC), (const bf16*)(ws + WS_WT_OUT) + (size_t)L * DM * DM, DM, DM, E); }
#endif
        else { EpiResT<xr_t, xr_t> E{XR, XR}; gemm_dense(X, (const bf16*)(ws + WS_CC), (const bf16*)(ws + WS_WT_OUT) + (size_t)L * DM * DM, DM, DM, E); }
    } SEAM(pb + 5);
#if FUSE_NORM
    if (L == 1) { PHASE(pb + 6); { phase_norm_route(X, p, XR, p.in[I_FFNN] + DM); } SEAM(pb + 6); }
    if (L == 0) {
        PHASE(8); { EpiSwiglu E{(bf16*)(ws + WS_HID), FF0, 0, (const float*)(ws + WS_MISC + MISC_SSXA)};
            gemm_dense(X, (const bf16*)XR, (const bf16*)(ws + WS_WT_GU), 2 * FF0, DM, E);
#if TAILFILL && MOE_FP8
            if (X.nblk == 256 && X.bid >= 128) tail_fill(X, p, TAIL_A + TAIL_B, TAILFILL_C, X.bid - 128, 128);
#endif
#ifdef PROBE_GU_NOEPI
            { EpiProbe EP{(float*)(ws + WS_CC)}; gemm_dense(X, (const bf16*)XR, (const bf16*)(ws + WS_WT_GU), 2 * FF0, DM, EP); }
#endif
            } SEAM(8);
        PHASE(9); { EpiResNormT<xr_t> E{XR, XR, (float*)(ws + WS_MISC + MISC_SSXB), 0.f, (LAS float*)(X.lds + 131072)};
            gemm_dense(X, (const bf16*)(ws + WS_HID), (const bf16*)(ws + WS_WT_DN), DM, FF0, E); } SEAM(9);
    }
#else
    PHASE(pb + 6); { if (L == 0) { phase_norm(X, p, XR, p.in[I_FFNN]); } else { phase_norm_route(X, p, XR, p.in[I_FFNN] + DM); } } SEAM(pb + 6);
    if (L == 0) {
        PHASE(8); { EpiSwiglu E{(bf16*)(ws + WS_HID), FF0, 0, nullptr};
            gemm_dense(X, (const bf16*)(ws + WS_XB), (const bf16*)(ws + WS_WT_GU), 2 * FF0, DM, E); } SEAM(8);
        PHASE(9); { EpiResT<xr_t, xr_t> E{XR, XR};
            gemm_dense(X, (const bf16*)(ws + WS_HID), (const bf16*)(ws + WS_WT_DN), DM, FF0, E); } SEAM(9);
        PHASE(10); { phase_norm(X, p, XR, p.in[I_MIXN] + DM); } SEAM(10);
    }
#endif
}

__global__ void __launch_bounds__(NTHREADS, 2) mega(Params p) {
    extern __shared__ __attribute__((aligned(16))) unsigned char lds_raw[];
    Ctx X; X.tid = threadIdx.x; X.lane = X.tid & 63; X.wave = __builtin_amdgcn_readfirstlane(X.tid >> 6); X.bid = blockIdx.x; X.nblk = gridDim.x; X.lds = (LAS unsigned char*)lds_raw;
    unsigned char* ws = p.ws;
    volatile LAS unsigned* MISC = (volatile LAS unsigned*)(X.lds + LDS_MISC_OFF);
    if (X.tid < 32) MISC[X.tid] = 0u;
    __syncthreads();
    const XcdBarrier bar = xcd_barrier_post((unsigned*)(ws + WS_CTL) + CW_BAR, MISC + 8);

    PHASE(0); { REP_X(REP_PRO, phase_prologue(X, p);) } SEAM(0);
    run_layer<0>(X, p, bar);
    run_layer<1>(X, p, bar);
    PHASE(18); { REP_X(REP_ROUTE, phase_scatter(X, p);) } SEAM(18);
#if MOE_FP8
    PHASE(19); { const int* NTp = (const int*)(ws + WS_MISC + MISC_NT); const int* TILE_E = (const int*)(ws + WS_MISC + MISC_TILE_E); const int nt = NTp[0];
        EpiSwiglu8 E{(unsigned char*)(ws + WS_HIDM), FFM, 0};
        REP_X(REP_MOEGU, gemm_moe(X, (const bf16*)(ws + WS_XS), (const bf16*)(ws + WS_WT_MGU), 0, nt, 2 * FFM, DM / 2, TILE_E, 0, 0x79797979, E);) } SEAM(19);
    PHASE(20); { const int* NTp = (const int*)(ws + WS_MISC + MISC_NT); const int* TILE_E = (const int*)(ws + WS_MISC + MISC_TILE_E); const int nt = NTp[0];
        EpiBf16Plain E{(bf16*)(ws + WS_YS), DM};
#if DN_SPLITK
        const int nfull = nt < 128 ? nt : 128;
        gemm_moe(X, (const bf16*)(ws + WS_HIDM), (const bf16*)(ws + WS_WT_MDN), 0, nfull, DM, FFM / 2, TILE_E, 0, 0x78787878, E);
        { const int nsub = (nt - nfull) * 4 * 7, sidx = (int)X.bid;
          pg8::OneUnit S1; S1.have = sidx < nsub;
          const int ks = sidx % 7, up = sidx / 7, pn = up & 3, pm = nfull + (up >> 2);
          S1.u.pm = pm; S1.u.pn = pn; S1.u.pa = pm; S1.u.pb = (S1.have ? __builtin_amdgcn_readfirstlane(TILE_E[pm]) : 0) * 4 + pn;
          pg8::Gemm g1{(const bf16*)(ws + WS_HIDM + (size_t)ks * 512), (const bf16*)(ws + WS_WT_MDN + (size_t)ks * 512), 256, DM, 256, 0x78787878, FFM / 2};
          EpiSlab E1{(float*)(ws + WS_SLAB), ks};
          pg8::gemm_phase<EpiSlab, pg8::OneUnit, true, true, true>(X.lds, g1, S1, E1); }
        } SEAM(20);
#else
        REP_X(REP_MOEDN, gemm_moe(X, (const bf16*)(ws + WS_HIDM), (const bf16*)(ws + WS_WT_MDN), 0, nt, DM, FFM / 2, TILE_E, 0, 0x78787878, E);) } SEAM(20);
#endif
#else
    for (int c = 0; c < 3; ++c) {
        PHASE(19 + 2 * c); { const int* NTp = (const int*)(ws + WS_MISC + MISC_NT); const int* TILE_E = (const int*)(ws + WS_MISC + MISC_TILE_E);
            const int nt = NTp[0], t0 = CHUNK_TILES * c, t1 = min(nt, t0 + CHUNK_TILES);
            if (t1 > t0) { EpiSwiglu E{(bf16*)(ws + WS_HIDM), FFM, t0 * 256, nullptr};
                REP_X(REP_MOEGU, gemm_moe(X, (const bf16*)(ws + WS_XS), (const bf16*)(ws + WS_WT_MGU), t0, t1, 2 * FFM, DM, TILE_E, 0, 0, E);) } } SEAM(19 + 2 * c);
        PHASE(20 + 2 * c); { const int* NTp = (const int*)(ws + WS_MISC + MISC_NT); const int* TILE_E = (const int*)(ws + WS_MISC + MISC_TILE_E);
            const int nt = NTp[0], t0 = CHUNK_TILES * c, t1 = min(nt, t0 + CHUNK_TILES);
            if (t1 > t0) { EpiBf16Plain E{(bf16*)(ws + WS_YS), DM};
                REP_X(REP_MOEDN, gemm_moe(X, (const bf16*)(ws + WS_HIDM), (const bf16*)(ws + WS_WT_MDN), t0, t1, DM, FFM, TILE_E, t0, 0, E);) } } SEAM(20 + 2 * c);
    }
#endif
#if XR_BF16
    PHASE(25); { phase_combine(X, p, (const xr_t*)(p.ws + WS_XRB)); }
#else
    PHASE(25); { phase_combine(X, p, (const xr_t*)p.out); }
#endif
}
#undef PHASE
#undef SEAM

extern "C" void kernel_launch(void* const* d_in, const int* in_sizes, int n_in, void* d_out, int out_size, void* d_ws, size_t ws_size, hipStream_t stream) {
    static int grid = 0;
    if (grid == 0) {
        if (n_in != 20 || out_size != T * DM || ws_size < WS_END) { fprintf(stderr, "kernel_launch: unexpected shapes (n_in %d out %d ws %zu)\n", n_in, out_size, ws_size); grid = -1; return; }
        int dev = 0, cus = 0;
        if (hipGetDevice(&dev) != hipSuccess || hipDeviceGetAttribute(&cus, hipDeviceAttributeMultiprocessorCount, dev) != hipSuccess) { grid = -1; return; }
        if (hipFuncSetAttribute((const void*)mega, hipFuncAttributeMaxDynamicSharedMemorySize, LDS_BYTES) != hipSuccess) { fprintf(stderr, "kernel_launch: hipFuncSetAttribute failed\n"); grid = -1; return; }
        int per_cu = 0; (void)hipOccupancyMaxActiveBlocksPerMultiprocessor(&per_cu, (const void*)mega, NTHREADS, LDS_BYTES); (void)hipGetLastError();
        grid = cus;
    }
    if (grid < 0) return;
    (void)hipMemsetAsync((char*)d_ws + WS_CTL, 0, CTL_BYTES, stream);
    Params p{};
    for (int i = 0; i < 20; ++i) p.in[i] = (const float*)d_in[i];
    p.out = (float*)d_out; p.ws = (unsigned char*)d_ws;
    p.ph_lo = 0; p.ph_hi = NPHASES;
    hipLaunchKernelGGL(mega, dim3(grid), dim3(NTHREADS), LDS_BYTES, stream, p);
}
```

```cpp
#include <hip/hip_runtime.h>
#include <cstdio>
#include <cstdint>

#ifndef N_LAUNCH_MODE
#define N_LAUNCH_MODE 1
#endif

#ifndef FAST_GEMM
#define FAST_GEMM 1
#endif
#ifndef REP_ATTN
#define REP_ATTN 1
#endif
#ifndef REP_INPROJ
#define REP_INPROJ 1
#endif
#ifndef REP_H3
#define REP_H3 1
#endif
#ifndef REP_PRO
#define REP_PRO 1
#endif
#ifndef REP_MOEGU
#define REP_MOEGU 1
#endif
#ifndef REP_MOEDN
#define REP_MOEDN 1
#endif
#ifndef REP_DGU
#define REP_DGU 1
#endif
#ifndef REP_NORM
#define REP_NORM 1
#endif
#ifndef REP_ROUTE
#define REP_ROUTE 1
#endif
#ifndef REP_OUT0
#define REP_OUT0 1
#endif
#ifndef REP_QKV
#define REP_QKV 1
#endif
#define REP_1(stmt) stmt
#define REP_2(stmt) stmt stmt
#define REP_CAT(a, b) a##b
#define REP_X(n, stmt) REP_CAT(REP_, n)(stmt)
#ifndef MOE_FP8
#define MOE_FP8 1
#endif
#ifndef DN_SPLITK
#define DN_SPLITK 1
#endif
#ifndef FUSE_NORM
#define FUSE_NORM 1
#endif
#ifndef XR_BF16
#define XR_BF16 1
#endif
#ifndef HG_V2
#define HG_V2 1
#endif
#ifndef FAST_ATTN
#define FAST_ATTN 1
#endif
#ifndef TAILFILL
#define TAILFILL 1
#endif
#ifndef TAILFILL_A
#define TAILFILL_A 8
#endif
#ifndef TAILFILL_B
#define TAILFILL_B 0
#endif
#ifndef TAILFILL_C
#define TAILFILL_C 8
#endif
#ifndef H1_WIDE
#define H1_WIDE 1
#endif
#ifndef H3_STAGED_EPI
#define H3_STAGED_EPI 1
#endif
#ifndef ATTN_STAGED_EPI
#define ATTN_STAGED_EPI 1
#endif
#ifndef FAST_HGRN
#define FAST_HGRN 1
#endif
#define GAS __attribute__((address_space(1)))
#define LAS __attribute__((address_space(3)))
typedef unsigned short bf16;
typedef float f32x4 __attribute__((ext_vector_type(4)));
typedef short bf16x8 __attribute__((ext_vector_type(8)));
typedef unsigned u32x4 __attribute__((ext_vector_type(4)));
typedef unsigned u32x2 __attribute__((ext_vector_type(2)));

constexpr int T = 16384, SEQ = 8192, DM = 1024, NLAYER = 2;
constexpr int QR = 384, KVR = 256, ROPE = 64, NPROJ = 2752, NPROJ_P = 2816;
constexpr int NH = 4, DQK = 192, DNOPE = 128, DV = 128;
constexpr int HGW = 512;
constexpr int FF0 = 2816, FFM = 3584, NE = 8;
constexpr int MAXTILES = 136;
constexpr float EPS = 1e-6f;
constexpr int NWAVES = 8, NTHREADS = 512;

constexpr size_t MiB = 1u << 20;
constexpr size_t WS_CTL = 0, CTL_BYTES = 32768;
constexpr size_t WS_MISC = 1 * MiB;
constexpr size_t MISC_LB = 0, MISC_GCNT = 8192, MISC_TILE_E = 16384, MISC_NT = 17408, MISC_TOPI = 65536, MISC_TOPG = 196608, MISC_POS = 327680, MISC_SSXA = 458752, MISC_SSXB = 720896;
constexpr size_t WS_COS = 2 * MiB, WS_SIN = 4 * MiB;
constexpr size_t WS_WT_IN = 6 * MiB, WS_WT_QB = 17 * MiB, WS_WT_KVB = 19 * MiB, WS_WT_OUT = 20 * MiB, WS_WT_GU = 24 * MiB, WS_WT_DN = 35 * MiB, WS_WT_MGU = 41 * MiB, WS_WT_MDN = 153 * MiB;
constexpr size_t WS_XB = 209 * MiB;
constexpr size_t WS_CQ = 242 * MiB, WS_CKV = 254 * MiB, WS_KPE = 262 * MiB, WS_SSQ = 264 * MiB, WS_HQ = 266 * MiB, WS_HK = 282 * MiB, WS_LF = 298 * MiB, WS_HV = 330 * MiB, WS_HG = 346 * MiB;
constexpr size_t WS_Q = 362 * MiB, WS_KN = 386 * MiB, WS_V = 402 * MiB, WS_CC = 418 * MiB, WS_END = 464 * MiB;
constexpr size_t WS_HID = 242 * MiB;
#if MOE_FP8
constexpr size_t WS_XS = 242 * MiB;
constexpr size_t WS_YS = 276 * MiB;
constexpr size_t WS_HIDM = 344 * MiB;
constexpr int CHUNK_TILES = 136;
static_assert(WS_HIDM + (size_t)34816 * 3584 <= 464 * MiB, "MoE hidden fits below the guaranteed workspace size");
#else
constexpr size_t WS_XS = 242 * MiB;
constexpr size_t WS_YS = WS_XS;
constexpr size_t WS_HIDM = 310 * MiB;
constexpr int CHUNK_TILES = 64;
#endif
constexpr size_t WS_AP2 = WS_CQ;
constexpr size_t WS_AML = WS_SSQ;
constexpr size_t WS_HD = WS_XB + 32 * MiB, WS_HR = WS_HD + 512 * 1024;
constexpr size_t WS_XRB = 97 * MiB;
constexpr size_t WS_SLAB = 209 * MiB;
constexpr int CW_BAR = 4096;

constexpr int LDS_BYTES = 147456;
constexpr int LDS_MISC_OFF = 143360;

__device__ __forceinline__ unsigned f2bf(float f) { unsigned u = __float_as_uint(f); return (u + 0x7fffu + ((u >> 16) & 1u)) >> 16; }
typedef float pk2_f32x2 __attribute__((ext_vector_type(2)));
typedef __bf16 pk2_bf16x2 __attribute__((ext_vector_type(2)));
__device__ __forceinline__ unsigned pk2(float lo, float hi) { const pk2_f32x2 v = {lo, hi}; return __builtin_bit_cast(unsigned, __builtin_convertvector(v, pk2_bf16x2)); }
__device__ __forceinline__ float bf2f(unsigned short b) { return __uint_as_float(((unsigned)b) << 16); }
__device__ __forceinline__ float bflo(unsigned w) { return __uint_as_float(w << 16); }
__device__ __forceinline__ float bfhi(unsigned w) { return __uint_as_float(w & 0xffff0000u); }
__device__ __forceinline__ float clamp8(float x) { return __builtin_amdgcn_fmed3f(x, -448.f, 448.f); }
__device__ __forceinline__ unsigned pk4_fp8(float a, float b, float c, float d) {
    int w = __builtin_amdgcn_cvt_pk_fp8_f32(clamp8(a), clamp8(b), 0, false); w = __builtin_amdgcn_cvt_pk_fp8_f32(clamp8(c), clamp8(d), w, true); return (unsigned)w; }
__device__ __forceinline__ u32x4 pack8(f32x4 a, f32x4 b) { u32x4 w; w.x = pk2(a.x, a.y); w.y = pk2(a.z, a.w); w.z = pk2(b.x, b.y); w.w = pk2(b.z, b.w); return w; }
#if XR_BF16
typedef bf16 xr_t;
#else
typedef float xr_t;
#endif
__device__ __forceinline__ f32x4 ldrow4(const float* row, int idx) { return *((const f32x4*)row + idx); }
__device__ __forceinline__ f32x4 ldrow4(const bf16* row, int idx) { const u32x2 w = *((const u32x2*)row + idx); f32x4 r; r.x = __uint_as_float(w.x << 16); r.y = __uint_as_float(w.x & 0xffff0000u); r.z = __uint_as_float(w.y << 16); r.w = __uint_as_float(w.y & 0xffff0000u); return r; }
#define DPP_F(v, ctrl) __int_as_float(__builtin_amdgcn_update_dpp(0, __float_as_int(v), (ctrl), 0xf, 0xf, true))
#define DPP_I(v, ctrl) __builtin_amdgcn_update_dpp(0, (v), (ctrl), 0xf, 0xf, true)
__device__ __forceinline__ float xsum16(float v) { const auto r = __builtin_amdgcn_permlane16_swap(__float_as_uint(v), __float_as_uint(v), false, false); return __uint_as_float(r[0]) + __uint_as_float(r[1]); }
__device__ __forceinline__ float xsum32(float v) { const auto r = __builtin_amdgcn_permlane32_swap(__float_as_uint(v), __float_as_uint(v), false, false); return __uint_as_float(r[0]) + __uint_as_float(r[1]); }
__device__ __forceinline__ float xget16(float v, int odd_row) { const auto r = __builtin_amdgcn_permlane16_swap(__float_as_uint(v), __float_as_uint(v), false, false); return __uint_as_float(odd_row ? r[0] : r[1]); }
__device__ __forceinline__ float xget32(float v, int upper) { const auto r = __builtin_amdgcn_permlane32_swap(__float_as_uint(v), __float_as_uint(v), false, false); return __uint_as_float(upper ? r[0] : r[1]); }
__device__ __forceinline__ float wave_sum(float v) {
    v += DPP_F(v, 0xB1); v += DPP_F(v, 0x4E); v += DPP_F(v, 0x124); v += DPP_F(v, 0x128); v = xsum16(v); v = xsum32(v);
    return v;
}
__device__ __forceinline__ float wave_max(float v) {
    v = fmaxf(v, DPP_F(v, 0xB1)); v = fmaxf(v, DPP_F(v, 0x4E)); v = fmaxf(v, DPP_F(v, 0x124)); v = fmaxf(v, DPP_F(v, 0x128));
    { const auto r = __builtin_amdgcn_permlane16_swap(__float_as_uint(v), __float_as_uint(v), false, false); v = fmaxf(__uint_as_float(r[0]), __uint_as_float(r[1])); }
    { const auto r = __builtin_amdgcn_permlane32_swap(__float_as_uint(v), __float_as_uint(v), false, false); v = fmaxf(__uint_as_float(r[0]), __uint_as_float(r[1])); }
    return v;
}
__device__ __forceinline__ float fast_exp(float x) { return __builtin_amdgcn_exp2f(x * 1.4426950408889634f); }
__device__ __forceinline__ float sigmoidf_(float x) { return __builtin_amdgcn_rcpf(1.f + fast_exp(-x)); }
__device__ __forceinline__ float siluf_(float x) { return x * __builtin_amdgcn_rcpf(1.f + fast_exp(-x)); }
typedef float f32x2v __attribute__((ext_vector_type(2)));
__device__ __forceinline__ f32x2v silu_mul_pk(f32x2v g, f32x2v u) {
    const f32x2v t = g * (-1.4426950408889634f); f32x2v e; e.x = __builtin_amdgcn_exp2f(t.x); e.y = __builtin_amdgcn_exp2f(t.y);
    const f32x2v d = e + 1.0f; f32x2v r; r.x = __builtin_amdgcn_rcpf(d.x); r.y = __builtin_amdgcn_rcpf(d.y);
    return (g * u) * r;
}
__device__ __forceinline__ int perm32(int rho) { const int n = rho >> 4, i = rho & 15; return 8 * (i >> 2) + 4 * n + (i & 3); }

__device__ const double kInvRev[32] = {
    1.59154943091895346e-01, 1.19349370211248862e-01, 8.94994016088910133e-02, 6.71150830052272551e-02, 5.03292121044870353e-02, 3.77415847174197711e-02, 2.83021958306233987e-02, 2.12236527647776604e-02,
    1.59154943091895339e-02, 1.19349370211248862e-02, 8.94994016088910237e-03, 6.71150830052272534e-03, 5.03292121044870370e-03, 3.77415847174197719e-03, 2.83021958306233987e-03, 2.12236527647776622e-03,
    1.59154943091895356e-03, 1.19349370211248849e-03, 8.94994016088910237e-04, 6.71150830052272599e-04, 5.03292121044870326e-04, 3.77415847174197741e-04, 2.83021958306233954e-04, 2.12236527647776605e-04,
    1.59154943091895351e-04, 1.19349370211248862e-04, 8.94994016088910182e-05, 6.71150830052272545e-05, 5.03292121044870354e-05, 3.77415847174197768e-05, 2.83021958306233961e-05, 2.12236527647776592e-05};

#define XB_TMO      128
#define XB_XCNT(j)  (256  + 64 * (j))
#define XB_XSUB(j)  (1280 + 64 * (j))
#define XB_XGEN(j)  (2304 + 64 * (j))
#define XB_TOP      3328
#define XB_TOPGEN   3392
#define XCD_BAR_WORDS 3456
#define XB_SPIN_CAP (1u << 18)
__device__ __forceinline__ unsigned xb_ld(unsigned* p)              { return __hip_atomic_load(p, __ATOMIC_RELAXED, __HIP_MEMORY_SCOPE_AGENT); }
__device__ __forceinline__ unsigned xb_add(unsigned* p, unsigned v) { return __hip_atomic_fetch_add(p, v, __ATOMIC_RELAXED, __HIP_MEMORY_SCOPE_AGENT); }
__device__ __forceinline__ unsigned xb_xcc_id() { return (unsigned)__builtin_amdgcn_s_getreg((3 << 11) | 20) & 0xFu; }
#define XB_SPIN(cond, bar) do { unsigned _sp = 0; while (cond) { __builtin_amdgcn_s_sleep(1); \
    if ((++_sp & 255u) == 0u) { if (xb_ld(&(bar)[XB_TMO])) break; if (_sp > XB_SPIN_CAP) { atomicAdd(&(bar)[XB_TMO], 1u); break; } } } } while (0)
struct XcdBarrier { unsigned* bar; unsigned x; volatile LAS unsigned* st; };
__device__ __forceinline__ XcdBarrier xcd_barrier_post(unsigned* bar, volatile LAS unsigned* st) {
    XcdBarrier b; b.bar = bar; b.x = xb_xcc_id(); b.st = st;
    if (threadIdx.x == 0) (void)xb_add(&bar[XB_XCNT(b.x)], 1u);
    return b;
}
__device__ __forceinline__ void xcd_barrier_complete(unsigned* bar, unsigned x, unsigned& nloc, unsigned& nx) {
    const unsigned G = gridDim.x * gridDim.y * gridDim.z;
    unsigned sum, cnt, mine, sp = 0u;
    for (;;) {
        sum = 0u; cnt = 0u; mine = 0u;
#pragma unroll
        for (unsigned j = 0; j < 16; ++j) { const unsigned c = xb_ld(&bar[XB_XCNT(j)]); sum += c; cnt += (c > 0u) ? 1u : 0u; mine = (j == x) ? c : mine; }
        if (sum == G) break;
        __builtin_amdgcn_s_sleep(1);
        if ((++sp & 255u) == 0u) { if (xb_ld(&bar[XB_TMO])) break; if (sp > XB_SPIN_CAP) { atomicAdd(&bar[XB_TMO], 1u); break; } }
    }
    nloc = mine > 0u ? mine : 1u; nx = cnt > 0u ? cnt : 1u;
}
__device__ __forceinline__ void xcd_barrier(const XcdBarrier& b) {
    asm volatile("s_waitcnt vmcnt(0)" ::: "memory");
    __syncthreads();
    unsigned long long bar_ = (unsigned long long)b.bar; asm volatile("" : "+s"(bar_));
    if (threadIdx.x == 0) {
        unsigned* bar = (unsigned*)(GAS unsigned*)bar_;
        __builtin_amdgcn_s_waitcnt(0);
        unsigned nloc = b.st[0], nx = b.st[1];
        if (nloc == 0u) { xcd_barrier_complete(bar, b.x, nloc, nx); b.st[0] = nloc; b.st[1] = nx; }
        const unsigned old = xb_add(&bar[XB_XSUB(b.x)], 1u);
        const unsigned gen = old / nloc;
        if (old + 1u == (gen + 1u) * nloc) {
            __builtin_amdgcn_fence(__ATOMIC_RELEASE, "agent");
            asm volatile("s_waitcnt vmcnt(0)" ::: "memory");
            const unsigned og = xb_add(&bar[XB_TOP], 1u);
            const unsigned tg = og / nx;
            if (og + 1u == (tg + 1u) * nx) xb_add(&bar[XB_TOPGEN], 1u);
            else XB_SPIN(xb_ld(&bar[XB_TOPGEN]) == tg, bar);
            __builtin_amdgcn_fence(__ATOMIC_ACQUIRE, "agent");
            xb_add(&bar[XB_XGEN(b.x)], 1u);
            asm volatile("s_waitcnt vmcnt(0)" ::: "memory");
        } else {
            XB_SPIN(xb_ld(&bar[XB_XGEN(b.x)]) == gen, bar);
            __builtin_amdgcn_fence(__ATOMIC_ACQUIRE, "agent");
            asm volatile("s_waitcnt vmcnt(0)" ::: "memory");
        }
    }
    __syncthreads();
}

struct Params { const float* in[20]; float* out; unsigned char* ws; int ph_lo, ph_hi; };
enum { I_X = 0, I_POS, I_MIXN, I_WIN, I_QAN, I_WQB, I_KVAN, I_WKVB, I_HLB, I_HON, I_WOUT, I_FFNN, I_DWG, I_DWU, I_DWD, I_ROUTER, I_MWG, I_MWU, I_MWD, I_FINN };

struct Ctx {
    int tid, lane, wave, bid, nblk;
    LAS unsigned char* lds;
};

struct EpiProj {
    unsigned char* ws; int l; int ssx;
    __device__ __forceinline__ void launder() { unsigned long long w = (unsigned long long)ws; asm volatile("" : "+s"(w)); ws = (unsigned char*)(GAS unsigned char*)w;     }
    static constexpr int HAS_ROWSCALE = 1;
    __device__ __forceinline__ float rowscale(int row) const { if (!ssx) return 1.f; const float* sx = (const float*)(ws + WS_MISC + ssx) + row; return __builtin_amdgcn_rsqf(((sx[0] + sx[T]) + (sx[2 * T] + sx[3 * T])) * (1.f / DM) + EPS); }
    __device__ __forceinline__ void operator()(int row, int c, f32x4 a, f32x4 b) const {
        bf16* CQ = (bf16*)(ws + WS_CQ); bf16* CKV = (bf16*)(ws + WS_CKV); bf16* KPE = (bf16*)(ws + WS_KPE); bf16* HQ = (bf16*)(ws + WS_HQ); bf16* HK = (bf16*)(ws + WS_HK); bf16* HV = (bf16*)(ws + WS_HV); bf16* HG = (bf16*)(ws + WS_HG);
        float* LF = (float*)(ws + WS_LF); float* SSQ = (float*)(ws + WS_SSQ); const float* LB = (const float*)(ws + WS_MISC + MISC_LB) + l * HGW; const float* COS = (const float*)(ws + WS_COS); const float* SIN = (const float*)(ws + WS_SIN);
        if (c < 640) {
            float ss = (a.x * a.x + a.y * a.y) + (a.z * a.z + a.w * a.w) + (b.x * b.x + b.y * b.y) + (b.z * b.z + b.w * b.w);
            { const auto r = __builtin_amdgcn_permlane16_swap(__float_as_uint(ss), __float_as_uint(ss), false, false); ss = __uint_as_float(r[0]) + __uint_as_float(r[1]); }
            { const auto r = __builtin_amdgcn_permlane32_swap(__float_as_uint(ss), __float_as_uint(ss), false, false); ss = __uint_as_float(r[0]) + __uint_as_float(r[1]); }
            if ((threadIdx.x & 63) < 16) SSQ[(size_t)(c >> 5) * T + row] = ss;
            const u32x4 w = pack8(a, b);
            if (c < QR) *(u32x4*)(CQ + (size_t)row * QR + c) = w; else *(u32x4*)(CKV + (size_t)row * KVR + (c - QR)) = w;
        } else if (c < 704) {
            const int g = (c - 640) >> 3;
            const f32x4 cs = *(const f32x4*)(COS + (size_t)row * 32 + 4 * g), sn = *(const f32x4*)(SIN + (size_t)row * 32 + 4 * g);
            const f32x4 o1 = a * cs - b * sn, o2 = a * sn + b * cs;
            *(u32x4*)(KPE + (size_t)row * ROPE + 8 * g) = pack8(o1, o2);
        } else if (c < 1216) {
            f32x4 x, y; x.x = siluf_(a.x); x.y = siluf_(a.y); x.z = siluf_(a.z); x.w = siluf_(a.w); y.x = siluf_(b.x); y.y = siluf_(b.y); y.z = siluf_(b.z); y.w = siluf_(b.w);
            *(u32x4*)(HQ + (size_t)row * HGW + (c - 704)) = pack8(x, y);
#if HG_V2
        } else if (c < 1728) {
            *(u32x4*)(HK + (size_t)row * HGW + (c - 1216)) = pack8(a, b);
#else
        } else if (c < 1728) {
            const int d = c - 1216;
            const f32x4 l0 = *(const f32x4*)(LB + d), l1 = *(const f32x4*)(LB + d + 4);
            f32x4 k0, k1, f0, f1;
#define HGATE(z, lb, kk, lf) do { const float zc = fminf(fmaxf((z), -60.f), 60.f); const float e = fast_exp(-zc); const float sg = __builtin_amdgcn_rcpf(1.f + e); const float om = 1.f - (lb); \
                kk = om * (e * sg); const float f = (lb) + om * sg; lf = __builtin_amdgcn_logf(fmaxf(f, 1e-30f)) * 0.6931471805599453f; } while (0)
            HGATE(a.x, l0.x, k0.x, f0.x); HGATE(a.y, l0.y, k0.y, f0.y); HGATE(a.z, l0.z, k0.z, f0.z); HGATE(a.w, l0.w, k0.w, f0.w);
            HGATE(b.x, l1.x, k1.x, f1.x); HGATE(b.y, l1.y, k1.y, f1.y); HGATE(b.z, l1.z, k1.z, f1.z); HGATE(b.w, l1.w, k1.w, f1.w);
#undef HGATE
            *(u32x4*)(HK + (size_t)row * HGW + d) = pack8(k0, k1);
            *(f32x4*)(LF + (size_t)row * HGW + d) = f0; *(f32x4*)(LF + (size_t)row * HGW + d + 4) = f1;
#endif
        } else if (c < 2240) {
            *(u32x4*)(HV + (size_t)row * HGW + (c - 1728)) = pack8(a, b);
        } else if (c < 2752) {
            *(u32x4*)(HG + (size_t)row * HGW + (c - 2240)) = pack8(a, b);
        }
    }
};
struct EpiQ {
    unsigned char* ws;
    __device__ __forceinline__ void launder() { unsigned long long w = (unsigned long long)ws; asm volatile("" : "+s"(w)); ws = (unsigned char*)(GAS unsigned char*)w;     }
    static constexpr int HAS_ROWSCALE = 1;
    __device__ __forceinline__ float rowscale(int row) const { const float* SSQ = (const float*)(ws + WS_SSQ); float s = 0.f;
#pragma unroll
        for (int i = 0; i < 12; ++i) s += SSQ[(size_t)i * T + row];
        return __builtin_amdgcn_rsqf(s * (1.f / QR) + EPS); }
    __device__ __forceinline__ void operator()(int row, int c, f32x4 a, f32x4 b) const {
        bf16* Q = (bf16*)(ws + WS_Q); const float* COS = (const float*)(ws + WS_COS); const float* SIN = (const float*)(ws + WS_SIN);
        const int h = c / DQK, cc = c - h * DQK, bb = row >> 13, sq = row & (SEQ - 1);
        bf16* dst = Q + ((size_t)((bb * NH + h) * SEQ + sq)) * DQK + cc;
        if (cc < DNOPE) { *(u32x4*)dst = pack8(a, b); }
        else { const int g = (cc - DNOPE) >> 3;
            const f32x4 cs = *(const f32x4*)(COS + (size_t)row * 32 + 4 * g), sn = *(const f32x4*)(SIN + (size_t)row * 32 + 4 * g);
            *(u32x4*)dst = pack8(a * cs - b * sn, a * sn + b * cs); }
    }
};
struct EpiKV {
    unsigned char* ws;
    __device__ __forceinline__ void launder() { unsigned long long w = (unsigned long long)ws; asm volatile("" : "+s"(w)); ws = (unsigned char*)(GAS unsigned char*)w;     }
    static constexpr int HAS_ROWSCALE = 1;
    __device__ __forceinline__ float rowscale(int row) const { const float* SSQ = (const float*)(ws + WS_SSQ); float s = 0.f;
#pragma unroll
        for (int i = 12; i < 20; ++i) s += SSQ[(size_t)i * T + row];
        return __builtin_amdgcn_rsqf(s * (1.f / KVR) + EPS); }
    __device__ __forceinline__ void operator()(int row, int c, f32x4 a, f32x4 b) const {
        bf16* KN = (bf16*)(ws + WS_KN); bf16* V = (bf16*)(ws + WS_V);
        const int h = c >> 8, cc = c & 255, bb = row >> 13, sq = row & (SEQ - 1);
        const size_t r = ((size_t)((bb * NH + h) * SEQ + sq)) * 128;
        if (cc < 128) *(u32x4*)(KN + r + cc) = pack8(a, b); else *(u32x4*)(V + r + (cc - 128)) = pack8(a, b);
    }
};
template <class TS, class TD> struct EpiResT {
    static constexpr int HAS_PAIR = 1;
    __device__ __forceinline__ void pair(int row, int c, f32x4 a0, f32x4 b0, f32x4 a1, f32x4 b1) const {
        const size_t o = (size_t)row * DM + c;
        f32x4 s0, s1, t0, t1;
        if constexpr (sizeof(TS) == 4) { s0 = *(const f32x4*)((const float*)SRC + o); s1 = *(const f32x4*)((const float*)SRC + o + 4); t0 = *(const f32x4*)((const float*)SRC + o + 128); t1 = *(const f32x4*)((const float*)SRC + o + 132); }
        else { const u32x4 w = *(const u32x4*)((const bf16*)SRC + o), v = *(const u32x4*)((const bf16*)SRC + o + 128);
            s0.x = bflo(w.x); s0.y = bfhi(w.x); s0.z = bflo(w.y); s0.w = bfhi(w.y); s1.x = bflo(w.z); s1.y = bfhi(w.z); s1.z = bflo(w.w); s1.w = bfhi(w.w);
            t0.x = bflo(v.x); t0.y = bfhi(v.x); t0.z = bflo(v.y); t0.w = bfhi(v.y); t1.x = bflo(v.z); t1.y = bfhi(v.z); t1.z = bflo(v.w); t1.w = bfhi(v.w); }
        s0 = s0 + a0; s1 = s1 + b0; t0 = t0 + a1; t1 = t1 + b1;
        if constexpr (sizeof(TD) == 4) { *(f32x4*)((float*)DST + o) = s0; *(f32x4*)((float*)DST + o + 4) = s1; *(f32x4*)((float*)DST + o + 128) = t0; *(f32x4*)((float*)DST + o + 132) = t1; }
        else { *(u32x4*)((bf16*)DST + o) = pack8(s0, s1); *(u32x4*)((bf16*)DST + o + 128) = pack8(t0, t1); }
    }
    const TS* SRC; TD* DST;
    __device__ __forceinline__ void launder() {}
    __device__ __forceinline__ void operator()(int row, int c, f32x4 a, f32x4 b) const {
        const size_t o = (size_t)row * DM + c;
        f32x4 s0, s1;
        if constexpr (sizeof(TS) == 4) { s0 = *(const f32x4*)((const float*)SRC + o); s1 = *(const f32x4*)((const float*)SRC + o + 4); }
        else { const u32x4 w = *(const u32x4*)((const bf16*)SRC + o); s0.x = bflo(w.x); s0.y = bfhi(w.x); s0.z = bflo(w.y); s0.w = bfhi(w.y); s1.x = bflo(w.z); s1.y = bfhi(w.z); s1.z = bflo(w.w); s1.w = bfhi(w.w); }
        s0 = s0 + a; s1 = s1 + b;
        if constexpr (sizeof(TD) == 4) { *(f32x4*)((float*)DST + o) = s0; *(f32x4*)((float*)DST + o + 4) = s1; }
        else *(u32x4*)((bf16*)DST + o) = pack8(s0, s1);
    }
};
template <class TS> struct EpiResNormT {
    static constexpr bool HAS_FINISH = true;
    const TS* SRC; bf16* DST; float* SSX; float ssb;
    __device__ __forceinline__ void launder() {}
    __device__ __forceinline__ void operator()(int row, int c, f32x4 a, f32x4 b) {
        const size_t o = (size_t)row * DM + c;
        f32x4 s0, s1;
        if constexpr (sizeof(TS) == 4) { s0 = *(const f32x4*)((const float*)SRC + o); s1 = *(const f32x4*)((const float*)SRC + o + 4); }
        else { const u32x4 w = *(const u32x4*)((const bf16*)SRC + o); s0.x = bflo(w.x); s0.y = bfhi(w.x); s0.z = bflo(w.y); s0.w = bfhi(w.y); s1.x = bflo(w.z); s1.y = bfhi(w.z); s1.z = bflo(w.w); s1.w = bfhi(w.w); }
        s0 = s0 + a; s1 = s1 + b;
        *(u32x4*)(DST + o) = pack8(s0, s1);
        float ss = (s0.x * s0.x + s0.y * s0.y) + (s0.z * s0.z + s0.w * s0.w) + (s1.x * s1.x + s1.y * s1.y) + (s1.z * s1.z + s1.w * s1.w);
        if ((c & 128) == 0) { ssb = ss; }
        else { ss += ssb; ss += __shfl_xor(ss, 16); ss += __shfl_xor(ss, 32);
            if ((threadIdx.x & 63) < 16) part[(row & 255) * 4 + ((c >> 5) & 3)] = ss; }
    }
    static constexpr int HAS_PAIR = 1;
    __device__ __forceinline__ void pair(int row, int c, f32x4 a0, f32x4 b0, f32x4 a1, f32x4 b1) const {
        const size_t o = (size_t)row * DM + c;
        f32x4 s0, s1, t0, t1;
        if constexpr (sizeof(TS) == 4) { s0 = *(const f32x4*)((const float*)SRC + o); s1 = *(const f32x4*)((const float*)SRC + o + 4); t0 = *(const f32x4*)((const float*)SRC + o + 128); t1 = *(const f32x4*)((const float*)SRC + o + 132); }
        else { const u32x4 w = *(const u32x4*)((const bf16*)SRC + o), v = *(const u32x4*)((const bf16*)SRC + o + 128);
            s0.x = bflo(w.x); s0.y = bfhi(w.x); s0.z = bflo(w.y); s0.w = bfhi(w.y); s1.x = bflo(w.z); s1.y = bfhi(w.z); s1.z = bflo(w.w); s1.w = bfhi(w.w);
            t0.x = bflo(v.x); t0.y = bfhi(v.x); t0.z = bflo(v.y); t0.w = bfhi(v.y); t1.x = bflo(v.z); t1.y = bfhi(v.z); t1.z = bflo(v.w); t1.w = bfhi(v.w); }
        s0 = s0 + a0; s1 = s1 + b0; t0 = t0 + a1; t1 = t1 + b1;
        *(u32x4*)(DST + o) = pack8(s0, s1); *(u32x4*)(DST + o + 128) = pack8(t0, t1);
        const f32x4 q = s0 * s0 + s1 * s1 + (t0 * t0 + t1 * t1);
        float ss = (q.x + q.y) + (q.z + q.w);
        { const auto r = __builtin_amdgcn_permlane16_swap(__float_as_uint(ss), __float_as_uint(ss), false, false); ss = __uint_as_float(r[0]) + __uint_as_float(r[1]); }
        { const auto r = __builtin_amdgcn_permlane32_swap(__float_as_uint(ss), __float_as_uint(ss), false, false); ss = __uint_as_float(r[0]) + __uint_as_float(r[1]); }
        if ((threadIdx.x & 63) < 16) part[(row & 255) * 4 + (__builtin_amdgcn_readfirstlane(c) >> 5 & 3)] = ss;
    }
    LAS float* part;
    __device__ __forceinline__ void finish(int pm, int pn, int tid) {
        asm volatile("s_waitcnt lgkmcnt(0)" ::: "memory"); __builtin_amdgcn_s_barrier(); asm volatile("" ::: "memory");
        if (tid < 256) { const LAS float* q = part + tid * 4; SSX[(size_t)pn * T + pm * 256 + tid] = (q[0] + q[1]) + (q[2] + q[3]); }
    }
};
struct EpiSwiglu {
    bf16* HID; int ff; int rowbase; const float* SSX;
    static constexpr int HAS_ROWSCALE = 1;
    __device__ __forceinline__ void launder() {}
    __device__ __forceinline__ float rowscale(int row) const { if (!SSX) return 1.f; const float* sx = SSX + row; return __builtin_amdgcn_rsqf(((sx[0] + sx[T]) + (sx[2 * T] + sx[3 * T])) * (1.f / DM) + EPS); }
    __device__ __forceinline__ void operator()(int row, int c, f32x4 a, f32x4 b) const {
        const f32x2v h0 = silu_mul_pk((f32x2v){a.x, a.y}, (f32x2v){b.x, b.y}), h1 = silu_mul_pk((f32x2v){a.z, a.w}, (f32x2v){b.z, b.w});
        u32x2 w; w.x = pk2(h0.x, h0.y); w.y = pk2(h1.x, h1.y);
        *(u32x2*)(HID + (size_t)(row - rowbase) * ff + (c >> 1)) = w;
    }
    static constexpr int HAS_QUAD = 1;
    __device__ __forceinline__ void quad(int rowA, int c, int fq, const f32x4 (&A)[4][2], const float (&rs)[4]) const {
#pragma unroll
        for (int mp = 0; mp < 4; mp += 2) {
            u32x2 X, Y;
            { const f32x4 a = A[mp][0] * rs[mp], b = A[mp][1] * rs[mp]; const f32x2v h0 = silu_mul_pk((f32x2v){a.x, a.y}, (f32x2v){b.x, b.y}), h1 = silu_mul_pk((f32x2v){a.z, a.w}, (f32x2v){b.z, b.w}); X.x = pk2(h0.x, h0.y); X.y = pk2(h1.x, h1.y); }
            { const f32x4 a = A[mp + 1][0] * rs[mp + 1], b = A[mp + 1][1] * rs[mp + 1]; const f32x2v h0 = silu_mul_pk((f32x2v){a.x, a.y}, (f32x2v){b.x, b.y}), h1 = silu_mul_pk((f32x2v){a.z, a.w}, (f32x2v){b.z, b.w}); Y.x = pk2(h0.x, h0.y); Y.y = pk2(h1.x, h1.y); }
            const auto sx = __builtin_amdgcn_permlane16_swap(X.x, Y.x, false, false), sy = __builtin_amdgcn_permlane16_swap(X.y, Y.y, false, false);
            u32x4 w; w.x = sx[0]; w.y = sy[0]; w.z = sx[1]; w.w = sy[1];
            const int odd = fq & 1;
            *(u32x4*)(HID + (size_t)(rowA + 16 * (mp + odd) - rowbase) * ff + ((c - 8 * odd) >> 1)) = w;
        }
    }
};
struct EpiSwiglu8 {
    unsigned char* HID; int ff; int rowbase;
    __device__ __forceinline__ void launder() {}
    __device__ __forceinline__ void operator()(int row, int c, f32x4 a, f32x4 b) const {
        const f32x2v h0 = silu_mul_pk((f32x2v){a.x, a.y}, (f32x2v){b.x, b.y}), h1 = silu_mul_pk((f32x2v){a.z, a.w}, (f32x2v){b.z, b.w});
        *(unsigned*)(HID + (size_t)(row - rowbase) * ff + (c >> 1)) = pk4_fp8(h0.x, h0.y, h1.x, h1.y);
    }
    static constexpr int HAS_QUAD = 1;
    __device__ __forceinline__ float rowscale(int) const { return 1.f; }
    __device__ __forceinline__ void quad(int rowA, int c, int fq, const f32x4 (&A)[4][2], const float (&)[4]) const {
        unsigned d[4];
#pragma unroll
        for (int m = 0; m < 4; ++m) { const f32x4 a = A[m][0], b = A[m][1]; const f32x2v h0 = silu_mul_pk((f32x2v){a.x, a.y}, (f32x2v){b.x, b.y}), h1 = silu_mul_pk((f32x2v){a.z, a.w}, (f32x2v){b.z, b.w}); d[m] = pk4_fp8(h0.x, h0.y, h1.x, h1.y); }
        const auto r02 = __builtin_amdgcn_permlane32_swap(d[0], d[2], false, false), r13 = __builtin_amdgcn_permlane32_swap(d[1], d[3], false, false);
        const auto s01 = __builtin_amdgcn_permlane16_swap(r02[0], r13[0], false, false), s23 = __builtin_amdgcn_permlane16_swap(r02[1], r13[1], false, false);
        u32x4 w; w.x = s01[0]; w.y = s01[1]; w.z = s23[0]; w.w = s23[1];
        *(u32x4*)(HID + (size_t)(rowA + 16 * fq - rowbase) * ff + ((c - 8 * fq) >> 1)) = w;
    }
};
struct EpiProbe {
    float* sink;
    __device__ __forceinline__ void launder() {}
    __device__ __forceinline__ void operator()(int row, int c, f32x4 a, f32x4 b) const { if (a.x == 123456.789f && b.w == -98765.4321f) sink[row * 8 + (c & 7)] = a.y; }
};
struct EpiBf16Plain {
    bf16* O; int ld;
    __device__ __forceinline__ void launder() {}
    __device__ __forceinline__ void operator()(int row, int c, f32x4 a, f32x4 b) const { *(u32x4*)(O + (size_t)row * ld + c) = pack8(a, b); }
};

namespace pg8 {
#define PG8_LAS __attribute__((address_space(3)))
typedef unsigned short bf16_t;
typedef short bf16x8 __attribute__((ext_vector_type(8)));
typedef float f32x4 __attribute__((ext_vector_type(4)));
typedef unsigned u32x4 __attribute__((ext_vector_type(4)));
typedef int v4i_t __attribute__((ext_vector_type(4)));
typedef int v8i_t __attribute__((ext_vector_type(8)));
constexpr int BM = 256, BK = 64, HALF = 128, HTB = HALF * BK * 2  , STAGE_BYTES = 8 * HTB, NXCD = 8, WGM = 8;

__host__ __device__ __forceinline__ int lds_byte(int r, int c) { const int st = (r >> 4) * 2 + (c >> 5), rr = r & 15, cc = c & 31, ob = rr * 64 + cc * 2; return st * 1024 + (ob ^ (((ob >> 9) & 1) << 5)); }
__host__ __device__ __forceinline__ void stage_rc(int b, int& R, int& C) { const int st = b / 1024, sb = b % 1024, swz = sb ^ (((sb >> 9) & 1) << 5); R = (st >> 1) * 16 + swz / 64; C = (st & 1) * 32 + (swz % 64) / 2; }
__host__ __device__ __forceinline__ int perm32(int rho) { const int n = rho >> 4, i = rho & 15; return 8 * (i >> 2) + 4 * n + (i & 3); }

template <class E, class = void> struct has_finish { static constexpr bool value = false; };
template <class E> struct has_finish<E, decltype((void)E::HAS_FINISH)> { static constexpr bool value = true; };
template <class E, class = void> struct has_pair { static constexpr bool value = false; };
template <class E> struct has_pair<E, decltype((void)E::HAS_PAIR)> { static constexpr bool value = true; };
template <class E, class = void> struct has_quad { static constexpr bool value = false; };
template <class E> struct has_quad<E, decltype((void)E::HAS_QUAD)> { static constexpr bool value = true; };
template <class E, class = void> struct has_rowscale { static constexpr bool value = false; };
template <class E> struct has_rowscale<E, decltype((void)E::HAS_ROWSCALE)> { static constexpr bool value = true; };
struct Unit { int pm, pn, pa, pb; };
struct Gemm { const bf16_t* A; const bf16_t* Bt; int M, N, K; int wscale; int ld; };

struct StaticOrder {
    int nM, nN, nwg, G, c;
    __host__ __device__ void init(int M, int N, int G_, int c_) { nM = M / BM; nN = N / BM; nwg = nM * nN; G = G_; c = c_; }
    __host__ __device__ bool next(int i, Unit& u) const {
        const long L = (long)i * G + c; if (L >= nwg) return false;
        int wgid = (int)L; { const int q = nwg / NXCD, r = nwg % NXCD, xcd = wgid % NXCD, off = wgid / NXCD; wgid = (xcd < r ? xcd * (q + 1) : r * (q + 1) + (xcd - r) * q) + off; }
        const int nig = WGM * nN, gid = wgid / nig, fm = gid * WGM, gsz = (nM - fm) < WGM ? (nM - fm) : WGM;
        u.pm = fm + ((wgid % nig) % gsz); u.pn = (wgid % nig) / gsz; u.pa = u.pm; u.pb = u.pn; return true;
    }
    __device__ __forceinline__ void a_ready(const Unit&) const {}
    __device__ __forceinline__ void done(const Unit&) const {}
};
template <class Epi, class Sched, bool ALIGN_EPI = false, bool SP2 = false, bool FP8 = false>
__device__ __forceinline__ void gemm_phase(PG8_LAS unsigned char* lds, const Gemm g, const Sched& S, const Epi& E) {
    int tid_ = threadIdx.x; asm volatile("" : "+v"(tid_));
    const int tid = tid_, wid = __builtin_amdgcn_readfirstlane(tid >> 6), lane = tid & 63, wr = wid >> 2, wc = wid & 3, fr = lane & 15, fq = lane >> 4;
    const int K = g.ld ? g.ld : g.K, nt = g.K / BK;
    unsigned voffA[2], voffB[2];
#pragma unroll
    for (int i = 0; i < 2; ++i) { int R, C; stage_rc(tid * 16 + i * 8192, R, C); const int Rb = (R & ~31) + perm32(R & 31);
        voffA[i] = (unsigned)(R * K + C) * 2u; voffB[i] = (unsigned)(Rb * K + C) * 2u; }
    const size_t kstep = (size_t)(BK * 2);
    const size_t hstep = (size_t)HALF * K * 2;
    const size_t tstep = 2 * hstep;
    const unsigned ldsw = (unsigned)wid * 1024u;
    const int aoff = lds_byte(wr * 64 + fr, fq * 8), boff = lds_byte(wc * 32 + fr, fq * 8);
#define PG8_SA(b, h) (((b) * 2 + (h)) * HTB)
#define PG8_SB(b, h) ((4 + (b) * 2 + (h)) * HTB)
#define PG8_STAGE(bufoff, gbase, voff) do { _Pragma("unroll") for (int _i = 0; _i < 2; ++_i) \
        __builtin_amdgcn_global_load_lds((const unsigned*)((const char*)(gbase) + (voff)[_i]), (PG8_LAS unsigned*)(lds + (bufoff) + ldsw + _i * 8192), 16, 0, 0); } while (0)
#define PG8_RD(off) (*(const PG8_LAS bf16x8*)(lds + (off)))
#define PG8_CAT(lo, hi) __builtin_shufflevector(__builtin_bit_cast(v4i_t, lo), __builtin_bit_cast(v4i_t, hi), 0, 1, 2, 3, 4, 5, 6, 7)
#define PG8_LDA(dst, b, h) do { _Pragma("unroll") for (int m = 0; m < 4; ++m) { if constexpr (FP8) dst##8[m] = PG8_CAT(PG8_RD(PG8_SA(b, h) + aoff + m * 2048), PG8_RD(PG8_SA(b, h) + aoff + m * 2048 + 1024)); \
        else { dst[m][0] = PG8_RD(PG8_SA(b, h) + aoff + m * 2048); dst[m][1] = PG8_RD(PG8_SA(b, h) + aoff + m * 2048 + 1024); } } } while (0)
#define PG8_LDB(dst, b, h) do { _Pragma("unroll") for (int n = 0; n < 2; ++n) { if constexpr (FP8) dst##8[n] = PG8_CAT(PG8_RD(PG8_SB(b, h) + boff + n * 2048), PG8_RD(PG8_SB(b, h) + boff + n * 2048 + 1024)); \
        else { dst[n][0] = PG8_RD(PG8_SB(b, h) + boff + n * 2048); dst[n][1] = PG8_RD(PG8_SB(b, h) + boff + n * 2048 + 1024); } } } while (0)
#define PG8_MMA(ai, bj, At, Bt) do { __builtin_amdgcn_s_setprio(1); if constexpr (FP8) { _Pragma("unroll") for (int m = 0; m < 4; ++m) _Pragma("unroll") for (int n = 0; n < 2; ++n) \
        asm volatile("v_mfma_scale_f32_16x16x128_f8f6f4 %0, %1, %2, %0, %3, %4 op_sel_hi:[0,0,0]" : "+v"(acc[ai][bj][m][n]) : "v"(Bt##8[n]), "v"(At##8[m]), "v"(sc_w), "v"(sc_1)); } \
        else { _Pragma("unroll") for (int m = 0; m < 4; ++m) _Pragma("unroll") for (int n = 0; n < 2; ++n) _Pragma("unroll") for (int k = 0; k < 2; ++k) \
        acc[ai][bj][m][n] = __builtin_amdgcn_mfma_f32_16x16x32_bf16(Bt[n][k], At[m][k], acc[ai][bj][m][n], 0, 0, 0); } __builtin_amdgcn_s_setprio(0); } while (0)
#define PG8_WAIT_V(n) asm volatile("s_waitcnt vmcnt(" #n ")" ::: "memory")
#define PG8_WAIT_L(n) asm volatile("s_waitcnt lgkmcnt(" #n ")" ::: "memory")
#define PG8_BAR __builtin_amdgcn_s_barrier()
#define PG8_SCHED __builtin_amdgcn_sched_barrier(0)
    Unit cur, nxt; int ui = 0;
    if (!S.next(0, cur)) return;
    f32x4 acc[2][2][4][2];
#pragma unroll
    for (int a = 0; a < 2; ++a)
#pragma unroll
        for (int b = 0; b < 2; ++b)
#pragma unroll
            for (int m = 0; m < 4; ++m)
#pragma unroll
                for (int n = 0; n < 2; ++n) acc[a][b][m][n] = (f32x4){0.f, 0.f, 0.f, 0.f};
    const int sc_w = g.wscale, sc_1 = 0x7F7F7F7F;
    bf16x8 At[4][2], B0[2][2], B1[2][2]; v8i_t At8[4], B08[2], B18[2];
    const char* cA = (const char*)g.A + (size_t)cur.pa * tstep; const char* cB = (const char*)g.Bt + (size_t)cur.pb * tstep;
    S.a_ready(cur);
    if constexpr (SP2) {
        PG8_STAGE(PG8_SB(0, 0), cB, voffB); PG8_STAGE(PG8_SB(0, 1), cB + hstep, voffB); PG8_STAGE(PG8_SA(0, 0), cA, voffA); PG8_STAGE(PG8_SA(0, 1), cA + hstep, voffA);
        if (wr == 1) PG8_BAR;
        PG8_WAIT_V(2); PG8_BAR;
        PG8_STAGE(PG8_SB(1, 0), cB + kstep, voffB); PG8_STAGE(PG8_SA(1, 0), cA + kstep, voffA); PG8_STAGE(PG8_SB(1, 1), cB + hstep + kstep, voffB);
        PG8_WAIT_V(6); PG8_BAR;
    } else {
        PG8_STAGE(PG8_SB(0, 0), cB, voffB); PG8_STAGE(PG8_SA(0, 0), cA, voffA); PG8_STAGE(PG8_SB(0, 1), cB + hstep, voffB); PG8_STAGE(PG8_SA(0, 1), cA + hstep, voffA);
        if (wr == 1) PG8_BAR;
        PG8_WAIT_V(4); PG8_BAR;
        PG8_STAGE(PG8_SB(1, 0), cB + kstep, voffB); PG8_STAGE(PG8_SA(1, 0), cA + kstep, voffA); PG8_STAGE(PG8_SB(1, 1), cB + hstep + kstep, voffB);
        PG8_WAIT_V(6); PG8_BAR;
    }
    for (;;) {
        const bool has_next = S.next(ui + 1, nxt);
        const char* nA = has_next ? (const char*)g.A + (size_t)nxt.pa * tstep : cA; const char* nB = has_next ? (const char*)g.Bt + (size_t)nxt.pb * tstep : cB;
#pragma nounroll
        for (int t = 0; t < nt; t += 2) {
            const bool last = (t == nt - 2);
            const char* a1 = cA + (size_t)(t + 1) * kstep;
            const char* a2 = last ? nA : cA + (size_t)(t + 2) * kstep; const char* b2 = last ? nB : cB + (size_t)(t + 2) * kstep;
            const char* a3 = a2 + kstep; const char* b3 = b2 + kstep;
            if (last && has_next) S.a_ready(nxt);
            if constexpr (SP2) {
            PG8_LDB(B0, 0, 0); PG8_LDB(B1, 0, 1); PG8_SCHED; PG8_LDA(At, 0, 0); PG8_STAGE(PG8_SA(1, 1), a1 + hstep, voffA);
            PG8_WAIT_V(8); PG8_WAIT_L(0); PG8_BAR; PG8_MMA(0, 0, At, B0); PG8_MMA(0, 1, At, B1); PG8_BAR; PG8_SCHED;
            PG8_LDA(At, 0, 1); PG8_STAGE(PG8_SB(0, 0), b2, voffB); PG8_STAGE(PG8_SB(0, 1), b2 + hstep, voffB); PG8_STAGE(PG8_SA(0, 0), a2, voffA);
            PG8_WAIT_V(8); PG8_WAIT_L(0); PG8_BAR; PG8_MMA(1, 0, At, B0); PG8_MMA(1, 1, At, B1); PG8_BAR; PG8_SCHED;
            PG8_LDB(B0, 1, 0); PG8_LDB(B1, 1, 1); PG8_SCHED; PG8_LDA(At, 1, 0); PG8_STAGE(PG8_SA(0, 1), a2 + hstep, voffA);
            PG8_WAIT_V(8); PG8_WAIT_L(0); PG8_BAR; PG8_MMA(0, 0, At, B0); PG8_MMA(0, 1, At, B1); PG8_BAR; PG8_SCHED;
            PG8_LDA(At, 1, 1); PG8_STAGE(PG8_SB(1, 0), b3, voffB); PG8_STAGE(PG8_SB(1, 1), b3 + hstep, voffB); PG8_STAGE(PG8_SA(1, 0), a3, voffA);
            PG8_WAIT_V(8); PG8_WAIT_L(0); PG8_BAR; PG8_MMA(1, 0, At, B0); PG8_MMA(1, 1, At, B1); PG8_BAR; PG8_SCHED;
            } else {
            PG8_LDB(B0, 0, 0); PG8_SCHED; PG8_LDA(At, 0, 0); PG8_STAGE(PG8_SA(1, 1), a1 + hstep, voffA);
            PG8_WAIT_L(8); PG8_BAR; PG8_WAIT_L(0); PG8_MMA(0, 0, At, B0); PG8_BAR; PG8_SCHED;
            PG8_LDB(B1, 0, 1); PG8_STAGE(PG8_SB(0, 0), b2, voffB);
            PG8_BAR; PG8_WAIT_L(0); PG8_MMA(0, 1, At, B1); PG8_BAR;
            PG8_LDA(At, 0, 1); PG8_STAGE(PG8_SA(0, 0), a2, voffA);
            PG8_BAR; PG8_WAIT_L(0); PG8_MMA(1, 0, At, B0); PG8_BAR; PG8_SCHED;
            PG8_STAGE(PG8_SB(0, 1), b2 + hstep, voffB);
            PG8_WAIT_V(6); PG8_BAR; PG8_MMA(1, 1, At, B1); PG8_BAR;
            PG8_LDB(B0, 1, 0); PG8_SCHED; PG8_LDA(At, 1, 0); PG8_STAGE(PG8_SA(0, 1), a2 + hstep, voffA);
            PG8_WAIT_L(8); PG8_BAR; PG8_WAIT_L(0); PG8_MMA(0, 0, At, B0); PG8_BAR; PG8_SCHED;
            PG8_LDB(B1, 1, 1); PG8_STAGE(PG8_SB(1, 0), b3, voffB);
            PG8_BAR; PG8_WAIT_L(0); PG8_MMA(0, 1, At, B1); PG8_BAR;
            PG8_LDA(At, 1, 1); PG8_STAGE(PG8_SA(1, 0), a3, voffA);
            PG8_BAR; PG8_WAIT_L(0); PG8_MMA(1, 0, At, B0); PG8_BAR; PG8_SCHED;
            PG8_STAGE(PG8_SB(1, 1), b3 + hstep, voffB);
            PG8_WAIT_V(6); PG8_BAR; PG8_MMA(1, 1, At, B1); PG8_BAR;
            }
        }
        if constexpr (ALIGN_EPI) { if (wr == 0) PG8_BAR; }
        if constexpr (FP8) asm volatile("s_nop 15\n\ts_nop 15" ::: "memory");
        {
            int fr_ = fr, fq_ = fq; asm volatile("" : "+v"(fr_), "+v"(fq_));
            const int row0 = cur.pm * BM + wr * 64 + fr_, col0 = cur.pn * BM + wc * 32 + 8 * fq_;
            Epi E2 = E; E2.launder();
            if constexpr (has_quad<Epi>::value) {
                float rs[2][4];
#pragma unroll
                for (int ai = 0; ai < 2; ++ai)
#pragma unroll
                    for (int m = 0; m < 4; ++m) rs[ai][m] = E2.rowscale(row0 + ai * HALF + m * 16);
#pragma unroll
                for (int ai = 0; ai < 2; ++ai)
#pragma unroll
                    for (int bj = 0; bj < 2; ++bj) E2.quad(row0 + ai * HALF, col0 + bj * HALF, fq_, acc[ai][bj], rs[ai]);
            } else if constexpr (has_pair<Epi>::value) {
#pragma unroll
                for (int ai = 0; ai < 2; ++ai)
#pragma unroll
                    for (int m = 0; m < 4; ++m) E2.pair(row0 + ai * HALF + m * 16, col0, acc[ai][0][m][0], acc[ai][0][m][1], acc[ai][1][m][0], acc[ai][1][m][1]);
            } else if constexpr (has_rowscale<Epi>::value) {
#pragma unroll
                for (int ai = 0; ai < 2; ++ai) {
                    float rs[4];
#pragma unroll
                    for (int m = 0; m < 4; ++m) rs[m] = E2.rowscale(row0 + ai * HALF + m * 16);
                    asm volatile("" ::: "memory");
#pragma unroll
                    for (int m = 0; m < 4; ++m)
#pragma unroll
                        for (int bj = 0; bj < 2; ++bj) E2(row0 + ai * HALF + m * 16, col0 + bj * HALF, acc[ai][bj][m][0] * rs[m], acc[ai][bj][m][1] * rs[m]);
                    asm volatile("" ::: "memory");
                }
            } else {
#pragma unroll
            for (int ai = 0; ai < 2; ++ai)
#pragma unroll
                for (int m = 0; m < 4; ++m)
#pragma unroll
                    for (int bj = 0; bj < 2; ++bj) E2(row0 + ai * HALF + m * 16, col0 + bj * HALF, acc[ai][bj][m][0], acc[ai][bj][m][1]);
            }
            if constexpr (has_finish<Epi>::value) E2.finish(cur.pm, cur.pn, tid);
            S.done(cur);
        }
        if (!has_next) break;
#pragma unroll
        for (int a = 0; a < 2; ++a)
#pragma unroll
            for (int b = 0; b < 2; ++b)
#pragma unroll
                for (int m = 0; m < 4; ++m)
#pragma unroll
                    for (int n = 0; n < 2; ++n) acc[a][b][m][n] = (f32x4){0.f, 0.f, 0.f, 0.f};
        cur = nxt; cA = nA; cB = nB; ++ui;
        if constexpr (ALIGN_EPI) { if (wr == 1) PG8_BAR; }
    }
    PG8_WAIT_V(0);
    if constexpr (!ALIGN_EPI) { if (wr == 0) PG8_BAR; }
    PG8_BAR;
#undef PG8_SA
#undef PG8_SB
#undef PG8_STAGE
#undef PG8_LDA
#undef PG8_RD
#undef PG8_LDB
#undef PG8_MMA
#undef PG8_CAT
#undef PG8_WAIT_V
#undef PG8_WAIT_L
#undef PG8_BAR
#undef PG8_SCHED
}

struct MoeOrder {
    StaticOrder so; int t0, abase, nN; const int* tile_e;
    __device__ void init(int t0_, int t1_, int N, int G_, int c_, const int* te, int abase_) { so.init((t1_ - t0_) * BM, N, G_, c_); t0 = t0_; abase = abase_; nN = N / BM; tile_e = te; }
    __device__ bool next(int i, Unit& u) const { if (!so.next(i, u)) return false; u.pm += t0; u.pa = u.pm - abase; u.pb = __builtin_amdgcn_readfirstlane(tile_e[u.pm]) * nN + u.pn; return true; }
    __device__ __forceinline__ void a_ready(const Unit&) const {}
    __device__ __forceinline__ void done(const Unit&) const {}
};
}

template <class Epi>
__device__ __forceinline__ void simple_gemm(const Ctx& X, const bf16* A, const bf16* Bt, int row_lo, int nrows, int N, int K, const int* tile_e, size_t expert_stride, int a_rowbase, const Epi& E) {
    const int fr = X.lane & 15, fq = X.lane >> 4;
    const int ncb = N / 32, ntile = (nrows / 16) * ncb;
    const int gw = X.bid * NWAVES + X.wave, ngw = X.nblk * NWAVES;
    for (int t = gw; t < ntile; t += ngw) {
        const int tm = t / ncb, tn = t - tm * ncb, r0 = row_lo + tm * 16, c0 = tn * 32;
        const bf16* Bb = Bt; if (tile_e) Bb += (size_t)tile_e[r0 >> 8] * expert_stride;
        const bf16* arow = A + (size_t)(r0 - a_rowbase + fr) * K + 8 * fq;
        const bf16* b0 = Bb + (size_t)(c0 + perm32(fr)) * K + 8 * fq;
        const bf16* b1 = Bb + (size_t)(c0 + perm32(16 + fr)) * K + 8 * fq;
        f32x4 acc0 = {0.f, 0.f, 0.f, 0.f}, acc1 = {0.f, 0.f, 0.f, 0.f};
        for (int k = 0; k < K; k += 32) {
            const bf16x8 a = *(const bf16x8*)(arow + k), w0 = *(const bf16x8*)(b0 + k), w1 = *(const bf16x8*)(b1 + k);
            acc0 = __builtin_amdgcn_mfma_f32_16x16x32_bf16(w0, a, acc0, 0, 0, 0);
            acc1 = __builtin_amdgcn_mfma_f32_16x16x32_bf16(w1, a, acc1, 0, 0, 0);
        }
        E(r0 + fr, c0 + 8 * fq, acc0, acc1);
    }
}


namespace pg8 { struct OneUnit { Unit u; bool have;
    __device__ bool next(int i, Unit& o) const { if (i != 0 || !have) return false; o = u; return true; }
    __device__ __forceinline__ void a_ready(const Unit&) const {}
    __device__ __forceinline__ void done(const Unit&) const {} }; }
struct EpiSlab {
    float* slab; int ks;
    __device__ __forceinline__ void launder() {}
    __device__ __forceinline__ void operator()(int row, int c, f32x4 a, f32x4 b) const {
        float* d = slab + ((size_t)((((row >> 8) - 128) * 4 + (c >> 8)) * 7 + ks) * 256 + (row & 255)) * 256 + (c & 255);
        *(f32x4*)d = a; *(f32x4*)(d + 4) = b; }
};
template <class Epi>
__device__ __forceinline__ void gemm_dense(const Ctx& X, const bf16* A, const bf16* Bt, int N, int K, const Epi& E) {
#if FAST_GEMM
    pg8::Gemm g{A, Bt, T, N, K, 0}; pg8::StaticOrder S; S.init(T, N, X.nblk, X.bid);
    pg8::gemm_phase<Epi, pg8::StaticOrder, true, true>(X.lds, g, S, E);
#else
    simple_gemm(X, A, Bt, 0, T, N, K, nullptr, 0, 0, E);
#endif
}
template <class Epi>
__device__ __forceinline__ void gemm_moe(const Ctx& X, const bf16* A, const bf16* Bt, int t0, int t1, int N, int K, const int* tile_e, int abase, int wscale, const Epi& E) {
#if FAST_GEMM
    pg8::Gemm g{A, Bt, (t1 - t0) * 256, N, K, wscale, 0}; pg8::MoeOrder S; S.init(t0, t1, N, X.nblk, X.bid, tile_e, abase);
    pg8::gemm_phase<Epi, pg8::MoeOrder, true, true, MOE_FP8 != 0>(X.lds, g, S, E);
#else
    simple_gemm(X, A, Bt, t0 * 256, (t1 - t0) * 256, N, K, tile_e, (size_t)N * K, abase * 256, E);
#endif
}

struct SrcPlain { const float* W; int N; __device__ __forceinline__ f32x4 load4(int k, int n4) const { return *(const f32x4*)(W + (size_t)k * N + n4); } };
struct SrcScaled { const float* W; int N; const float* rs; __device__ __forceinline__ f32x4 load4(int k, int n4) const { return *(const f32x4*)(W + (size_t)k * N + n4) * rs[k]; } };
__device__ __forceinline__ int rope_src(int j) { const int g = j >> 3, jj = j & 7; return (jj < 4) ? (4 * g + jj) : (32 + 4 * g + (jj - 4)); }
struct SrcIn { const float* W; const float* rs;
    __device__ __forceinline__ f32x4 load4(int k, int n4) const { if (n4 >= NPROJ) return (f32x4){0.f, 0.f, 0.f, 0.f}; int m = n4; if (n4 >= 640 && n4 < 704) m = 640 + rope_src(n4 - 640); const f32x4 v = *(const f32x4*)(W + (size_t)k * NPROJ + m); return rs ? v * rs[k] : v; } };
struct SrcQB { const float* W; const float* gain;
    __device__ __forceinline__ f32x4 load4(int k, int n4) const { const int h = n4 / DQK; int c = n4 - h * DQK; if (c >= DNOPE) c = DNOPE + rope_src(c - DNOPE);
        return *(const f32x4*)(W + (size_t)k * (NH * DQK) + h * DQK + c) * (gain[k] * 0.07216878364870322f); } };
struct SrcGU { const float* Wg; const float* Wu; int FF; const float* rs;
    __device__ __forceinline__ f32x4 load4(int k, int n4) const { const int g = n4 >> 3; const long long d = (n4 & 4) ? (long long)(Wu - Wg) : 0ll; const f32x4 v = *(const f32x4*)(Wg + d + (long long)k * FF + 4 * g); return rs ? v * rs[k] : v; } };

template <class Src>
__device__ __forceinline__ void transpose_item(const Src& S, int K, int nblk, bf16* WT, LAS float* scr, int item, int lane) {
    const int kb = item / nblk, nb = item - kb * nblk, k0 = 64 * kb, n0 = 32 * nb;
    const int kk0 = lane >> 3, qd = lane & 7;
    f32x4 v[8];
#pragma unroll
    for (int i = 0; i < 8; ++i) v[i] = S.load4(k0 + 8 * i + kk0, n0 + 4 * qd);
#pragma unroll
    for (int i = 0; i < 8; ++i) { LAS float* d = scr + (8 * i + kk0) * 33 + 4 * qd; d[0] = v[i].x; d[1] = v[i].y; d[2] = v[i].z; d[3] = v[i].w; }
    asm volatile("s_waitcnt lgkmcnt(0)" ::: "memory");
    const int c = lane & 7;
#pragma unroll
    for (int j = 0; j < 4; ++j) { const int n = (lane >> 3) + 8 * j; const LAS float* s = scr + (8 * c) * 33 + n;
        u32x4 o; o.x = pk2(s[0 * 33], s[1 * 33]); o.y = pk2(s[2 * 33], s[3 * 33]); o.z = pk2(s[4 * 33], s[5 * 33]); o.w = pk2(s[6 * 33], s[7 * 33]);
        *(u32x4*)(WT + (size_t)(n0 + n) * K + k0 + 8 * c) = o; }
    asm volatile("s_waitcnt lgkmcnt(0)" ::: "memory");
}

template <class Src>
__device__ __forceinline__ void transpose_item_fp8(const Src& S, int K, int nblk, unsigned char* WT, LAS float* scr, int item, int lane, float scale) {
    const int kb = item / nblk, nb = item - kb * nblk, k0 = 64 * kb, n0 = 32 * nb;
    const int kk0 = lane >> 3, qd = lane & 7;
    f32x4 v[8];
#pragma unroll
    for (int i = 0; i < 8; ++i) v[i] = S.load4(k0 + 8 * i + kk0, n0 + 4 * qd);
#pragma unroll
    for (int i = 0; i < 8; ++i) { LAS float* d = scr + (8 * i + kk0) * 33 + 4 * qd; d[0] = v[i].x * scale; d[1] = v[i].y * scale; d[2] = v[i].z * scale; d[3] = v[i].w * scale; }
    asm volatile("s_waitcnt lgkmcnt(0)" ::: "memory");
    const int c = lane & 3;
#pragma unroll
    for (int j = 0; j < 2; ++j) { const int n = (lane >> 2) + 16 * j; const LAS float* s = scr + (16 * c) * 33 + n;
        u32x4 o; o.x = pk4_fp8(s[0 * 33], s[1 * 33], s[2 * 33], s[3 * 33]); o.y = pk4_fp8(s[4 * 33], s[5 * 33], s[6 * 33], s[7 * 33]);
        o.z = pk4_fp8(s[8 * 33], s[9 * 33], s[10 * 33], s[11 * 33]); o.w = pk4_fp8(s[12 * 33], s[13 * 33], s[14 * 33], s[15 * 33]);
        *(u32x4*)(WT + (size_t)(n0 + n) * K + k0 + 16 * c) = o; }
    asm volatile("s_waitcnt lgkmcnt(0)" ::: "memory");
}

template <int NR, class TS>
__device__ __forceinline__ void norm_rows_bf16(const TS* src, const float* gain, bf16* dst, int row0, int rstep, int lane) {
    f32x4 v[NR][4];
#pragma unroll
    for (int i = 0; i < NR; ++i)
#pragma unroll
        for (int j = 0; j < 4; ++j) v[i][j] = ldrow4(src + (size_t)(row0 + i * rstep) * DM, lane + 64 * j);
    f32x4 g[4];
#pragma unroll
    for (int j = 0; j < 4; ++j) g[j] = *((const f32x4*)gain + lane + 64 * j);
#pragma unroll
    for (int i = 0; i < NR; ++i) { float s = 0.f;
#pragma unroll
        for (int j = 0; j < 4; ++j) s += (v[i][j].x * v[i][j].x + v[i][j].y * v[i][j].y) + (v[i][j].z * v[i][j].z + v[i][j].w * v[i][j].w);
        const float rstd = __builtin_amdgcn_rsqf(wave_sum(s) * (1.f / DM) + EPS);
#pragma unroll
        for (int j = 0; j < 4; ++j) { const f32x4 y = v[i][j] * rstd * g[j]; u32x2 w; w.x = pk2(y.x, y.y); w.y = pk2(y.z, y.w); *((u32x2*)(dst + (size_t)(row0 + i * rstep) * DM) + lane + 64 * j) = w; } }
}
template <class TS>
__device__ __forceinline__ void norm_all_rows(const Ctx& X, const TS* src, const float* gain, bf16* dst) {
    const int gw = X.bid * NWAVES + X.wave, ngw = X.nblk * NWAVES;
    int m = gw;
    for (; m + 3 * ngw < T; m += 4 * ngw) norm_rows_bf16<4, TS>(src, gain, dst, m, ngw, X.lane);
    for (; m < T; m += ngw) norm_rows_bf16<1, TS>(src, gain, dst, m, ngw, X.lane);
}

constexpr int TAIL_A = 64 * 8 * TAILFILL_A, TAIL_B = 64 * 8 * TAILFILL_B, TAIL_C = 128 * 8 * TAILFILL_C;
constexpr int TAIL_ITEMS = TAILFILL ? (2 * TAIL_A + 2 * TAIL_B + TAIL_C) : 0;
constexpr int MDN_ITEMS = NE * 56 * 32;
constexpr int MGU_ITEMS = NE * 16 * 224;
static_assert(TAIL_ITEMS <= MDN_ITEMS + MGU_ITEMS, "tail slices exceed the expert weight copy items");
__device__ __forceinline__ void tail_fill(const Ctx& X, const Params& p, int slice_first, int per_wave, int rank, int nranks) {
    unsigned char* ws = p.ws; LAS float* scr = (LAS float*)(X.lds + X.wave * 16384);
    constexpr int I_MDN = 56 * 32, I_MGU = 16 * 224;
#pragma unroll 1
    for (int k = 0; k < per_wave; ++k) { const int idx = (MGU_ITEMS + MDN_ITEMS - TAIL_ITEMS) + slice_first + (k * nranks + rank) * NWAVES + X.wave;
        if (idx < MGU_ITEMS) { const int e = idx / I_MGU, r = idx - e * I_MGU; SrcGU S{p.in[I_MWG] + (size_t)e * DM * FFM, p.in[I_MWU] + (size_t)e * DM * FFM, FFM, nullptr};
            transpose_item_fp8(S, DM, (2 * FFM) / 32, (unsigned char*)(ws + WS_WT_MGU) + (size_t)e * (2 * FFM) * DM, scr, r, X.lane, 64.f); }
        else { const int i2 = idx - MGU_ITEMS, e = i2 / I_MDN, r = i2 - e * I_MDN; SrcPlain S{p.in[I_MWD] + (size_t)e * FFM * DM, DM};
            transpose_item_fp8(S, FFM, DM / 32, (unsigned char*)(ws + WS_WT_MDN) + (size_t)e * DM * FFM, scr, r, X.lane, 128.f); } }
}
__device__ __forceinline__ void phase_prologue(const Ctx& X, const Params& p) {
    unsigned char* ws = p.ws;
    LAS float* scr = (LAS float*)(X.lds + X.wave * 16384);
    const int gw = X.bid * NWAVES + X.wave, ngw = X.nblk * NWAVES;
    constexpr int I_IN = 16 * 88, I_QB = 6 * 24, I_KVB = 4 * 32, I_OUT = 16 * 32, I_GU = 16 * 176, I_DN = 44 * 32, I_MGU = 16 * 224, I_MDN = 56 * 32;
    constexpr int I_LAYER = I_IN + I_QB + I_KVB + I_OUT;
    constexpr int NITEMS = 2 * I_LAYER + I_GU + I_DN + NE * (I_MGU + I_MDN);
    const int nitems = (X.nblk == 256) ? NITEMS - TAIL_ITEMS : NITEMS;
    for (int it = gw; it < nitems; it += ngw) {
        int r = it;
        if (r < 2 * I_LAYER) {
            const int l = r / I_LAYER; r -= l * I_LAYER;
            if (r < I_IN) { SrcIn S{p.in[I_WIN] + (size_t)l * DM * NPROJ, (FUSE_NORM && l == 1) ? p.in[I_MIXN] + DM : nullptr}; transpose_item(S, DM, NPROJ_P / 32, (bf16*)(ws + WS_WT_IN) + (size_t)l * NPROJ_P * DM, scr, r, X.lane); continue; } r -= I_IN;
            if (r < I_QB) { SrcQB S{p.in[I_WQB] + (size_t)l * QR * (NH * DQK), p.in[I_QAN] + l * QR}; transpose_item(S, QR, (NH * DQK) / 32, (bf16*)(ws + WS_WT_QB) + (size_t)l * (NH * DQK) * QR, scr, r, X.lane); continue; } r -= I_QB;
            if (r < I_KVB) { SrcScaled S{p.in[I_WKVB] + (size_t)l * KVR * 1024, 1024, p.in[I_KVAN] + l * KVR}; transpose_item(S, KVR, 1024 / 32, (bf16*)(ws + WS_WT_KVB) + (size_t)l * 1024 * KVR, scr, r, X.lane); continue; } r -= I_KVB;
            { SrcPlain S{p.in[I_WOUT] + (size_t)l * DM * DM, DM}; transpose_item(S, DM, DM / 32, (bf16*)(ws + WS_WT_OUT) + (size_t)l * DM * DM, scr, r, X.lane); continue; }
        }
        r -= 2 * I_LAYER;
        if (r < I_GU) { SrcGU S{p.in[I_DWG], p.in[I_DWU], FF0, FUSE_NORM ? p.in[I_FFNN] : nullptr}; transpose_item(S, DM, (2 * FF0) / 32, (bf16*)(ws + WS_WT_GU), scr, r, X.lane); continue; } r -= I_GU;
        if (r < I_DN) { SrcPlain S{p.in[I_DWD], DM}; transpose_item(S, FF0, DM / 32, (bf16*)(ws + WS_WT_DN), scr, r, X.lane); continue; } r -= I_DN;
        if (r < NE * I_MGU) { const int e = r / I_MGU; r -= e * I_MGU; SrcGU S{p.in[I_MWG] + (size_t)e * DM * FFM, p.in[I_MWU] + (size_t)e * DM * FFM, FFM, nullptr};
#if MOE_FP8
            transpose_item_fp8(S, DM, (2 * FFM) / 32, (unsigned char*)(ws + WS_WT_MGU) + (size_t)e * (2 * FFM) * DM, scr, r, X.lane, 64.f); continue; } r -= NE * I_MGU;
        { const int e = r / I_MDN; r -= e * I_MDN; SrcPlain S{p.in[I_MWD] + (size_t)e * FFM * DM, DM};
            transpose_item_fp8(S, FFM, DM / 32, (unsigned char*)(ws + WS_WT_MDN) + (size_t)e * DM * FFM, scr, r, X.lane, 128.f); }
#else
            transpose_item(S, DM, (2 * FFM) / 32, (bf16*)(ws + WS_WT_MGU) + (size_t)e * (2 * FFM) * DM, scr, r, X.lane); continue; } r -= NE * I_MGU;
        { const int e = r / I_MDN; r -= e * I_MDN; SrcPlain S{p.in[I_MWD] + (size_t)e * FFM * DM, DM};
            transpose_item(S, FFM, DM / 32, (bf16*)(ws + WS_WT_MDN) + (size_t)e * DM * FFM, scr, r, X.lane); }
#endif
    }
    { const int* pos = (const int*)p.in[I_POS]; float* COS = (float*)(ws + WS_COS); float* SIN = (float*)(ws + WS_SIN);
      for (int i = X.bid * NTHREADS + X.tid; i < T * 32; i += X.nblk * NTHREADS) {
          const int row = i >> 5, f = i & 31; const double a = (double)pos[row] * kInvRev[f]; const float rev = (float)(a - floor(a));
          COS[i] = __builtin_amdgcn_cosf(rev); SIN[i] = __builtin_amdgcn_sinf(rev); } }
    if (X.bid == 0) { float* LB = (float*)(ws + WS_MISC + MISC_LB); const float* h = p.in[I_HLB];
        for (int i = X.tid; i < HGW; i += NTHREADS) { LB[i] = 0.f; LB[HGW + i] = 1.f / (1.f + expf(h[i] - h[HGW + i])); } }
    norm_all_rows(X, p.in[I_X], p.in[I_MIXN], (bf16*)(ws + WS_XB));
}

__device__ __forceinline__ void phase_attn_simple(const Ctx& X, const Params& p) {
    unsigned char* ws = p.ws;
    const bf16* Q = (const bf16*)(ws + WS_Q); const bf16* KN = (const bf16*)(ws + WS_KN); const bf16* KPE = (const bf16*)(ws + WS_KPE); const bf16* V = (const bf16*)(ws + WS_V);
    bf16* CC = (bf16*)(ws + WS_CC);
    LAS float* ql = (LAS float*)(X.lds + X.wave * 1024);
    const int gw = X.bid * NWAVES + X.wave, ngw = X.nblk * NWAVES, lane = X.lane;
    for (int idx = gw; idx < 2 * NH * SEQ; idx += ngw) {
        const int bh = idx & 7, q = SEQ - 1 - (idx >> 3), b = bh >> 2, h = bh & 3;
        const bf16* qrow = Q + ((size_t)bh * SEQ + q) * DQK;
        ql[lane] = bf2f(qrow[lane]); ql[64 + lane] = bf2f(qrow[64 + lane]); ql[128 + lane] = bf2f(qrow[128 + lane]);
        asm volatile("s_waitcnt lgkmcnt(0)" ::: "memory");
        float m = -1e30f, l = 0.f, o0 = 0.f, o1 = 0.f;
        for (int k0 = 0; k0 <= q; k0 += 64) {
            const int key = k0 + lane; const bool valid = key <= q;
            float s = 0.f;
            const bf16* kr = KN + ((size_t)bh * SEQ + key) * 128; const bf16* kp = KPE + ((size_t)b * SEQ + key) * ROPE;
#pragma unroll 4
            for (int c = 0; c < 16; ++c) { const u32x4 w = *(const u32x4*)(kr + 8 * c); const LAS float* qq = ql + 8 * c;
                s += bflo(w.x) * qq[0] + bfhi(w.x) * qq[1] + bflo(w.y) * qq[2] + bfhi(w.y) * qq[3] + bflo(w.z) * qq[4] + bfhi(w.z) * qq[5] + bflo(w.w) * qq[6] + bfhi(w.w) * qq[7]; }
#pragma unroll 4
            for (int c = 0; c < 8; ++c) { const u32x4 w = *(const u32x4*)(kp + 8 * c); const LAS float* qq = ql + 128 + 8 * c;
                s += bflo(w.x) * qq[0] + bfhi(w.x) * qq[1] + bflo(w.y) * qq[2] + bfhi(w.y) * qq[3] + bflo(w.z) * qq[4] + bfhi(w.z) * qq[5] + bflo(w.w) * qq[6] + bfhi(w.w) * qq[7]; }
            if (!valid) s = -1e30f;
            const float mx = wave_max(s), mn = fmaxf(m, mx), alpha = fast_exp(m - mn);
            const float pr = valid ? fast_exp(s - mn) : 0.f;
            l = l * alpha + wave_sum(pr); o0 *= alpha; o1 *= alpha; m = mn;
            const bf16* vb = V + ((size_t)bh * SEQ + k0) * 128 + 2 * lane;
            for (int j = 0; j < 64; ++j) { const float pj = __shfl(pr, j); const unsigned w = *(const unsigned*)(vb + (size_t)j * 128); o0 += pj * bflo(w); o1 += pj * bfhi(w); }
        }
        const float inv = 1.f / l;
        *(unsigned*)(CC + ((size_t)(b * SEQ + q)) * DM + h * 128 + 2 * lane) = pk2(o0 * inv, o1 * inv);
    }
}


namespace att {
typedef short s16x4 __attribute__((ext_vector_type(4)));
typedef float f32x16 __attribute__((ext_vector_type(16)));
constexpr int NW = 8, QBLK = 32, KVBLK = 64, QB = 256, NQB = SEQ / QB;
constexpr int KROW = 400, SHM_V = KVBLK * 128 * 2, SHM_K = KVBLK * KROW;
constexpr int LDS_V = 0, LDS_K = 2 * SHM_V, LDS_WS = LDS_K + 2 * SHM_K, LDS_TOTAL = LDS_WS + NW * 64 * 4;
constexpr float THR = 8.f;
constexpr int LDS_STAGE = LDS_TOTAL, STAGE_P = 144, STAGE_W = 32 * STAGE_P;
static_assert(LDS_STAGE + NW * STAGE_W <= LDS_MISC_OFF, "attention staging overlaps the barrier words");
#define SBAR() __builtin_amdgcn_sched_barrier(0)
__device__ __forceinline__ int v_st(int k, int c) { const int kk = (k & ~0xC) | ((k & 4) << 1) | ((k & 8) >> 1); return ((kk >> 3) * 4 + (c >> 5)) * 512 + ((kk & 7) * 32 + (c & 31)) * 2; }
__device__ __forceinline__ int v_rd_base(int lane) { return ((lane & 3) << 3) | (((lane >> 2) & 3) << 6) | (((lane >> 4) & 1) << 5) | (((lane >> 5) & 1) << 8); }
constexpr int v_rd_off(int d0, int ks, int half) { return d0 * 512 + ks * 4096 + half * 2048; }
__device__ __forceinline__ int crow(int r, int hi) { return (r & 3) + 8 * (r >> 2) + 4 * hi; }
__device__ __forceinline__ unsigned cvtpk(float lo, float hi) { unsigned r; asm volatile("v_cvt_pk_bf16_f32 %0, %1, %2" : "=v"(r) : "v"(lo), "v"(hi)); return r; }
__device__ __forceinline__ bf16x8 load8(const bf16* p) { return *reinterpret_cast<const bf16x8*>(p); }
__device__ __forceinline__ bf16x8 bload8(__amdgpu_buffer_rsrc_t r, unsigned voff, unsigned soff) { const u32x4 x = __builtin_amdgcn_raw_buffer_load_b128(r, voff, soff, 0); return __builtin_bit_cast(bf16x8, x); }
__device__ __forceinline__ void mask_tile(f32x16& p0, f32x16& p1, int dq) {
    const float NEG = -__builtin_inff();
#pragma unroll
    for (int r = 0; r < 16; ++r) { const int c = (r & 3) + 8 * (r >> 2); if (dq - c < 0) p0[r] = NEG; if (dq - c - 32 < 0) p1[r] = NEG; }
}
__device__ __forceinline__ void partialSM(f32x16& p0, f32x16& p1, float& m_reg, float& mn, float& alpha) {
    float pmax = p0[0]; for (int r = 1; r < 16; ++r) pmax = fmaxf(pmax, p0[r]); for (int r = 0; r < 16; ++r) pmax = fmaxf(pmax, p1[r]);
    { auto rr = __builtin_amdgcn_permlane32_swap(__float_as_uint(pmax), __float_as_uint(pmax), false, false);
      pmax = fmaxf(__uint_as_float(rr[0]), __uint_as_float(rr[1])); }
    constexpr float C2 = 1.4426950408889634f;
    if (__builtin_expect(__all((pmax - m_reg) <= THR), 1)) { mn = m_reg; alpha = 1.f; }
    else { mn = fmaxf(m_reg, pmax); alpha = __builtin_amdgcn_exp2f((m_reg - mn) * C2); m_reg = mn; }
    const float mnL = -mn * C2;
    for (int r = 0; r < 16; ++r) p0[r] = fmaf(p0[r], C2, mnL); for (int r = 0; r < 16; ++r) p1[r] = fmaf(p1[r], C2, mnL);
    for (int r = 0; r < 16; ++r) p0[r] = __builtin_amdgcn_exp2f(p0[r]);
}
__device__ __forceinline__ void finishSM(f32x16& p0, f32x16& p1, float alpha, float& l_reg, bf16x8& pa0, bf16x8& pa1, bf16x8& pa2, bf16x8& pa3) {
    for (int r = 0; r < 16; ++r) p1[r] = __builtin_amdgcn_exp2f(p1[r]);
    float ps = 0; for (int r = 0; r < 16; ++r) ps += p0[r]; for (int r = 0; r < 16; ++r) ps += p1[r];
    { auto rr = __builtin_amdgcn_permlane32_swap(__float_as_uint(ps), __float_as_uint(ps), false, false);
      ps = __uint_as_float(rr[0]) + __uint_as_float(rr[1]); }
    l_reg = l_reg * alpha + ps;
#define PK4(P, B_, OUT) do { unsigned a0 = cvtpk(P[B_+0], P[B_+1]), a1 = cvtpk(P[B_+2], P[B_+3]);                          \
        unsigned b0 = cvtpk(P[B_+4], P[B_+5]), b1 = cvtpk(P[B_+6], P[B_+7]);                                             \
        auto r0 = __builtin_amdgcn_permlane32_swap(a0, b0, false, false); auto r1 = __builtin_amdgcn_permlane32_swap(a1, b1, false, false); \
        u32x4 w = {r0[0], r1[0], r0[1], r1[1]}; OUT = *reinterpret_cast<bf16x8*>(&w); } while (0)
    PK4(p0, 0, pa0); PK4(p0, 8, pa1); PK4(p1, 0, pa2); PK4(p1, 8, pa3);
#undef PK4
}
template <int KB>
__device__ __forceinline__ void qkt(f32x16& p0, f32x16& p1, const LAS char* K_lds, int r32, int hi, const bf16x8* qr) {
    p0 = f32x16{}; p1 = f32x16{};
    const LAS char* kb = K_lds + KB * SHM_K + r32 * KROW + hi * 16;
#pragma unroll
    for (int d0 = 0; d0 < 12; ++d0) {
        const bf16x8 b0 = *reinterpret_cast<const LAS bf16x8*>(kb + d0 * 32);
        const bf16x8 b1 = *reinterpret_cast<const LAS bf16x8*>(kb + d0 * 32 + 32 * KROW);
        p0 = __builtin_amdgcn_mfma_f32_32x32x16_bf16(b0, qr[d0], p0, 0, 0, 0);
        p1 = __builtin_amdgcn_mfma_f32_32x32x16_bf16(b1, qr[d0], p1, 0, 0, 0); }
}
template <int VB>
__device__ __forceinline__ void pv_tile(f32x16* o, int vb0, bf16x8 pa0, bf16x8 pa1, bf16x8 pa2, bf16x8 pa3) {
#define TRRD(dst, off) asm volatile("ds_read_b64_tr_b16 %0, %1 offset:%2" : "=&v"(dst) : "v"(vb0), "i"(off) : "memory")
#define PV_D0(d0) do { s16x4 l0, l1, l2, l3, h0, h1, h2, h3; constexpr int b_ = VB * SHM_V + v_rd_off(d0, 0, 0); \
        TRRD(l0, b_); TRRD(h0, b_ + 2048); TRRD(l1, b_ + 4096); TRRD(h1, b_ + 6144); TRRD(l2, b_ + 8192); TRRD(h2, b_ + 10240); TRRD(l3, b_ + 12288); TRRD(h3, b_ + 14336); \
        asm volatile("s_waitcnt lgkmcnt(0)" ::: "memory"); SBAR();   \
        o[d0] = __builtin_amdgcn_mfma_f32_32x32x16_bf16(pa0, (bf16x8){l0[0], l0[1], l0[2], l0[3], h0[0], h0[1], h0[2], h0[3]}, o[d0], 0, 0, 0);   \
        o[d0] = __builtin_amdgcn_mfma_f32_32x32x16_bf16(pa1, (bf16x8){l1[0], l1[1], l1[2], l1[3], h1[0], h1[1], h1[2], h1[3]}, o[d0], 0, 0, 0);   \
        o[d0] = __builtin_amdgcn_mfma_f32_32x32x16_bf16(pa2, (bf16x8){l2[0], l2[1], l2[2], l2[3], h2[0], h2[1], h2[2], h2[3]}, o[d0], 0, 0, 0);   \
        o[d0] = __builtin_amdgcn_mfma_f32_32x32x16_bf16(pa3, (bf16x8){l3[0], l3[1], l3[2], l3[3], h3[0], h3[1], h3[2], h3[3]}, o[d0], 0, 0, 0); } while (0)
    PV_D0(0); PV_D0(1); PV_D0(2); PV_D0(3);
#undef PV_D0
#undef TRRD
}
struct BlockRef { const bf16* Q; const bf16* KN; const bf16* KP; const bf16* V; bf16* O; float* ML; int ostride, P0, par, NT; };
struct Seam { bf16x8 qr[12]; bf16x8 st_v0, st_v1, st_k0, st_k1, st_k2; };
#define VMW() asm volatile("s_waitcnt vmcnt(0)" ::: "memory")
#define VMWN(n) asm volatile("s_waitcnt vmcnt(%0)" :: "i"(n) : "memory")
#define SLOAD(R, k0) do { const unsigned so_ = (unsigned)(k0) * 256u, sp_ = (unsigned)(k0) * 128u; \
                          S.st_v0 = bload8(rV, lofs, so_); S.st_v1 = bload8(rV, lofs, so_ + 8192u); S.st_k0 = bload8(rK, lofs, so_); S.st_k1 = bload8(rK, lofs, so_ + 8192u); S.st_k2 = bload8(rP, lofp, sp_); } while (0)
#define SWRITE_K(bf) do { *(LAS bf16x8*)(K_lds + (bf) * SHM_K + kws) = S.st_k0; *(LAS bf16x8*)(K_lds + (bf) * SHM_K + kws + 32 * KROW) = S.st_k1; *(LAS bf16x8*)(K_lds + (bf) * SHM_K + kwp) = S.st_k2; } while (0)
#define SWRITE_V(bf) do { *(LAS bf16x8*)(V_lds + (bf) * SHM_V + vst0) = S.st_v0; *(LAS bf16x8*)(V_lds + (bf) * SHM_V + vst1) = S.st_v1; } while (0)
#define KBASE_OF(R, t) (((R).par + 2 * (t)) * KVBLK)
__device__ __forceinline__ void attn_block(const BlockRef& cur, LAS char* lds, int tid) {
    Seam S;
    const int wid = __builtin_amdgcn_readfirstlane(tid >> 6), lane = tid & 63, r32 = lane & 31, hi = lane >> 5;
    const int NT = cur.NT;
    const int qlo = cur.P0 + wid * QBLK, qm = qlo + r32 - 4 * hi;
    LAS char* V_lds = lds + LDS_V; LAS char* K_lds = lds + LDS_K;
    LAS float* wsc = (LAS float*)(lds + LDS_WS) + wid * 64; LAS float* li_l = wsc; LAS float* al_l = wsc + 32;
    float m_reg = -1e30f, l_reg = 0; f32x16 o[4] = {};
    const int sr = tid >> 4, sc = (tid & 15) * 8, vst0 = v_st(sr, sc), vst1 = v_st(32 + sr, sc), kws = sr * KROW + sc * 2, pr = tid >> 3, pc = (tid & 7) * 8, kwp = pr * KROW + 256 + pc * 2;
    const unsigned lofs = (unsigned)(sr * 128 + sc) * 2u, lofp = (unsigned)(pr * 64 + pc) * 2u;
    const __amdgpu_buffer_rsrc_t rV = __builtin_amdgcn_make_buffer_rsrc((void*)cur.V, 0, SEQ * 128 * 2, 0x00020000), rK = __builtin_amdgcn_make_buffer_rsrc((void*)cur.KN, 0, SEQ * 128 * 2, 0x00020000),
                                 rP = __builtin_amdgcn_make_buffer_rsrc((void*)cur.KP, 0, SEQ * ROPE * 2, 0x00020000);
    const int vb0 = (int)(unsigned)(size_t)V_lds + v_rd_base(lane);
#define RESC(a) do { if (__any((a) < 1.f)) { if (hi == 0) al_l[r32] = (a); asm volatile("s_waitcnt lgkmcnt(0)" ::: "memory");              \
                     for (int d_ = 0; d_ < 4; ++d_) for (int r = 0; r < 16; ++r) o[d_][r] *= al_l[crow(r, hi)]; } } while (0)
#define KBASE(t) KBASE_OF(cur, t)
#define MASKT(P0_, P1_, t) do { const int kb_ = KBASE(t); if (kb_ + KVBLK - 1 > qlo) mask_tile(P0_, P1_, qm - kb_); } while (0)
    f32x16 pA0, pA1, pB0, pB1; float mnA, mnB, alA, alB; bf16x8 pa0, pa1, pa2, pa3;
#pragma unroll
    for (int d0 = 0; d0 < 12; ++d0) S.qr[d0] = load8(cur.Q + (size_t)(wid * QBLK + r32) * DQK + d0 * 16 + hi * 8);
    SLOAD(cur, KBASE(0)); VMW(); SWRITE_K(0); SWRITE_V(0);
    __syncthreads();
    SLOAD(cur, KBASE(1));
    SBAR(); qkt<0>(pA0, pA1, K_lds, r32, hi, S.qr);
    MASKT(pA0, pA1, 0); partialSM(pA0, pA1, m_reg, mnA, alA);
    VMW(); SWRITE_V(1); SWRITE_K(1);
    __syncthreads();
#define HALF_STEP(PX0, PX1, mnX, alX, PY0, PY1, alY, t, KB, VB, SB) do {                                                      \
        SBAR(); qkt<KB>(PX0, PX1, K_lds, r32, hi, S.qr);                                                                      \
        finishSM(PY0, PY1, alY, l_reg, pa0, pa1, pa2, pa3); SBAR();                                                           \
        if ((t) + 1 < NT) { SLOAD(cur, KBASE((t) + 1)); SBAR(); }                                                             \
        pv_tile<VB>(o, vb0, pa0, pa1, pa2, pa3); MASKT(PX0, PX1, (t)); partialSM(PX0, PX1, m_reg, mnX, alX);                  \
        __syncthreads();                                                                                                      \
        if ((t) + 1 < NT) { VMW(); SWRITE_V(SB); SWRITE_K(SB); }                                                              \
        RESC(alX); __syncthreads(); } while (0)
    for (int t = 1; t + 1 < NT; t += 2) {
        HALF_STEP(pB0, pB1, mnB, alB, pA0, pA1, alA, t, 1, 0, 0);
        HALF_STEP(pA0, pA1, mnA, alA, pB0, pB1, alB, t + 1, 0, 1, 1);
    }
    SBAR(); qkt<1>(pB0, pB1, K_lds, r32, hi, S.qr); SBAR();
    finishSM(pA0, pA1, alA, l_reg, pa0, pa1, pa2, pa3); SBAR();
    pv_tile<0>(o, vb0, pa0, pa1, pa2, pa3);
    MASKT(pB0, pB1, NT - 1); partialSM(pB0, pB1, m_reg, mnB, alB); __syncthreads(); RESC(alB);
    finishSM(pB0, pB1, alB, l_reg, pa0, pa1, pa2, pa3); SBAR(); pv_tile<1>(o, vb0, pa0, pa1, pa2, pa3);
    if (hi == 0) { li_l[r32] = l_reg; *(float2*)(cur.ML + (size_t)(wid * QBLK + r32) * 2) = make_float2(m_reg, l_reg); }
    asm volatile("s_waitcnt lgkmcnt(0)" ::: "memory");
    float rli[16];
#pragma unroll
    for (int r = 0; r < 16; ++r) { const float lv = li_l[crow(r, hi)]; rli[r] = lv > 0.f ? __builtin_amdgcn_rcpf(lv) : 0.f; }
    bf16* Ow = cur.O + (size_t)(wid * QBLK) * cur.ostride;
#if ATTN_STAGED_EPI
    {   LAS char* stg = lds + LDS_STAGE + wid * STAGE_W;
        const int wbase = hi * (4 * STAGE_P) + r32 * 2, rrow = lane >> 3, rchunk = lane & 7;
#pragma unroll
        for (int ps = 0; ps < 2; ++ps) {
#pragma unroll
            for (int r = 0; r < 16; r += 2)
#pragma unroll
                for (int dd = 0; dd < 2; ++dd) { const unsigned w = cvtpk(o[2 * ps + dd][r] * rli[r], o[2 * ps + dd][r + 1] * rli[r + 1]);
                    *(LAS unsigned short*)(stg + wbase + ((r & 3) + 8 * (r >> 2)) * STAGE_P + dd * 64) = (unsigned short)w;
                    *(LAS unsigned short*)(stg + wbase + ((r & 3) + 1 + 8 * (r >> 2)) * STAGE_P + dd * 64) = (unsigned short)(w >> 16); }
            u32x4 t[4];
#pragma unroll
            for (int j = 0; j < 4; ++j) t[j] = *(const LAS u32x4*)(stg + (rrow + 8 * j) * STAGE_P + rchunk * 16);
#pragma unroll
            for (int j = 0; j < 4; ++j) *(u32x4*)(Ow + (size_t)(rrow + 8 * j) * cur.ostride + ps * 64 + rchunk * 8) = t[j];
        }
    }
#else
#pragma unroll
    for (int r = 0; r < 16; ++r) { const int orow = crow(r, hi);
#pragma unroll
        for (int d0 = 0; d0 < 4; ++d0) { const float v = o[d0][r] * rli[r]; const float vn = __shfl_xor(v, 1);
            if ((r32 & 1) == 0) *(unsigned*)(Ow + (size_t)orow * cur.ostride + d0 * 32 + r32) = cvtpk(v, vn); } }
#endif
    __syncthreads();
#undef RESC
#undef KBASE
#undef MASKT
#undef HALF_STEP
}
#undef SLOAD
#undef SWRITE_K
#undef SWRITE_V
#undef VMW
#undef VMWN
struct Item { int bh, x, par; };
__device__ __forceinline__ Item decode(int L) { Item it; it.bh = L & 7; const int rest = L >> 3; it.x = rest >> 1; it.par = rest & 1; return it; }
__device__ __forceinline__ BlockRef make_ref(unsigned char* ws, const Item& it, int pass) {
    const int qb = pass ? (NQB - 1 - it.x) : it.x, bh = it.bh; BlockRef r;
    r.Q = (const bf16*)(ws + WS_Q) + ((size_t)bh * SEQ + (size_t)qb * QB) * DQK;
    r.KN = (const bf16*)(ws + WS_KN) + (size_t)bh * SEQ * 128; r.KP = (const bf16*)(ws + WS_KPE) + (size_t)(bh >> 2) * SEQ * ROPE; r.V = (const bf16*)(ws + WS_V) + (size_t)bh * SEQ * 128;
    if (it.par == 0) { r.O = (bf16*)(ws + WS_CC) + ((size_t)((bh >> 2) * SEQ + qb * QB)) * DM + (bh & 3) * 128; r.ostride = DM; }
    else { r.O = (bf16*)(ws + WS_AP2) + ((size_t)bh * SEQ + (size_t)qb * QB) * 128; r.ostride = 128; }
    r.ML = (float*)(ws + WS_AML) + ((size_t)(it.par * 8 + bh) * SEQ + (size_t)qb * QB) * 2;
    r.P0 = qb * QB; r.par = it.par; r.NT = 2 * (qb + 1);
    return r;
}
}
__device__ __forceinline__ void phase_attn_fast(const Ctx& X, unsigned char* ws) {
    constexpr int TOTAL = 2 * NH * (att::NQB / 2) * 2;
    int L = X.bid; if (L >= TOTAL) return;
    const int stride = X.nblk;
    LAS char* lds = (LAS char*)X.lds;
    if (X.wave >= 4) __builtin_amdgcn_s_setprio(1);
    for (; L < TOTAL; L += stride) {
        const att::Item it = att::decode(L);
#pragma nounroll
        for (int pass = 0; pass < 2; ++pass) { const att::BlockRef cur = att::make_ref(ws, it, pass); att::attn_block(cur, lds, X.tid); }
    }
    __builtin_amdgcn_s_setprio(0);
}
__device__ __forceinline__ void phase_attn_combine(const Ctx& X, unsigned char* ws) {
    bf16* CC = (bf16*)(ws + WS_CC); const bf16* P2 = (const bf16*)(ws + WS_AP2); const float* ML = (const float*)(ws + WS_AML);
    const int gw = X.bid * NWAVES + X.wave, ngw = X.nblk * NWAVES, lane = X.lane, h = lane >> 4, dd = (lane & 15) * 8;
    for (int r0 = gw; r0 < T; r0 += 4 * ngw) {
        u32x4 a[4], q[4]; float2 s1[4], s2[4];
#pragma unroll
        for (int i = 0; i < 4; ++i) { const int row = (r0 + i * ngw < T) ? r0 + i * ngw : r0, b = row >> 13, sq = row & (SEQ - 1), bh = b * NH + h;
            a[i] = *(const u32x4*)(CC + (size_t)row * DM + h * 128 + dd); q[i] = *(const u32x4*)(P2 + ((size_t)bh * SEQ + sq) * 128 + dd);
            s1[i] = *(const float2*)(ML + ((size_t)bh * SEQ + sq) * 2); s2[i] = *(const float2*)(ML + ((size_t)(8 + bh) * SEQ + sq) * 2); }
#pragma unroll
        for (int i = 0; i < 4; ++i) { const int row = (r0 + i * ngw < T) ? r0 + i * ngw : r0;
            const float m = fmaxf(s1[i].x, s2[i].x), w1 = s1[i].y * fast_exp(s1[i].x - m), w2 = s2[i].y * fast_exp(s2[i].x - m), inv = __builtin_amdgcn_rcpf(w1 + w2), c1 = w1 * inv, c2 = w2 * inv;
            u32x4 o; o.x = pk2(c1 * bflo(a[i].x) + c2 * bflo(q[i].x), c1 * bfhi(a[i].x) + c2 * bfhi(q[i].x)); o.y = pk2(c1 * bflo(a[i].y) + c2 * bflo(q[i].y), c1 * bfhi(a[i].y) + c2 * bfhi(q[i].y));
            o.z = pk2(c1 * bflo(a[i].z) + c2 * bflo(q[i].z), c1 * bfhi(a[i].z) + c2 * bfhi(q[i].z)); o.w = pk2(c1 * bflo(a[i].w) + c2 * bflo(q[i].w), c1 * bfhi(a[i].w) + c2 * bfhi(q[i].w));
            *(u32x4*)(CC + (size_t)row * DM + h * 128 + dd) = o; }
    }
}

namespace hg {
using att::s16x4; using att::f32x16; using att::v_st; using att::v_rd_base; using att::v_rd_off; using att::crow; using att::cvtpk;
constexpr int CH = 64, NCH = SEQ / CH;
constexpr int KROW2 = 272;
constexpr int TILE_V = 16384, TILE_K2 = CH * KROW2;
constexpr size_t US_BH = (size_t)NCH * 16384;
#define TRRD2(dst, base, off) asm volatile("ds_read_b64_tr_b16 %0, %1 offset:%2" : "=&v"(dst) : "v"(base), "i"(off) : "memory")
__device__ __forceinline__ float ex(float x) { return __builtin_amdgcn_exp2f(x * 1.4426950408889634f); }
#if HG_V2
__device__ __forceinline__ void h1_unit(const Ctx& X, unsigned char* ws, int u, const float* lbl) {
    int tid_ = X.tid; asm volatile("" : "+v"(tid_));
    const int bb = u >> 7, c = u & 127, row0 = bb * SEQ + c * CH, tid = tid_, lane = tid & 63, wave = X.wave;
    const bf16* HZ = (const bf16*)(ws + WS_HK); const bf16* HQ = (const bf16*)(ws + WS_HQ); const bf16* HV = (const bf16*)(ws + WS_HV);
    bf16* KRB = (bf16*)(ws + WS_LF); bf16* QRB = (bf16*)(ws + WS_LF + 16 * MiB);
    float* Dd = (float*)(ws + WS_HD); float* Rr = (float*)(ws + WS_HR); bf16* US = (bf16*)(ws + WS_XB);
    LAS char* lds = (LAS char*)X.lds;
    {
        const int t0 = tid >> 4, c8 = (tid & 15) * 8; const size_t g0 = (size_t)(row0 + t0) * HGW + c8; const int vst0 = v_st(t0, c8);
        u32x4 vw[8];
#pragma unroll
        for (int j = 0; j < 8; ++j) vw[j] = *(const u32x4*)(HV + g0 + (size_t)((j & 1) * 32 * HGW + (j >> 1) * 128));
#pragma unroll
        for (int j = 0; j < 8; ++j) *(LAS u32x4*)(lds + 65536 + (j >> 1) * TILE_V + vst0 + (j & 1) * 8192) = vw[j];
    }
#if H1_WIDE
    {
        const int tg = wave, cg = lane, col = 8 * cg, head = cg >> 4, dcol = col & 127;
        const size_t cb = (size_t)row0 * HGW * 2; const unsigned vo = (unsigned)((8 * tg * HGW + col) * 2);
        const __amdgpu_buffer_rsrc_t rZ = __builtin_amdgcn_make_buffer_rsrc((void*)((const char*)HZ + cb), 0, CH * HGW * 2, 0x00020000), rQ = __builtin_amdgcn_make_buffer_rsrc((void*)((const char*)HQ + cb), 0, CH * HGW * 2, 0x00020000),
                                     rK = __builtin_amdgcn_make_buffer_rsrc((void*)((char*)KRB + cb), 0, CH * HGW * 2, 0x00020000), rR = __builtin_amdgcn_make_buffer_rsrc((void*)((char*)QRB + cb), 0, CH * HGW * 2, 0x00020000);
        u32x4 zw[8], qw[8];
#pragma unroll
        for (int jj = 0; jj < 8; ++jj) zw[jj] = __builtin_amdgcn_raw_buffer_load_b128(rZ, vo, jj * HGW * 2, 0);
        const f32x4 lb0 = *(const f32x4*)(lbl + col), lb1 = *(const f32x4*)(lbl + col + 4);
        const float lbv[8] = {lb0.x, lb0.y, lb0.z, lb0.w, lb1.x, lb1.y, lb1.z, lb1.w};
        float bq[8][8];
#pragma unroll
        for (int jj = 0; jj < 8; ++jj) { const unsigned zz[4] = {zw[jj].x, zw[jj].y, zw[jj].z, zw[jj].w};
#pragma unroll
            for (int cc = 0; cc < 8; ++cc) { const float z = (cc & 1) ? bfhi(zz[cc >> 1]) : bflo(zz[cc >> 1]);
                const float zc = fminf(fmaxf(z, -60.f), 60.f), e = fast_exp(-zc), sg = __builtin_amdgcn_rcpf(1.f + e), f = lbv[cc] + (1.f - lbv[cc]) * sg;
                const float ff = fmaxf(f, 1e-30f); bq[jj][cc] = __builtin_amdgcn_logf(ff) * 0.6931471805599453f; }
            __builtin_amdgcn_sched_barrier(0); }
#pragma unroll
        for (int jj = 1; jj < 8; ++jj)
#pragma unroll
            for (int cc = 0; cc < 8; ++cc) bq[jj][cc] += bq[jj - 1][cc];
        LAS float* tot = (LAS float*)lds;
        *(LAS f32x4*)(tot + tg * HGW + col) = (f32x4){bq[7][0], bq[7][1], bq[7][2], bq[7][3]}; *(LAS f32x4*)(tot + tg * HGW + col + 4) = (f32x4){bq[7][4], bq[7][5], bq[7][6], bq[7][7]};
        __syncthreads();
        float off[8], rr[8], bl[8];
        { float run[8] = {0.f, 0.f, 0.f, 0.f, 0.f, 0.f, 0.f, 0.f};
#pragma unroll
          for (int cc = 0; cc < 8; ++cc) off[cc] = 0.f;
#pragma unroll
          for (int g = 0; g < 8; ++g) { const f32x4 t0 = *(const LAS f32x4*)(tot + g * HGW + col), t1 = *(const LAS f32x4*)(tot + g * HGW + col + 4); const float tv[8] = {t0.x, t0.y, t0.z, t0.w, t1.x, t1.y, t1.z, t1.w};
#pragma unroll
              for (int cc = 0; cc < 8; ++cc) { run[cc] += tv[cc]; if (g + 1 == tg) off[cc] = run[cc]; if (g == 3) rr[cc] = fmaxf(run[cc], -60.f); } }
#pragma unroll
          for (int cc = 0; cc < 8; ++cc) bl[cc] = run[cc]; }
        __syncthreads();
#pragma unroll
        for (int jj = 0; jj < 8; ++jj) qw[jj] = __builtin_amdgcn_raw_buffer_load_b128(rQ, vo, jj * HGW * 2, 0);
#pragma unroll
        for (int jj = 0; jj < 8; ++jj)
#pragma unroll
            for (int cc = 0; cc < 8; ++cc) bq[jj][cc] += off[cc];
        if (tg == 0) { float* dp = Dd + (size_t)u * HGW + col; float* rp = Rr + (size_t)u * HGW + col;
            *(f32x4*)dp = (f32x4){ex(bl[0]), ex(bl[1]), ex(bl[2]), ex(bl[3])}; *(f32x4*)(dp + 4) = (f32x4){ex(bl[4]), ex(bl[5]), ex(bl[6]), ex(bl[7])};
            *(f32x4*)rp = (f32x4){ex(rr[0]), ex(rr[1]), ex(rr[2]), ex(rr[3])}; *(f32x4*)(rp + 4) = (f32x4){ex(rr[4]), ex(rr[5]), ex(rr[6]), ex(rr[7])}; }
#pragma unroll
        for (int jj = 0; jj < 8; ++jj) { const unsigned qq[4] = {qw[jj].x, qw[jj].y, qw[jj].z, qw[jj].w}; float kr[8], qr_[8], kd[8];
#pragma unroll
            for (int cc = 0; cc < 8; ++cc) { const float b = bq[jj][cc], kk = 1.f - ex(b - (jj ? bq[jj ? jj - 1 : 0][cc] : off[cc])), qv = (cc & 1) ? bfhi(qq[cc >> 1]) : bflo(qq[cc >> 1]);
                kr[cc] = kk * ex(fminf(rr[cc] - b, 80.f)); qr_[cc] = qv * ex(fminf(b - rr[cc], 80.f)); kd[cc] = kk * ex(bl[cc] - b); }
            u32x4 ko, qo, dk; ko.x = pk2(kr[0], kr[1]); ko.y = pk2(kr[2], kr[3]); ko.z = pk2(kr[4], kr[5]); ko.w = pk2(kr[6], kr[7]);
            qo.x = pk2(qr_[0], qr_[1]); qo.y = pk2(qr_[2], qr_[3]); qo.z = pk2(qr_[4], qr_[5]); qo.w = pk2(qr_[6], qr_[7]);
            dk.x = pk2(kd[0], kd[1]); dk.y = pk2(kd[2], kd[3]); dk.z = pk2(kd[4], kd[5]); dk.w = pk2(kd[6], kd[7]);
            __builtin_amdgcn_raw_buffer_store_b128(ko, rK, vo, jj * HGW * 2, 0); __builtin_amdgcn_raw_buffer_store_b128(qo, rR, vo, jj * HGW * 2, 0);
            *(LAS u32x4*)(lds + head * TILE_V + v_st(8 * tg + jj, dcol)) = dk; __builtin_amdgcn_sched_barrier(0); }
    }
#else
    {
        const int head = tid >> 7, d = tid & 127; const unsigned vo = (unsigned)tid * 2u; const size_t cb = (size_t)row0 * HGW * 2;
        const __amdgpu_buffer_rsrc_t rZ = __builtin_amdgcn_make_buffer_rsrc((void*)((const char*)HZ + cb), 0, CH * HGW * 2, 0x00020000), rQ = __builtin_amdgcn_make_buffer_rsrc((void*)((const char*)HQ + cb), 0, CH * HGW * 2, 0x00020000),
                                     rK = __builtin_amdgcn_make_buffer_rsrc((void*)((char*)KRB + cb), 0, CH * HGW * 2, 0x00020000), rR = __builtin_amdgcn_make_buffer_rsrc((void*)((char*)QRB + cb), 0, CH * HGW * 2, 0x00020000);
        float zl[CH], qv[CH];
#pragma unroll
        for (int t = 0; t < CH; ++t) { zl[t] = bf2f((unsigned short)__builtin_amdgcn_raw_buffer_load_b16(rZ, vo, t * HGW * 2, 0)); qv[t] = bf2f((unsigned short)__builtin_amdgcn_raw_buffer_load_b16(rQ, vo, t * HGW * 2, 0)); }
        const float lb = lbl[tid], om = 1.f - lb;
        float b = 0.f, r = 0.f;
#pragma unroll
        for (int t = 0; t < CH; ++t) { const float zc = fminf(fmaxf(zl[t], -60.f), 60.f), e = fast_exp(-zc), sg = __builtin_amdgcn_rcpf(1.f + e), f = lb + om * sg;
            const float lf = __builtin_amdgcn_logf(fmaxf(f, 1e-30f)) * 0.6931471805599453f; zl[t] = lf; b += lf; if (t == 31) r = b; }
        const float bl = b; r = fmaxf(r, -60.f);
        Dd[(size_t)u * HGW + tid] = ex(bl); Rr[(size_t)u * HGW + tid] = ex(r);
        b = 0.f;
        LAS char* kd = lds + head * TILE_V + ((d >> 5) * 512 + (d & 31) * 2);
#pragma unroll
        for (int t = 0; t < CH; ++t) { const float lf = zl[t]; b += lf; const float kk = 1.f - ex(lf);
            __builtin_amdgcn_raw_buffer_store_b16((short)pk2(kk * ex(fminf(r - b, 80.f)), 0.f), rK, vo, t * HGW * 2, 0);
            __builtin_amdgcn_raw_buffer_store_b16((short)pk2(qv[t] * ex(fminf(b - r, 80.f)), 0.f), rR, vo, t * HGW * 2, 0);
            constexpr int dummy = 0; (void)dummy;
            const int kk_t = (t & ~0xC) | ((t & 4) << 1) | ((t & 8) >> 1);
            *(LAS unsigned short*)(kd + (kk_t >> 3) * 4 * 512 + (kk_t & 7) * 64) = (unsigned short)pk2(kk * ex(bl - b), 0.f); }
    }
#endif
    __syncthreads();
#else
__device__ __forceinline__ void h1_unit(const Ctx& X, unsigned char* ws, int u) {
    const int bb = u >> 7, c = u & 127, row0 = bb * SEQ + c * CH, tid = X.tid, lane = X.lane, wave = X.wave;
    float* LFB = (float*)(ws + WS_LF); const bf16* HK = (const bf16*)(ws + WS_HK); const bf16* HV = (const bf16*)(ws + WS_HV);
    float* Dd = (float*)(ws + WS_HD); float* Rr = (float*)(ws + WS_HR); bf16* US = (bf16*)(ws + WS_XB);
    LAS char* lds = (LAS char*)X.lds; LAS float* bl = (LAS float*)(lds + 131072);
    {
        float* col = LFB + (size_t)row0 * HGW + tid; float b = 0.f, r = 0.f;
#pragma unroll 1
        for (int t0 = 0; t0 < CH; t0 += 8) { float x[8];
#pragma unroll
            for (int i = 0; i < 8; ++i) x[i] = col[(size_t)(t0 + i) * HGW];
#pragma unroll
            for (int i = 0; i < 8; ++i) { b += x[i]; col[(size_t)(t0 + i) * HGW] = b; if (t0 + i == 31) r = b; } }
        bl[tid] = b; r = fmaxf(r, -60.f);
        Dd[(size_t)u * HGW + tid] = ex(b); Rr[(size_t)u * HGW + tid] = ex(r);
    }
    asm volatile("s_waitcnt vmcnt(0)" ::: "memory");
    __syncthreads();
#pragma unroll 2
    for (int j = 0; j < 8; ++j) { const int i = tid + 512 * j, head = i >> 10, rem = i & 1023, t = rem >> 4, c8 = (rem & 15) * 8; const size_t g = (size_t)(row0 + t) * HGW + head * 128 + c8;
        const u32x4 kw = *(const u32x4*)(HK + g), vw = *(const u32x4*)(HV + g); const f32x4 b0 = *(const f32x4*)(LFB + g), b1 = *(const f32x4*)(LFB + g + 4);
        const f32x4 l0 = *(const LAS f32x4*)(bl + head * 128 + c8), l1 = *(const LAS f32x4*)(bl + head * 128 + c8 + 4);
        u32x4 o; o.x = pk2(bflo(kw.x) * ex(l0.x - b0.x), bfhi(kw.x) * ex(l0.y - b0.y)); o.y = pk2(bflo(kw.y) * ex(l0.z - b0.z), bfhi(kw.y) * ex(l0.w - b0.w));
        o.z = pk2(bflo(kw.z) * ex(l1.x - b1.x), bfhi(kw.z) * ex(l1.y - b1.y)); o.w = pk2(bflo(kw.w) * ex(l1.z - b1.z), bfhi(kw.w) * ex(l1.w - b1.w));
        *(LAS u32x4*)(lds + head * TILE_V + v_st(t, c8)) = o; *(LAS u32x4*)(lds + 65536 + head * TILE_V + v_st(t, c8)) = vw; }
    __syncthreads();
#endif
    {
        const int head = wave >> 1, db0 = (wave & 1) * 2, r32 = lane & 31, hiC = lane >> 5;
        const int ab = (int)(unsigned)(size_t)(lds + head * TILE_V) + v_rd_base(lane), vb = (int)(unsigned)(size_t)(lds + 65536 + head * TILE_V) + v_rd_base(lane);
        f32x16 acc[2][4];
#pragma unroll
        for (int a = 0; a < 2; ++a)
#pragma unroll
            for (int v = 0; v < 4; ++v) acc[a][v] = f32x16{};
#define FRAG(dst, base, d0, ks) do { s16x4 lo_, hi_; TRRD2(lo_, base, v_rd_off(d0, ks, 0)); TRRD2(hi_, base, v_rd_off(d0, ks, 1)); asm volatile("s_waitcnt lgkmcnt(0)" ::: "memory"); __builtin_amdgcn_sched_barrier(0); \
            dst = (bf16x8){lo_[0], lo_[1], lo_[2], lo_[3], hi_[0], hi_[1], hi_[2], hi_[3]}; } while (0)
#define U_KS(ks) do { bf16x8 a0, a1, b0, b1, b2, b3; \
            if (db0 == 0) { FRAG(a0, ab, 0, ks); FRAG(a1, ab, 1, ks); } else { FRAG(a0, ab, 2, ks); FRAG(a1, ab, 3, ks); } \
            FRAG(b0, vb, 0, ks); FRAG(b1, vb, 1, ks); FRAG(b2, vb, 2, ks); FRAG(b3, vb, 3, ks); \
            acc[0][0] = __builtin_amdgcn_mfma_f32_32x32x16_bf16(a0, b0, acc[0][0], 0, 0, 0); acc[0][1] = __builtin_amdgcn_mfma_f32_32x32x16_bf16(a0, b1, acc[0][1], 0, 0, 0); \
            acc[0][2] = __builtin_amdgcn_mfma_f32_32x32x16_bf16(a0, b2, acc[0][2], 0, 0, 0); acc[0][3] = __builtin_amdgcn_mfma_f32_32x32x16_bf16(a0, b3, acc[0][3], 0, 0, 0); \
            acc[1][0] = __builtin_amdgcn_mfma_f32_32x32x16_bf16(a1, b0, acc[1][0], 0, 0, 0); acc[1][1] = __builtin_amdgcn_mfma_f32_32x32x16_bf16(a1, b1, acc[1][1], 0, 0, 0); \
            acc[1][2] = __builtin_amdgcn_mfma_f32_32x32x16_bf16(a1, b2, acc[1][2], 0, 0, 0); acc[1][3] = __builtin_amdgcn_mfma_f32_32x32x16_bf16(a1, b3, acc[1][3], 0, 0, 0); } while (0)
        U_KS(0); U_KS(1); U_KS(2); U_KS(3);
#undef U_KS
        bf16* Ub = US + ((size_t)(bb * NH + head) * NCH + c) * 16384;
#pragma unroll
        for (int a = 0; a < 2; ++a)
#pragma unroll
            for (int v = 0; v < 4; ++v)
#pragma unroll
                for (int q4 = 0; q4 < 4; ++q4) { const int ks = 2 * (db0 + a) + (q4 >> 1), lanep = (q4 & 1) * 32 + r32;
                    u32x2 w; w.x = pk2(acc[a][v][4 * q4 + 0], acc[a][v][4 * q4 + 1]); w.y = pk2(acc[a][v][4 * q4 + 2], acc[a][v][4 * q4 + 3]);
                    *(u32x2*)(Ub + ((size_t)((ks * 4 + v) * 64 + lanep)) * 8 + 4 * hiC) = w; }
    }
    __syncthreads();
}
#if HG_V2
__device__ __forceinline__ void phase_h1(const Ctx& X, unsigned char* ws, int l) { const float* lbl = (const float*)(ws + WS_MISC + MISC_LB) + l * HGW; if (X.wave >= 4) __builtin_amdgcn_s_setprio(1); for (int u = X.bid; u < 2 * NCH; u += X.nblk) h1_unit(X, ws, u, lbl); __builtin_amdgcn_s_setprio(0); }
#else
__device__ __forceinline__ void phase_h1(const Ctx& X, unsigned char* ws, int) { for (int u = X.bid; u < 2 * NCH; u += X.nblk) h1_unit(X, ws, u); }
#endif
__device__ __forceinline__ void phase_h2(const Ctx& X, unsigned char* ws) {
    bf16* US = (bf16*)(ws + WS_XB); const float* Dd = (const float*)(ws + WS_HD); const float* Rr = (const float*)(ws + WS_HR);
    for (int u = X.bid; u < 256; u += X.nblk) {
        if (X.tid < 256) {
            const int bh = u >> 5, slot = u & 31, ks = slot >> 2, bb = bh >> 2, h = bh & 3, lanep = X.tid >> 2, j = 2 * (X.tid & 3), d = 16 * ks + 8 * (lanep >> 5) + j;
            unsigned* p = (unsigned*)(US + (size_t)bh * US_BH + (size_t)slot * 512 + 2 * X.tid);
            const float* dp = Dd + (size_t)bb * NCH * HGW + h * 128 + d; const float* rp = Rr + (size_t)bb * NCH * HGW + h * 128 + d;
            float s0 = 0.f, s1 = 0.f;
#pragma unroll 1
            for (int c0 = 0; c0 < NCH; c0 += 8) { unsigned uw[8]; float2 dv[8], rv[8];
#pragma unroll
                for (int i = 0; i < 8; ++i) { uw[i] = p[(size_t)(c0 + i) * 8192]; dv[i] = *(const float2*)(dp + (size_t)(c0 + i) * HGW); rv[i] = *(const float2*)(rp + (size_t)(c0 + i) * HGW); }
#pragma unroll
                for (int i = 0; i < 8; ++i) { p[(size_t)(c0 + i) * 8192] = pk2(rv[i].x * s0, rv[i].y * s1); s0 = dv[i].x * s0 + bflo(uw[i]); s1 = dv[i].y * s1 + bfhi(uw[i]); } }
        }
    }
}
__device__ __forceinline__ void h3_unit(const Ctx& X, unsigned char* ws, const float* onorm, int u) {
    const int bb = u >> 7, c = u & 127, row0 = bb * SEQ + c * CH, tid = X.tid, lane = X.lane, wave = X.wave;
    const float* LFB = (const float*)(ws + WS_LF); const bf16* HQ = (const bf16*)(ws + WS_HQ); const bf16* HK = (const bf16*)(ws + WS_HK); const bf16* HV = (const bf16*)(ws + WS_HV); const bf16* HG = (const bf16*)(ws + WS_HG);
    const bf16* US = (const bf16*)(ws + WS_XB); bf16* CC = (bf16*)(ws + WS_CC);
    LAS char* lds = (LAS char*)X.lds;
#if HG_V2
    const bf16* KRB = (const bf16*)(ws + WS_LF); const bf16* QRB = (const bf16*)(ws + WS_LF + 16 * MiB);
    const int head = wave >> 1, th = wave & 1, r32 = lane & 31, hi = lane >> 5, trow = row0 + 32 * th + r32;
    bf16x8 qr[8];
    { const int t0 = tid >> 4, c8 = (tid & 15) * 8; const size_t g0 = (size_t)(row0 + t0) * HGW + c8; const int kst0 = t0 * KROW2 + c8 * 2, vst0 = 4 * TILE_K2 + v_st(t0, c8);
      u32x4 kw[8], vw[8];
#pragma unroll
      for (int j = 0; j < 8; ++j) { const size_t g = g0 + (size_t)((j & 1) * 32 * HGW + (j >> 1) * 128); kw[j] = *(const u32x4*)(KRB + g); vw[j] = *(const u32x4*)(HV + g); }
      const size_t gq = (size_t)trow * HGW + head * 128 + hi * 8;
#pragma unroll
      for (int d0 = 0; d0 < 8; ++d0) qr[d0] = *reinterpret_cast<const bf16x8*>(QRB + gq + d0 * 16);
#pragma unroll
      for (int j = 0; j < 8; ++j) { *(LAS u32x4*)(lds + kst0 + (j >> 1) * TILE_K2 + (j & 1) * 32 * KROW2) = kw[j]; *(LAS u32x4*)(lds + vst0 + (j >> 1) * TILE_V + (j & 1) * 8192) = vw[j]; } }
#else
#pragma unroll 2
    for (int j = 0; j < 8; ++j) { const int i = tid + 512 * j, head = i >> 10, rem = i & 1023, t = rem >> 4, c8 = (rem & 15) * 8; const size_t g = (size_t)(row0 + t) * HGW + head * 128 + c8, gr = (size_t)(row0 + 31) * HGW + head * 128 + c8;
        const u32x4 kw = *(const u32x4*)(HK + g), vw = *(const u32x4*)(HV + g); const f32x4 b0 = *(const f32x4*)(LFB + g), b1 = *(const f32x4*)(LFB + g + 4); f32x4 r0 = *(const f32x4*)(LFB + gr), r1 = *(const f32x4*)(LFB + gr + 4);
#define KE(rr, bv) ex(fminf(fmaxf((rr), -60.f) - (bv), 80.f))
        u32x4 o; o.x = pk2(bflo(kw.x) * KE(r0.x, b0.x), bfhi(kw.x) * KE(r0.y, b0.y)); o.y = pk2(bflo(kw.y) * KE(r0.z, b0.z), bfhi(kw.y) * KE(r0.w, b0.w));
        o.z = pk2(bflo(kw.z) * KE(r1.x, b1.x), bfhi(kw.z) * KE(r1.y, b1.y)); o.w = pk2(bflo(kw.w) * KE(r1.z, b1.z), bfhi(kw.w) * KE(r1.w, b1.w));
#undef KE
        *(LAS u32x4*)(lds + head * TILE_K2 + t * KROW2 + c8 * 2) = o; *(LAS u32x4*)(lds + 4 * TILE_K2 + head * TILE_V + v_st(t, c8)) = vw; }
    const int head = wave >> 1, th = wave & 1, r32 = lane & 31, hi = lane >> 5, trow = row0 + 32 * th + r32;
    bf16x8 qr[8];
    {
        const size_t g = (size_t)trow * HGW + head * 128 + hi * 8, gr = (size_t)(row0 + 31) * HGW + head * 128 + hi * 8;
#pragma unroll
        for (int d0 = 0; d0 < 8; ++d0) { const u32x4 qw = *(const u32x4*)(HQ + g + d0 * 16); const f32x4 b0 = *(const f32x4*)(LFB + g + d0 * 16), b1 = *(const f32x4*)(LFB + g + d0 * 16 + 4), r0 = *(const f32x4*)(LFB + gr + d0 * 16), r1 = *(const f32x4*)(LFB + gr + d0 * 16 + 4);
#define QE(bv, rr) ex(fminf((bv) - fmaxf((rr), -60.f), 80.f))
            u32x4 o; o.x = pk2(bflo(qw.x) * QE(b0.x, r0.x), bfhi(qw.x) * QE(b0.y, r0.y)); o.y = pk2(bflo(qw.y) * QE(b0.z, r0.z), bfhi(qw.y) * QE(b0.w, r0.w));
            o.z = pk2(bflo(qw.z) * QE(b1.x, r1.x), bfhi(qw.z) * QE(b1.y, r1.y)); o.w = pk2(bflo(qw.w) * QE(b1.z, r1.z), bfhi(qw.w) * QE(b1.w, r1.w));
#undef QE
            qr[d0] = __builtin_bit_cast(bf16x8, o); }
    }
#endif
    __syncthreads();
    f32x16 p0 = f32x16{}, p1 = f32x16{};
    { const LAS char* kb = lds + head * TILE_K2 + r32 * KROW2 + hi * 16;
#pragma unroll
      for (int d0 = 0; d0 < 8; ++d0) { const bf16x8 k0 = *reinterpret_cast<const LAS bf16x8*>(kb + d0 * 32); p0 = __builtin_amdgcn_mfma_f32_32x32x16_bf16(k0, qr[d0], p0, 0, 0, 0);
          if (th) { const bf16x8 k1 = *reinterpret_cast<const LAS bf16x8*>(kb + d0 * 32 + 32 * KROW2); p1 = __builtin_amdgcn_mfma_f32_32x32x16_bf16(k1, qr[d0], p1, 0, 0, 0); } } }
    { const int tq = 32 * th + r32 - 4 * hi;
#pragma unroll
      for (int r = 0; r < 16; ++r) { const int cr = (r & 3) + 8 * (r >> 2); if (tq - cr < 0) p0[r] = 0.f; if (tq - cr - 32 < 0) p1[r] = 0.f; } }
    bf16x8 pa0, pa1, pa2, pa3;
#define PK4(P, B_, OUT) do { unsigned a0 = cvtpk(P[B_+0], P[B_+1]), a1 = cvtpk(P[B_+2], P[B_+3]);                          \
        unsigned b0 = cvtpk(P[B_+4], P[B_+5]), b1 = cvtpk(P[B_+6], P[B_+7]);                                             \
        auto r0 = __builtin_amdgcn_permlane32_swap(a0, b0, false, false); auto r1 = __builtin_amdgcn_permlane32_swap(a1, b1, false, false); \
        u32x4 w = {r0[0], r1[0], r0[1], r1[1]}; OUT = *reinterpret_cast<bf16x8*>(&w); } while (0)
    PK4(p0, 0, pa0); PK4(p0, 8, pa1); PK4(p1, 0, pa2); PK4(p1, 8, pa3);
#undef PK4
    f32x16 o[4] = {};
    { const int vb = (int)(unsigned)(size_t)(lds + 4 * TILE_K2 + head * TILE_V) + v_rd_base(lane);
#define PV(d0) do { bf16x8 f0, f1, f2, f3; FRAG(f0, vb, d0, 0); FRAG(f1, vb, d0, 1); FRAG(f2, vb, d0, 2); FRAG(f3, vb, d0, 3); \
        o[d0] = __builtin_amdgcn_mfma_f32_32x32x16_bf16(pa0, f0, o[d0], 0, 0, 0); o[d0] = __builtin_amdgcn_mfma_f32_32x32x16_bf16(pa1, f1, o[d0], 0, 0, 0); \
        o[d0] = __builtin_amdgcn_mfma_f32_32x32x16_bf16(pa2, f2, o[d0], 0, 0, 0); o[d0] = __builtin_amdgcn_mfma_f32_32x32x16_bf16(pa3, f3, o[d0], 0, 0, 0); } while (0)
      PV(0); PV(1); PV(2); PV(3);
#undef PV
    }
    { const bf16* Sb = US + ((size_t)(bb * NH + head) * NCH + c) * 16384 + (size_t)lane * 8;
#pragma unroll
      for (int vb = 0; vb < 4; ++vb)
#pragma unroll
          for (int ks = 0; ks < 8; ++ks) { const bf16x8 sf = *reinterpret_cast<const bf16x8*>(Sb + (size_t)(ks * 4 + vb) * 512); o[vb] = __builtin_amdgcn_mfma_f32_32x32x16_bf16(qr[ks], sf, o[vb], 0, 0, 0); } }
    float rs[16];
#if H3_STAGED_EPI
#define DPP_ADD(v, ctrl) ((v) + __int_as_float(__builtin_amdgcn_update_dpp(0, __float_as_int(v), (ctrl), 0xf, 0xf, true)))
#pragma unroll
    for (int r = 0; r < 16; ++r) { float q = o[0][r] * o[0][r] + o[1][r] * o[1][r] + o[2][r] * o[2][r] + o[3][r] * o[3][r];
        q = DPP_ADD(q, 0xB1); q = DPP_ADD(q, 0x4E); q = DPP_ADD(q, 0x124); q = DPP_ADD(q, 0x128);
        { const auto rr = __builtin_amdgcn_permlane16_swap(__float_as_uint(q), __float_as_uint(q), false, false); q = __uint_as_float(rr[0]) + __uint_as_float(rr[1]); }
        rs[r] = __builtin_amdgcn_rsqf(q * (1.f / 128.f) + EPS); }
#undef DPP_ADD
    __syncthreads();
    {   LAS char* stg = lds + wave * (TILE_K2 / 2);
        const int wbase = hi * (4 * KROW2) + r32 * 2;
#pragma unroll
        for (int vb = 0; vb < 4; ++vb) { const float gn = onorm[32 * vb + r32];
#pragma unroll
            for (int r = 0; r < 16; r += 2) { const unsigned w = cvtpk(o[vb][r] * rs[r] * gn, o[vb][r + 1] * rs[r + 1] * gn);
                *(LAS unsigned short*)(stg + wbase + ((r & 3) + 8 * (r >> 2)) * KROW2 + vb * 64) = (unsigned short)w;
                *(LAS unsigned short*)(stg + wbase + ((r & 3) + 1 + 8 * (r >> 2)) * KROW2 + vb * 64) = (unsigned short)(w >> 16); } }
        const int rrow = lane >> 4, rchunk = lane & 15;
#pragma unroll
        for (int jh = 0; jh < 2; ++jh) { u32x4 t[4], g[4];
#pragma unroll
            for (int j = 0; j < 4; ++j) { const int lr = rrow + 4 * (jh * 4 + j); t[j] = *(const LAS u32x4*)(stg + lr * KROW2 + rchunk * 16);
                g[j] = *(const u32x4*)(HG + (size_t)(row0 + 32 * th + lr) * HGW + head * 128 + rchunk * 8); }
#pragma unroll
            for (int j = 0; j < 4; ++j) { const int lr = rrow + 4 * (jh * 4 + j); u32x4 w;
                w.x = pk2(bflo(t[j].x) * siluf_(bflo(g[j].x)), bfhi(t[j].x) * siluf_(bfhi(g[j].x))); w.y = pk2(bflo(t[j].y) * siluf_(bflo(g[j].y)), bfhi(t[j].y) * siluf_(bfhi(g[j].y)));
                w.z = pk2(bflo(t[j].z) * siluf_(bflo(g[j].z)), bfhi(t[j].z) * siluf_(bfhi(g[j].z))); w.w = pk2(bflo(t[j].w) * siluf_(bflo(g[j].w)), bfhi(t[j].w) * siluf_(bfhi(g[j].w)));
                *(u32x4*)(CC + (size_t)(row0 + 32 * th + lr) * DM + 512 + head * 128 + rchunk * 8) = w; } }
    }
#else
#pragma unroll
    for (int r = 0; r < 16; ++r) { float q = o[0][r] * o[0][r] + o[1][r] * o[1][r] + o[2][r] * o[2][r] + o[3][r] * o[3][r];
        q += __shfl_xor(q, 1); q += __shfl_xor(q, 2); q += __shfl_xor(q, 4); q += __shfl_xor(q, 8); q += __shfl_xor(q, 16); rs[r] = rsqrtf(q * (1.f / 128.f) + EPS); }
#pragma unroll
    for (int vb = 0; vb < 4; ++vb) { const float gn = onorm[32 * vb + r32];
#pragma unroll
        for (int r = 0; r < 16; ++r) { const size_t row = (size_t)(row0 + 32 * th + crow(r, hi));
            const float g = bf2f(HG[row * HGW + head * 128 + 32 * vb + r32]); const float val = o[vb][r] * rs[r] * gn * siluf_(g); const float vn = __shfl_xor(val, 1);
            if ((r32 & 1) == 0) *(unsigned*)(CC + row * DM + 512 + head * 128 + 32 * vb + r32) = cvtpk(val, vn); } }
#endif
    __syncthreads();
}
#undef FRAG
#undef TRRD2
__device__ __forceinline__ void phase_h3(const Ctx& X, unsigned char* ws, const float* onorm) { if (X.wave >= 4) __builtin_amdgcn_s_setprio(1); for (int u = X.bid; u < 2 * NCH; u += X.nblk) h3_unit(X, ws, onorm, u); __builtin_amdgcn_s_setprio(0); }
}

__device__ __forceinline__ void phase_hgrn_simple(const Ctx& X, const Params& p) {
    unsigned char* ws = p.ws;
    const bf16* HQ = (const bf16*)(ws + WS_HQ); const bf16* HK = (const bf16*)(ws + WS_HK); const bf16* HV = (const bf16*)(ws + WS_HV); const float* LF = (const float*)(ws + WS_LF);
    float* OB = (float*)(ws + WS_XB);
    for (int bh = X.bid; bh < 2 * NH; bh += X.nblk) {
        if (X.tid < 256) {
            const int v = X.tid >> 1, hf = X.tid & 1, b = bh >> 2, h = bh & 3;
            float S[64];
#pragma unroll
            for (int j = 0; j < 64; ++j) S[j] = 0.f;
            for (int t = 0; t < SEQ; ++t) {
                const size_t base = ((size_t)(b * SEQ + t)) * HGW + h * 128;
                const float vt = bf2f(HV[base + v]);
                float o = 0.f;
#pragma unroll
                for (int j8 = 0; j8 < 8; ++j8) {
                    const size_t bj = base + 64 * hf + 8 * j8;
                    const f32x4 f0 = *(const f32x4*)(LF + bj), f1 = *(const f32x4*)(LF + bj + 4);
                    const u32x4 kw = *(const u32x4*)(HK + bj), qw = *(const u32x4*)(HQ + bj);
#define HSTEP(J, lf, kk, qq) do { S[8 * j8 + J] = fast_exp(lf) * S[8 * j8 + J] + (kk) * vt; o += (qq) * S[8 * j8 + J]; } while (0)
                    HSTEP(0, f0.x, bflo(kw.x), bflo(qw.x)); HSTEP(1, f0.y, bfhi(kw.x), bfhi(qw.x)); HSTEP(2, f0.z, bflo(kw.y), bflo(qw.y)); HSTEP(3, f0.w, bfhi(kw.y), bfhi(qw.y));
                    HSTEP(4, f1.x, bflo(kw.z), bflo(qw.z)); HSTEP(5, f1.y, bfhi(kw.z), bfhi(qw.z)); HSTEP(6, f1.z, bflo(kw.w), bflo(qw.w)); HSTEP(7, f1.w, bfhi(kw.w), bfhi(qw.w));
#undef HSTEP
                }
                o += __shfl_xor(o, 1);
                if (hf == 0) OB[base + v] = o;
            }
        }
    }
}
__device__ __forceinline__ void phase_hgrn_out(const Ctx& X, const Params& p, int l) {
    unsigned char* ws = p.ws;
    const float* OB = (const float*)(ws + WS_XB); const bf16* HG = (const bf16*)(ws + WS_HG); bf16* CC = (bf16*)(ws + WS_CC); const float* on = p.in[I_HON] + l * 128;
    const int gw = X.bid * NWAVES + X.wave, ngw = X.nblk * NWAVES, lane = X.lane;
    for (int i = gw; i < T * NH; i += ngw) {
        const int row = i >> 2, h = i & 3; const size_t base = (size_t)row * HGW + h * 128 + 2 * lane;
        const float o0 = OB[base], o1 = OB[base + 1];
        const float rstd = rsqrtf(wave_sum(o0 * o0 + o1 * o1) * (1.f / 128.f) + EPS);
        const unsigned gw2 = *(const unsigned*)(HG + base);
        *(unsigned*)(CC + (size_t)row * DM + 512 + h * 128 + 2 * lane) = pk2(o0 * rstd * on[2 * lane] * siluf_(bflo(gw2)), o1 * rstd * on[2 * lane + 1] * siluf_(bfhi(gw2)));
    }
}

template <class TS>
__device__ __forceinline__ void phase_norm(const Ctx& X, const Params& p, const TS* src, const float* gain) { norm_all_rows(X, src, gain, (bf16*)(p.ws + WS_XB)); }
template <class TS>
__device__ __forceinline__ void phase_norm_route(const Ctx& X, const Params& p, const TS* src, const float* gain) {
    unsigned char* ws = p.ws;
    int* GCNT = (int*)(ws + WS_MISC + MISC_GCNT); int* TOPI = (int*)(ws + WS_MISC + MISC_TOPI); float* TOPG = (float*)(ws + WS_MISC + MISC_TOPG);
    const float* wr = p.in[I_ROUTER];
    LAS int* wcnt = (LAS int*)(X.lds);
    const int lane = X.lane, b5 = lane >> 5, b4 = (lane >> 4) & 1, b3 = (lane >> 3) & 1;
    f32x4 w0[4][4], w1[4][4], gn[4];
#pragma unroll
    for (int j = 0; j < 4; ++j) { gn[j] = *((const f32x4*)gain + lane + 64 * j);
#pragma unroll
        for (int q = 0; q < 4; ++q) { const float* wp = wr + (size_t)(4 * (lane + 64 * j) + q) * NE; w0[j][q] = *(const f32x4*)wp; w1[j][q] = *(const f32x4*)(wp + 4); } }
    for (int g = X.bid; g < T / 64; g += X.nblk) {
        int cn[NE];
#pragma unroll
        for (int e = 0; e < NE; ++e) cn[e] = 0;
#pragma unroll 1
        for (int bt = 0; bt < 4; ++bt) {
            const int rbase = g * 64 + X.wave * 8 + 2 * bt;
            f32x4 v[2][4];
#pragma unroll
            for (int i = 0; i < 2; ++i)
#pragma unroll
                for (int j = 0; j < 4; ++j) v[i][j] = ldrow4(src + (size_t)(rbase + i) * DM, lane + 64 * j);
#pragma unroll
            for (int i = 0; i < 2; ++i) { const int row = rbase + i; float s = 0.f;
#pragma unroll
                for (int j = 0; j < 4; ++j) s += (v[i][j].x * v[i][j].x + v[i][j].y * v[i][j].y) + (v[i][j].z * v[i][j].z + v[i][j].w * v[i][j].w);
                const float rstd = __builtin_amdgcn_rsqf(wave_sum(s) * (1.f / DM) + EPS);
                float lg[NE];
#pragma unroll
                for (int e = 0; e < NE; ++e) lg[e] = 0.f;
#pragma unroll
                for (int j = 0; j < 4; ++j) { const f32x4 y = v[i][j] * rstd * gn[j];
                    *((unsigned*)((unsigned char*)(ws + WS_XB) + (size_t)row * DM) + lane + 64 * j) = pk4_fp8(y.x, y.y, y.z, y.w);
#pragma unroll
                    for (int q = 0; q < 4; ++q) { const float yv = (q == 0) ? y.x : (q == 1) ? y.y : (q == 2) ? y.z : y.w;
                        lg[0] += yv * w0[j][q].x; lg[1] += yv * w0[j][q].y; lg[2] += yv * w0[j][q].z; lg[3] += yv * w0[j][q].w; lg[4] += yv * w1[j][q].x; lg[5] += yv * w1[j][q].y; lg[6] += yv * w1[j][q].z; lg[7] += yv * w1[j][q].w; } }
                float k4[4], k2[2], k1;
#pragma unroll
                for (int t = 0; t < 4; ++t) { const float keep = b5 ? lg[4 + t] : lg[t], send = b5 ? lg[t] : lg[4 + t]; k4[t] = keep + xget32(send, b5); }
#pragma unroll
                for (int t = 0; t < 2; ++t) { const float keep = b4 ? k4[2 + t] : k4[t], send = b4 ? k4[t] : k4[2 + t]; k2[t] = keep + xget16(send, b4); }
                { const float keep = b3 ? k2[1] : k2[0], send = b3 ? k2[0] : k2[1]; k1 = keep + DPP_F(send, 0x128); }
                k1 += DPP_F(k1, 0xB1); k1 += DPP_F(k1, 0x4E); k1 += DPP_F(k1, 0x141);
                float tl[NE];
#pragma unroll
                for (int e = 0; e < NE; ++e) tl[e] = __int_as_float(__builtin_amdgcn_readlane(__float_as_int(k1), (e >> 2) * 32 + ((e >> 1) & 1) * 16 + (e & 1) * 8));
                int e1 = 0; float l1 = tl[0];
#pragma unroll
                for (int e = 1; e < NE; ++e) if (tl[e] > l1) { l1 = tl[e]; e1 = e; }
                int e2 = -1; float l2 = -3.0e38f;
#pragma unroll
                for (int e = 0; e < NE; ++e) if (e != e1 && tl[e] > l2) { l2 = tl[e]; e2 = e; }
#pragma unroll
                for (int e = 0; e < NE; ++e) cn[e] += (e == e1) + (e == e2);
                if (lane == 0) { const float g1 = 1.f / (1.f + expf(l2 - l1)); TOPI[row * 2] = e1; TOPI[row * 2 + 1] = e2; TOPG[row * 2] = g1; TOPG[row * 2 + 1] = 1.f - g1; }
            }
        }
        if (lane == 0) {
#pragma unroll
            for (int e = 0; e < NE; ++e) wcnt[X.wave * NE + e] = cn[e]; }
        __syncthreads();
        if (X.tid < NE) { int t = 0;
#pragma unroll
            for (int w = 0; w < NWAVES; ++w) t += wcnt[w * NE + X.tid];
            GCNT[g * NE + X.tid] = t; }
        __syncthreads();
    }
}
__device__ __forceinline__ void phase_scatter(const Ctx& X, const Params& p) {
    unsigned char* ws = p.ws;
    const int* GCNT = (const int*)(ws + WS_MISC + MISC_GCNT); const int* TOPI = (const int*)(ws + WS_MISC + MISC_TOPI); int* POS = (int*)(ws + WS_MISC + MISC_POS);
    int* TILE_E = (int*)(ws + WS_MISC + MISC_TILE_E); int* NT = (int*)(ws + WS_MISC + MISC_NT);
    const unsigned char* XF = (const unsigned char*)(ws + WS_XB); unsigned char* XS = (unsigned char*)(ws + WS_XS);
    LAS int* gc = (LAS int*)(X.lds);
    LAS int* pstart = gc + 256 * NE;
    LAS int* ntot = pstart + 8;
    LAS int* basel = ntot + 8;
    LAS int* posl = basel + 8;
    for (int i = X.tid; i < 256 * NE; i += NTHREADS) gc[i] = GCNT[i];
    __syncthreads();
    { const int e = X.wave; int n = 0;
#pragma unroll
      for (int k = 0; k < 4; ++k) n += gc[(X.lane + 64 * k) * NE + e];
      n += DPP_I(n, 0xB1); n += DPP_I(n, 0x4E); n += DPP_I(n, 0x124); n += DPP_I(n, 0x128); { const auto r = __builtin_amdgcn_permlane16_swap((unsigned)n, (unsigned)n, false, false); n = (int)(r[0] + r[1]); } { const auto r = __builtin_amdgcn_permlane32_swap((unsigned)n, (unsigned)n, false, false); n = (int)(r[0] + r[1]); }
      if (X.lane == 0) ntot[e] = n; }
    __syncthreads();
    if (X.tid == 0) { int acc = 0;
        for (int e = 0; e < NE; ++e) { pstart[e] = acc; const int nt = (ntot[e] + 255) >> 8; if (X.bid == 0) for (int t = 0; t < nt; ++t) TILE_E[(acc >> 8) + t] = e; acc += nt * 256; }
        if (X.bid == 0) NT[0] = acc >> 8; }
    __syncthreads();
    for (int g = X.bid; g < T / 64; g += X.nblk) {
        { const int e = X.wave; int n = 0;
#pragma unroll
          for (int k = 0; k < 4; ++k) { const int gg = X.lane + 64 * k; n += (gg < g) ? gc[gg * NE + e] : 0; }
          n += DPP_I(n, 0xB1); n += DPP_I(n, 0x4E); n += DPP_I(n, 0x124); n += DPP_I(n, 0x128); { const auto r = __builtin_amdgcn_permlane16_swap((unsigned)n, (unsigned)n, false, false); n = (int)(r[0] + r[1]); } { const auto r = __builtin_amdgcn_permlane32_swap((unsigned)n, (unsigned)n, false, false); n = (int)(r[0] + r[1]); }
          if (X.lane == 0) basel[e] = pstart[e] + n; }
        __syncthreads();
        if (X.wave == 0) {
            const int row = g * 64 + X.lane; const int e1 = TOPI[row * 2], e2 = TOPI[row * 2 + 1];
            int p1 = 0, p2 = 0;
            const unsigned long long lt = (1ull << X.lane) - 1ull;
#pragma unroll
            for (int e = 0; e < NE; ++e) {
                const int base = basel[e];
                const unsigned long long m1 = __ballot(e1 == e), m2 = __ballot(e2 == e);
                if (e1 == e) p1 = base + __popcll(m1 & lt);
                if (e2 == e) p2 = base + __popcll(m1) + __popcll(m2 & lt);
            }
            POS[row * 2] = p1; POS[row * 2 + 1] = p2; posl[X.lane * 2] = p1; posl[X.lane * 2 + 1] = p2;
        }
        __syncthreads();
        { u32x4 a[8];
#pragma unroll
          for (int i = 0; i < 8; ++i) a[i] = ((const u32x4*)(XF + (size_t)(g * 64 + X.wave * 8 + i) * DM))[X.lane];
#pragma unroll
          for (int i = 0; i < 8; ++i) { const int r = X.wave * 8 + i; ((u32x4*)(XS + (size_t)posl[r * 2] * DM))[X.lane] = a[i]; ((u32x4*)(XS + (size_t)posl[r * 2 + 1] * DM))[X.lane] = a[i]; } }
        __syncthreads();
    }
}
template <class TS>
__device__ __forceinline__ void phase_combine(const Ctx& X, const Params& p, const TS* xr) {
    unsigned char* ws = p.ws;
    const int* POS = (const int*)(ws + WS_MISC + MISC_POS); const float* TOPG = (const float*)(ws + WS_MISC + MISC_TOPG); const bf16* YS = (const bf16*)(ws + WS_YS);
    const float* fn = p.in[I_FINN];
    const int gw = X.bid * NWAVES + X.wave, ngw = X.nblk * NWAVES, lane = X.lane;
    f32x4 gf[4];
#pragma unroll
    for (int j = 0; j < 4; ++j) gf[j] = *((const f32x4*)fn + lane + 64 * j);
    for (int r0 = gw; r0 < T; r0 += 2 * ngw) {
        int pp[2][2]; float gg[2][2]; f32x4 v[2][4]; u32x2 ya[2][4], yb[2][4];
#pragma unroll
        for (int i = 0; i < 2; ++i) { const int row = (r0 + i * ngw < T) ? r0 + i * ngw : r0; pp[i][0] = POS[row * 2]; pp[i][1] = POS[row * 2 + 1]; gg[i][0] = TOPG[row * 2]; gg[i][1] = TOPG[row * 2 + 1];
#pragma unroll
            for (int j = 0; j < 4; ++j) v[i][j] = ldrow4(xr + (size_t)row * DM, lane + 64 * j); }
#pragma unroll
        for (int i = 0; i < 2; ++i)
#pragma unroll
            for (int j = 0; j < 4; ++j) { ya[i][j] = *((const u32x2*)(YS + (size_t)pp[i][0] * DM) + lane + 64 * j); yb[i][j] = *((const u32x2*)(YS + (size_t)pp[i][1] * DM) + lane + 64 * j); }
#if DN_SPLITK
#pragma unroll
        for (int i = 0; i < 2; ++i)
#pragma unroll
            for (int k = 0; k < 2; ++k) { const int pos = pp[i][k];
                if (pos >= 128 * 256) { const float* sl = (const float*)(ws + WS_SLAB) + ((size_t)(((pos >> 8) - 128) * 4) * 7 * 256 + (pos & 255)) * 256 + 4 * lane;
#pragma unroll
                    for (int j = 0; j < 4; ++j) { f32x4 acc = *(const f32x4*)(sl + (size_t)(j * 7) * 65536);
#pragma unroll
                        for (int q = 1; q < 7; ++q) acc = acc + *(const f32x4*)(sl + (size_t)(j * 7 + q) * 65536);
                        u32x2 w; w.x = pk2(acc.x, acc.y); w.y = pk2(acc.z, acc.w); if (k == 0) ya[i][j] = w; else yb[i][j] = w; } } }
#endif
#pragma unroll
        for (int i = 0; i < 2; ++i) { const int row = (r0 + i * ngw < T) ? r0 + i * ngw : r0; const float g1 = gg[i][0], g2 = gg[i][1]; float s = 0.f;
#pragma unroll
            for (int j = 0; j < 4; ++j) { const u32x2 a = ya[i][j], b = yb[i][j]; f32x4& x = v[i][j];
                x.x += g1 * bflo(a.x) + g2 * bflo(b.x); x.y += g1 * bfhi(a.x) + g2 * bfhi(b.x); x.z += g1 * bflo(a.y) + g2 * bflo(b.y); x.w += g1 * bfhi(a.y) + g2 * bfhi(b.y);
                s += (x.x * x.x + x.y * x.y) + (x.z * x.z + x.w * x.w); }
            const float rstd = __builtin_amdgcn_rsqf(wave_sum(s) * (1.f / DM) + EPS);
#pragma unroll
            for (int j = 0; j < 4; ++j) *((f32x4*)(p.out + (size_t)row * DM) + lane + 64 * j) = v[i][j] * rstd * gf[j]; }
    }
}

__device__ __forceinline__ bool relaunder(Ctx& X, unsigned char*& ws, const Params& p) {
    int t = threadIdx.x; asm volatile("" : "+v"(t)); X.tid = t; X.lane = t & 63; X.wave = __builtin_amdgcn_readfirstlane(t >> 6);
    unsigned long long w = (unsigned long long)p.ws; asm volatile("" : "+s"(w)); ws = (unsigned char*)(GAS unsigned char*)w;
    return true;
}
constexpr int NPHASES = 26;
#define PHASE(k) relaunder(X, ws, p)
#define SEAM(k) xcd_barrier(bar)
template <int L>
__device__ __forceinline__ void run_layer(Ctx& X, const Params& p, const XcdBarrier& bar) {
    unsigned char* ws;
#if XR_BF16
    xr_t* XR = (xr_t*)(p.ws + WS_XRB);
#else
    xr_t* XR = p.out;
#endif
    PHASE(pb + 0); {
        EpiProj E{ws, L, (FUSE_NORM && L == 1) ? (int)MISC_SSXB : 0};
        gemm_dense(X, (FUSE_NORM && L == 1) ? (const bf16*)XR : (const bf16*)(ws + WS_XB), (const bf16*)(ws + WS_WT_IN) + (size_t)L * NPROJ_P * DM, NPROJ_P, DM, E);
#if TAILFILL && MOE_FP8
        if (X.nblk == 256 && X.bid >= 192) tail_fill(X, p, L == 0 ? 0 : TAIL_A + TAIL_B + TAIL_C, TAILFILL_A, X.bid - 192, 64);
#endif
#ifdef PROBE_INPROJ_NOEPI
        { EpiProbe EP{(float*)(ws + WS_CC)}; gemm_dense(X, (const bf16*)(ws + WS_XB), (const bf16*)(ws + WS_WT_IN) + (size_t)L * NPROJ_P * DM, NPROJ_P, DM, EP); }
#endif
    } SEAM(pb + 0);
    PHASE(pb + 1); {
        EpiQ EQ{ws}; EpiKV EK{ws};
        REP_X(REP_QKV, gemm_dense(X, (const bf16*)(ws + WS_CQ), (const bf16*)(ws + WS_WT_QB) + (size_t)L * (NH * DQK) * QR, NH * DQK, QR, EQ);
        gemm_dense(X, (const bf16*)(ws + WS_CKV), (const bf16*)(ws + WS_WT_KVB) + (size_t)L * 1024 * KVR, 1024, KVR, EK);)
#if FAST_HGRN
        hg::phase_h1(X, ws, L);
#endif
#if TAILFILL && MOE_FP8
        if (X.nblk == 256 && X.bid >= 192) tail_fill(X, p, (L == 0 ? 0 : TAIL_A + TAIL_B + TAIL_C) + TAIL_A, TAILFILL_B, X.bid - 192, 64);
#endif
    } SEAM(pb + 1);
#if FAST_ATTN
    PHASE(pb + 2); {
#if FAST_HGRN
        hg::phase_h2(X, ws);
#endif
        REP_X(REP_ATTN, phase_attn_fast(X, ws);) } SEAM(pb + 2);
#else
    PHASE(pb + 2); { phase_attn_simple(X, p); } SEAM(pb + 2);
#endif
#if !FAST_HGRN
    PHASE(pb + 3); { phase_hgrn_simple(X, p); } SEAM(pb + 3);
#endif
#if FAST_ATTN
#if FAST_HGRN
    PHASE(pb + 4); { phase_attn_combine(X, ws); REP_X(REP_H3, hg::phase_h3(X, ws, p.in[I_HON] + L * 128);) } SEAM(pb + 4);
#else
    PHASE(pb + 4); { phase_attn_combine(X, ws); phase_hgrn_out(X, p, L); } SEAM(pb + 4);
#endif
#else
    PHASE(pb + 4); { phase_hgrn_out(X, p, L); } SEAM(pb + 4);
#endif
    PHASE(pb + 5); {
#if FUSE_NORM
        if (L == 0) { EpiResNormT<float> E{p.in[I_X], XR, (float*)(ws + WS_MISC + MISC_SSXA), 0.f, (LAS float*)(X.lds + 131072)}; gemm_dense(X, (const bf16*)(ws + WS_CC), (const bf16*)(ws + WS_WT_OUT) + (size_t)L * DM * DM, DM, DM, E); }
#else
        if (L == 0) { EpiResT<float, xr_t> E{p.in[I_X], XR}; gemm_dense(X, (const bf16*)(ws + WS_CC), (const bf16*)(ws + WS_WT_OUT) + (size_t)L * DM * DM, DM, DM, E); }
#endif
        else { EpiResT<xr_t, xr_t> E{XR, XR}; gemm_dense(X, (const bf16*)(ws + WS_CC), (const bf16*)(ws + WS_WT_OUT) + (size_t)L * DM * DM, DM, DM, E); }
    } SEAM(pb + 5);
#if FUSE_NORM
    if (L == 1) { PHASE(pb + 6); { phase_norm_route(X, p, XR, p.in[I_FFNN] + DM); } SEAM(pb + 6); }
    if (L == 0) {
        PHASE(8); { EpiSwiglu E{(bf16*)(ws + WS_HID), FF0, 0, (const float*)(ws + WS_MISC + MISC_SSXA)};
            gemm_dense(X, (const bf16*)XR, (const bf16*)(ws + WS_WT_GU), 2 * FF0, DM, E);
#if TAILFILL && MOE_FP8
            if (X.nblk == 256 && X.bid >= 128) tail_fill(X, p, TAIL_A + TAIL_B, TAILFILL_C, X.bid - 128, 128);
#endif
#ifdef PROBE_GU_NOEPI
            { EpiProbe EP{(float*)(ws + WS_CC)}; gemm_dense(X, (const bf16*)XR, (const bf16*)(ws + WS_WT_GU), 2 * FF0, DM, EP); }
#endif
            } SEAM(8);
        PHASE(9); { EpiResNormT<xr_t> E{XR, XR, (float*)(ws + WS_MISC + MISC_SSXB), 0.f, (LAS float*)(X.lds + 131072)};
            gemm_dense(X, (const bf16*)(ws + WS_HID), (const bf16*)(ws + WS_WT_DN), DM, FF0, E); } SEAM(9);
    }
#else
    PHASE(pb + 6); { if (L == 0) { phase_norm(X, p, XR, p.in[I_FFNN]); } else { phase_norm_route(X, p, XR, p.in[I_FFNN] + DM); } } SEAM(pb + 6);
    if (L == 0) {
        PHASE(8); { EpiSwiglu E{(bf16*)(ws + WS_HID), FF0, 0, nullptr};
            gemm_dense(X, (const bf16*)(ws + WS_XB), (const bf16*)(ws + WS_WT_GU), 2 * FF0, DM, E); } SEAM(8);
        PHASE(9); { EpiResT<xr_t, xr_t> E{XR, XR};
            gemm_dense(X, (const bf16*)(ws + WS_HID), (const bf16*)(ws + WS_WT_DN), DM, FF0, E); } SEAM(9);
        PHASE(10); { phase_norm(X, p, XR, p.in[I_MIXN] + DM); } SEAM(10);
    }
#endif
}

__global__ void __launch_bounds__(NTHREADS, 2) mega(Params p) {
    extern __shared__ __attribute__((aligned(16))) unsigned char lds_raw[];
    Ctx X; X.tid = threadIdx.x; X.lane = X.tid & 63; X.wave = __builtin_amdgcn_readfirstlane(X.tid >> 6); X.bid = blockIdx.x; X.nblk = gridDim.x; X.lds = (LAS unsigned char*)lds_raw;
    unsigned char* ws = p.ws;
    volatile LAS unsigned* MISC = (volatile LAS unsigned*)(X.lds + LDS_MISC_OFF);
    if (X.tid < 32) MISC[X.tid] = 0u;
    __syncthreads();
    const XcdBarrier bar = xcd_barrier_post((unsigned*)(ws + WS_CTL) + CW_BAR, MISC + 8);

    PHASE(0); { REP_X(REP_PRO, phase_prologue(X, p);) } SEAM(0);
    run_layer<0>(X, p, bar);
    run_layer<1>(X, p, bar);
    PHASE(18); { REP_X(REP_ROUTE, phase_scatter(X, p);) } SEAM(18);
#if MOE_FP8
    PHASE(19); { const int* NTp = (const int*)(ws + WS_MISC + MISC_NT); const int* TILE_E = (const int*)(ws + WS_MISC + MISC_TILE_E); const int nt = NTp[0];
        EpiSwiglu8 E{(unsigned char*)(ws + WS_HIDM), FFM, 0};
        REP_X(REP_MOEGU, gemm_moe(X, (const bf16*)(ws + WS_XS), (const bf16*)(ws + WS_WT_MGU), 0, nt, 2 * FFM, DM / 2, TILE_E, 0, 0x79797979, E);) } SEAM(19);
    PHASE(20); { const int* NTp = (const int*)(ws + WS_MISC + MISC_NT); const int* TILE_E = (const int*)(ws + WS_MISC + MISC_TILE_E); const int nt = NTp[0];
        EpiBf16Plain E{(bf16*)(ws + WS_YS), DM};
#if DN_SPLITK
        const int nfull = nt < 128 ? nt : 128;
        gemm_moe(X, (const bf16*)(ws + WS_HIDM), (const bf16*)(ws + WS_WT_MDN), 0, nfull, DM, FFM / 2, TILE_E, 0, 0x78787878, E);
        { const int nsub = (nt - nfull) * 4 * 7, sidx = (int)X.bid;
          pg8::OneUnit S1; S1.have = sidx < nsub;
          const int ks = sidx % 7, up = sidx / 7, pn = up & 3, pm = nfull + (up >> 2);
          S1.u.pm = pm; S1.u.pn = pn; S1.u.pa = pm; S1.u.pb = (S1.have ? __builtin_amdgcn_readfirstlane(TILE_E[pm]) : 0) * 4 + pn;
          pg8::Gemm g1{(const bf16*)(ws + WS_HIDM + (size_t)ks * 512), (const bf16*)(ws + WS_WT_MDN + (size_t)ks * 512), 256, DM, 256, 0x78787878, FFM / 2};
          EpiSlab E1{(float*)(ws + WS_SLAB), ks};
          pg8::gemm_phase<EpiSlab, pg8::OneUnit, true, true, true>(X.lds, g1, S1, E1); }
        } SEAM(20);
#else
        REP_X(REP_MOEDN, gemm_moe(X, (const bf16*)(ws + WS_HIDM), (const bf16*)(ws + WS_WT_MDN), 0, nt, DM, FFM / 2, TILE_E, 0, 0x78787878, E);) } SEAM(20);
#endif
#else
    for (int c = 0; c < 3; ++c) {
        PHASE(19 + 2 * c); { const int* NTp = (const int*)(ws + WS_MISC + MISC_NT); const int* TILE_E = (const int*)(ws + WS_MISC + MISC_TILE_E);
            const int nt = NTp[0], t0 = CHUNK_TILES * c, t1 = min(nt, t0 + CHUNK_TILES);
            if (t1 > t0) { EpiSwiglu E{(bf16*)(ws + WS_HIDM), FFM, t0 * 256, nullptr};
                REP_X(REP_MOEGU, gemm_moe(X, (const bf16*)(ws + WS_XS), (const bf16*)(ws + WS_WT_MGU), t0, t1, 2 * FFM, DM, TILE_E, 0, 0, E);) } } SEAM(19 + 2 * c);
        PHASE(20 + 2 * c); { const int* NTp = (const int*)(ws + WS_MISC + MISC_NT); const int* TILE_E = (const int*)(ws + WS_MISC + MISC_TILE_E);
            const int nt = NTp[0], t0 = CHUNK_TILES * c, t1 = min(nt, t0 + CHUNK_TILES);
            if (t1 > t0) { EpiBf16Plain E{(bf16*)(ws + WS_YS), DM};
                REP_X(REP_MOEDN, gemm_moe(X, (const bf16*)(ws + WS_HIDM), (const bf16*)(ws + WS_WT_MDN), t0, t1, DM, FFM, TILE_E, t0, 0, E);) } } SEAM(20 + 2 * c);
    }
#endif
#if XR_BF16
    PHASE(25); { phase_combine(X, p, (const xr_t*)(p.ws + WS_XRB)); }
#else
    PHASE(25); { phase_combine(X, p, (const xr_t*)p.out); }
#endif
}
#undef PHASE
#undef SEAM

extern "C" void kernel_launch(void* const* d_in, const int* in_sizes, int n_in, void* d_out, int out_size, void* d_ws, size_t ws_size, hipStream_t stream) {
    static int grid = 0;
    if (grid == 0) {
        if (n_in != 20 || out_size != T * DM || ws_size < WS_END) { fprintf(stderr, "kernel_launch: unexpected shapes (n_in %d out %d ws %zu)\n", n_in, out_size, ws_size); grid = -1; return; }
        int dev = 0, cus = 0;
        if (hipGetDevice(&dev) != hipSuccess || hipDeviceGetAttribute(&cus, hipDeviceAttributeMultiprocessorCount, dev) != hipSuccess) { grid = -1; return; }
        if (hipFuncSetAttribute((const void*)mega, hipFuncAttributeMaxDynamicSharedMemorySize, LDS_BYTES) != hipSuccess) { fprintf(stderr, "kernel_launch: hipFuncSetAttribute failed\n"); grid = -1; return; }
        int per_cu = 0; (void)hipOccupancyMaxActiveBlocksPerMultiprocessor(&per_cu, (const void*)mega, NTHREADS, LDS_BYTES); (void)hipGetLastError();
        grid = cus;
    }
    if (grid < 0) return;
    (void)hipMemsetAsync((char*)d_ws + WS_CTL, 0, CTL_BYTES, stream);
    Params p{};
    for (int i = 0; i < 20; ++i) p.in[i] = (const float*)d_in[i];
    p.out = (float*)d_out; p.ws = (unsigned char*)d_ws;
    p.ph_lo = 0; p.ph_hi = NPHASES;
    hipLaunchKernelGGL(mega, dim3(grid), dim3(NTHREADS), LDS_BYTES, stream, p);
}
```

```cpp
#include <hip/hip_runtime.h>
#include <cstdio>
#include <cstdint>

#ifndef N_LAUNCH_MODE
#define N_LAUNCH_MODE 1
#endif

#ifndef FAST_GEMM
#define FAST_GEMM 1
#endif
#ifndef REP_ATTN
#define REP_ATTN 1
#endif
#ifndef REP_INPROJ
#define REP_INPROJ 1
#endif
#ifndef REP_H3
#define REP_H3 1
#endif
#ifndef REP_PRO
#define REP_PRO 1
#endif
#ifndef REP_MOEGU
#define REP_MOEGU 1
#endif
#ifndef REP_MOEDN
#define REP_MOEDN 1
#endif
#ifndef REP_DGU
#define REP_DGU 1
#endif
#ifndef REP_NORM
#define REP_NORM 1
#endif
#ifndef REP_ROUTE
#define REP_ROUTE 1
#endif
#ifndef REP_OUT0
#define REP_OUT0 1
#endif
#ifndef REP_QKV
#define REP_QKV 1
#endif
#define REP_1(stmt) stmt
#define REP_2(stmt) stmt stmt
#define REP_CAT(a, b) a##b
#define REP_X(n, stmt) REP_CAT(REP_, n)(stmt)
#ifndef MOE_FP8
#define MOE_FP8 1
#endif
#ifndef DN_SPLITK
#define DN_SPLITK 1
#endif
#ifndef FUSE_NORM
#define FUSE_NORM 1
#endif
#ifndef XR_BF16
#define XR_BF16 1
#endif
#ifndef HG_V2
#define HG_V2 1
#endif
#ifndef FAST_ATTN
#define FAST_ATTN 1
#endif
#ifndef TAILFILL
#define TAILFILL 1
#endif
#ifndef TAILFILL_A
#define TAILFILL_A 8
#endif
#ifndef TAILFILL_B
#define TAILFILL_B 0
#endif
#ifndef TAILFILL_C
#define TAILFILL_C 8
#endif
#ifndef RAW_L0
#define RAW_L0 1
#endif
#ifndef RES_LDSPRE
#define RES_LDSPRE 1
#endif
#ifndef QKV_UNITBEGIN
#define QKV_UNITBEGIN 1
#endif
#ifndef SSX_UNITBEGIN
#define SSX_UNITBEGIN 1
#endif
#ifndef SLAB_BF16
#define SLAB_BF16 1
#endif
#ifndef H1_WIDE
#define H1_WIDE 1
#endif
#ifndef H3_STAGED_EPI
#define H3_STAGED_EPI 1
#endif
#ifndef ATTN_STAGED_EPI
#define ATTN_STAGED_EPI 1
#endif
#ifndef FAST_HGRN
#define FAST_HGRN 1
#endif
#define GAS __attribute__((address_space(1)))
#define LAS __attribute__((address_space(3)))
typedef unsigned short bf16;
typedef float f32x4 __attribute__((ext_vector_type(4)));
typedef short bf16x8 __attribute__((ext_vector_type(8)));
typedef unsigned u32x4 __attribute__((ext_vector_type(4)));
typedef unsigned u32x2 __attribute__((ext_vector_type(2)));

constexpr int T = 16384, SEQ = 8192, DM = 1024, NLAYER = 2;
constexpr int QR = 384, KVR = 256, ROPE = 64, NPROJ = 2752, NPROJ_P = 2816;
constexpr int NH = 4, DQK = 192, DNOPE = 128, DV = 128;
constexpr int HGW = 512;
constexpr int FF0 = 2816, FFM = 3584, NE = 8;
constexpr int MAXTILES = 136;
constexpr float EPS = 1e-6f;
constexpr int NWAVES = 8, NTHREADS = 512;

constexpr size_t MiB = 1u << 20;
constexpr size_t WS_CTL = 0, CTL_BYTES = 32768;
constexpr size_t WS_MISC = 1 * MiB;
constexpr size_t MISC_LB = 0, MISC_GCNT = 8192, MISC_TILE_E = 16384, MISC_NT = 17408, MISC_TOPI = 65536, MISC_TOPG = 196608, MISC_POS = 327680, MISC_SSXA = 458752, MISC_SSXB = 720896;
constexpr size_t WS_COS = 2 * MiB, WS_SIN = 4 * MiB;
constexpr size_t WS_WT_IN = 6 * MiB, WS_WT_QB = 17 * MiB, WS_WT_KVB = 19 * MiB, WS_WT_OUT = 20 * MiB, WS_WT_GU = 24 * MiB, WS_WT_DN = 35 * MiB, WS_WT_MGU = 41 * MiB, WS_WT_MDN = 153 * MiB;
constexpr size_t WS_XB = 209 * MiB;
constexpr size_t WS_CQ = 242 * MiB, WS_CKV = 254 * MiB, WS_KPE = 262 * MiB, WS_SSQ = 264 * MiB, WS_HQ = 266 * MiB, WS_HK = 282 * MiB, WS_LF = 298 * MiB, WS_HV = 330 * MiB, WS_HG = 346 * MiB;
constexpr size_t WS_Q = 362 * MiB, WS_KN = 386 * MiB, WS_V = 402 * MiB, WS_CC = 418 * MiB, WS_END = 464 * MiB;
constexpr size_t WS_HID = 242 * MiB;
#if MOE_FP8
constexpr size_t WS_XS = 242 * MiB;
constexpr size_t WS_YS = 276 * MiB;
constexpr size_t WS_HIDM = 344 * MiB;
constexpr int CHUNK_TILES = 136;
static_assert(WS_HIDM + (size_t)34816 * 3584 <= 464 * MiB, "MoE hidden fits below the guaranteed workspace size");
#else
constexpr size_t WS_XS = 242 * MiB;
constexpr size_t WS_YS = WS_XS;
constexpr size_t WS_HIDM = 310 * MiB;
constexpr int CHUNK_TILES = 64;
#endif
constexpr size_t WS_AP2 = WS_CQ;
constexpr size_t WS_AML = WS_SSQ;
constexpr size_t WS_HD = WS_XB + 32 * MiB, WS_HR = WS_HD + 512 * 1024;
constexpr size_t WS_XRB = 97 * MiB;
constexpr size_t WS_SLAB = 209 * MiB;
constexpr int CW_BAR = 4096;

constexpr int LDS_BYTES = 147456;
constexpr int LDS_MISC_OFF = 143360;

__device__ __forceinline__ unsigned f2bf(float f) { unsigned u = __float_as_uint(f); return (u + 0x7fffu + ((u >> 16) & 1u)) >> 16; }
typedef float pk2_f32x2 __attribute__((ext_vector_type(2)));
typedef __bf16 pk2_bf16x2 __attribute__((ext_vector_type(2)));
__device__ __forceinline__ unsigned pk2(float lo, float hi) { const pk2_f32x2 v = {lo, hi}; return __builtin_bit_cast(unsigned, __builtin_convertvector(v, pk2_bf16x2)); }
__device__ __forceinline__ float bf2f(unsigned short b) { return __uint_as_float(((unsigned)b) << 16); }
__device__ __forceinline__ float bflo(unsigned w) { return __uint_as_float(w << 16); }
__device__ __forceinline__ float bfhi(unsigned w) { return __uint_as_float(w & 0xffff0000u); }
__device__ __forceinline__ float clamp8(float x) { return __builtin_amdgcn_fmed3f(x, -448.f, 448.f); }
__device__ __forceinline__ unsigned pk4_fp8(float a, float b, float c, float d) {
    int w = __builtin_amdgcn_cvt_pk_fp8_f32(clamp8(a), clamp8(b), 0, false); w = __builtin_amdgcn_cvt_pk_fp8_f32(clamp8(c), clamp8(d), w, true); return (unsigned)w; }
__device__ __forceinline__ u32x4 pack8(f32x4 a, f32x4 b) { u32x4 w; w.x = pk2(a.x, a.y); w.y = pk2(a.z, a.w); w.z = pk2(b.x, b.y); w.w = pk2(b.z, b.w); return w; }
#if XR_BF16
typedef bf16 xr_t;
#else
typedef float xr_t;
#endif
__device__ __forceinline__ f32x4 ldrow4(const float* row, int idx) { return *((const f32x4*)row + idx); }
__device__ __forceinline__ f32x4 ldrow4(const bf16* row, int idx) { const u32x2 w = *((const u32x2*)row + idx); f32x4 r; r.x = __uint_as_float(w.x << 16); r.y = __uint_as_float(w.x & 0xffff0000u); r.z = __uint_as_float(w.y << 16); r.w = __uint_as_float(w.y & 0xffff0000u); return r; }
#define DPP_F(v, ctrl) __int_as_float(__builtin_amdgcn_update_dpp(0, __float_as_int(v), (ctrl), 0xf, 0xf, true))
#define DPP_I(v, ctrl) __builtin_amdgcn_update_dpp(0, (v), (ctrl), 0xf, 0xf, true)
__device__ __forceinline__ float xsum16(float v) { const auto r = __builtin_amdgcn_permlane16_swap(__float_as_uint(v), __float_as_uint(v), false, false); return __uint_as_float(r[0]) + __uint_as_float(r[1]); }
__device__ __forceinline__ float xsum32(float v) { const auto r = __builtin_amdgcn_permlane32_swap(__float_as_uint(v), __float_as_uint(v), false, false); return __uint_as_float(r[0]) + __uint_as_float(r[1]); }
__device__ __forceinline__ float xget16(float v, int odd_row) { const auto r = __builtin_amdgcn_permlane16_swap(__float_as_uint(v), __float_as_uint(v), false, false); return __uint_as_float(odd_row ? r[0] : r[1]); }
__device__ __forceinline__ float xget32(float v, int upper) { const auto r = __builtin_amdgcn_permlane32_swap(__float_as_uint(v), __float_as_uint(v), false, false); return __uint_as_float(upper ? r[0] : r[1]); }
__device__ __forceinline__ float wave_sum(float v) {
    v += DPP_F(v, 0xB1); v += DPP_F(v, 0x4E); v += DPP_F(v, 0x124); v += DPP_F(v, 0x128); v = xsum16(v); v = xsum32(v);
    return v;
}
__device__ __forceinline__ float wave_max(float v) {
    v = fmaxf(v, DPP_F(v, 0xB1)); v = fmaxf(v, DPP_F(v, 0x4E)); v = fmaxf(v, DPP_F(v, 0x124)); v = fmaxf(v, DPP_F(v, 0x128));
    { const auto r = __builtin_amdgcn_permlane16_swap(__float_as_uint(v), __float_as_uint(v), false, false); v = fmaxf(__uint_as_float(r[0]), __uint_as_float(r[1])); }
    { const auto r = __builtin_amdgcn_permlane32_swap(__float_as_uint(v), __float_as_uint(v), false, false); v = fmaxf(__uint_as_float(r[0]), __uint_as_float(r[1])); }
    return v;
}
__device__ __forceinline__ float fast_exp(float x) { return __builtin_amdgcn_exp2f(x * 1.4426950408889634f); }
__device__ __forceinline__ float sigmoidf_(float x) { return __builtin_amdgcn_rcpf(1.f + fast_exp(-x)); }
__device__ __forceinline__ float siluf_(float x) { return x * __builtin_amdgcn_rcpf(1.f + fast_exp(-x)); }
typedef float f32x2v __attribute__((ext_vector_type(2)));
__device__ __forceinline__ f32x2v silu_mul_pk(f32x2v g, f32x2v u) {
    const f32x2v t = g * (-1.4426950408889634f); f32x2v e; e.x = __builtin_amdgcn_exp2f(t.x); e.y = __builtin_amdgcn_exp2f(t.y);
    const f32x2v d = e + 1.0f; f32x2v r; r.x = __builtin_amdgcn_rcpf(d.x); r.y = __builtin_amdgcn_rcpf(d.y);
    return (g * u) * r;
}
__device__ __forceinline__ int perm32(int rho) { const int n = rho >> 4, i = rho & 15; return 8 * (i >> 2) + 4 * n + (i & 3); }

__device__ const double kInvRev[32] = {
    1.59154943091895346e-01, 1.19349370211248862e-01, 8.94994016088910133e-02, 6.71150830052272551e-02, 5.03292121044870353e-02, 3.77415847174197711e-02, 2.83021958306233987e-02, 2.12236527647776604e-02,
    1.59154943091895339e-02, 1.19349370211248862e-02, 8.94994016088910237e-03, 6.71150830052272534e-03, 5.03292121044870370e-03, 3.77415847174197719e-03, 2.83021958306233987e-03, 2.12236527647776622e-03,
    1.59154943091895356e-03, 1.19349370211248849e-03, 8.94994016088910237e-04, 6.71150830052272599e-04, 5.03292121044870326e-04, 3.77415847174197741e-04, 2.83021958306233954e-04, 2.12236527647776605e-04,
    1.59154943091895351e-04, 1.19349370211248862e-04, 8.94994016088910182e-05, 6.71150830052272545e-05, 5.03292121044870354e-05, 3.77415847174197768e-05, 2.83021958306233961e-05, 2.12236527647776592e-05};

#define XB_TMO      128
#define XB_XCNT(j)  (256  + 64 * (j))
#define XB_XSUB(j)  (1280 + 64 * (j))
#define XB_XGEN(j)  (2304 + 64 * (j))
#define XB_TOP      3328
#define XB_TOPGEN   3392
#define XCD_BAR_WORDS 3456
#define XB_SPIN_CAP (1u << 18)
__device__ __forceinline__ unsigned xb_ld(unsigned* p)              { return __hip_atomic_load(p, __ATOMIC_RELAXED, __HIP_MEMORY_SCOPE_AGENT); }
__device__ __forceinline__ unsigned xb_add(unsigned* p, unsigned v) { return __hip_atomic_fetch_add(p, v, __ATOMIC_RELAXED, __HIP_MEMORY_SCOPE_AGENT); }
__device__ __forceinline__ unsigned xb_xcc_id() { return (unsigned)__builtin_amdgcn_s_getreg((3 << 11) | 20) & 0xFu; }
#define XB_SPIN(cond, bar) do { unsigned _sp = 0; while (cond) { __builtin_amdgcn_s_sleep(1); \
    if ((++_sp & 255u) == 0u) { if (xb_ld(&(bar)[XB_TMO])) break; if (_sp > XB_SPIN_CAP) { atomicAdd(&(bar)[XB_TMO], 1u); break; } } } } while (0)
struct XcdBarrier { unsigned* bar; unsigned x; volatile LAS unsigned* st; };
__device__ __forceinline__ XcdBarrier xcd_barrier_post(unsigned* bar, volatile LAS unsigned* st) {
    XcdBarrier b; b.bar = bar; b.x = xb_xcc_id(); b.st = st;
    if (threadIdx.x == 0) (void)xb_add(&bar[XB_XCNT(b.x)], 1u);
    return b;
}
__device__ __forceinline__ void xcd_barrier_complete(unsigned* bar, unsigned x, unsigned& nloc, unsigned& nx) {
    const unsigned G = gridDim.x * gridDim.y * gridDim.z;
    unsigned sum, cnt, mine, sp = 0u;
    for (;;) {
        sum = 0u; cnt = 0u; mine = 0u;
#pragma unroll
        for (unsigned j = 0; j < 16; ++j) { const unsigned c = xb_ld(&bar[XB_XCNT(j)]); sum += c; cnt += (c > 0u) ? 1u : 0u; mine = (j == x) ? c : mine; }
        if (sum == G) break;
        __builtin_amdgcn_s_sleep(1);
        if ((++sp & 255u) == 0u) { if (xb_ld(&bar[XB_TMO])) break; if (sp > XB_SPIN_CAP) { atomicAdd(&bar[XB_TMO], 1u); break; } }
    }
    nloc = mine > 0u ? mine : 1u; nx = cnt > 0u ? cnt : 1u;
}
__device__ __forceinline__ void xcd_barrier(const XcdBarrier& b) {
    asm volatile("s_waitcnt vmcnt(0)" ::: "memory");
    __syncthreads();
    unsigned long long bar_ = (unsigned long long)b.bar; asm volatile("" : "+s"(bar_));
    if (threadIdx.x == 0) {
        unsigned* bar = (unsigned*)(GAS unsigned*)bar_;
        __builtin_amdgcn_s_waitcnt(0);
        unsigned nloc = b.st[0], nx = b.st[1];
        if (nloc == 0u) { xcd_barrier_complete(bar, b.x, nloc, nx); b.st[0] = nloc; b.st[1] = nx; }
        const unsigned old = xb_add(&bar[XB_XSUB(b.x)], 1u);
        const unsigned gen = old / nloc;
        if (old + 1u == (gen + 1u) * nloc) {
            __builtin_amdgcn_fence(__ATOMIC_RELEASE, "agent");
            asm volatile("s_waitcnt vmcnt(0)" ::: "memory");
            const unsigned og = xb_add(&bar[XB_TOP], 1u);
            const unsigned tg = og / nx;
            if (og + 1u == (tg + 1u) * nx) xb_add(&bar[XB_TOPGEN], 1u);
            else XB_SPIN(xb_ld(&bar[XB_TOPGEN]) == tg, bar);
            __builtin_amdgcn_fence(__ATOMIC_ACQUIRE, "agent");
            xb_add(&bar[XB_XGEN(b.x)], 1u);
            asm volatile("s_waitcnt vmcnt(0)" ::: "memory");
        } else {
            XB_SPIN(xb_ld(&bar[XB_XGEN(b.x)]) == gen, bar);
            __builtin_amdgcn_fence(__ATOMIC_ACQUIRE, "agent");
            asm volatile("s_waitcnt vmcnt(0)" ::: "memory");
        }
    }
    __syncthreads();
}

struct Params { const float* in[20]; float* out; unsigned char* ws; int ph_lo, ph_hi; };
enum { I_X = 0, I_POS, I_MIXN, I_WIN, I_QAN, I_WQB, I_KVAN, I_WKVB, I_HLB, I_HON, I_WOUT, I_FFNN, I_DWG, I_DWU, I_DWD, I_ROUTER, I_MWG, I_MWU, I_MWD, I_FINN };

struct Ctx {
    int tid, lane, wave, bid, nblk;
    LAS unsigned char* lds;
};

struct EpiProj {
    unsigned char* ws; int l; int ssx;
    __device__ __forceinline__ void launder() { unsigned long long w = (unsigned long long)ws; asm volatile("" : "+s"(w)); ws = (unsigned char*)(GAS unsigned char*)w;     }
    static constexpr int HAS_ROWSCALE = 1;
#if SSX_UNITBEGIN
    static constexpr int HAS_UNITBEGIN = 1;
    LAS float* aux = nullptr;
    __device__ __forceinline__ void unit_begin(int pm, int tid) const { if (ssx && tid < 256) { const float* sx = (const float*)(ws + WS_MISC + ssx) + pm * 256 + tid; aux[tid] = __builtin_amdgcn_rsqf(((sx[0] + sx[T]) + (sx[2 * T] + sx[3 * T])) * (1.f / DM) + EPS); } }
    __device__ __forceinline__ float rowscale(int row) const { return ssx ? aux[row & 255] : 1.f; }
#else
    __device__ __forceinline__ float rowscale(int row) const { if (!ssx) return 1.f; const float* sx = (const float*)(ws + WS_MISC + ssx) + row; return __builtin_amdgcn_rsqf(((sx[0] + sx[T]) + (sx[2 * T] + sx[3 * T])) * (1.f / DM) + EPS); }
#endif
    __device__ __forceinline__ void operator()(int row, int c, f32x4 a, f32x4 b) const {
        bf16* CQ = (bf16*)(ws + WS_CQ); bf16* CKV = (bf16*)(ws + WS_CKV); bf16* KPE = (bf16*)(ws + WS_KPE); bf16* HQ = (bf16*)(ws + WS_HQ); bf16* HK = (bf16*)(ws + WS_HK); bf16* HV = (bf16*)(ws + WS_HV); bf16* HG = (bf16*)(ws + WS_HG);
        float* LF = (float*)(ws + WS_LF); float* SSQ = (float*)(ws + WS_SSQ); const float* LB = (const float*)(ws + WS_MISC + MISC_LB) + l * HGW; const float* COS = (const float*)(ws + WS_COS); const float* SIN = (const float*)(ws + WS_SIN);
        if (c < 640) {
            float ss = (a.x * a.x + a.y * a.y) + (a.z * a.z + a.w * a.w) + (b.x * b.x + b.y * b.y) + (b.z * b.z + b.w * b.w);
            { const auto r = __builtin_amdgcn_permlane16_swap(__float_as_uint(ss), __float_as_uint(ss), false, false); ss = __uint_as_float(r[0]) + __uint_as_float(r[1]); }
            { const auto r = __builtin_amdgcn_permlane32_swap(__float_as_uint(ss), __float_as_uint(ss), false, false); ss = __uint_as_float(r[0]) + __uint_as_float(r[1]); }
            if ((threadIdx.x & 63) < 16) SSQ[(size_t)(c >> 5) * T + row] = ss;
            const u32x4 w = pack8(a, b);
            if (c < QR) *(u32x4*)(CQ + (size_t)row * QR + c) = w; else *(u32x4*)(CKV + (size_t)row * KVR + (c - QR)) = w;
        } else if (c < 704) {
            const int g = (c - 640) >> 3;
            const f32x4 cs = *(const f32x4*)(COS + (size_t)row * 32 + 4 * g), sn = *(const f32x4*)(SIN + (size_t)row * 32 + 4 * g);
            const f32x4 o1 = a * cs - b * sn, o2 = a * sn + b * cs;
            *(u32x4*)(KPE + (size_t)row * ROPE + 8 * g) = pack8(o1, o2);
        } else if (c < 1216) {
            f32x4 x, y; x.x = siluf_(a.x); x.y = siluf_(a.y); x.z = siluf_(a.z); x.w = siluf_(a.w); y.x = siluf_(b.x); y.y = siluf_(b.y); y.z = siluf_(b.z); y.w = siluf_(b.w);
            *(u32x4*)(HQ + (size_t)row * HGW + (c - 704)) = pack8(x, y);
#if HG_V2
        } else if (c < 1728) {
            *(u32x4*)(HK + (size_t)row * HGW + (c - 1216)) = pack8(a, b);
#else
        } else if (c < 1728) {
            const int d = c - 1216;
            const f32x4 l0 = *(const f32x4*)(LB + d), l1 = *(const f32x4*)(LB + d + 4);
            f32x4 k0, k1, f0, f1;
#define HGATE(z, lb, kk, lf) do { const float zc = fminf(fmaxf((z), -60.f), 60.f); const float e = fast_exp(-zc); const float sg = __builtin_amdgcn_rcpf(1.f + e); const float om = 1.f - (lb); \
                kk = om * (e * sg); const float f = (lb) + om * sg; lf = __builtin_amdgcn_logf(fmaxf(f, 1e-30f)) * 0.6931471805599453f; } while (0)
            HGATE(a.x, l0.x, k0.x, f0.x); HGATE(a.y, l0.y, k0.y, f0.y); HGATE(a.z, l0.z, k0.z, f0.z); HGATE(a.w, l0.w, k0.w, f0.w);
            HGATE(b.x, l1.x, k1.x, f1.x); HGATE(b.y, l1.y, k1.y, f1.y); HGATE(b.z, l1.z, k1.z, f1.z); HGATE(b.w, l1.w, k1.w, f1.w);
#undef HGATE
            *(u32x4*)(HK + (size_t)row * HGW + d) = pack8(k0, k1);
            *(f32x4*)(LF + (size_t)row * HGW + d) = f0; *(f32x4*)(LF + (size_t)row * HGW + d + 4) = f1;
#endif
        } else if (c < 2240) {
            *(u32x4*)(HV + (size_t)row * HGW + (c - 1728)) = pack8(a, b);
        } else if (c < 2752) {
            *(u32x4*)(HG + (size_t)row * HGW + (c - 2240)) = pack8(a, b);
        }
    }
};
struct EpiQ {
    unsigned char* ws;
    __device__ __forceinline__ void launder() { unsigned long long w = (unsigned long long)ws; asm volatile("" : "+s"(w)); ws = (unsigned char*)(GAS unsigned char*)w;     }
    static constexpr int HAS_ROWSCALE = 1;
#if QKV_UNITBEGIN
    static constexpr int HAS_UNITBEGIN = 1;
    LAS float* aux;
    __device__ __forceinline__ void unit_begin(int pm, int tid) const { if (tid < 256) { const float* SSQ = (const float*)(ws + WS_SSQ) + pm * 256 + tid; float s = 0.f;
#pragma unroll
            for (int i = 0; i < 12; ++i) s += SSQ[(size_t)i * T];
            aux[tid] = __builtin_amdgcn_rsqf(s * (1.f / QR) + EPS); } }
    __device__ __forceinline__ float rowscale(int row) const { return aux[row & 255]; }
#else
    __device__ __forceinline__ float rowscale(int row) const { const float* SSQ = (const float*)(ws + WS_SSQ); float s = 0.f;
#pragma unroll
        for (int i = 0; i < 12; ++i) s += SSQ[(size_t)i * T + row];
        return __builtin_amdgcn_rsqf(s * (1.f / QR) + EPS); }
#endif
    __device__ __forceinline__ void operator()(int row, int c, f32x4 a, f32x4 b) const {
        bf16* Q = (bf16*)(ws + WS_Q); const float* COS = (const float*)(ws + WS_COS); const float* SIN = (const float*)(ws + WS_SIN);
        const int h = c / DQK, cc = c - h * DQK, bb = row >> 13, sq = row & (SEQ - 1);
        bf16* dst = Q + ((size_t)((bb * NH + h) * SEQ + sq)) * DQK + cc;
        if (cc < DNOPE) { *(u32x4*)dst = pack8(a, b); }
        else { const int g = (cc - DNOPE) >> 3;
            const f32x4 cs = *(const f32x4*)(COS + (size_t)row * 32 + 4 * g), sn = *(const f32x4*)(SIN + (size_t)row * 32 + 4 * g);
            *(u32x4*)dst = pack8(a * cs - b * sn, a * sn + b * cs); }
    }
};
struct EpiKV {
    unsigned char* ws;
    __device__ __forceinline__ void launder() { unsigned long long w = (unsigned long long)ws; asm volatile("" : "+s"(w)); ws = (unsigned char*)(GAS unsigned char*)w;     }
    static constexpr int HAS_ROWSCALE = 1;
#if QKV_UNITBEGIN
    static constexpr int HAS_UNITBEGIN = 1;
    LAS float* aux;
    __device__ __forceinline__ void unit_begin(int pm, int tid) const { if (tid < 256) { const float* SSQ = (const float*)(ws + WS_SSQ) + pm * 256 + tid; float s = 0.f;
#pragma unroll
            for (int i = 12; i < 20; ++i) s += SSQ[(size_t)i * T];
            aux[tid] = __builtin_amdgcn_rsqf(s * (1.f / KVR) + EPS); } }
    __device__ __forceinline__ float rowscale(int row) const { return aux[row & 255]; }
#else
    __device__ __forceinline__ float rowscale(int row) const { const float* SSQ = (const float*)(ws + WS_SSQ); float s = 0.f;
#pragma unroll
        for (int i = 12; i < 20; ++i) s += SSQ[(size_t)i * T + row];
        return __builtin_amdgcn_rsqf(s * (1.f / KVR) + EPS); }
#endif
    __device__ __forceinline__ void operator()(int row, int c, f32x4 a, f32x4 b) const {
        bf16* KN = (bf16*)(ws + WS_KN); bf16* V = (bf16*)(ws + WS_V);
        const int h = c >> 8, cc = c & 255, bb = row >> 13, sq = row & (SEQ - 1);
        const size_t r = ((size_t)((bb * NH + h) * SEQ + sq)) * 128;
        if (cc < 128) *(u32x4*)(KN + r + cc) = pack8(a, b); else *(u32x4*)(V + r + (cc - 128)) = pack8(a, b);
    }
};
template <class TS, class TD> struct EpiResT {
    static constexpr int HAS_PAIR = 1;
    static constexpr bool LDSPRE = (sizeof(TS) == 2) && (sizeof(TD) == 2) && (RES_LDSPRE != 0);
    __device__ __forceinline__ void pre_dma(LAS unsigned char* dst, int row, int c) const { __builtin_amdgcn_global_load_lds((const unsigned*)((const bf16*)SRC + (size_t)row * DM + c), (LAS unsigned*)dst, 16, 0, 0); }
    __device__ __forceinline__ void pair_w(int row, int c, f32x4 a0, f32x4 b0, f32x4 a1, f32x4 b1, u32x4 w, u32x4 v) const {
        const size_t o = (size_t)row * DM + c; f32x4 s0, s1, t0, t1;
        s0.x = bflo(w.x); s0.y = bfhi(w.x); s0.z = bflo(w.y); s0.w = bfhi(w.y); s1.x = bflo(w.z); s1.y = bfhi(w.z); s1.z = bflo(w.w); s1.w = bfhi(w.w);
        t0.x = bflo(v.x); t0.y = bfhi(v.x); t0.z = bflo(v.y); t0.w = bfhi(v.y); t1.x = bflo(v.z); t1.y = bfhi(v.z); t1.z = bflo(v.w); t1.w = bfhi(v.w);
        s0 = s0 + a0; s1 = s1 + b0; t0 = t0 + a1; t1 = t1 + b1;
        *(u32x4*)((bf16*)DST + o) = pack8(s0, s1); *(u32x4*)((bf16*)DST + o + 128) = pack8(t0, t1);
    }
    __device__ __forceinline__ void pair(int row, int c, f32x4 a0, f32x4 b0, f32x4 a1, f32x4 b1) const {
        const size_t o = (size_t)row * DM + c;
        f32x4 s0, s1, t0, t1;
        if constexpr (sizeof(TS) == 4) { s0 = *(const f32x4*)((const float*)SRC + o); s1 = *(const f32x4*)((const float*)SRC + o + 4); t0 = *(const f32x4*)((const float*)SRC + o + 128); t1 = *(const f32x4*)((const float*)SRC + o + 132); }
        else { const u32x4 w = *(const u32x4*)((const bf16*)SRC + o), v = *(const u32x4*)((const bf16*)SRC + o + 128);
            s0.x = bflo(w.x); s0.y = bfhi(w.x); s0.z = bflo(w.y); s0.w = bfhi(w.y); s1.x = bflo(w.z); s1.y = bfhi(w.z); s1.z = bflo(w.w); s1.w = bfhi(w.w);
            t0.x = bflo(v.x); t0.y = bfhi(v.x); t0.z = bflo(v.y); t0.w = bfhi(v.y); t1.x = bflo(v.z); t1.y = bfhi(v.z); t1.z = bflo(v.w); t1.w = bfhi(v.w); }
        s0 = s0 + a0; s1 = s1 + b0; t0 = t0 + a1; t1 = t1 + b1;
        if constexpr (sizeof(TD) == 4) { *(f32x4*)((float*)DST + o) = s0; *(f32x4*)((float*)DST + o + 4) = s1; *(f32x4*)((float*)DST + o + 128) = t0; *(f32x4*)((float*)DST + o + 132) = t1; }
        else { *(u32x4*)((bf16*)DST + o) = pack8(s0, s1); *(u32x4*)((bf16*)DST + o + 128) = pack8(t0, t1); }
    }
    const TS* SRC; TD* DST;
    __device__ __forceinline__ void launder() {}
    __device__ __forceinline__ void operator()(int row, int c, f32x4 a, f32x4 b) const {
        const size_t o = (size_t)row * DM + c;
        f32x4 s0, s1;
        if constexpr (sizeof(TS) == 4) { s0 = *(const f32x4*)((const float*)SRC + o); s1 = *(const f32x4*)((const float*)SRC + o + 4); }
        else { const u32x4 w = *(const u32x4*)((const bf16*)SRC + o); s0.x = bflo(w.x); s0.y = bfhi(w.x); s0.z = bflo(w.y); s0.w = bfhi(w.y); s1.x = bflo(w.z); s1.y = bfhi(w.z); s1.z = bflo(w.w); s1.w = bfhi(w.w); }
        s0 = s0 + a; s1 = s1 + b;
        if constexpr (sizeof(TD) == 4) { *(f32x4*)((float*)DST + o) = s0; *(f32x4*)((float*)DST + o + 4) = s1; }
        else *(u32x4*)((bf16*)DST + o) = pack8(s0, s1);
    }
};
template <class TS> struct EpiResNormT {
    static constexpr bool HAS_FINISH = true;
    const TS* SRC; bf16* DST; float* SSX; float ssb;
    __device__ __forceinline__ void launder() {}
    __device__ __forceinline__ void operator()(int row, int c, f32x4 a, f32x4 b) {
        const size_t o = (size_t)row * DM + c;
        f32x4 s0, s1;
        if constexpr (sizeof(TS) == 4) { s0 = *(const f32x4*)((const float*)SRC + o); s1 = *(const f32x4*)((const float*)SRC + o + 4); }
        else { const u32x4 w = *(const u32x4*)((const bf16*)SRC + o); s0.x = bflo(w.x); s0.y = bfhi(w.x); s0.z = bflo(w.y); s0.w = bfhi(w.y); s1.x = bflo(w.z); s1.y = bfhi(w.z); s1.z = bflo(w.w); s1.w = bfhi(w.w); }
        s0 = s0 + a; s1 = s1 + b;
        *(u32x4*)(DST + o) = pack8(s0, s1);
        float ss = (s0.x * s0.x + s0.y * s0.y) + (s0.z * s0.z + s0.w * s0.w) + (s1.x * s1.x + s1.y * s1.y) + (s1.z * s1.z + s1.w * s1.w);
        if ((c & 128) == 0) { ssb = ss; }
        else { ss += ssb; ss += __shfl_xor(ss, 16); ss += __shfl_xor(ss, 32);
            if ((threadIdx.x & 63) < 16) part[(row & 255) * 4 + ((c >> 5) & 3)] = ss; }
    }
    static constexpr bool LDSPRE = (sizeof(TS) == 2) && (RES_LDSPRE != 0);
    __device__ __forceinline__ void pre_dma(LAS unsigned char* dst, int row, int c) const { __builtin_amdgcn_global_load_lds((const unsigned*)((const bf16*)SRC + (size_t)row * DM + c), (LAS unsigned*)dst, 16, 0, 0); }
    __device__ __forceinline__ void pair_w(int row, int c, f32x4 a0, f32x4 b0, f32x4 a1, f32x4 b1, u32x4 w, u32x4 v) const {
        const size_t o = (size_t)row * DM + c; f32x4 s0, s1, t0, t1;
        s0.x = bflo(w.x); s0.y = bfhi(w.x); s0.z = bflo(w.y); s0.w = bfhi(w.y); s1.x = bflo(w.z); s1.y = bfhi(w.z); s1.z = bflo(w.w); s1.w = bfhi(w.w);
        t0.x = bflo(v.x); t0.y = bfhi(v.x); t0.z = bflo(v.y); t0.w = bfhi(v.y); t1.x = bflo(v.z); t1.y = bfhi(v.z); t1.z = bflo(v.w); t1.w = bfhi(v.w);
        s0 = s0 + a0; s1 = s1 + b0; t0 = t0 + a1; t1 = t1 + b1;
        *(u32x4*)(DST + o) = pack8(s0, s1); *(u32x4*)(DST + o + 128) = pack8(t0, t1);
        const f32x4 q = s0 * s0 + s1 * s1 + (t0 * t0 + t1 * t1);
        float ss = (q.x + q.y) + (q.z + q.w);
        { const auto r = __builtin_amdgcn_permlane16_swap(__float_as_uint(ss), __float_as_uint(ss), false, false); ss = __uint_as_float(r[0]) + __uint_as_float(r[1]); }
        { const auto r = __builtin_amdgcn_permlane32_swap(__float_as_uint(ss), __float_as_uint(ss), false, false); ss = __uint_as_float(r[0]) + __uint_as_float(r[1]); }
        if ((threadIdx.x & 63) < 16) part[(row & 255) * 4 + (__builtin_amdgcn_readfirstlane(c) >> 5 & 3)] = ss;
    }
    static constexpr int HAS_PAIR = 1;
    __device__ __forceinline__ void pair(int row, int c, f32x4 a0, f32x4 b0, f32x4 a1, f32x4 b1) const {
        const size_t o = (size_t)row * DM + c;
        f32x4 s0, s1, t0, t1;
        if constexpr (sizeof(TS) == 4) { s0 = *(const f32x4*)((const float*)SRC + o); s1 = *(const f32x4*)((const float*)SRC + o + 4); t0 = *(const f32x4*)((const float*)SRC + o + 128); t1 = *(const f32x4*)((const float*)SRC + o + 132); }
        else { const u32x4 w = *(const u32x4*)((const bf16*)SRC + o), v = *(const u32x4*)((const bf16*)SRC + o + 128);
            s0.x = bflo(w.x); s0.y = bfhi(w.x); s0.z = bflo(w.y); s0.w = bfhi(w.y); s1.x = bflo(w.z); s1.y = bfhi(w.z); s1.z = bflo(w.w); s1.w = bfhi(w.w);
            t0.x = bflo(v.x); t0.y = bfhi(v.x); t0.z = bflo(v.y); t0.w = bfhi(v.y); t1.x = bflo(v.z); t1.y = bfhi(v.z); t1.z = bflo(v.w); t1.w = bfhi(v.w); }
        s0 = s0 + a0; s1 = s1 + b0; t0 = t0 + a1; t1 = t1 + b1;
        *(u32x4*)(DST + o) = pack8(s0, s1); *(u32x4*)(DST + o + 128) = pack8(t0, t1);
        const f32x4 q = s0 * s0 + s1 * s1 + (t0 * t0 + t1 * t1);
        float ss = (q.x + q.y) + (q.z + q.w);
        { const auto r = __builtin_amdgcn_permlane16_swap(__float_as_uint(ss), __float_as_uint(ss), false, false); ss = __uint_as_float(r[0]) + __uint_as_float(r[1]); }
        { const auto r = __builtin_amdgcn_permlane32_swap(__float_as_uint(ss), __float_as_uint(ss), false, false); ss = __uint_as_float(r[0]) + __uint_as_float(r[1]); }
        if ((threadIdx.x & 63) < 16) part[(row & 255) * 4 + (__builtin_amdgcn_readfirstlane(c) >> 5 & 3)] = ss;
    }
    LAS float* part;
    __device__ __forceinline__ void finish(int pm, int pn, int tid) {
        asm volatile("s_waitcnt lgkmcnt(0)" ::: "memory"); __builtin_amdgcn_s_barrier(); asm volatile("" ::: "memory");
        if (tid < 256) { const LAS float* q = part + tid * 4; SSX[(size_t)pn * T + pm * 256 + tid] = (q[0] + q[1]) + (q[2] + q[3]); }
    }
};
struct EpiSwiglu {
    bf16* HID; int ff; int rowbase; const float* SSX;
    static constexpr int HAS_ROWSCALE = 1;
    __device__ __forceinline__ void launder() {}
#if SSX_UNITBEGIN
    static constexpr int HAS_UNITBEGIN = 1;
    LAS float* aux = nullptr;
    __device__ __forceinline__ void unit_begin(int pm, int tid) const { if (SSX && tid < 256) { const float* sx = SSX + pm * 256 + tid; aux[tid] = __builtin_amdgcn_rsqf(((sx[0] + sx[T]) + (sx[2 * T] + sx[3 * T])) * (1.f / DM) + EPS); } }
    __device__ __forceinline__ float rowscale(int row) const { return SSX ? aux[row & 255] : 1.f; }
#else
    __device__ __forceinline__ float rowscale(int row) const { if (!SSX) return 1.f; const float* sx = SSX + row; return __builtin_amdgcn_rsqf(((sx[0] + sx[T]) + (sx[2 * T] + sx[3 * T])) * (1.f / DM) + EPS); }
#endif
    __device__ __forceinline__ void operator()(int row, int c, f32x4 a, f32x4 b) const {
        const f32x2v h0 = silu_mul_pk((f32x2v){a.x, a.y}, (f32x2v){b.x, b.y}), h1 = silu_mul_pk((f32x2v){a.z, a.w}, (f32x2v){b.z, b.w});
        u32x2 w; w.x = pk2(h0.x, h0.y); w.y = pk2(h1.x, h1.y);
        *(u32x2*)(HID + (size_t)(row - rowbase) * ff + (c >> 1)) = w;
    }
    static constexpr int HAS_QUAD = 1;
    __device__ __forceinline__ void quad(int rowA, int c, int fq, const f32x4 (&A)[4][2], const float (&rs)[4]) const {
#pragma unroll
        for (int mp = 0; mp < 4; mp += 2) {
            u32x2 X, Y;
            { const f32x4 a = A[mp][0] * rs[mp], b = A[mp][1] * rs[mp]; const f32x2v h0 = silu_mul_pk((f32x2v){a.x, a.y}, (f32x2v){b.x, b.y}), h1 = silu_mul_pk((f32x2v){a.z, a.w}, (f32x2v){b.z, b.w}); X.x = pk2(h0.x, h0.y); X.y = pk2(h1.x, h1.y); }
            { const f32x4 a = A[mp + 1][0] * rs[mp + 1], b = A[mp + 1][1] * rs[mp + 1]; const f32x2v h0 = silu_mul_pk((f32x2v){a.x, a.y}, (f32x2v){b.x, b.y}), h1 = silu_mul_pk((f32x2v){a.z, a.w}, (f32x2v){b.z, b.w}); Y.x = pk2(h0.x, h0.y); Y.y = pk2(h1.x, h1.y); }
            const auto sx = __builtin_amdgcn_permlane16_swap(X.x, Y.x, false, false), sy = __builtin_amdgcn_permlane16_swap(X.y, Y.y, false, false);
            u32x4 w; w.x = sx[0]; w.y = sy[0]; w.z = sx[1]; w.w = sy[1];
            const int odd = fq & 1;
            *(u32x4*)(HID + (size_t)(rowA + 16 * (mp + odd) - rowbase) * ff + ((c - 8 * odd) >> 1)) = w;
        }
    }
};
struct EpiSwiglu8 {
    unsigned char* HID; int ff; int rowbase;
    __device__ __forceinline__ void launder() {}
    __device__ __forceinline__ void operator()(int row, int c, f32x4 a, f32x4 b) const {
        const f32x2v h0 = silu_mul_pk((f32x2v){a.x, a.y}, (f32x2v){b.x, b.y}), h1 = silu_mul_pk((f32x2v){a.z, a.w}, (f32x2v){b.z, b.w});
        *(unsigned*)(HID + (size_t)(row - rowbase) * ff + (c >> 1)) = pk4_fp8(h0.x, h0.y, h1.x, h1.y);
    }
    static constexpr int HAS_QUAD = 1;
    __device__ __forceinline__ float rowscale(int) const { return 1.f; }
    __device__ __forceinline__ void quad(int rowA, int c, int fq, const f32x4 (&A)[4][2], const float (&)[4]) const {
        unsigned d[4];
#pragma unroll
        for (int m = 0; m < 4; ++m) { const f32x4 a = A[m][0], b = A[m][1]; const f32x2v h0 = silu_mul_pk((f32x2v){a.x, a.y}, (f32x2v){b.x, b.y}), h1 = silu_mul_pk((f32x2v){a.z, a.w}, (f32x2v){b.z, b.w}); d[m] = pk4_fp8(h0.x, h0.y, h1.x, h1.y); }
        const auto r02 = __builtin_amdgcn_permlane32_swap(d[0], d[2], false, false), r13 = __builtin_amdgcn_permlane32_swap(d[1], d[3], false, false);
        const auto s01 = __builtin_amdgcn_permlane16_swap(r02[0], r13[0], false, false), s23 = __builtin_amdgcn_permlane16_swap(r02[1], r13[1], false, false);
        u32x4 w; w.x = s01[0]; w.y = s01[1]; w.z = s23[0]; w.w = s23[1];
        *(u32x4*)(HID + (size_t)(rowA + 16 * fq - rowbase) * ff + ((c - 8 * fq) >> 1)) = w;
    }
};
struct EpiProbe {
    float* sink;
    __device__ __forceinline__ void launder() {}
    __device__ __forceinline__ void operator()(int row, int c, f32x4 a, f32x4 b) const { if (a.x == 123456.789f && b.w == -98765.4321f) sink[row * 8 + (c & 7)] = a.y; }
};
struct EpiBf16Plain {
    bf16* O; int ld;
    __device__ __forceinline__ void launder() {}
    __device__ __forceinline__ void operator()(int row, int c, f32x4 a, f32x4 b) const { *(u32x4*)(O + (size_t)row * ld + c) = pack8(a, b); }
};

namespace pg8 {
#define PG8_LAS __attribute__((address_space(3)))
typedef unsigned short bf16_t;
typedef short bf16x8 __attribute__((ext_vector_type(8)));
typedef float f32x4 __attribute__((ext_vector_type(4)));
typedef unsigned u32x4 __attribute__((ext_vector_type(4)));
typedef int v4i_t __attribute__((ext_vector_type(4)));
typedef int v8i_t __attribute__((ext_vector_type(8)));
constexpr int BM = 256, BK = 64, HALF = 128, HTB = HALF * BK * 2  , STAGE_BYTES = 8 * HTB, NXCD = 8, WGM = 8;

__host__ __device__ __forceinline__ int lds_byte(int r, int c) { const int st = (r >> 4) * 2 + (c >> 5), rr = r & 15, cc = c & 31, ob = rr * 64 + cc * 2; return st * 1024 + (ob ^ (((ob >> 9) & 1) << 5)); }
__host__ __device__ __forceinline__ void stage_rc(int b, int& R, int& C) { const int st = b / 1024, sb = b % 1024, swz = sb ^ (((sb >> 9) & 1) << 5); R = (st >> 1) * 16 + swz / 64; C = (st & 1) * 32 + (swz % 64) / 2; }
__host__ __device__ __forceinline__ int perm32(int rho) { const int n = rho >> 4, i = rho & 15; return 8 * (i >> 2) + 4 * n + (i & 3); }

template <class E, class = void> struct has_finish { static constexpr bool value = false; };
template <class E> struct has_finish<E, decltype((void)E::HAS_FINISH)> { static constexpr bool value = true; };
template <class E, class = void> struct has_pair { static constexpr bool value = false; };
template <class E> struct has_pair<E, decltype((void)E::HAS_PAIR)> { static constexpr bool value = true; };
template <class E, class = void> struct has_ldspre { static constexpr bool value = false; };
template <class E> struct has_ldspre<E, decltype((void)E::LDSPRE)> { static constexpr bool value = E::LDSPRE; };
template <class E, class = void> struct has_unitbegin { static constexpr bool value = false; };
template <class E> struct has_unitbegin<E, decltype((void)E::HAS_UNITBEGIN)> { static constexpr bool value = true; };
template <class E, class = void> struct has_quad { static constexpr bool value = false; };
template <class E> struct has_quad<E, decltype((void)E::HAS_QUAD)> { static constexpr bool value = true; };
template <class E, class = void> struct has_rowscale { static constexpr bool value = false; };
template <class E> struct has_rowscale<E, decltype((void)E::HAS_ROWSCALE)> { static constexpr bool value = true; };
struct Unit { int pm, pn, pa, pb; };
struct Gemm { const bf16_t* A; const bf16_t* Bt; int M, N, K; int wscale; int ld; };

struct StaticOrder {
    int nM, nN, nwg, G, c;
    __host__ __device__ void init(int M, int N, int G_, int c_) { nM = M / BM; nN = N / BM; nwg = nM * nN; G = G_; c = c_; }
    __host__ __device__ bool next(int i, Unit& u) const {
        const long L = (long)i * G + c; if (L >= nwg) return false;
        int wgid = (int)L; { const int q = nwg / NXCD, r = nwg % NXCD, xcd = wgid % NXCD, off = wgid / NXCD; wgid = (xcd < r ? xcd * (q + 1) : r * (q + 1) + (xcd - r) * q) + off; }
        const int nig = WGM * nN, gid = wgid / nig, fm = gid * WGM, gsz = (nM - fm) < WGM ? (nM - fm) : WGM;
        u.pm = fm + ((wgid % nig) % gsz); u.pn = (wgid % nig) / gsz; u.pa = u.pm; u.pb = u.pn; return true;
    }
    __device__ __forceinline__ void a_ready(const Unit&) const {}
    __device__ __forceinline__ void done(const Unit&) const {}
};
template <class Epi, class Sched, bool ALIGN_EPI = false, bool SP2 = false, bool FP8 = false>
__device__ __forceinline__ void gemm_phase(PG8_LAS unsigned char* lds, const Gemm g, const Sched& S, const Epi& E) {
    int tid_ = threadIdx.x; asm volatile("" : "+v"(tid_));
    const int tid = tid_, wid = __builtin_amdgcn_readfirstlane(tid >> 6), lane = tid & 63, wr = wid >> 2, wc = wid & 3, fr = lane & 15, fq = lane >> 4;
    const int K = g.ld ? g.ld : g.K, nt = g.K / BK;
    unsigned voffA[2], voffB[2];
#pragma unroll
    for (int i = 0; i < 2; ++i) { int R, C; stage_rc(tid * 16 + i * 8192, R, C); const int Rb = (R & ~31) + perm32(R & 31);
        voffA[i] = (unsigned)(R * K + C) * 2u; voffB[i] = (unsigned)(Rb * K + C) * 2u; }
    const size_t kstep = (size_t)(BK * 2);
    const size_t hstep = (size_t)HALF * K * 2;
    const size_t tstep = 2 * hstep;
    const unsigned ldsw = (unsigned)wid * 1024u;
    const int aoff = lds_byte(wr * 64 + fr, fq * 8), boff = lds_byte(wc * 32 + fr, fq * 8);
#define PG8_SA(b, h) (((b) * 2 + (h)) * HTB)
#define PG8_SB(b, h) ((4 + (b) * 2 + (h)) * HTB)
#define PG8_STAGE(bufoff, gbase, voff) do { _Pragma("unroll") for (int _i = 0; _i < 2; ++_i) \
        __builtin_amdgcn_global_load_lds((const unsigned*)((const char*)(gbase) + (voff)[_i]), (PG8_LAS unsigned*)(lds + (bufoff) + ldsw + _i * 8192), 16, 0, 0); } while (0)
#define PG8_RD(off) (*(const PG8_LAS bf16x8*)(lds + (off)))
#define PG8_CAT(lo, hi) __builtin_shufflevector(__builtin_bit_cast(v4i_t, lo), __builtin_bit_cast(v4i_t, hi), 0, 1, 2, 3, 4, 5, 6, 7)
#define PG8_LDA(dst, b, h) do { _Pragma("unroll") for (int m = 0; m < 4; ++m) { if constexpr (FP8) dst##8[m] = PG8_CAT(PG8_RD(PG8_SA(b, h) + aoff + m * 2048), PG8_RD(PG8_SA(b, h) + aoff + m * 2048 + 1024)); \
        else { dst[m][0] = PG8_RD(PG8_SA(b, h) + aoff + m * 2048); dst[m][1] = PG8_RD(PG8_SA(b, h) + aoff + m * 2048 + 1024); } } } while (0)
#define PG8_LDB(dst, b, h) do { _Pragma("unroll") for (int n = 0; n < 2; ++n) { if constexpr (FP8) dst##8[n] = PG8_CAT(PG8_RD(PG8_SB(b, h) + boff + n * 2048), PG8_RD(PG8_SB(b, h) + boff + n * 2048 + 1024)); \
        else { dst[n][0] = PG8_RD(PG8_SB(b, h) + boff + n * 2048); dst[n][1] = PG8_RD(PG8_SB(b, h) + boff + n * 2048 + 1024); } } } while (0)
#define PG8_MMA(ai, bj, At, Bt) do { __builtin_amdgcn_s_setprio(1); if constexpr (FP8) { _Pragma("unroll") for (int m = 0; m < 4; ++m) _Pragma("unroll") for (int n = 0; n < 2; ++n) \
        asm volatile("v_mfma_scale_f32_16x16x128_f8f6f4 %0, %1, %2, %0, %3, %4 op_sel_hi:[0,0,0]" : "+v"(acc[ai][bj][m][n]) : "v"(Bt##8[n]), "v"(At##8[m]), "v"(sc_w), "v"(sc_1)); } \
        else { _Pragma("unroll") for (int m = 0; m < 4; ++m) _Pragma("unroll") for (int n = 0; n < 2; ++n) _Pragma("unroll") for (int k = 0; k < 2; ++k) \
        acc[ai][bj][m][n] = __builtin_amdgcn_mfma_f32_16x16x32_bf16(Bt[n][k], At[m][k], acc[ai][bj][m][n], 0, 0, 0); } __builtin_amdgcn_s_setprio(0); } while (0)
#define PG8_WAIT_V(n) asm volatile("s_waitcnt vmcnt(" #n ")" ::: "memory")
#define PG8_WAIT_L(n) asm volatile("s_waitcnt lgkmcnt(" #n ")" ::: "memory")
#define PG8_BAR __builtin_amdgcn_s_barrier()
#define PG8_SCHED __builtin_amdgcn_sched_barrier(0)
    Unit cur, nxt; int ui = 0;
    if (!S.next(0, cur)) return;
    f32x4 acc[2][2][4][2];
#pragma unroll
    for (int a = 0; a < 2; ++a)
#pragma unroll
        for (int b = 0; b < 2; ++b)
#pragma unroll
            for (int m = 0; m < 4; ++m)
#pragma unroll
                for (int n = 0; n < 2; ++n) acc[a][b][m][n] = (f32x4){0.f, 0.f, 0.f, 0.f};
    const int sc_w = g.wscale, sc_1 = 0x7F7F7F7F;
    bf16x8 At[4][2], B0[2][2], B1[2][2]; v8i_t At8[4], B08[2], B18[2];
    const char* cA = (const char*)g.A + (size_t)cur.pa * tstep; const char* cB = (const char*)g.Bt + (size_t)cur.pb * tstep;
    if constexpr (has_unitbegin<Epi>::value) E.unit_begin(cur.pm, tid);
    S.a_ready(cur);
    if constexpr (SP2) {
        PG8_STAGE(PG8_SB(0, 0), cB, voffB); PG8_STAGE(PG8_SB(0, 1), cB + hstep, voffB); PG8_STAGE(PG8_SA(0, 0), cA, voffA); PG8_STAGE(PG8_SA(0, 1), cA + hstep, voffA);
        if (wr == 1) PG8_BAR;
        PG8_WAIT_V(2); PG8_BAR;
        PG8_STAGE(PG8_SB(1, 0), cB + kstep, voffB); PG8_STAGE(PG8_SA(1, 0), cA + kstep, voffA); PG8_STAGE(PG8_SB(1, 1), cB + hstep + kstep, voffB);
        PG8_WAIT_V(6); PG8_BAR;
    } else {
        PG8_STAGE(PG8_SB(0, 0), cB, voffB); PG8_STAGE(PG8_SA(0, 0), cA, voffA); PG8_STAGE(PG8_SB(0, 1), cB + hstep, voffB); PG8_STAGE(PG8_SA(0, 1), cA + hstep, voffA);
        if (wr == 1) PG8_BAR;
        PG8_WAIT_V(4); PG8_BAR;
        PG8_STAGE(PG8_SB(1, 0), cB + kstep, voffB); PG8_STAGE(PG8_SA(1, 0), cA + kstep, voffA); PG8_STAGE(PG8_SB(1, 1), cB + hstep + kstep, voffB);
        PG8_WAIT_V(6); PG8_BAR;
    }
    for (;;) {
        const bool has_next = S.next(ui + 1, nxt);
        const char* nA = has_next ? (const char*)g.A + (size_t)nxt.pa * tstep : cA; const char* nB = has_next ? (const char*)g.Bt + (size_t)nxt.pb * tstep : cB;
#pragma nounroll
        for (int t = 0; t < nt; t += 2) {
            const bool last = (t == nt - 2);
            const char* a1 = cA + (size_t)(t + 1) * kstep;
            const char* a2 = last ? nA : cA + (size_t)(t + 2) * kstep; const char* b2 = last ? nB : cB + (size_t)(t + 2) * kstep;
            const char* a3 = a2 + kstep; const char* b3 = b2 + kstep;
            if (last && has_next) S.a_ready(nxt);
            if constexpr (SP2) {
            PG8_LDB(B0, 0, 0); PG8_LDB(B1, 0, 1); PG8_SCHED; PG8_LDA(At, 0, 0); PG8_STAGE(PG8_SA(1, 1), a1 + hstep, voffA);
            PG8_WAIT_V(8); PG8_WAIT_L(0); PG8_BAR; PG8_MMA(0, 0, At, B0); PG8_MMA(0, 1, At, B1); PG8_BAR; PG8_SCHED;
            PG8_LDA(At, 0, 1); PG8_STAGE(PG8_SB(0, 0), b2, voffB); PG8_STAGE(PG8_SB(0, 1), b2 + hstep, voffB); PG8_STAGE(PG8_SA(0, 0), a2, voffA);
            PG8_WAIT_V(8); PG8_WAIT_L(0); PG8_BAR; PG8_MMA(1, 0, At, B0); PG8_MMA(1, 1, At, B1); PG8_BAR; PG8_SCHED;
            PG8_LDB(B0, 1, 0); PG8_LDB(B1, 1, 1); PG8_SCHED; PG8_LDA(At, 1, 0); PG8_STAGE(PG8_SA(0, 1), a2 + hstep, voffA);
            PG8_WAIT_V(8); PG8_WAIT_L(0); PG8_BAR; PG8_MMA(0, 0, At, B0); PG8_MMA(0, 1, At, B1); PG8_BAR; PG8_SCHED;
            PG8_LDA(At, 1, 1); PG8_STAGE(PG8_SB(1, 0), b3, voffB); PG8_STAGE(PG8_SB(1, 1), b3 + hstep, voffB); PG8_STAGE(PG8_SA(1, 0), a3, voffA);
            PG8_WAIT_V(8); PG8_WAIT_L(0); PG8_BAR; PG8_MMA(1, 0, At, B0); PG8_MMA(1, 1, At, B1); PG8_BAR; PG8_SCHED;
            } else {
            PG8_LDB(B0, 0, 0); PG8_SCHED; PG8_LDA(At, 0, 0); PG8_STAGE(PG8_SA(1, 1), a1 + hstep, voffA);
            PG8_WAIT_L(8); PG8_BAR; PG8_WAIT_L(0); PG8_MMA(0, 0, At, B0); PG8_BAR; PG8_SCHED;
            PG8_LDB(B1, 0, 1); PG8_STAGE(PG8_SB(0, 0), b2, voffB);
            PG8_BAR; PG8_WAIT_L(0); PG8_MMA(0, 1, At, B1); PG8_BAR;
            PG8_LDA(At, 0, 1); PG8_STAGE(PG8_SA(0, 0), a2, voffA);
            PG8_BAR; PG8_WAIT_L(0); PG8_MMA(1, 0, At, B0); PG8_BAR; PG8_SCHED;
            PG8_STAGE(PG8_SB(0, 1), b2 + hstep, voffB);
            PG8_WAIT_V(6); PG8_BAR; PG8_MMA(1, 1, At, B1); PG8_BAR;
            PG8_LDB(B0, 1, 0); PG8_SCHED; PG8_LDA(At, 1, 0); PG8_STAGE(PG8_SA(0, 1), a2 + hstep, voffA);
            PG8_WAIT_L(8); PG8_BAR; PG8_WAIT_L(0); PG8_MMA(0, 0, At, B0); PG8_BAR; PG8_SCHED;
            PG8_LDB(B1, 1, 1); PG8_STAGE(PG8_SB(1, 0), b3, voffB);
            PG8_BAR; PG8_WAIT_L(0); PG8_MMA(0, 1, At, B1); PG8_BAR;
            PG8_LDA(At, 1, 1); PG8_STAGE(PG8_SA(1, 0), a3, voffA);
            PG8_BAR; PG8_WAIT_L(0); PG8_MMA(1, 0, At, B0); PG8_BAR; PG8_SCHED;
            PG8_STAGE(PG8_SB(1, 1), b3 + hstep, voffB);
            PG8_WAIT_V(6); PG8_BAR; PG8_MMA(1, 1, At, B1); PG8_BAR;
            }
        }
        if constexpr (ALIGN_EPI) { if (wr == 0) PG8_BAR; }
        if constexpr (FP8) asm volatile("s_nop 15\n\ts_nop 15" ::: "memory");
        {
            int fr_ = fr, fq_ = fq; asm volatile("" : "+v"(fr_), "+v"(fq_));
            const int row0 = cur.pm * BM + wr * 64 + fr_, col0 = cur.pn * BM + wc * 32 + 8 * fq_;
            Epi E2 = E; E2.launder();
            if constexpr (has_quad<Epi>::value) {
                float rs[2][4];
#pragma unroll
                for (int ai = 0; ai < 2; ++ai)
#pragma unroll
                    for (int m = 0; m < 4; ++m) rs[ai][m] = E2.rowscale(row0 + ai * HALF + m * 16);
#pragma unroll
                for (int ai = 0; ai < 2; ++ai)
#pragma unroll
                    for (int bj = 0; bj < 2; ++bj) E2.quad(row0 + ai * HALF, col0 + bj * HALF, fq_, acc[ai][bj], rs[ai]);
            } else if constexpr (has_pair<Epi>::value) {
                bool done_ = false;
                if constexpr (has_ldspre<Epi>::value) { if (!has_next) {
                    PG8_WAIT_V(0); PG8_BAR;
                    PG8_LAS unsigned char* strip = lds + wid * 16384;
#pragma unroll
                    for (int ai = 0; ai < 2; ++ai)
#pragma unroll
                        for (int m = 0; m < 4; ++m)
#pragma unroll
                            for (int bj = 0; bj < 2; ++bj) E2.pre_dma(strip + ((ai * 4 + m) * 2 + bj) * 1024, row0 + ai * HALF + m * 16, col0 + bj * HALF);
                    PG8_WAIT_V(0);
#pragma unroll
                    for (int ai = 0; ai < 2; ++ai)
#pragma unroll
                        for (int m = 0; m < 4; ++m) { const u32x4 w_ = *(const PG8_LAS u32x4*)(strip + ((ai * 4 + m) * 2 + 0) * 1024 + lane * 16), v_ = *(const PG8_LAS u32x4*)(strip + ((ai * 4 + m) * 2 + 1) * 1024 + lane * 16);
                            E2.pair_w(row0 + ai * HALF + m * 16, col0, acc[ai][0][m][0], acc[ai][0][m][1], acc[ai][1][m][0], acc[ai][1][m][1], w_, v_); }
                    done_ = true; } }
                if (!done_) {
#pragma unroll
                for (int ai = 0; ai < 2; ++ai)
#pragma unroll
                    for (int m = 0; m < 4; ++m) E2.pair(row0 + ai * HALF + m * 16, col0, acc[ai][0][m][0], acc[ai][0][m][1], acc[ai][1][m][0], acc[ai][1][m][1]);
                }
            } else if constexpr (has_rowscale<Epi>::value) {
#pragma unroll
                for (int ai = 0; ai < 2; ++ai) {
                    float rs[4];
#pragma unroll
                    for (int m = 0; m < 4; ++m) rs[m] = E2.rowscale(row0 + ai * HALF + m * 16);
                    asm volatile("" ::: "memory");
#pragma unroll
                    for (int m = 0; m < 4; ++m)
#pragma unroll
                        for (int bj = 0; bj < 2; ++bj) E2(row0 + ai * HALF + m * 16, col0 + bj * HALF, acc[ai][bj][m][0] * rs[m], acc[ai][bj][m][1] * rs[m]);
                    asm volatile("" ::: "memory");
                }
            } else {
#pragma unroll
            for (int ai = 0; ai < 2; ++ai)
#pragma unroll
                for (int m = 0; m < 4; ++m)
#pragma unroll
                    for (int bj = 0; bj < 2; ++bj) E2(row0 + ai * HALF + m * 16, col0 + bj * HALF, acc[ai][bj][m][0], acc[ai][bj][m][1]);
            }
            if constexpr (has_finish<Epi>::value) E2.finish(cur.pm, cur.pn, tid);
            if constexpr (has_unitbegin<Epi>::value) { if (has_next) { PG8_BAR; E.unit_begin(nxt.pm, tid); } }
            S.done(cur);
        }
        if (!has_next) break;
#pragma unroll
        for (int a = 0; a < 2; ++a)
#pragma unroll
            for (int b = 0; b < 2; ++b)
#pragma unroll
                for (int m = 0; m < 4; ++m)
#pragma unroll
                    for (int n = 0; n < 2; ++n) acc[a][b][m][n] = (f32x4){0.f, 0.f, 0.f, 0.f};
        cur = nxt; cA = nA; cB = nB; ++ui;
        if constexpr (ALIGN_EPI) { if (wr == 1) PG8_BAR; }
    }
    PG8_WAIT_V(0);
    if constexpr (!ALIGN_EPI) { if (wr == 0) PG8_BAR; }
    PG8_BAR;
#undef PG8_SA
#undef PG8_SB
#undef PG8_STAGE
#undef PG8_LDA
#undef PG8_RD
#undef PG8_LDB
#undef PG8_MMA
#undef PG8_CAT
#undef PG8_WAIT_V
#undef PG8_WAIT_L
#undef PG8_BAR
#undef PG8_SCHED
}

struct MoeOrder {
    StaticOrder so; int t0, abase, nN; const int* tile_e;
    __device__ void init(int t0_, int t1_, int N, int G_, int c_, const int* te, int abase_) { so.init((t1_ - t0_) * BM, N, G_, c_); t0 = t0_; abase = abase_; nN = N / BM; tile_e = te; }
    __device__ bool next(int i, Unit& u) const { if (!so.next(i, u)) return false; u.pm += t0; u.pa = u.pm - abase; u.pb = __builtin_amdgcn_readfirstlane(tile_e[u.pm]) * nN + u.pn; return true; }
    __device__ __forceinline__ void a_ready(const Unit&) const {}
    __device__ __forceinline__ void done(const Unit&) const {}
};
}

template <class Epi>
__device__ __forceinline__ void simple_gemm(const Ctx& X, const bf16* A, const bf16* Bt, int row_lo, int nrows, int N, int K, const int* tile_e, size_t expert_stride, int a_rowbase, const Epi& E) {
    const int fr = X.lane & 15, fq = X.lane >> 4;
    const int ncb = N / 32, ntile = (nrows / 16) * ncb;
    const int gw = X.bid * NWAVES + X.wave, ngw = X.nblk * NWAVES;
    for (int t = gw; t < ntile; t += ngw) {
        const int tm = t / ncb, tn = t - tm * ncb, r0 = row_lo + tm * 16, c0 = tn * 32;
        const bf16* Bb = Bt; if (tile_e) Bb += (size_t)tile_e[r0 >> 8] * expert_stride;
        const bf16* arow = A + (size_t)(r0 - a_rowbase + fr) * K + 8 * fq;
        const bf16* b0 = Bb + (size_t)(c0 + perm32(fr)) * K + 8 * fq;
        const bf16* b1 = Bb + (size_t)(c0 + perm32(16 + fr)) * K + 8 * fq;
        f32x4 acc0 = {0.f, 0.f, 0.f, 0.f}, acc1 = {0.f, 0.f, 0.f, 0.f};
        for (int k = 0; k < K; k += 32) {
            const bf16x8 a = *(const bf16x8*)(arow + k), w0 = *(const bf16x8*)(b0 + k), w1 = *(const bf16x8*)(b1 + k);
            acc0 = __builtin_amdgcn_mfma_f32_16x16x32_bf16(w0, a, acc0, 0, 0, 0);
            acc1 = __builtin_amdgcn_mfma_f32_16x16x32_bf16(w1, a, acc1, 0, 0, 0);
        }
        E(r0 + fr, c0 + 8 * fq, acc0, acc1);
    }
}


namespace pg8 { struct OneUnit { Unit u; bool have;
    __device__ bool next(int i, Unit& o) const { if (i != 0 || !have) return false; o = u; return true; }
    __device__ __forceinline__ void a_ready(const Unit&) const {}
    __device__ __forceinline__ void done(const Unit&) const {} }; }
struct EpiSlab {
    float* slab; int ks;
    __device__ __forceinline__ void launder() {}
    __device__ __forceinline__ void operator()(int row, int c, f32x4 a, f32x4 b) const {
        const size_t e = ((size_t)((((row >> 8) - 128) * 4 + (c >> 8)) * 7 + ks) * 256 + (row & 255)) * 256 + (c & 255);
#if SLAB_BF16
        *(u32x4*)((bf16*)slab + e) = pack8(a, b);
#else
        float* d = slab + e; *(f32x4*)d = a; *(f32x4*)(d + 4) = b;
#endif
    }
};
template <class Epi>
__device__ __forceinline__ void gemm_dense(const Ctx& X, const bf16* A, const bf16* Bt, int N, int K, const Epi& E) {
#if FAST_GEMM
    pg8::Gemm g{A, Bt, T, N, K, 0}; pg8::StaticOrder S; S.init(T, N, X.nblk, X.bid);
    pg8::gemm_phase<Epi, pg8::StaticOrder, true, true>(X.lds, g, S, E);
#else
    simple_gemm(X, A, Bt, 0, T, N, K, nullptr, 0, 0, E);
#endif
}
template <class Epi>
__device__ __forceinline__ void gemm_moe(const Ctx& X, const bf16* A, const bf16* Bt, int t0, int t1, int N, int K, const int* tile_e, int abase, int wscale, const Epi& E) {
#if FAST_GEMM
    pg8::Gemm g{A, Bt, (t1 - t0) * 256, N, K, wscale, 0}; pg8::MoeOrder S; S.init(t0, t1, N, X.nblk, X.bid, tile_e, abase);
    pg8::gemm_phase<Epi, pg8::MoeOrder, true, true, MOE_FP8 != 0>(X.lds, g, S, E);
#else
    simple_gemm(X, A, Bt, t0 * 256, (t1 - t0) * 256, N, K, tile_e, (size_t)N * K, abase * 256, E);
#endif
}

struct SrcPlain { const float* W; int N; __device__ __forceinline__ f32x4 load4(int k, int n4) const { return *(const f32x4*)(W + (size_t)k * N + n4); } };
struct SrcScaled { const float* W; int N; const float* rs; __device__ __forceinline__ f32x4 load4(int k, int n4) const { return *(const f32x4*)(W + (size_t)k * N + n4) * rs[k]; } };
__device__ __forceinline__ int rope_src(int j) { const int g = j >> 3, jj = j & 7; return (jj < 4) ? (4 * g + jj) : (32 + 4 * g + (jj - 4)); }
struct SrcIn { const float* W; const float* rs;
    __device__ __forceinline__ f32x4 load4(int k, int n4) const { if (n4 >= NPROJ) return (f32x4){0.f, 0.f, 0.f, 0.f}; int m = n4; if (n4 >= 640 && n4 < 704) m = 640 + rope_src(n4 - 640); const f32x4 v = *(const f32x4*)(W + (size_t)k * NPROJ + m); return rs ? v * rs[k] : v; } };
struct SrcQB { const float* W; const float* gain;
    __device__ __forceinline__ f32x4 load4(int k, int n4) const { const int h = n4 / DQK; int c = n4 - h * DQK; if (c >= DNOPE) c = DNOPE + rope_src(c - DNOPE);
        return *(const f32x4*)(W + (size_t)k * (NH * DQK) + h * DQK + c) * (gain[k] * 0.07216878364870322f); } };
struct SrcGU { const float* Wg; const float* Wu; int FF; const float* rs;
    __device__ __forceinline__ f32x4 load4(int k, int n4) const { const int g = n4 >> 3; const long long d = (n4 & 4) ? (long long)(Wu - Wg) : 0ll; const f32x4 v = *(const f32x4*)(Wg + d + (long long)k * FF + 4 * g); return rs ? v * rs[k] : v; } };

template <class Src>
__device__ __forceinline__ void transpose_item(const Src& S, int K, int nblk, bf16* WT, LAS float* scr, int item, int lane) {
    const int kb = item / nblk, nb = item - kb * nblk, k0 = 64 * kb, n0 = 32 * nb;
    const int kk0 = lane >> 3, qd = lane & 7;
    f32x4 v[8];
#pragma unroll
    for (int i = 0; i < 8; ++i) v[i] = S.load4(k0 + 8 * i + kk0, n0 + 4 * qd);
#pragma unroll
    for (int i = 0; i < 8; ++i) { LAS float* d = scr + (8 * i + kk0) * 33 + 4 * qd; d[0] = v[i].x; d[1] = v[i].y; d[2] = v[i].z; d[3] = v[i].w; }
    asm volatile("s_waitcnt lgkmcnt(0)" ::: "memory");
    const int c = lane & 7;
#pragma unroll
    for (int j = 0; j < 4; ++j) { const int n = (lane >> 3) + 8 * j; const LAS float* s = scr + (8 * c) * 33 + n;
        u32x4 o; o.x = pk2(s[0 * 33], s[1 * 33]); o.y = pk2(s[2 * 33], s[3 * 33]); o.z = pk2(s[4 * 33], s[5 * 33]); o.w = pk2(s[6 * 33], s[7 * 33]);
        *(u32x4*)(WT + (size_t)(n0 + n) * K + k0 + 8 * c) = o; }
    asm volatile("s_waitcnt lgkmcnt(0)" ::: "memory");
}

template <class Src>
__device__ __forceinline__ void transpose_item_fp8(const Src& S, int K, int nblk, unsigned char* WT, LAS float* scr, int item, int lane, float scale) {
    const int kb = item / nblk, nb = item - kb * nblk, k0 = 64 * kb, n0 = 32 * nb;
    const int kk0 = lane >> 3, qd = lane & 7;
    f32x4 v[8];
#pragma unroll
    for (int i = 0; i < 8; ++i) v[i] = S.load4(k0 + 8 * i + kk0, n0 + 4 * qd);
#pragma unroll
    for (int i = 0; i < 8; ++i) { LAS float* d = scr + (8 * i + kk0) * 33 + 4 * qd; d[0] = v[i].x * scale; d[1] = v[i].y * scale; d[2] = v[i].z * scale; d[3] = v[i].w * scale; }
    asm volatile("s_waitcnt lgkmcnt(0)" ::: "memory");
    const int c = lane & 3;
#pragma unroll
    for (int j = 0; j < 2; ++j) { const int n = (lane >> 2) + 16 * j; const LAS float* s = scr + (16 * c) * 33 + n;
        u32x4 o; o.x = pk4_fp8(s[0 * 33], s[1 * 33], s[2 * 33], s[3 * 33]); o.y = pk4_fp8(s[4 * 33], s[5 * 33], s[6 * 33], s[7 * 33]);
        o.z = pk4_fp8(s[8 * 33], s[9 * 33], s[10 * 33], s[11 * 33]); o.w = pk4_fp8(s[12 * 33], s[13 * 33], s[14 * 33], s[15 * 33]);
        *(u32x4*)(WT + (size_t)(n0 + n) * K + k0 + 16 * c) = o; }
    asm volatile("s_waitcnt lgkmcnt(0)" ::: "memory");
}

template <int NR, class TS>
__device__ __forceinline__ void norm_rows_bf16(const TS* src, const float* gain, bf16* dst, int row0, int rstep, int lane) {
    f32x4 v[NR][4];
#pragma unroll
    for (int i = 0; i < NR; ++i)
#pragma unroll
        for (int j = 0; j < 4; ++j) v[i][j] = ldrow4(src + (size_t)(row0 + i * rstep) * DM, lane + 64 * j);
    f32x4 g[4];
#pragma unroll
    for (int j = 0; j < 4; ++j) g[j] = *((const f32x4*)gain + lane + 64 * j);
#pragma unroll
    for (int i = 0; i < NR; ++i) { float s = 0.f;
#pragma unroll
        for (int j = 0; j < 4; ++j) s += (v[i][j].x * v[i][j].x + v[i][j].y * v[i][j].y) + (v[i][j].z * v[i][j].z + v[i][j].w * v[i][j].w);
        const float rstd = __builtin_amdgcn_rsqf(wave_sum(s) * (1.f / DM) + EPS);
#pragma unroll
        for (int j = 0; j < 4; ++j) { const f32x4 y = v[i][j] * rstd * g[j]; u32x2 w; w.x = pk2(y.x, y.y); w.y = pk2(y.z, y.w); *((u32x2*)(dst + (size_t)(row0 + i * rstep) * DM) + lane + 64 * j) = w; } }
}
template <class TS>
__device__ __forceinline__ void norm_all_rows(const Ctx& X, const TS* src, const float* gain, bf16* dst) {
    const int gw = X.bid * NWAVES + X.wave, ngw = X.nblk * NWAVES;
    int m = gw;
    for (; m + 3 * ngw < T; m += 4 * ngw) norm_rows_bf16<4, TS>(src, gain, dst, m, ngw, X.lane);
    for (; m < T; m += ngw) norm_rows_bf16<1, TS>(src, gain, dst, m, ngw, X.lane);
}

__device__ __forceinline__ void raw_all_rows(const Ctx& X, const float* src, bf16* dst, float* ssx) {
    const int gw = X.bid * NWAVES + X.wave, ngw = X.nblk * NWAVES, lane = X.lane;
    int m = gw;
    for (; m + 3 * ngw < T; m += 4 * ngw) { f32x4 v[4][4];
#pragma unroll
        for (int i = 0; i < 4; ++i)
#pragma unroll
            for (int j = 0; j < 4; ++j) v[i][j] = ldrow4(src + (size_t)(m + i * ngw) * DM, lane + 64 * j);
#pragma unroll
        for (int i = 0; i < 4; ++i) { const int row = m + i * ngw; float s = 0.f;
#pragma unroll
            for (int j = 0; j < 4; ++j) { const f32x4 y = v[i][j]; s += (y.x * y.x + y.y * y.y) + (y.z * y.z + y.w * y.w); u32x2 w; w.x = pk2(y.x, y.y); w.y = pk2(y.z, y.w); *((u32x2*)(dst + (size_t)row * DM) + lane + 64 * j) = w; }
            s = wave_sum(s); if (lane < 4) ssx[(size_t)lane * T + row] = lane == 0 ? s : 0.f; } }
    for (; m < T; m += ngw) { float s = 0.f;
#pragma unroll
        for (int j = 0; j < 4; ++j) { const f32x4 y = ldrow4(src + (size_t)m * DM, lane + 64 * j); s += (y.x * y.x + y.y * y.y) + (y.z * y.z + y.w * y.w); u32x2 w; w.x = pk2(y.x, y.y); w.y = pk2(y.z, y.w); *((u32x2*)(dst + (size_t)m * DM) + lane + 64 * j) = w; }
        s = wave_sum(s); if (lane < 4) ssx[(size_t)lane * T + m] = lane == 0 ? s : 0.f; }
}

constexpr int TAIL_A = 64 * 8 * TAILFILL_A, TAIL_B = 64 * 8 * TAILFILL_B, TAIL_C = 128 * 8 * TAILFILL_C;
constexpr int TAIL_ITEMS = TAILFILL ? (2 * TAIL_A + 2 * TAIL_B + TAIL_C) : 0;
constexpr int MDN_ITEMS = NE * 56 * 32;
constexpr int MGU_ITEMS = NE * 16 * 224;
static_assert(TAIL_ITEMS <= MDN_ITEMS + MGU_ITEMS, "tail slices exceed the expert weight copy items");
__device__ __forceinline__ void tail_fill(const Ctx& X, const Params& p, int slice_first, int per_wave, int rank, int nranks) {
    unsigned char* ws = p.ws; LAS float* scr = (LAS float*)(X.lds + X.wave * 16384);
    constexpr int I_MDN = 56 * 32, I_MGU = 16 * 224;
#pragma unroll 1
    for (int k = 0; k < per_wave; ++k) { const int idx = (MGU_ITEMS + MDN_ITEMS - TAIL_ITEMS) + slice_first + (k * nranks + rank) * NWAVES + X.wave;
        if (idx < MGU_ITEMS) { const int e = idx / I_MGU, r = idx - e * I_MGU; SrcGU S{p.in[I_MWG] + (size_t)e * DM * FFM, p.in[I_MWU] + (size_t)e * DM * FFM, FFM, nullptr};
            transpose_item_fp8(S, DM, (2 * FFM) / 32, (unsigned char*)(ws + WS_WT_MGU) + (size_t)e * (2 * FFM) * DM, scr, r, X.lane, 64.f); }
        else { const int i2 = idx - MGU_ITEMS, e = i2 / I_MDN, r = i2 - e * I_MDN; SrcPlain S{p.in[I_MWD] + (size_t)e * FFM * DM, DM};
            transpose_item_fp8(S, FFM, DM / 32, (unsigned char*)(ws + WS_WT_MDN) + (size_t)e * DM * FFM, scr, r, X.lane, 128.f); } }
}
__device__ __forceinline__ void phase_prologue(const Ctx& X, const Params& p) {
    unsigned char* ws = p.ws;
    LAS float* scr = (LAS float*)(X.lds + X.wave * 16384);
    const int gw = X.bid * NWAVES + X.wave, ngw = X.nblk * NWAVES;
    constexpr int I_IN = 16 * 88, I_QB = 6 * 24, I_KVB = 4 * 32, I_OUT = 16 * 32, I_GU = 16 * 176, I_DN = 44 * 32, I_MGU = 16 * 224, I_MDN = 56 * 32;
    constexpr int I_LAYER = I_IN + I_QB + I_KVB + I_OUT;
    constexpr int NITEMS = 2 * I_LAYER + I_GU + I_DN + NE * (I_MGU + I_MDN);
    const int nitems = (X.nblk == 256) ? NITEMS - TAIL_ITEMS : NITEMS;
    for (int it = gw; it < nitems; it += ngw) {
        int r = it;
        if (r < 2 * I_LAYER) {
            const int l = r / I_LAYER; r -= l * I_LAYER;
            if (r < I_IN) { SrcIn S{p.in[I_WIN] + (size_t)l * DM * NPROJ, (FUSE_NORM && (l == 1 || RAW_L0)) ? p.in[I_MIXN] + l * DM : nullptr}; transpose_item(S, DM, NPROJ_P / 32, (bf16*)(ws + WS_WT_IN) + (size_t)l * NPROJ_P * DM, scr, r, X.lane); continue; } r -= I_IN;
            if (r < I_QB) { SrcQB S{p.in[I_WQB] + (size_t)l * QR * (NH * DQK), p.in[I_QAN] + l * QR}; transpose_item(S, QR, (NH * DQK) / 32, (bf16*)(ws + WS_WT_QB) + (size_t)l * (NH * DQK) * QR, scr, r, X.lane); continue; } r -= I_QB;
            if (r < I_KVB) { SrcScaled S{p.in[I_WKVB] + (size_t)l * KVR * 1024, 1024, p.in[I_KVAN] + l * KVR}; transpose_item(S, KVR, 1024 / 32, (bf16*)(ws + WS_WT_KVB) + (size_t)l * 1024 * KVR, scr, r, X.lane); continue; } r -= I_KVB;
            { SrcPlain S{p.in[I_WOUT] + (size_t)l * DM * DM, DM}; transpose_item(S, DM, DM / 32, (bf16*)(ws + WS_WT_OUT) + (size_t)l * DM * DM, scr, r, X.lane); continue; }
        }
        r -= 2 * I_LAYER;
        if (r < I_GU) { SrcGU S{p.in[I_DWG], p.in[I_DWU], FF0, FUSE_NORM ? p.in[I_FFNN] : nullptr}; transpose_item(S, DM, (2 * FF0) / 32, (bf16*)(ws + WS_WT_GU), scr, r, X.lane); continue; } r -= I_GU;
        if (r < I_DN) { SrcPlain S{p.in[I_DWD], DM}; transpose_item(S, FF0, DM / 32, (bf16*)(ws + WS_WT_DN), scr, r, X.lane); continue; } r -= I_DN;
        if (r < NE * I_MGU) { const int e = r / I_MGU; r -= e * I_MGU; SrcGU S{p.in[I_MWG] + (size_t)e * DM * FFM, p.in[I_MWU] + (size_t)e * DM * FFM, FFM, nullptr};
#if MOE_FP8
            transpose_item_fp8(S, DM, (2 * FFM) / 32, (unsigned char*)(ws + WS_WT_MGU) + (size_t)e * (2 * FFM) * DM, scr, r, X.lane, 64.f); continue; } r -= NE * I_MGU;
        { const int e = r / I_MDN; r -= e * I_MDN; SrcPlain S{p.in[I_MWD] + (size_t)e * FFM * DM, DM};
            transpose_item_fp8(S, FFM, DM / 32, (unsigned char*)(ws + WS_WT_MDN) + (size_t)e * DM * FFM, scr, r, X.lane, 128.f); }
#else
            transpose_item(S, DM, (2 * FFM) / 32, (bf16*)(ws + WS_WT_MGU) + (size_t)e * (2 * FFM) * DM, scr, r, X.lane); continue; } r -= NE * I_MGU;
        { const int e = r / I_MDN; r -= e * I_MDN; SrcPlain S{p.in[I_MWD] + (size_t)e * FFM * DM, DM};
            transpose_item(S, FFM, DM / 32, (bf16*)(ws + WS_WT_MDN) + (size_t)e * DM * FFM, scr, r, X.lane); }
#endif
    }
    { const int* pos = (const int*)p.in[I_POS]; float* COS = (float*)(ws + WS_COS); float* SIN = (float*)(ws + WS_SIN);
      for (int i = X.bid * NTHREADS + X.tid; i < T * 32; i += X.nblk * NTHREADS) {
          const int row = i >> 5, f = i & 31; const double a = (double)pos[row] * kInvRev[f]; const float rev = (float)(a - floor(a));
          COS[i] = __builtin_amdgcn_cosf(rev); SIN[i] = __builtin_amdgcn_sinf(rev); } }
    if (X.bid == 0) { float* LB = (float*)(ws + WS_MISC + MISC_LB); const float* h = p.in[I_HLB];
        for (int i = X.tid; i < HGW; i += NTHREADS) { LB[i] = 0.f; LB[HGW + i] = 1.f / (1.f + expf(h[i] - h[HGW + i])); } }
#if RAW_L0 && FUSE_NORM && XR_BF16
    raw_all_rows(X, p.in[I_X], (bf16*)(ws + WS_XRB), (float*)(ws + WS_MISC + MISC_SSXA));
#else
    norm_all_rows(X, p.in[I_X], p.in[I_MIXN], (bf16*)(ws + WS_XB));
#endif
}

__device__ __forceinline__ void phase_attn_simple(const Ctx& X, const Params& p) {
    unsigned char* ws = p.ws;
    const bf16* Q = (const bf16*)(ws + WS_Q); const bf16* KN = (const bf16*)(ws + WS_KN); const bf16* KPE = (const bf16*)(ws + WS_KPE); const bf16* V = (const bf16*)(ws + WS_V);
    bf16* CC = (bf16*)(ws + WS_CC);
    LAS float* ql = (LAS float*)(X.lds + X.wave * 1024);
    const int gw = X.bid * NWAVES + X.wave, ngw = X.nblk * NWAVES, lane = X.lane;
    for (int idx = gw; idx < 2 * NH * SEQ; idx += ngw) {
        const int bh = idx & 7, q = SEQ - 1 - (idx >> 3), b = bh >> 2, h = bh & 3;
        const bf16* qrow = Q + ((size_t)bh * SEQ + q) * DQK;
        ql[lane] = bf2f(qrow[lane]); ql[64 + lane] = bf2f(qrow[64 + lane]); ql[128 + lane] = bf2f(qrow[128 + lane]);
        asm volatile("s_waitcnt lgkmcnt(0)" ::: "memory");
        float m = -1e30f, l = 0.f, o0 = 0.f, o1 = 0.f;
        for (int k0 = 0; k0 <= q; k0 += 64) {
            const int key = k0 + lane; const bool valid = key <= q;
            float s = 0.f;
            const bf16* kr = KN + ((size_t)bh * SEQ + key) * 128; const bf16* kp = KPE + ((size_t)b * SEQ + key) * ROPE;
#pragma unroll 4
            for (int c = 0; c < 16; ++c) { const u32x4 w = *(const u32x4*)(kr + 8 * c); const LAS float* qq = ql + 8 * c;
                s += bflo(w.x) * qq[0] + bfhi(w.x) * qq[1] + bflo(w.y) * qq[2] + bfhi(w.y) * qq[3] + bflo(w.z) * qq[4] + bfhi(w.z) * qq[5] + bflo(w.w) * qq[6] + bfhi(w.w) * qq[7]; }
#pragma unroll 4
            for (int c = 0; c < 8; ++c) { const u32x4 w = *(const u32x4*)(kp + 8 * c); const LAS float* qq = ql + 128 + 8 * c;
                s += bflo(w.x) * qq[0] + bfhi(w.x) * qq[1] + bflo(w.y) * qq[2] + bfhi(w.y) * qq[3] + bflo(w.z) * qq[4] + bfhi(w.z) * qq[5] + bflo(w.w) * qq[6] + bfhi(w.w) * qq[7]; }
            if (!valid) s = -1e30f;
            const float mx = wave_max(s), mn = fmaxf(m, mx), alpha = fast_exp(m - mn);
            const float pr = valid ? fast_exp(s - mn) : 0.f;
            l = l * alpha + wave_sum(pr); o0 *= alpha; o1 *= alpha; m = mn;
            const bf16* vb = V + ((size_t)bh * SEQ + k0) * 128 + 2 * lane;
            for (int j = 0; j < 64; ++j) { const float pj = __shfl(pr, j); const unsigned w = *(const unsigned*)(vb + (size_t)j * 128); o0 += pj * bflo(w); o1 += pj * bfhi(w); }
        }
        const float inv = 1.f / l;
        *(unsigned*)(CC + ((size_t)(b * SEQ + q)) * DM + h * 128 + 2 * lane) = pk2(o0 * inv, o1 * inv);
    }
}


namespace att {
typedef short s16x4 __attribute__((ext_vector_type(4)));
typedef float f32x16 __attribute__((ext_vector_type(16)));
constexpr int NW = 8, QBLK = 32, KVBLK = 64, QB = 256, NQB = SEQ / QB;
constexpr int KROW = 400, SHM_V = KVBLK * 128 * 2, SHM_K = KVBLK * KROW;
constexpr int LDS_V = 0, LDS_K = 2 * SHM_V, LDS_WS = LDS_K + 2 * SHM_K, LDS_TOTAL = LDS_WS + NW * 64 * 4;
constexpr float THR = 8.f;
constexpr int LDS_STAGE = LDS_TOTAL, STAGE_P = 144, STAGE_W = 32 * STAGE_P;
static_assert(LDS_STAGE + NW * STAGE_W <= LDS_MISC_OFF, "attention staging overlaps the barrier words");
#define SBAR() __builtin_amdgcn_sched_barrier(0)
__device__ __forceinline__ int v_st(int k, int c) { const int kk = (k & ~0xC) | ((k & 4) << 1) | ((k & 8) >> 1); return ((kk >> 3) * 4 + (c >> 5)) * 512 + ((kk & 7) * 32 + (c & 31)) * 2; }
__device__ __forceinline__ int v_rd_base(int lane) { return ((lane & 3) << 3) | (((lane >> 2) & 3) << 6) | (((lane >> 4) & 1) << 5) | (((lane >> 5) & 1) << 8); }
constexpr int v_rd_off(int d0, int ks, int half) { return d0 * 512 + ks * 4096 + half * 2048; }
__device__ __forceinline__ int crow(int r, int hi) { return (r & 3) + 8 * (r >> 2) + 4 * hi; }
__device__ __forceinline__ unsigned cvtpk(float lo, float hi) { unsigned r; asm volatile("v_cvt_pk_bf16_f32 %0, %1, %2" : "=v"(r) : "v"(lo), "v"(hi)); return r; }
__device__ __forceinline__ bf16x8 load8(const bf16* p) { return *reinterpret_cast<const bf16x8*>(p); }
__device__ __forceinline__ bf16x8 bload8(__amdgpu_buffer_rsrc_t r, unsigned voff, unsigned soff) { const u32x4 x = __builtin_amdgcn_raw_buffer_load_b128(r, voff, soff, 0); return __builtin_bit_cast(bf16x8, x); }
__device__ __forceinline__ void mask_tile(f32x16& p0, f32x16& p1, int dq) {
    const float NEG = -__builtin_inff();
#pragma unroll
    for (int r = 0; r < 16; ++r) { const int c = (r & 3) + 8 * (r >> 2); if (dq - c < 0) p0[r] = NEG; if (dq - c - 32 < 0) p1[r] = NEG; }
}
__device__ __forceinline__ void partialSM(f32x16& p0, f32x16& p1, float& m_reg, float& mn, float& alpha) {
    float pmax = p0[0]; for (int r = 1; r < 16; ++r) pmax = fmaxf(pmax, p0[r]); for (int r = 0; r < 16; ++r) pmax = fmaxf(pmax, p1[r]);
    { auto rr = __builtin_amdgcn_permlane32_swap(__float_as_uint(pmax), __float_as_uint(pmax), false, false);
      pmax = fmaxf(__uint_as_float(rr[0]), __uint_as_float(rr[1])); }
    constexpr float C2 = 1.4426950408889634f;
    if (__builtin_expect(__all((pmax - m_reg) <= THR), 1)) { mn = m_reg; alpha = 1.f; }
    else { mn = fmaxf(m_reg, pmax); alpha = __builtin_amdgcn_exp2f((m_reg - mn) * C2); m_reg = mn; }
    const float mnL = -mn * C2;
    for (int r = 0; r < 16; ++r) p0[r] = fmaf(p0[r], C2, mnL); for (int r = 0; r < 16; ++r) p1[r] = fmaf(p1[r], C2, mnL);
    for (int r = 0; r < 16; ++r) p0[r] = __builtin_amdgcn_exp2f(p0[r]);
}
__device__ __forceinline__ void finishSM(f32x16& p0, f32x16& p1, float alpha, float& l_reg, bf16x8& pa0, bf16x8& pa1, bf16x8& pa2, bf16x8& pa3) {
    for (int r = 0; r < 16; ++r) p1[r] = __builtin_amdgcn_exp2f(p1[r]);
    float ps = 0; for (int r = 0; r < 16; ++r) ps += p0[r]; for (int r = 0; r < 16; ++r) ps += p1[r];
    { auto rr = __builtin_amdgcn_permlane32_swap(__float_as_uint(ps), __float_as_uint(ps), false, false);
      ps = __uint_as_float(rr[0]) + __uint_as_float(rr[1]); }
    l_reg = l_reg * alpha + ps;
#define PK4(P, B_, OUT) do { unsigned a0 = cvtpk(P[B_+0], P[B_+1]), a1 = cvtpk(P[B_+2], P[B_+3]);                          \
        unsigned b0 = cvtpk(P[B_+4], P[B_+5]), b1 = cvtpk(P[B_+6], P[B_+7]);                                             \
        auto r0 = __builtin_amdgcn_permlane32_swap(a0, b0, false, false); auto r1 = __builtin_amdgcn_permlane32_swap(a1, b1, false, false); \
        u32x4 w = {r0[0], r1[0], r0[1], r1[1]}; OUT = *reinterpret_cast<bf16x8*>(&w); } while (0)
    PK4(p0, 0, pa0); PK4(p0, 8, pa1); PK4(p1, 0, pa2); PK4(p1, 8, pa3);
#undef PK4
}
template <int KB>
__device__ __forceinline__ void qkt(f32x16& p0, f32x16& p1, const LAS char* K_lds, int r32, int hi, const bf16x8* qr) {
    p0 = f32x16{}; p1 = f32x16{};
    const LAS char* kb = K_lds + KB * SHM_K + r32 * KROW + hi * 16;
#pragma unroll
    for (int d0 = 0; d0 < 12; ++d0) {
        const bf16x8 b0 = *reinterpret_cast<const LAS bf16x8*>(kb + d0 * 32);
        const bf16x8 b1 = *reinterpret_cast<const LAS bf16x8*>(kb + d0 * 32 + 32 * KROW);
        p0 = __builtin_amdgcn_mfma_f32_32x32x16_bf16(b0, qr[d0], p0, 0, 0, 0);
        p1 = __builtin_amdgcn_mfma_f32_32x32x16_bf16(b1, qr[d0], p1, 0, 0, 0); }
}
template <int VB>
__device__ __forceinline__ void pv_tile(f32x16* o, int vb0, bf16x8 pa0, bf16x8 pa1, bf16x8 pa2, bf16x8 pa3) {
#define TRRD(dst, off) asm volatile("ds_read_b64_tr_b16 %0, %1 offset:%2" : "=&v"(dst) : "v"(vb0), "i"(off) : "memory")
#define PV_D0(d0) do { s16x4 l0, l1, l2, l3, h0, h1, h2, h3; constexpr int b_ = VB * SHM_V + v_rd_off(d0, 0, 0); \
        TRRD(l0, b_); TRRD(h0, b_ + 2048); TRRD(l1, b_ + 4096); TRRD(h1, b_ + 6144); TRRD(l2, b_ + 8192); TRRD(h2, b_ + 10240); TRRD(l3, b_ + 12288); TRRD(h3, b_ + 14336); \
        asm volatile("s_waitcnt lgkmcnt(0)" ::: "memory"); SBAR();   \
        o[d0] = __builtin_amdgcn_mfma_f32_32x32x16_bf16(pa0, (bf16x8){l0[0], l0[1], l0[2], l0[3], h0[0], h0[1], h0[2], h0[3]}, o[d0], 0, 0, 0);   \
        o[d0] = __builtin_amdgcn_mfma_f32_32x32x16_bf16(pa1, (bf16x8){l1[0], l1[1], l1[2], l1[3], h1[0], h1[1], h1[2], h1[3]}, o[d0], 0, 0, 0);   \
        o[d0] = __builtin_amdgcn_mfma_f32_32x32x16_bf16(pa2, (bf16x8){l2[0], l2[1], l2[2], l2[3], h2[0], h2[1], h2[2], h2[3]}, o[d0], 0, 0, 0);   \
        o[d0] = __builtin_amdgcn_mfma_f32_32x32x16_bf16(pa3, (bf16x8){l3[0], l3[1], l3[2], l3[3], h3[0], h3[1], h3[2], h3[3]}, o[d0], 0, 0, 0); } while (0)
    PV_D0(0); PV_D0(1); PV_D0(2); PV_D0(3);
#undef PV_D0
#undef TRRD
}
struct BlockRef { const bf16* Q; const bf16* KN; const bf16* KP; const bf16* V; bf16* O; float* ML; int ostride, P0, par, NT; };
struct Seam { bf16x8 qr[12]; bf16x8 st_v0, st_v1, st_k0, st_k1, st_k2; };
#define VMW() asm volatile("s_waitcnt vmcnt(0)" ::: "memory")
#define VMWN(n) asm volatile("s_waitcnt vmcnt(%0)" :: "i"(n) : "memory")
#define SLOAD(R, k0) do { const unsigned so_ = (unsigned)(k0) * 256u, sp_ = (unsigned)(k0) * 128u; \
                          S.st_v0 = bload8(rV, lofs, so_); S.st_v1 = bload8(rV, lofs, so_ + 8192u); S.st_k0 = bload8(rK, lofs, so_); S.st_k1 = bload8(rK, lofs, so_ + 8192u); S.st_k2 = bload8(rP, lofp, sp_); } while (0)
#define SWRITE_K(bf) do { *(LAS bf16x8*)(K_lds + (bf) * SHM_K + kws) = S.st_k0; *(LAS bf16x8*)(K_lds + (bf) * SHM_K + kws + 32 * KROW) = S.st_k1; *(LAS bf16x8*)(K_lds + (bf) * SHM_K + kwp) = S.st_k2; } while (0)
#define SWRITE_V(bf) do { *(LAS bf16x8*)(V_lds + (bf) * SHM_V + vst0) = S.st_v0; *(LAS bf16x8*)(V_lds + (bf) * SHM_V + vst1) = S.st_v1; } while (0)
#define KBASE_OF(R, t) (((R).par + 2 * (t)) * KVBLK)
__device__ __forceinline__ void attn_block(const BlockRef& cur, LAS char* lds, int tid) {
    Seam S;
    const int wid = __builtin_amdgcn_readfirstlane(tid >> 6), lane = tid & 63, r32 = lane & 31, hi = lane >> 5;
    const int NT = cur.NT;
    const int qlo = cur.P0 + wid * QBLK, qm = qlo + r32 - 4 * hi;
    LAS char* V_lds = lds + LDS_V; LAS char* K_lds = lds + LDS_K;
    LAS float* wsc = (LAS float*)(lds + LDS_WS) + wid * 64; LAS float* li_l = wsc; LAS float* al_l = wsc + 32;
    float m_reg = -1e30f, l_reg = 0; f32x16 o[4] = {};
    const int sr = tid >> 4, sc = (tid & 15) * 8, vst0 = v_st(sr, sc), vst1 = v_st(32 + sr, sc), kws = sr * KROW + sc * 2, pr = tid >> 3, pc = (tid & 7) * 8, kwp = pr * KROW + 256 + pc * 2;
    const unsigned lofs = (unsigned)(sr * 128 + sc) * 2u, lofp = (unsigned)(pr * 64 + pc) * 2u;
    const __amdgpu_buffer_rsrc_t rV = __builtin_amdgcn_make_buffer_rsrc((void*)cur.V, 0, SEQ * 128 * 2, 0x00020000), rK = __builtin_amdgcn_make_buffer_rsrc((void*)cur.KN, 0, SEQ * 128 * 2, 0x00020000),
                                 rP = __builtin_amdgcn_make_buffer_rsrc((void*)cur.KP, 0, SEQ * ROPE * 2, 0x00020000);
    const int vb0 = (int)(unsigned)(size_t)V_lds + v_rd_base(lane);
#define RESC(a) do { if (__any((a) < 1.f)) { if (hi == 0) al_l[r32] = (a); asm volatile("s_waitcnt lgkmcnt(0)" ::: "memory");              \
                     for (int d_ = 0; d_ < 4; ++d_) for (int r = 0; r < 16; ++r) o[d_][r] *= al_l[crow(r, hi)]; } } while (0)
#define KBASE(t) KBASE_OF(cur, t)
#define MASKT(P0_, P1_, t) do { const int kb_ = KBASE(t); if (kb_ + KVBLK - 1 > qlo) mask_tile(P0_, P1_, qm - kb_); } while (0)
    f32x16 pA0, pA1, pB0, pB1; float mnA, mnB, alA, alB; bf16x8 pa0, pa1, pa2, pa3;
#pragma unroll
    for (int d0 = 0; d0 < 12; ++d0) S.qr[d0] = load8(cur.Q + (size_t)(wid * QBLK + r32) * DQK + d0 * 16 + hi * 8);
    SLOAD(cur, KBASE(0)); VMW(); SWRITE_K(0); SWRITE_V(0);
    __syncthreads();
    SLOAD(cur, KBASE(1));
    SBAR(); qkt<0>(pA0, pA1, K_lds, r32, hi, S.qr);
    MASKT(pA0, pA1, 0); partialSM(pA0, pA1, m_reg, mnA, alA);
    VMW(); SWRITE_V(1); SWRITE_K(1);
    __syncthreads();
#define HALF_STEP(PX0, PX1, mnX, alX, PY0, PY1, alY, t, KB, VB, SB) do {                                                      \
        SBAR(); qkt<KB>(PX0, PX1, K_lds, r32, hi, S.qr);                                                                      \
        finishSM(PY0, PY1, alY, l_reg, pa0, pa1, pa2, pa3); SBAR();                                                           \
        if ((t) + 1 < NT) { SLOAD(cur, KBASE((t) + 1)); SBAR(); }                                                             \
        pv_tile<VB>(o, vb0, pa0, pa1, pa2, pa3); MASKT(PX0, PX1, (t)); partialSM(PX0, PX1, m_reg, mnX, alX);                  \
        __syncthreads();                                                                                                      \
        if ((t) + 1 < NT) { VMW(); SWRITE_V(SB); SWRITE_K(SB); }                                                              \
        RESC(alX); __syncthreads(); } while (0)
    for (int t = 1; t + 1 < NT; t += 2) {
        HALF_STEP(pB0, pB1, mnB, alB, pA0, pA1, alA, t, 1, 0, 0);
        HALF_STEP(pA0, pA1, mnA, alA, pB0, pB1, alB, t + 1, 0, 1, 1);
    }
    SBAR(); qkt<1>(pB0, pB1, K_lds, r32, hi, S.qr); SBAR();
    finishSM(pA0, pA1, alA, l_reg, pa0, pa1, pa2, pa3); SBAR();
    pv_tile<0>(o, vb0, pa0, pa1, pa2, pa3);
    MASKT(pB0, pB1, NT - 1); partialSM(pB0, pB1, m_reg, mnB, alB); __syncthreads(); RESC(alB);
    finishSM(pB0, pB1, alB, l_reg, pa0, pa1, pa2, pa3); SBAR(); pv_tile<1>(o, vb0, pa0, pa1, pa2, pa3);
    if (hi == 0) { li_l[r32] = l_reg; *(float2*)(cur.ML + (size_t)(wid * QBLK + r32) * 2) = make_float2(m_reg, l_reg); }
    asm volatile("s_waitcnt lgkmcnt(0)" ::: "memory");
    float rli[16];
#pragma unroll
    for (int r = 0; r < 16; ++r) { const float lv = li_l[crow(r, hi)]; rli[r] = lv > 0.f ? __builtin_amdgcn_rcpf(lv) : 0.f; }
    bf16* Ow = cur.O + (size_t)(wid * QBLK) * cur.ostride;
#if ATTN_STAGED_EPI
    {   LAS char* stg = lds + LDS_STAGE + wid * STAGE_W;
        const int wbase = hi * (4 * STAGE_P) + r32 * 2, rrow = lane >> 3, rchunk = lane & 7;
#pragma unroll
        for (int ps = 0; ps < 2; ++ps) {
#pragma unroll
            for (int r = 0; r < 16; r += 2)
#pragma unroll
                for (int dd = 0; dd < 2; ++dd) { const unsigned w = cvtpk(o[2 * ps + dd][r] * rli[r], o[2 * ps + dd][r + 1] * rli[r + 1]);
                    *(LAS unsigned short*)(stg + wbase + ((r & 3) + 8 * (r >> 2)) * STAGE_P + dd * 64) = (unsigned short)w;
                    *(LAS unsigned short*)(stg + wbase + ((r & 3) + 1 + 8 * (r >> 2)) * STAGE_P + dd * 64) = (unsigned short)(w >> 16); }
            u32x4 t[4];
#pragma unroll
            for (int j = 0; j < 4; ++j) t[j] = *(const LAS u32x4*)(stg + (rrow + 8 * j) * STAGE_P + rchunk * 16);
#pragma unroll
            for (int j = 0; j < 4; ++j) *(u32x4*)(Ow + (size_t)(rrow + 8 * j) * cur.ostride + ps * 64 + rchunk * 8) = t[j];
        }
    }
#else
#pragma unroll
    for (int r = 0; r < 16; ++r) { const int orow = crow(r, hi);
#pragma unroll
        for (int d0 = 0; d0 < 4; ++d0) { const float v = o[d0][r] * rli[r]; const float vn = __shfl_xor(v, 1);
            if ((r32 & 1) == 0) *(unsigned*)(Ow + (size_t)orow * cur.ostride + d0 * 32 + r32) = cvtpk(v, vn); } }
#endif
    __syncthreads();
#undef RESC
#undef KBASE
#undef MASKT
#undef HALF_STEP
}
#undef SLOAD
#undef SWRITE_K
#undef SWRITE_V
#undef VMW
#undef VMWN
struct Item { int bh, x, par; };
__device__ __forceinline__ Item decode(int L) { Item it; it.bh = L & 7; const int rest = L >> 3; it.x = rest >> 1; it.par = rest & 1; return it; }
__device__ __forceinline__ BlockRef make_ref(unsigned char* ws, const Item& it, int pass) {
    const int qb = pass ? (NQB - 1 - it.x) : it.x, bh = it.bh; BlockRef r;
    r.Q = (const bf16*)(ws + WS_Q) + ((size_t)bh * SEQ + (size_t)qb * QB) * DQK;
    r.KN = (const bf16*)(ws + WS_KN) + (size_t)bh * SEQ * 128; r.KP = (const bf16*)(ws + WS_KPE) + (size_t)(bh >> 2) * SEQ * ROPE; r.V = (const bf16*)(ws + WS_V) + (size_t)bh * SEQ * 128;
    if (it.par == 0) { r.O = (bf16*)(ws + WS_CC) + ((size_t)((bh >> 2) * SEQ + qb * QB)) * DM + (bh & 3) * 128; r.ostride = DM; }
    else { r.O = (bf16*)(ws + WS_AP2) + ((size_t)bh * SEQ + (size_t)qb * QB) * 128; r.ostride = 128; }
    r.ML = (float*)(ws + WS_AML) + ((size_t)(it.par * 8 + bh) * SEQ + (size_t)qb * QB) * 2;
    r.P0 = qb * QB; r.par = it.par; r.NT = 2 * (qb + 1);
    return r;
}
}
__device__ __forceinline__ void phase_attn_fast(const Ctx& X, unsigned char* ws) {
    constexpr int TOTAL = 2 * NH * (att::NQB / 2) * 2;
    int L = X.bid; if (L >= TOTAL) return;
    const int stride = X.nblk;
    LAS char* lds = (LAS char*)X.lds;
    if (X.wave >= 4) __builtin_amdgcn_s_setprio(1);
    for (; L < TOTAL; L += stride) {
        const att::Item it = att::decode(L);
#pragma nounroll
        for (int pass = 0; pass < 2; ++pass) { const att::BlockRef cur = att::make_ref(ws, it, pass); att::attn_block(cur, lds, X.tid); }
    }
    __builtin_amdgcn_s_setprio(0);
}
__device__ __forceinline__ void phase_attn_combine(const Ctx& X, unsigned char* ws) {
    bf16* CC = (bf16*)(ws + WS_CC); const bf16* P2 = (const bf16*)(ws + WS_AP2); const float* ML = (const float*)(ws + WS_AML);
    const int gw = X.bid * NWAVES + X.wave, ngw = X.nblk * NWAVES, lane = X.lane, h = lane >> 4, dd = (lane & 15) * 8;
    for (int r0 = gw; r0 < T; r0 += 4 * ngw) {
        u32x4 a[4], q[4]; float2 s1[4], s2[4];
#pragma unroll
        for (int i = 0; i < 4; ++i) { const int row = (r0 + i * ngw < T) ? r0 + i * ngw : r0, b = row >> 13, sq = row & (SEQ - 1), bh = b * NH + h;
            a[i] = *(const u32x4*)(CC + (size_t)row * DM + h * 128 + dd); q[i] = *(const u32x4*)(P2 + ((size_t)bh * SEQ + sq) * 128 + dd);
            s1[i] = *(const float2*)(ML + ((size_t)bh * SEQ + sq) * 2); s2[i] = *(const float2*)(ML + ((size_t)(8 + bh) * SEQ + sq) * 2); }
#pragma unroll
        for (int i = 0; i < 4; ++i) { const int row = (r0 + i * ngw < T) ? r0 + i * ngw : r0;
            const float m = fmaxf(s1[i].x, s2[i].x), w1 = s1[i].y * fast_exp(s1[i].x - m), w2 = s2[i].y * fast_exp(s2[i].x - m), inv = __builtin_amdgcn_rcpf(w1 + w2), c1 = w1 * inv, c2 = w2 * inv;
            u32x4 o; o.x = pk2(c1 * bflo(a[i].x) + c2 * bflo(q[i].x), c1 * bfhi(a[i].x) + c2 * bfhi(q[i].x)); o.y = pk2(c1 * bflo(a[i].y) + c2 * bflo(q[i].y), c1 * bfhi(a[i].y) + c2 * bfhi(q[i].y));
            o.z = pk2(c1 * bflo(a[i].z) + c2 * bflo(q[i].z), c1 * bfhi(a[i].z) + c2 * bfhi(q[i].z)); o.w = pk2(c1 * bflo(a[i].w) + c2 * bflo(q[i].w), c1 * bfhi(a[i].w) + c2 * bfhi(q[i].w));
            *(u32x4*)(CC + (size_t)row * DM + h * 128 + dd) = o; }
    }
}

namespace hg {
using att::s16x4; using att::f32x16; using att::v_st; using att::v_rd_base; using att::v_rd_off; using att::crow; using att::cvtpk;
constexpr int CH = 64, NCH = SEQ / CH;
constexpr int KROW2 = 272;
constexpr int TILE_V = 16384, TILE_K2 = CH * KROW2;
constexpr size_t US_BH = (size_t)NCH * 16384;
#define TRRD2(dst, base, off) asm volatile("ds_read_b64_tr_b16 %0, %1 offset:%2" : "=&v"(dst) : "v"(base), "i"(off) : "memory")
__device__ __forceinline__ float ex(float x) { return __builtin_amdgcn_exp2f(x * 1.4426950408889634f); }
#if HG_V2
__device__ __forceinline__ void h1_unit(const Ctx& X, unsigned char* ws, int u, const float* lbl) {
    int tid_ = X.tid; asm volatile("" : "+v"(tid_));
    const int bb = u >> 7, c = u & 127, row0 = bb * SEQ + c * CH, tid = tid_, lane = tid & 63, wave = X.wave;
    const bf16* HZ = (const bf16*)(ws + WS_HK); const bf16* HQ = (const bf16*)(ws + WS_HQ); const bf16* HV = (const bf16*)(ws + WS_HV);
    bf16* KRB = (bf16*)(ws + WS_LF); bf16* QRB = (bf16*)(ws + WS_LF + 16 * MiB);
    float* Dd = (float*)(ws + WS_HD); float* Rr = (float*)(ws + WS_HR); bf16* US = (bf16*)(ws + WS_XB);
    LAS char* lds = (LAS char*)X.lds;
    {
        const int t0 = tid >> 4, c8 = (tid & 15) * 8; const size_t g0 = (size_t)(row0 + t0) * HGW + c8; const int vst0 = v_st(t0, c8);
        u32x4 vw[8];
#pragma unroll
        for (int j = 0; j < 8; ++j) vw[j] = *(const u32x4*)(HV + g0 + (size_t)((j & 1) * 32 * HGW + (j >> 1) * 128));
#pragma unroll
        for (int j = 0; j < 8; ++j) *(LAS u32x4*)(lds + 65536 + (j >> 1) * TILE_V + vst0 + (j & 1) * 8192) = vw[j];
    }
#if H1_WIDE
    {
        const int tg = wave, cg = lane, col = 8 * cg, head = cg >> 4, dcol = col & 127;
        const size_t cb = (size_t)row0 * HGW * 2; const unsigned vo = (unsigned)((8 * tg * HGW + col) * 2);
        const __amdgpu_buffer_rsrc_t rZ = __builtin_amdgcn_make_buffer_rsrc((void*)((const char*)HZ + cb), 0, CH * HGW * 2, 0x00020000), rQ = __builtin_amdgcn_make_buffer_rsrc((void*)((const char*)HQ + cb), 0, CH * HGW * 2, 0x00020000),
                                     rK = __builtin_amdgcn_make_buffer_rsrc((void*)((char*)KRB + cb), 0, CH * HGW * 2, 0x00020000), rR = __builtin_amdgcn_make_buffer_rsrc((void*)((char*)QRB + cb), 0, CH * HGW * 2, 0x00020000);
        u32x4 zw[8], qw[8];
#pragma unroll
        for (int jj = 0; jj < 8; ++jj) zw[jj] = __builtin_amdgcn_raw_buffer_load_b128(rZ, vo, jj * HGW * 2, 0);
        const f32x4 lb0 = *(const f32x4*)(lbl + col), lb1 = *(const f32x4*)(lbl + col + 4);
        const float lbv[8] = {lb0.x, lb0.y, lb0.z, lb0.w, lb1.x, lb1.y, lb1.z, lb1.w};
        float bq[8][8];
#pragma unroll
        for (int jj = 0; jj < 8; ++jj) { const unsigned zz[4] = {zw[jj].x, zw[jj].y, zw[jj].z, zw[jj].w};
#pragma unroll
            for (int cc = 0; cc < 8; ++cc) { const float z = (cc & 1) ? bfhi(zz[cc >> 1]) : bflo(zz[cc >> 1]);
                const float zc = fminf(fmaxf(z, -60.f), 60.f), e = fast_exp(-zc), sg = __builtin_amdgcn_rcpf(1.f + e), f = lbv[cc] + (1.f - lbv[cc]) * sg;
                const float ff = fmaxf(f, 1e-30f); bq[jj][cc] = __builtin_amdgcn_logf(ff) * 0.6931471805599453f; }
            __builtin_amdgcn_sched_barrier(0); }
#pragma unroll
        for (int jj = 1; jj < 8; ++jj)
#pragma unroll
            for (int cc = 0; cc < 8; ++cc) bq[jj][cc] += bq[jj - 1][cc];
        LAS float* tot = (LAS float*)lds;
        *(LAS f32x4*)(tot + tg * HGW + col) = (f32x4){bq[7][0], bq[7][1], bq[7][2], bq[7][3]}; *(LAS f32x4*)(tot + tg * HGW + col + 4) = (f32x4){bq[7][4], bq[7][5], bq[7][6], bq[7][7]};
        __syncthreads();
        float off[8], rr[8], bl[8];
        { float run[8] = {0.f, 0.f, 0.f, 0.f, 0.f, 0.f, 0.f, 0.f};
#pragma unroll
          for (int cc = 0; cc < 8; ++cc) off[cc] = 0.f;
#pragma unroll
          for (int g = 0; g < 8; ++g) { const f32x4 t0 = *(const LAS f32x4*)(tot + g * HGW + col), t1 = *(const LAS f32x4*)(tot + g * HGW + col + 4); const float tv[8] = {t0.x, t0.y, t0.z, t0.w, t1.x, t1.y, t1.z, t1.w};
#pragma unroll
              for (int cc = 0; cc < 8; ++cc) { run[cc] += tv[cc]; if (g + 1 == tg) off[cc] = run[cc]; if (g == 3) rr[cc] = fmaxf(run[cc], -60.f); } }
#pragma unroll
          for (int cc = 0; cc < 8; ++cc) bl[cc] = run[cc]; }
        __syncthreads();
#pragma unroll
        for (int jj = 0; jj < 8; ++jj) qw[jj] = __builtin_amdgcn_raw_buffer_load_b128(rQ, vo, jj * HGW * 2, 0);
#pragma unroll
        for (int jj = 0; jj < 8; ++jj)
#pragma unroll
            for (int cc = 0; cc < 8; ++cc) bq[jj][cc] += off[cc];
        if (tg == 0) { float* dp = Dd + (size_t)u * HGW + col; float* rp = Rr + (size_t)u * HGW + col;
            *(f32x4*)dp = (f32x4){ex(bl[0]), ex(bl[1]), ex(bl[2]), ex(bl[3])}; *(f32x4*)(dp + 4) = (f32x4){ex(bl[4]), ex(bl[5]), ex(bl[6]), ex(bl[7])};
            *(f32x4*)rp = (f32x4){ex(rr[0]), ex(rr[1]), ex(rr[2]), ex(rr[3])}; *(f32x4*)(rp + 4) = (f32x4){ex(rr[4]), ex(rr[5]), ex(rr[6]), ex(rr[7])}; }
#pragma unroll
        for (int jj = 0; jj < 8; ++jj) { const unsigned qq[4] = {qw[jj].x, qw[jj].y, qw[jj].z, qw[jj].w}; float kr[8], qr_[8], kd[8];
#pragma unroll
            for (int cc = 0; cc < 8; ++cc) { const float b = bq[jj][cc], kk = 1.f - ex(b - (jj ? bq[jj ? jj - 1 : 0][cc] : off[cc])), qv = (cc & 1) ? bfhi(qq[cc >> 1]) : bflo(qq[cc >> 1]);
                kr[cc] = kk * ex(fminf(rr[cc] - b, 80.f)); qr_[cc] = qv * ex(fminf(b - rr[cc], 80.f)); kd[cc] = kk * ex(bl[cc] - b); }
            u32x4 ko, qo, dk; ko.x = pk2(kr[0], kr[1]); ko.y = pk2(kr[2], kr[3]); ko.z = pk2(kr[4], kr[5]); ko.w = pk2(kr[6], kr[7]);
            qo.x = pk2(qr_[0], qr_[1]); qo.y = pk2(qr_[2], qr_[3]); qo.z = pk2(qr_[4], qr_[5]); qo.w = pk2(qr_[6], qr_[7]);
            dk.x = pk2(kd[0], kd[1]); dk.y = pk2(kd[2], kd[3]); dk.z = pk2(kd[4], kd[5]); dk.w = pk2(kd[6], kd[7]);
            __builtin_amdgcn_raw_buffer_store_b128(ko, rK, vo, jj * HGW * 2, 0); __builtin_amdgcn_raw_buffer_store_b128(qo, rR, vo, jj * HGW * 2, 0);
            *(LAS u32x4*)(lds + head * TILE_V + v_st(8 * tg + jj, dcol)) = dk; __builtin_amdgcn_sched_barrier(0); }
    }
#else
    {
        const int head = tid >> 7, d = tid & 127; const unsigned vo = (unsigned)tid * 2u; const size_t cb = (size_t)row0 * HGW * 2;
        const __amdgpu_buffer_rsrc_t rZ = __builtin_amdgcn_make_buffer_rsrc((void*)((const char*)HZ + cb), 0, CH * HGW * 2, 0x00020000), rQ = __builtin_amdgcn_make_buffer_rsrc((void*)((const char*)HQ + cb), 0, CH * HGW * 2, 0x00020000),
                                     rK = __builtin_amdgcn_make_buffer_rsrc((void*)((char*)KRB + cb), 0, CH * HGW * 2, 0x00020000), rR = __builtin_amdgcn_make_buffer_rsrc((void*)((char*)QRB + cb), 0, CH * HGW * 2, 0x00020000);
        float zl[CH], qv[CH];
#pragma unroll
        for (int t = 0; t < CH; ++t) { zl[t] = bf2f((unsigned short)__builtin_amdgcn_raw_buffer_load_b16(rZ, vo, t * HGW * 2, 0)); qv[t] = bf2f((unsigned short)__builtin_amdgcn_raw_buffer_load_b16(rQ, vo, t * HGW * 2, 0)); }
        const float lb = lbl[tid], om = 1.f - lb;
        float b = 0.f, r = 0.f;
#pragma unroll
        for (int t = 0; t < CH; ++t) { const float zc = fminf(fmaxf(zl[t], -60.f), 60.f), e = fast_exp(-zc), sg = __builtin_amdgcn_rcpf(1.f + e), f = lb + om * sg;
            const float lf = __builtin_amdgcn_logf(fmaxf(f, 1e-30f)) * 0.6931471805599453f; zl[t] = lf; b += lf; if (t == 31) r = b; }
        const float bl = b; r = fmaxf(r, -60.f);
        Dd[(size_t)u * HGW + tid] = ex(bl); Rr[(size_t)u * HGW + tid] = ex(r);
        b = 0.f;
        LAS char* kd = lds + head * TILE_V + ((d >> 5) * 512 + (d & 31) * 2);
#pragma unroll
        for (int t = 0; t < CH; ++t) { const float lf = zl[t]; b += lf; const float kk = 1.f - ex(lf);
            __builtin_amdgcn_raw_buffer_store_b16((short)pk2(kk * ex(fminf(r - b, 80.f)), 0.f), rK, vo, t * HGW * 2, 0);
            __builtin_amdgcn_raw_buffer_store_b16((short)pk2(qv[t] * ex(fminf(b - r, 80.f)), 0.f), rR, vo, t * HGW * 2, 0);
            constexpr int dummy = 0; (void)dummy;
            const int kk_t = (t & ~0xC) | ((t & 4) << 1) | ((t & 8) >> 1);
            *(LAS unsigned short*)(kd + (kk_t >> 3) * 4 * 512 + (kk_t & 7) * 64) = (unsigned short)pk2(kk * ex(bl - b), 0.f); }
    }
#endif
    __syncthreads();
#else
__device__ __forceinline__ void h1_unit(const Ctx& X, unsigned char* ws, int u) {
    const int bb = u >> 7, c = u & 127, row0 = bb * SEQ + c * CH, tid = X.tid, lane = X.lane, wave = X.wave;
    float* LFB = (float*)(ws + WS_LF); const bf16* HK = (const bf16*)(ws + WS_HK); const bf16* HV = (const bf16*)(ws + WS_HV);
    float* Dd = (float*)(ws + WS_HD); float* Rr = (float*)(ws + WS_HR); bf16* US = (bf16*)(ws + WS_XB);
    LAS char* lds = (LAS char*)X.lds; LAS float* bl = (LAS float*)(lds + 131072);
    {
        float* col = LFB + (size_t)row0 * HGW + tid; float b = 0.f, r = 0.f;
#pragma unroll 1
        for (int t0 = 0; t0 < CH; t0 += 8) { float x[8];
#pragma unroll
            for (int i = 0; i < 8; ++i) x[i] = col[(size_t)(t0 + i) * HGW];
#pragma unroll
            for (int i = 0; i < 8; ++i) { b += x[i]; col[(size_t)(t0 + i) * HGW] = b; if (t0 + i == 31) r = b; } }
        bl[tid] = b; r = fmaxf(r, -60.f);
        Dd[(size_t)u * HGW + tid] = ex(b); Rr[(size_t)u * HGW + tid] = ex(r);
    }
    asm volatile("s_waitcnt vmcnt(0)" ::: "memory");
    __syncthreads();
#pragma unroll 2
    for (int j = 0; j < 8; ++j) { const int i = tid + 512 * j, head = i >> 10, rem = i & 1023, t = rem >> 4, c8 = (rem & 15) * 8; const size_t g = (size_t)(row0 + t) * HGW + head * 128 + c8;
        const u32x4 kw = *(const u32x4*)(HK + g), vw = *(const u32x4*)(HV + g); const f32x4 b0 = *(const f32x4*)(LFB + g), b1 = *(const f32x4*)(LFB + g + 4);
        const f32x4 l0 = *(const LAS f32x4*)(bl + head * 128 + c8), l1 = *(const LAS f32x4*)(bl + head * 128 + c8 + 4);
        u32x4 o; o.x = pk2(bflo(kw.x) * ex(l0.x - b0.x), bfhi(kw.x) * ex(l0.y - b0.y)); o.y = pk2(bflo(kw.y) * ex(l0.z - b0.z), bfhi(kw.y) * ex(l0.w - b0.w));
        o.z = pk2(bflo(kw.z) * ex(l1.x - b1.x), bfhi(kw.z) * ex(l1.y - b1.y)); o.w = pk2(bflo(kw.w) * ex(l1.z - b1.z), bfhi(kw.w) * ex(l1.w - b1.w));
        *(LAS u32x4*)(lds + head * TILE_V + v_st(t, c8)) = o; *(LAS u32x4*)(lds + 65536 + head * TILE_V + v_st(t, c8)) = vw; }
    __syncthreads();
#endif
    {
        const int head = wave >> 1, db0 = (wave & 1) * 2, r32 = lane & 31, hiC = lane >> 5;
        const int ab = (int)(unsigned)(size_t)(lds + head * TILE_V) + v_rd_base(lane), vb = (int)(unsigned)(size_t)(lds + 65536 + head * TILE_V) + v_rd_base(lane);
        f32x16 acc[2][4];
#pragma unroll
        for (int a = 0; a < 2; ++a)
#pragma unroll
            for (int v = 0; v < 4; ++v) acc[a][v] = f32x16{};
#define FRAG(dst, base, d0, ks) do { s16x4 lo_, hi_; TRRD2(lo_, base, v_rd_off(d0, ks, 0)); TRRD2(hi_, base, v_rd_off(d0, ks, 1)); asm volatile("s_waitcnt lgkmcnt(0)" ::: "memory"); __builtin_amdgcn_sched_barrier(0); \
            dst = (bf16x8){lo_[0], lo_[1], lo_[2], lo_[3], hi_[0], hi_[1], hi_[2], hi_[3]}; } while (0)
#define U_KS(ks) do { bf16x8 a0, a1, b0, b1, b2, b3; \
            if (db0 == 0) { FRAG(a0, ab, 0, ks); FRAG(a1, ab, 1, ks); } else { FRAG(a0, ab, 2, ks); FRAG(a1, ab, 3, ks); } \
            FRAG(b0, vb, 0, ks); FRAG(b1, vb, 1, ks); FRAG(b2, vb, 2, ks); FRAG(b3, vb, 3, ks); \
            acc[0][0] = __builtin_amdgcn_mfma_f32_32x32x16_bf16(a0, b0, acc[0][0], 0, 0, 0); acc[0][1] = __builtin_amdgcn_mfma_f32_32x32x16_bf16(a0, b1, acc[0][1], 0, 0, 0); \
            acc[0][2] = __builtin_amdgcn_mfma_f32_32x32x16_bf16(a0, b2, acc[0][2], 0, 0, 0); acc[0][3] = __builtin_amdgcn_mfma_f32_32x32x16_bf16(a0, b3, acc[0][3], 0, 0, 0); \
            acc[1][0] = __builtin_amdgcn_mfma_f32_32x32x16_bf16(a1, b0, acc[1][0], 0, 0, 0); acc[1][1] = __builtin_amdgcn_mfma_f32_32x32x16_bf16(a1, b1, acc[1][1], 0, 0, 0); \
            acc[1][2] = __builtin_amdgcn_mfma_f32_32x32x16_bf16(a1, b2, acc[1][2], 0, 0, 0); acc[1][3] = __builtin_amdgcn_mfma_f32_32x32x16_bf16(a1, b3, acc[1][3], 0, 0, 0); } while (0)
        U_KS(0); U_KS(1); U_KS(2); U_KS(3);
#undef U_KS
        bf16* Ub = US + ((size_t)(bb * NH + head) * NCH + c) * 16384;
#pragma unroll
        for (int a = 0; a < 2; ++a)
#pragma unroll
            for (int v = 0; v < 4; ++v)
#pragma unroll
                for (int q4 = 0; q4 < 4; ++q4) { const int ks = 2 * (db0 + a) + (q4 >> 1), lanep = (q4 & 1) * 32 + r32;
                    u32x2 w; w.x = pk2(acc[a][v][4 * q4 + 0], acc[a][v][4 * q4 + 1]); w.y = pk2(acc[a][v][4 * q4 + 2], acc[a][v][4 * q4 + 3]);
                    *(u32x2*)(Ub + ((size_t)((ks * 4 + v) * 64 + lanep)) * 8 + 4 * hiC) = w; }
    }
    __syncthreads();
}
#if HG_V2
__device__ __forceinline__ void phase_h1(const Ctx& X, unsigned char* ws, int l) { const float* lbl = (const float*)(ws + WS_MISC + MISC_LB) + l * HGW; if (X.wave >= 4) __builtin_amdgcn_s_setprio(1); for (int u = X.bid; u < 2 * NCH; u += X.nblk) h1_unit(X, ws, u, lbl); __builtin_amdgcn_s_setprio(0); }
#else
__device__ __forceinline__ void phase_h1(const Ctx& X, unsigned char* ws, int) { for (int u = X.bid; u < 2 * NCH; u += X.nblk) h1_unit(X, ws, u); }
#endif
__device__ __forceinline__ void phase_h2(const Ctx& X, unsigned char* ws) {
    bf16* US = (bf16*)(ws + WS_XB); const float* Dd = (const float*)(ws + WS_HD); const float* Rr = (const float*)(ws + WS_HR);
    for (int u = X.bid; u < 256; u += X.nblk) {
        if (X.tid < 256) {
            const int bh = u >> 5, slot = u & 31, ks = slot >> 2, bb = bh >> 2, h = bh & 3, lanep = X.tid >> 2, j = 2 * (X.tid & 3), d = 16 * ks + 8 * (lanep >> 5) + j;
            unsigned* p = (unsigned*)(US + (size_t)bh * US_BH + (size_t)slot * 512 + 2 * X.tid);
            const float* dp = Dd + (size_t)bb * NCH * HGW + h * 128 + d; const float* rp = Rr + (size_t)bb * NCH * HGW + h * 128 + d;
            float s0 = 0.f, s1 = 0.f;
#pragma unroll 1
            for (int c0 = 0; c0 < NCH; c0 += 8) { unsigned uw[8]; float2 dv[8], rv[8];
#pragma unroll
                for (int i = 0; i < 8; ++i) { uw[i] = p[(size_t)(c0 + i) * 8192]; dv[i] = *(const float2*)(dp + (size_t)(c0 + i) * HGW); rv[i] = *(const float2*)(rp + (size_t)(c0 + i) * HGW); }
#pragma unroll
                for (int i = 0; i < 8; ++i) { p[(size_t)(c0 + i) * 8192] = pk2(rv[i].x * s0, rv[i].y * s1); s0 = dv[i].x * s0 + bflo(uw[i]); s1 = dv[i].y * s1 + bfhi(uw[i]); } }
        }
    }
}
__device__ __forceinline__ void h3_unit(const Ctx& X, unsigned char* ws, const float* onorm, int u) {
    const int bb = u >> 7, c = u & 127, row0 = bb * SEQ + c * CH, tid = X.tid, lane = X.lane, wave = X.wave;
    const float* LFB = (const float*)(ws + WS_LF); const bf16* HQ = (const bf16*)(ws + WS_HQ); const bf16* HK = (const bf16*)(ws + WS_HK); const bf16* HV = (const bf16*)(ws + WS_HV); const bf16* HG = (const bf16*)(ws + WS_HG);
    const bf16* US = (const bf16*)(ws + WS_XB); bf16* CC = (bf16*)(ws + WS_CC);
    LAS char* lds = (LAS char*)X.lds;
#if HG_V2
    const bf16* KRB = (const bf16*)(ws + WS_LF); const bf16* QRB = (const bf16*)(ws + WS_LF + 16 * MiB);
    const int head = wave >> 1, th = wave & 1, r32 = lane & 31, hi = lane >> 5, trow = row0 + 32 * th + r32;
    bf16x8 qr[8];
    { const int t0 = tid >> 4, c8 = (tid & 15) * 8; const size_t g0 = (size_t)(row0 + t0) * HGW + c8; const int kst0 = t0 * KROW2 + c8 * 2, vst0 = 4 * TILE_K2 + v_st(t0, c8);
      u32x4 kw[8], vw[8];
#pragma unroll
      for (int j = 0; j < 8; ++j) { const size_t g = g0 + (size_t)((j & 1) * 32 * HGW + (j >> 1) * 128); kw[j] = *(const u32x4*)(KRB + g); vw[j] = *(const u32x4*)(HV + g); }
      const size_t gq = (size_t)trow * HGW + head * 128 + hi * 8;
#pragma unroll
      for (int d0 = 0; d0 < 8; ++d0) qr[d0] = *reinterpret_cast<const bf16x8*>(QRB + gq + d0 * 16);
#pragma unroll
      for (int j = 0; j < 8; ++j) { *(LAS u32x4*)(lds + kst0 + (j >> 1) * TILE_K2 + (j & 1) * 32 * KROW2) = kw[j]; *(LAS u32x4*)(lds + vst0 + (j >> 1) * TILE_V + (j & 1) * 8192) = vw[j]; } }
#else
#pragma unroll 2
    for (int j = 0; j < 8; ++j) { const int i = tid + 512 * j, head = i >> 10, rem = i & 1023, t = rem >> 4, c8 = (rem & 15) * 8; const size_t g = (size_t)(row0 + t) * HGW + head * 128 + c8, gr = (size_t)(row0 + 31) * HGW + head * 128 + c8;
        const u32x4 kw = *(const u32x4*)(HK + g), vw = *(const u32x4*)(HV + g); const f32x4 b0 = *(const f32x4*)(LFB + g), b1 = *(const f32x4*)(LFB + g + 4); f32x4 r0 = *(const f32x4*)(LFB + gr), r1 = *(const f32x4*)(LFB + gr + 4);
#define KE(rr, bv) ex(fminf(fmaxf((rr), -60.f) - (bv), 80.f))
        u32x4 o; o.x = pk2(bflo(kw.x) * KE(r0.x, b0.x), bfhi(kw.x) * KE(r0.y, b0.y)); o.y = pk2(bflo(kw.y) * KE(r0.z, b0.z), bfhi(kw.y) * KE(r0.w, b0.w));
        o.z = pk2(bflo(kw.z) * KE(r1.x, b1.x), bfhi(kw.z) * KE(r1.y, b1.y)); o.w = pk2(bflo(kw.w) * KE(r1.z, b1.z), bfhi(kw.w) * KE(r1.w, b1.w));
#undef KE
        *(LAS u32x4*)(lds + head * TILE_K2 + t * KROW2 + c8 * 2) = o; *(LAS u32x4*)(lds + 4 * TILE_K2 + head * TILE_V + v_st(t, c8)) = vw; }
    const int head = wave >> 1, th = wave & 1, r32 = lane & 31, hi = lane >> 5, trow = row0 + 32 * th + r32;
    bf16x8 qr[8];
    {
        const size_t g = (size_t)trow * HGW + head * 128 + hi * 8, gr = (size_t)(row0 + 31) * HGW + head * 128 + hi * 8;
#pragma unroll
        for (int d0 = 0; d0 < 8; ++d0) { const u32x4 qw = *(const u32x4*)(HQ + g + d0 * 16); const f32x4 b0 = *(const f32x4*)(LFB + g + d0 * 16), b1 = *(const f32x4*)(LFB + g + d0 * 16 + 4), r0 = *(const f32x4*)(LFB + gr + d0 * 16), r1 = *(const f32x4*)(LFB + gr + d0 * 16 + 4);
#define QE(bv, rr) ex(fminf((bv) - fmaxf((rr), -60.f), 80.f))
            u32x4 o; o.x = pk2(bflo(qw.x) * QE(b0.x, r0.x), bfhi(qw.x) * QE(b0.y, r0.y)); o.y = pk2(bflo(qw.y) * QE(b0.z, r0.z), bfhi(qw.y) * QE(b0.w, r0.w));
            o.z = pk2(bflo(qw.z) * QE(b1.x, r1.x), bfhi(qw.z) * QE(b1.y, r1.y)); o.w = pk2(bflo(qw.w) * QE(b1.z, r1.z), bfhi(qw.w) * QE(b1.w, r1.w));
#undef QE
            qr[d0] = __builtin_bit_cast(bf16x8, o); }
    }
#endif
    __syncthreads();
    f32x16 p0 = f32x16{}, p1 = f32x16{};
    { const LAS char* kb = lds + head * TILE_K2 + r32 * KROW2 + hi * 16;
#pragma unroll
      for (int d0 = 0; d0 < 8; ++d0) { const bf16x8 k0 = *reinterpret_cast<const LAS bf16x8*>(kb + d0 * 32); p0 = __builtin_amdgcn_mfma_f32_32x32x16_bf16(k0, qr[d0], p0, 0, 0, 0);
          if (th) { const bf16x8 k1 = *reinterpret_cast<const LAS bf16x8*>(kb + d0 * 32 + 32 * KROW2); p1 = __builtin_amdgcn_mfma_f32_32x32x16_bf16(k1, qr[d0], p1, 0, 0, 0); } } }
    { const int tq = 32 * th + r32 - 4 * hi;
#pragma unroll
      for (int r = 0; r < 16; ++r) { const int cr = (r & 3) + 8 * (r >> 2); if (tq - cr < 0) p0[r] = 0.f; if (tq - cr - 32 < 0) p1[r] = 0.f; } }
    bf16x8 pa0, pa1, pa2, pa3;
#define PK4(P, B_, OUT) do { unsigned a0 = cvtpk(P[B_+0], P[B_+1]), a1 = cvtpk(P[B_+2], P[B_+3]);                          \
        unsigned b0 = cvtpk(P[B_+4], P[B_+5]), b1 = cvtpk(P[B_+6], P[B_+7]);                                             \
        auto r0 = __builtin_amdgcn_permlane32_swap(a0, b0, false, false); auto r1 = __builtin_amdgcn_permlane32_swap(a1, b1, false, false); \
        u32x4 w = {r0[0], r1[0], r0[1], r1[1]}; OUT = *reinterpret_cast<bf16x8*>(&w); } while (0)
    PK4(p0, 0, pa0); PK4(p0, 8, pa1); PK4(p1, 0, pa2); PK4(p1, 8, pa3);
#undef PK4
    f32x16 o[4] = {};
    { const int vb = (int)(unsigned)(size_t)(lds + 4 * TILE_K2 + head * TILE_V) + v_rd_base(lane);
#define PV(d0) do { bf16x8 f0, f1, f2, f3; FRAG(f0, vb, d0, 0); FRAG(f1, vb, d0, 1); FRAG(f2, vb, d0, 2); FRAG(f3, vb, d0, 3); \
        o[d0] = __builtin_amdgcn_mfma_f32_32x32x16_bf16(pa0, f0, o[d0], 0, 0, 0); o[d0] = __builtin_amdgcn_mfma_f32_32x32x16_bf16(pa1, f1, o[d0], 0, 0, 0); \
        o[d0] = __builtin_amdgcn_mfma_f32_32x32x16_bf16(pa2, f2, o[d0], 0, 0, 0); o[d0] = __builtin_amdgcn_mfma_f32_32x32x16_bf16(pa3, f3, o[d0], 0, 0, 0); } while (0)
      PV(0); PV(1); PV(2); PV(3);
#undef PV
    }
    { const bf16* Sb = US + ((size_t)(bb * NH + head) * NCH + c) * 16384 + (size_t)lane * 8;
#pragma unroll
      for (int vb = 0; vb < 4; ++vb)
#pragma unroll
          for (int ks = 0; ks < 8; ++ks) { const bf16x8 sf = *reinterpret_cast<const bf16x8*>(Sb + (size_t)(ks * 4 + vb) * 512); o[vb] = __builtin_amdgcn_mfma_f32_32x32x16_bf16(qr[ks], sf, o[vb], 0, 0, 0); } }
    float rs[16];
#if H3_STAGED_EPI
#define DPP_ADD(v, ctrl) ((v) + __int_as_float(__builtin_amdgcn_update_dpp(0, __float_as_int(v), (ctrl), 0xf, 0xf, true)))
#pragma unroll
    for (int r = 0; r < 16; ++r) { float q = o[0][r] * o[0][r] + o[1][r] * o[1][r] + o[2][r] * o[2][r] + o[3][r] * o[3][r];
        q = DPP_ADD(q, 0xB1); q = DPP_ADD(q, 0x4E); q = DPP_ADD(q, 0x124); q = DPP_ADD(q, 0x128);
        { const auto rr = __builtin_amdgcn_permlane16_swap(__float_as_uint(q), __float_as_uint(q), false, false); q = __uint_as_float(rr[0]) + __uint_as_float(rr[1]); }
        rs[r] = __builtin_amdgcn_rsqf(q * (1.f / 128.f) + EPS); }
#undef DPP_ADD
    __syncthreads();
    {   LAS char* stg = lds + wave * (TILE_K2 / 2);
        const int wbase = hi * (4 * KROW2) + r32 * 2;
#pragma unroll
        for (int vb = 0; vb < 4; ++vb) { const float gn = onorm[32 * vb + r32];
#pragma unroll
            for (int r = 0; r < 16; r += 2) { const unsigned w = cvtpk(o[vb][r] * rs[r] * gn, o[vb][r + 1] * rs[r + 1] * gn);
                *(LAS unsigned short*)(stg + wbase + ((r & 3) + 8 * (r >> 2)) * KROW2 + vb * 64) = (unsigned short)w;
                *(LAS unsigned short*)(stg + wbase + ((r & 3) + 1 + 8 * (r >> 2)) * KROW2 + vb * 64) = (unsigned short)(w >> 16); } }
        const int rrow = lane >> 4, rchunk = lane & 15;
#pragma unroll
        for (int jh = 0; jh < 2; ++jh) { u32x4 t[4], g[4];
#pragma unroll
            for (int j = 0; j < 4; ++j) { const int lr = rrow + 4 * (jh * 4 + j); t[j] = *(const LAS u32x4*)(stg + lr * KROW2 + rchunk * 16);
                g[j] = *(const u32x4*)(HG + (size_t)(row0 + 32 * th + lr) * HGW + head * 128 + rchunk * 8); }
#pragma unroll
            for (int j = 0; j < 4; ++j) { const int lr = rrow + 4 * (jh * 4 + j); u32x4 w;
                w.x = pk2(bflo(t[j].x) * siluf_(bflo(g[j].x)), bfhi(t[j].x) * siluf_(bfhi(g[j].x))); w.y = pk2(bflo(t[j].y) * siluf_(bflo(g[j].y)), bfhi(t[j].y) * siluf_(bfhi(g[j].y)));
                w.z = pk2(bflo(t[j].z) * siluf_(bflo(g[j].z)), bfhi(t[j].z) * siluf_(bfhi(g[j].z))); w.w = pk2(bflo(t[j].w) * siluf_(bflo(g[j].w)), bfhi(t[j].w) * siluf_(bfhi(g[j].w)));
                *(u32x4*)(CC + (size_t)(row0 + 32 * th + lr) * DM + 512 + head * 128 + rchunk * 8) = w; } }
    }
#else
#pragma unroll
    for (int r = 0; r < 16; ++r) { float q = o[0][r] * o[0][r] + o[1][r] * o[1][r] + o[2][r] * o[2][r] + o[3][r] * o[3][r];
        q += __shfl_xor(q, 1); q += __shfl_xor(q, 2); q += __shfl_xor(q, 4); q += __shfl_xor(q, 8); q += __shfl_xor(q, 16); rs[r] = rsqrtf(q * (1.f / 128.f) + EPS); }
#pragma unroll
    for (int vb = 0; vb < 4; ++vb) { const float gn = onorm[32 * vb + r32];
#pragma unroll
        for (int r = 0; r < 16; ++r) { const size_t row = (size_t)(row0 + 32 * th + crow(r, hi));
            const float g = bf2f(HG[row * HGW + head * 128 + 32 * vb + r32]); const float val = o[vb][r] * rs[r] * gn * siluf_(g); const float vn = __shfl_xor(val, 1);
            if ((r32 & 1) == 0) *(unsigned*)(CC + row * DM + 512 + head * 128 + 32 * vb + r32) = cvtpk(val, vn); } }
#endif
    __syncthreads();
}
#undef FRAG
#undef TRRD2
__device__ __forceinline__ void phase_h3(const Ctx& X, unsigned char* ws, const float* onorm) { if (X.wave >= 4) __builtin_amdgcn_s_setprio(1); for (int u = X.bid; u < 2 * NCH; u += X.nblk) h3_unit(X, ws, onorm, u); __builtin_amdgcn_s_setprio(0); }
}

__device__ __forceinline__ void phase_hgrn_simple(const Ctx& X, const Params& p) {
    unsigned char* ws = p.ws;
    const bf16* HQ = (const bf16*)(ws + WS_HQ); const bf16* HK = (const bf16*)(ws + WS_HK); const bf16* HV = (const bf16*)(ws + WS_HV); const float* LF = (const float*)(ws + WS_LF);
    float* OB = (float*)(ws + WS_XB);
    for (int bh = X.bid; bh < 2 * NH; bh += X.nblk) {
        if (X.tid < 256) {
            const int v = X.tid >> 1, hf = X.tid & 1, b = bh >> 2, h = bh & 3;
            float S[64];
#pragma unroll
            for (int j = 0; j < 64; ++j) S[j] = 0.f;
            for (int t = 0; t < SEQ; ++t) {
                const size_t base = ((size_t)(b * SEQ + t)) * HGW + h * 128;
                const float vt = bf2f(HV[base + v]);
                float o = 0.f;
#pragma unroll
                for (int j8 = 0; j8 < 8; ++j8) {
                    const size_t bj = base + 64 * hf + 8 * j8;
                    const f32x4 f0 = *(const f32x4*)(LF + bj), f1 = *(const f32x4*)(LF + bj + 4);
                    const u32x4 kw = *(const u32x4*)(HK + bj), qw = *(const u32x4*)(HQ + bj);
#define HSTEP(J, lf, kk, qq) do { S[8 * j8 + J] = fast_exp(lf) * S[8 * j8 + J] + (kk) * vt; o += (qq) * S[8 * j8 + J]; } while (0)
                    HSTEP(0, f0.x, bflo(kw.x), bflo(qw.x)); HSTEP(1, f0.y, bfhi(kw.x), bfhi(qw.x)); HSTEP(2, f0.z, bflo(kw.y), bflo(qw.y)); HSTEP(3, f0.w, bfhi(kw.y), bfhi(qw.y));
                    HSTEP(4, f1.x, bflo(kw.z), bflo(qw.z)); HSTEP(5, f1.y, bfhi(kw.z), bfhi(qw.z)); HSTEP(6, f1.z, bflo(kw.w), bflo(qw.w)); HSTEP(7, f1.w, bfhi(kw.w), bfhi(qw.w));
#undef HSTEP
                }
                o += __shfl_xor(o, 1);
                if (hf == 0) OB[base + v] = o;
            }
        }
    }
}
__device__ __forceinline__ void phase_hgrn_out(const Ctx& X, const Params& p, int l) {
    unsigned char* ws = p.ws;
    const float* OB = (const float*)(ws + WS_XB); const bf16* HG = (const bf16*)(ws + WS_HG); bf16* CC = (bf16*)(ws + WS_CC); const float* on = p.in[I_HON] + l * 128;
    const int gw = X.bid * NWAVES + X.wave, ngw = X.nblk * NWAVES, lane = X.lane;
    for (int i = gw; i < T * NH; i += ngw) {
        const int row = i >> 2, h = i & 3; const size_t base = (size_t)row * HGW + h * 128 + 2 * lane;
        const float o0 = OB[base], o1 = OB[base + 1];
        const float rstd = rsqrtf(wave_sum(o0 * o0 + o1 * o1) * (1.f / 128.f) + EPS);
        const unsigned gw2 = *(const unsigned*)(HG + base);
        *(unsigned*)(CC + (size_t)row * DM + 512 + h * 128 + 2 * lane) = pk2(o0 * rstd * on[2 * lane] * siluf_(bflo(gw2)), o1 * rstd * on[2 * lane + 1] * siluf_(bfhi(gw2)));
    }
}

template <class TS>
__device__ __forceinline__ void phase_norm(const Ctx& X, const Params& p, const TS* src, const float* gain) { norm_all_rows(X, src, gain, (bf16*)(p.ws + WS_XB)); }
template <class TS>
__device__ __forceinline__ void phase_norm_route(const Ctx& X, const Params& p, const TS* src, const float* gain) {
    unsigned char* ws = p.ws;
    int* GCNT = (int*)(ws + WS_MISC + MISC_GCNT); int* TOPI = (int*)(ws + WS_MISC + MISC_TOPI); float* TOPG = (float*)(ws + WS_MISC + MISC_TOPG);
    const float* wr = p.in[I_ROUTER];
    LAS int* wcnt = (LAS int*)(X.lds);
    const int lane = X.lane, b5 = lane >> 5, b4 = (lane >> 4) & 1, b3 = (lane >> 3) & 1;
    f32x4 w0[4][4], w1[4][4], gn[4];
#pragma unroll
    for (int j = 0; j < 4; ++j) { gn[j] = *((const f32x4*)gain + lane + 64 * j);
#pragma unroll
        for (int q = 0; q < 4; ++q) { const float* wp = wr + (size_t)(4 * (lane + 64 * j) + q) * NE; w0[j][q] = *(const f32x4*)wp; w1[j][q] = *(const f32x4*)(wp + 4); } }
    for (int g = X.bid; g < T / 64; g += X.nblk) {
        int cn[NE];
#pragma unroll
        for (int e = 0; e < NE; ++e) cn[e] = 0;
#pragma unroll 1
        for (int bt = 0; bt < 4; ++bt) {
            const int rbase = g * 64 + X.wave * 8 + 2 * bt;
            f32x4 v[2][4];
#pragma unroll
            for (int i = 0; i < 2; ++i)
#pragma unroll
                for (int j = 0; j < 4; ++j) v[i][j] = ldrow4(src + (size_t)(rbase + i) * DM, lane + 64 * j);
#pragma unroll
            for (int i = 0; i < 2; ++i) { const int row = rbase + i; float s = 0.f;
#pragma unroll
                for (int j = 0; j < 4; ++j) s += (v[i][j].x * v[i][j].x + v[i][j].y * v[i][j].y) + (v[i][j].z * v[i][j].z + v[i][j].w * v[i][j].w);
                const float rstd = __builtin_amdgcn_rsqf(wave_sum(s) * (1.f / DM) + EPS);
                float lg[NE];
#pragma unroll
                for (int e = 0; e < NE; ++e) lg[e] = 0.f;
#pragma unroll
                for (int j = 0; j < 4; ++j) { const f32x4 y = v[i][j] * rstd * gn[j];
                    *((unsigned*)((unsigned char*)(ws + WS_XB) + (size_t)row * DM) + lane + 64 * j) = pk4_fp8(y.x, y.y, y.z, y.w);
#pragma unroll
                    for (int q = 0; q < 4; ++q) { const float yv = (q == 0) ? y.x : (q == 1) ? y.y : (q == 2) ? y.z : y.w;
                        lg[0] += yv * w0[j][q].x; lg[1] += yv * w0[j][q].y; lg[2] += yv * w0[j][q].z; lg[3] += yv * w0[j][q].w; lg[4] += yv * w1[j][q].x; lg[5] += yv * w1[j][q].y; lg[6] += yv * w1[j][q].z; lg[7] += yv * w1[j][q].w; } }
                float k4[4], k2[2], k1;
#pragma unroll
                for (int t = 0; t < 4; ++t) { const float keep = b5 ? lg[4 + t] : lg[t], send = b5 ? lg[t] : lg[4 + t]; k4[t] = keep + xget32(send, b5); }
#pragma unroll
                for (int t = 0; t < 2; ++t) { const float keep = b4 ? k4[2 + t] : k4[t], send = b4 ? k4[t] : k4[2 + t]; k2[t] = keep + xget16(send, b4); }
                { const float keep = b3 ? k2[1] : k2[0], send = b3 ? k2[0] : k2[1]; k1 = keep + DPP_F(send, 0x128); }
                k1 += DPP_F(k1, 0xB1); k1 += DPP_F(k1, 0x4E); k1 += DPP_F(k1, 0x141);
                float tl[NE];
#pragma unroll
                for (int e = 0; e < NE; ++e) tl[e] = __int_as_float(__builtin_amdgcn_readlane(__float_as_int(k1), (e >> 2) * 32 + ((e >> 1) & 1) * 16 + (e & 1) * 8));
                int e1 = 0; float l1 = tl[0];
#pragma unroll
                for (int e = 1; e < NE; ++e) if (tl[e] > l1) { l1 = tl[e]; e1 = e; }
                int e2 = -1; float l2 = -3.0e38f;
#pragma unroll
                for (int e = 0; e < NE; ++e) if (e != e1 && tl[e] > l2) { l2 = tl[e]; e2 = e; }
#pragma unroll
                for (int e = 0; e < NE; ++e) cn[e] += (e == e1) + (e == e2);
                if (lane == 0) { const float g1 = 1.f / (1.f + expf(l2 - l1)); TOPI[row * 2] = e1; TOPI[row * 2 + 1] = e2; TOPG[row * 2] = g1; TOPG[row * 2 + 1] = 1.f - g1; }
            }
        }
        if (lane == 0) {
#pragma unroll
            for (int e = 0; e < NE; ++e) wcnt[X.wave * NE + e] = cn[e]; }
        __syncthreads();
        if (X.tid < NE) { int t = 0;
#pragma unroll
            for (int w = 0; w < NWAVES; ++w) t += wcnt[w * NE + X.tid];
            GCNT[g * NE + X.tid] = t; }
        __syncthreads();
    }
}
__device__ __forceinline__ void phase_scatter(const Ctx& X, const Params& p) {
    unsigned char* ws = p.ws;
    const int* GCNT = (const int*)(ws + WS_MISC + MISC_GCNT); const int* TOPI = (const int*)(ws + WS_MISC + MISC_TOPI); int* POS = (int*)(ws + WS_MISC + MISC_POS);
    int* TILE_E = (int*)(ws + WS_MISC + MISC_TILE_E); int* NT = (int*)(ws + WS_MISC + MISC_NT);
    const unsigned char* XF = (const unsigned char*)(ws + WS_XB); unsigned char* XS = (unsigned char*)(ws + WS_XS);
    LAS int* gc = (LAS int*)(X.lds);
    LAS int* pstart = gc + 256 * NE;
    LAS int* ntot = pstart + 8;
    LAS int* basel = ntot + 8;
    LAS int* posl = basel + 8;
    for (int i = X.tid; i < 256 * NE; i += NTHREADS) gc[i] = GCNT[i];
    __syncthreads();
    { const int e = X.wave; int n = 0;
#pragma unroll
      for (int k = 0; k < 4; ++k) n += gc[(X.lane + 64 * k) * NE + e];
      n += DPP_I(n, 0xB1); n += DPP_I(n, 0x4E); n += DPP_I(n, 0x124); n += DPP_I(n, 0x128); { const auto r = __builtin_amdgcn_permlane16_swap((unsigned)n, (unsigned)n, false, false); n = (int)(r[0] + r[1]); } { const auto r = __builtin_amdgcn_permlane32_swap((unsigned)n, (unsigned)n, false, false); n = (int)(r[0] + r[1]); }
      if (X.lane == 0) ntot[e] = n; }
    __syncthreads();
    if (X.tid == 0) { int acc = 0;
        for (int e = 0; e < NE; ++e) { pstart[e] = acc; const int nt = (ntot[e] + 255) >> 8; if (X.bid == 0) for (int t = 0; t < nt; ++t) TILE_E[(acc >> 8) + t] = e; acc += nt * 256; }
        if (X.bid == 0) NT[0] = acc >> 8; }
    __syncthreads();
    for (int g = X.bid; g < T / 64; g += X.nblk) {
        { const int e = X.wave; int n = 0;
#pragma unroll
          for (int k = 0; k < 4; ++k) { const int gg = X.lane + 64 * k; n += (gg < g) ? gc[gg * NE + e] : 0; }
          n += DPP_I(n, 0xB1); n += DPP_I(n, 0x4E); n += DPP_I(n, 0x124); n += DPP_I(n, 0x128); { const auto r = __builtin_amdgcn_permlane16_swap((unsigned)n, (unsigned)n, false, false); n = (int)(r[0] + r[1]); } { const auto r = __builtin_amdgcn_permlane32_swap((unsigned)n, (unsigned)n, false, false); n = (int)(r[0] + r[1]); }
          if (X.lane == 0) basel[e] = pstart[e] + n; }
        __syncthreads();
        if (X.wave == 0) {
            const int row = g * 64 + X.lane; const int e1 = TOPI[row * 2], e2 = TOPI[row * 2 + 1];
            int p1 = 0, p2 = 0;
            const unsigned long long lt = (1ull << X.lane) - 1ull;
#pragma unroll
            for (int e = 0; e < NE; ++e) {
                const int base = basel[e];
                const unsigned long long m1 = __ballot(e1 == e), m2 = __ballot(e2 == e);
                if (e1 == e) p1 = base + __popcll(m1 & lt);
                if (e2 == e) p2 = base + __popcll(m1) + __popcll(m2 & lt);
            }
            POS[row * 2] = p1; POS[row * 2 + 1] = p2; posl[X.lane * 2] = p1; posl[X.lane * 2 + 1] = p2;
        }
        __syncthreads();
        { u32x4 a[8];
#pragma unroll
          for (int i = 0; i < 8; ++i) a[i] = ((const u32x4*)(XF + (size_t)(g * 64 + X.wave * 8 + i) * DM))[X.lane];
#pragma unroll
          for (int i = 0; i < 8; ++i) { const int r = X.wave * 8 + i; ((u32x4*)(XS + (size_t)posl[r * 2] * DM))[X.lane] = a[i]; ((u32x4*)(XS + (size_t)posl[r * 2 + 1] * DM))[X.lane] = a[i]; } }
        __syncthreads();
    }
}
template <class TS>
__device__ __forceinline__ void phase_combine(const Ctx& X, const Params& p, const TS* xr) {
    unsigned char* ws = p.ws;
    const int* POS = (const int*)(ws + WS_MISC + MISC_POS); const float* TOPG = (const float*)(ws + WS_MISC + MISC_TOPG); const bf16* YS = (const bf16*)(ws + WS_YS);
    const float* fn = p.in[I_FINN];
    const int gw = X.bid * NWAVES + X.wave, ngw = X.nblk * NWAVES, lane = X.lane;
    f32x4 gf[4];
#pragma unroll
    for (int j = 0; j < 4; ++j) gf[j] = *((const f32x4*)fn + lane + 64 * j);
    for (int r0 = gw; r0 < T; r0 += 2 * ngw) {
        int pp[2][2]; float gg[2][2]; f32x4 v[2][4]; u32x2 ya[2][4], yb[2][4];
#pragma unroll
        for (int i = 0; i < 2; ++i) { const int row = (r0 + i * ngw < T) ? r0 + i * ngw : r0; pp[i][0] = POS[row * 2]; pp[i][1] = POS[row * 2 + 1]; gg[i][0] = TOPG[row * 2]; gg[i][1] = TOPG[row * 2 + 1];
#pragma unroll
            for (int j = 0; j < 4; ++j) v[i][j] = ldrow4(xr + (size_t)row * DM, lane + 64 * j); }
#pragma unroll
        for (int i = 0; i < 2; ++i)
#pragma unroll
            for (int j = 0; j < 4; ++j) { ya[i][j] = *((const u32x2*)(YS + (size_t)pp[i][0] * DM) + lane + 64 * j); yb[i][j] = *((const u32x2*)(YS + (size_t)pp[i][1] * DM) + lane + 64 * j); }
#if DN_SPLITK
#pragma unroll
        for (int i = 0; i < 2; ++i)
#pragma unroll
            for (int k = 0; k < 2; ++k) { const int pos = pp[i][k];
#if SLAB_BF16
                if (pos >= 128 * 256) { const bf16* sl = (const bf16*)(ws + WS_SLAB) + ((size_t)(((pos >> 8) - 128) * 4) * 7 * 256 + (pos & 255)) * 256 + 4 * lane;
#pragma unroll
                    for (int j = 0; j < 4; ++j) { f32x4 acc = {0.f, 0.f, 0.f, 0.f};
#pragma unroll
                        for (int q = 0; q < 7; ++q) { const u32x2 t = *(const u32x2*)(sl + (size_t)(j * 7 + q) * 65536); acc.x += bflo(t.x); acc.y += bfhi(t.x); acc.z += bflo(t.y); acc.w += bfhi(t.y); }
#else
                if (pos >= 128 * 256) { const float* sl = (const float*)(ws + WS_SLAB) + ((size_t)(((pos >> 8) - 128) * 4) * 7 * 256 + (pos & 255)) * 256 + 4 * lane;
#pragma unroll
                    for (int j = 0; j < 4; ++j) { f32x4 acc = *(const f32x4*)(sl + (size_t)(j * 7) * 65536);
#pragma unroll
                        for (int q = 1; q < 7; ++q) acc = acc + *(const f32x4*)(sl + (size_t)(j * 7 + q) * 65536);
#endif
                        u32x2 w; w.x = pk2(acc.x, acc.y); w.y = pk2(acc.z, acc.w); if (k == 0) ya[i][j] = w; else yb[i][j] = w; } } }
#endif
#pragma unroll
        for (int i = 0; i < 2; ++i) { const int row = (r0 + i * ngw < T) ? r0 + i * ngw : r0; const float g1 = gg[i][0], g2 = gg[i][1]; float s = 0.f;
#pragma unroll
            for (int j = 0; j < 4; ++j) { const u32x2 a = ya[i][j], b = yb[i][j]; f32x4& x = v[i][j];
                x.x += g1 * bflo(a.x) + g2 * bflo(b.x); x.y += g1 * bfhi(a.x) + g2 * bfhi(b.x); x.z += g1 * bflo(a.y) + g2 * bflo(b.y); x.w += g1 * bfhi(a.y) + g2 * bfhi(b.y);
                s += (x.x * x.x + x.y * x.y) + (x.z * x.z + x.w * x.w); }
            const float rstd = __builtin_amdgcn_rsqf(wave_sum(s) * (1.f / DM) + EPS);
#pragma unroll
            for (int j = 0; j < 4; ++j) *((f32x4*)(p.out + (size_t)row * DM) + lane + 64 * j) = v[i][j] * rstd * gf[j]; }
    }
}

__device__ __forceinline__ bool relaunder(Ctx& X, unsigned char*& ws, const Params& p) {
    int t = threadIdx.x; asm volatile("" : "+v"(t)); X.tid = t; X.lane = t & 63; X.wave = __builtin_amdgcn_readfirstlane(t >> 6);
    unsigned long long w = (unsigned long long)p.ws; asm volatile("" : "+s"(w)); ws = (unsigned char*)(GAS unsigned char*)w;
    return true;
}
constexpr int NPHASES = 26;
#define PHASE(k) relaunder(X, ws, p)
#define SEAM(k) xcd_barrier(bar)
#if RAW_L0 && FUSE_NORM && XR_BF16
typedef xr_t xr_src0_t;
#else
typedef float xr_src0_t;
#endif
template <int L>
__device__ __forceinline__ void run_layer(Ctx& X, const Params& p, const XcdBarrier& bar) {
    unsigned char* ws;
#if XR_BF16
    xr_t* XR = (xr_t*)(p.ws + WS_XRB);
#else
    xr_t* XR = p.out;
#endif
    PHASE(pb + 0); {
        EpiProj E{ws, L, (FUSE_NORM && L == 1) ? (int)MISC_SSXB : (FUSE_NORM && RAW_L0) ? (int)MISC_SSXA : 0};
#if SSX_UNITBEGIN
        E.aux = (LAS float*)(X.lds + 131072 + 8192);
#endif
        gemm_dense(X, (FUSE_NORM && (L == 1 || RAW_L0)) ? (const bf16*)XR : (const bf16*)(ws + WS_XB), (const bf16*)(ws + WS_WT_IN) + (size_t)L * NPROJ_P * DM, NPROJ_P, DM, E);
#if TAILFILL && MOE_FP8
        if (X.nblk == 256 && X.bid >= 192) tail_fill(X, p, L == 0 ? 0 : TAIL_A + TAIL_B + TAIL_C, TAILFILL_A, X.bid - 192, 64);
#endif
#ifdef PROBE_INPROJ_NOEPI
        { EpiProbe EP{(float*)(ws + WS_CC)}; gemm_dense(X, (const bf16*)(ws + WS_XB), (const bf16*)(ws + WS_WT_IN) + (size_t)L * NPROJ_P * DM, NPROJ_P, DM, EP); }
#endif
    } SEAM(pb + 0);
    PHASE(pb + 1); {
#if QKV_UNITBEGIN
        EpiQ EQ{ws, (LAS float*)(X.lds + 131072 + 8192)}; EpiKV EK{ws, (LAS float*)(X.lds + 131072 + 8192 + 1024)};
#else
        EpiQ EQ{ws}; EpiKV EK{ws};
#endif
        REP_X(REP_QKV, gemm_dense(X, (const bf16*)(ws + WS_CQ), (const bf16*)(ws + WS_WT_QB) + (size_t)L * (NH * DQK) * QR, NH * DQK, QR, EQ);
        gemm_dense(X, (const bf16*)(ws + WS_CKV), (const bf16*)(ws + WS_WT_KVB) + (size_t)L * 1024 * KVR, 1024, KVR, EK);)
#if FAST_HGRN
        hg::phase_h1(X, ws, L);
#endif
#if TAILFILL && MOE_FP8
        if (X.nblk == 256 && X.bid >= 192) tail_fill(X, p, (L == 0 ? 0 : TAIL_A + TAIL_B + TAIL_C) + TAIL_A, TAILFILL_B, X.bid - 192, 64);
#endif
    } SEAM(pb + 1);
#if FAST_ATTN
    PHASE(pb + 2); {
#if FAST_HGRN
        hg::phase_h2(X, ws);
#endif
        REP_X(REP_ATTN, phase_attn_fast(X, ws);) } SEAM(pb + 2);
#else
    PHASE(pb + 2); { phase_attn_simple(X, p); } SEAM(pb + 2);
#endif
#if !FAST_HGRN
    PHASE(pb + 3); { phase_hgrn_simple(X, p); } SEAM(pb + 3);
#endif
#if FAST_ATTN
#if FAST_HGRN
    PHASE(pb + 4); { phase_attn_combine(X, ws); REP_X(REP_H3, hg::phase_h3(X, ws, p.in[I_HON] + L * 128);) } SEAM(pb + 4);
#else
    PHASE(pb + 4); { phase_attn_combine(X, ws); phase_hgrn_out(X, p, L); } SEAM(pb + 4);
#endif
#else
    PHASE(pb + 4); { phase_hgrn_out(X, p, L); } SEAM(pb + 4);
#endif
    PHASE(pb + 5); {
#if FUSE_NORM
        if (L == 0) { EpiResNormT<xr_src0_t> E{(const xr_src0_t*)(RAW_L0 ? (const void*)XR : (const void*)p.in[I_X]), XR, (float*)(ws + WS_MISC + MISC_SSXA), 0.f, (LAS float*)(X.lds + 131072)}; gemm_dense(X, (const bf16*)(ws + WS_CC), (const bf16*)(ws + WS_WT_OUT) + (size_t)L * DM * DM, DM, DM, E); }
#else
        if (L == 0) { EpiResT<float, xr_t> E{p.in[I_X], XR}; gemm_dense(X, (const bf16*)(ws + WS_CC), (const bf16*)(ws + WS_WT_OUT) + (size_t)L * DM * DM, DM, DM, E); }
#endif
        else { EpiResT<xr_t, xr_t> E{XR, XR}; gemm_dense(X, (const bf16*)(ws + WS_CC), (const bf16*)(ws + WS_WT_OUT) + (size_t)L * DM * DM, DM, DM, E); }
    } SEAM(pb + 5);
#if FUSE_NORM
    if (L == 1) { PHASE(pb + 6); { phase_norm_route(X, p, XR, p.in[I_FFNN] + DM); } SEAM(pb + 6); }
    if (L == 0) {
        PHASE(8); { EpiSwiglu E{(bf16*)(ws + WS_HID), FF0, 0, (const float*)(ws + WS_MISC + MISC_SSXA)}; E.aux = SSX_UNITBEGIN ? (LAS float*)(X.lds + 131072 + 8192) : nullptr;
            gemm_dense(X, (const bf16*)XR, (const bf16*)(ws + WS_WT_GU), 2 * FF0, DM, E);
#if TAILFILL && MOE_FP8
            if (X.nblk == 256 && X.bid >= 128) tail_fill(X, p, TAIL_A + TAIL_B, TAILFILL_C, X.bid - 128, 128);
#endif
#ifdef PROBE_GU_NOEPI
            { EpiProbe EP{(float*)(ws + WS_CC)}; gemm_dense(X, (const bf16*)XR, (const bf16*)(ws + WS_WT_GU), 2 * FF0, DM, EP); }
#endif
            } SEAM(8);
        PHASE(9); { EpiResNormT<xr_t> E{XR, XR, (float*)(ws + WS_MISC + MISC_SSXB), 0.f, (LAS float*)(X.lds + 131072)};
            gemm_dense(X, (const bf16*)(ws + WS_HID), (const bf16*)(ws + WS_WT_DN), DM, FF0, E); } SEAM(9);
    }
#else
    PHASE(pb + 6); { if (L == 0) { phase_norm(X, p, XR, p.in[I_FFNN]); } else { phase_norm_route(X, p, XR, p.in[I_FFNN] + DM); } } SEAM(pb + 6);
    if (L == 0) {
        PHASE(8); { EpiSwiglu E{(bf16*)(ws + WS_HID), FF0, 0, nullptr};
            gemm_dense(X, (const bf16*)(ws + WS_XB), (const bf16*)(ws + WS_WT_GU), 2 * FF0, DM, E); } SEAM(8);
        PHASE(9); { EpiResT<xr_t, xr_t> E{XR, XR};
            gemm_dense(X, (const bf16*)(ws + WS_HID), (const bf16*)(ws + WS_WT_DN), DM, FF0, E); } SEAM(9);
        PHASE(10); { phase_norm(X, p, XR, p.in[I_MIXN] + DM); } SEAM(10);
    }
#endif
}

__global__ void __launch_bounds__(NTHREADS, 2) mega(Params p) {
    extern __shared__ __attribute__((aligned(16))) unsigned char lds_raw[];
    Ctx X; X.tid = threadIdx.x; X.lane = X.tid & 63; X.wave = __builtin_amdgcn_readfirstlane(X.tid >> 6); X.bid = blockIdx.x; X.nblk = gridDim.x; X.lds = (LAS unsigned char*)lds_raw;
    unsigned char* ws = p.ws;
    volatile LAS unsigned* MISC = (volatile LAS unsigned*)(X.lds + LDS_MISC_OFF);
    if (X.tid < 32) MISC[X.tid] = 0u;
    __syncthreads();
    const XcdBarrier bar = xcd_barrier_post((unsigned*)(ws + WS_CTL) + CW_BAR, MISC + 8);

    PHASE(0); { REP_X(REP_PRO, phase_prologue(X, p);) } SEAM(0);
    run_layer<0>(X, p, bar);
    run_layer<1>(X, p, bar);
    PHASE(18); { REP_X(REP_ROUTE, phase_scatter(X, p);) } SEAM(18);
#if MOE_FP8
    PHASE(19); { const int* NTp = (const int*)(ws + WS_MISC + MISC_NT); const int* TILE_E = (const int*)(ws + WS_MISC + MISC_TILE_E); const int nt = NTp[0];
        EpiSwiglu8 E{(unsigned char*)(ws + WS_HIDM), FFM, 0};
        REP_X(REP_MOEGU, gemm_moe(X, (const bf16*)(ws + WS_XS), (const bf16*)(ws + WS_WT_MGU), 0, nt, 2 * FFM, DM / 2, TILE_E, 0, 0x79797979, E);) } SEAM(19);
    PHASE(20); { const int* NTp = (const int*)(ws + WS_MISC + MISC_NT); const int* TILE_E = (const int*)(ws + WS_MISC + MISC_TILE_E); const int nt = NTp[0];
        EpiBf16Plain E{(bf16*)(ws + WS_YS), DM};
#if DN_SPLITK
        const int nfull = nt < 128 ? nt : 128;
        gemm_moe(X, (const bf16*)(ws + WS_HIDM), (const bf16*)(ws + WS_WT_MDN), 0, nfull, DM, FFM / 2, TILE_E, 0, 0x78787878, E);
        { const int nsub = (nt - nfull) * 4 * 7, sidx = (int)X.bid;
          pg8::OneUnit S1; S1.have = sidx < nsub;
          const int ks = sidx % 7, up = sidx / 7, pn = up & 3, pm = nfull + (up >> 2);
          S1.u.pm = pm; S1.u.pn = pn; S1.u.pa = pm; S1.u.pb = (S1.have ? __builtin_amdgcn_readfirstlane(TILE_E[pm]) : 0) * 4 + pn;
          pg8::Gemm g1{(const bf16*)(ws + WS_HIDM + (size_t)ks * 512), (const bf16*)(ws + WS_WT_MDN + (size_t)ks * 512), 256, DM, 256, 0x78787878, FFM / 2};
          EpiSlab E1{(float*)(ws + WS_SLAB), ks};
          pg8::gemm_phase<EpiSlab, pg8::OneUnit, true, true, true>(X.lds, g1, S1, E1); }
        } SEAM(20);
#else
        REP_X(REP_MOEDN, gemm_moe(X, (const bf16*)(ws + WS_HIDM), (const bf16*)(ws + WS_WT_MDN), 0, nt, DM, FFM / 2, TILE_E, 0, 0x78787878, E);) } SEAM(20);
#endif
#else
    for (int c = 0; c < 3; ++c) {
        PHASE(19 + 2 * c); { const int* NTp = (const int*)(ws + WS_MISC + MISC_NT); const int* TILE_E = (const int*)(ws + WS_MISC + MISC_TILE_E);
            const int nt = NTp[0], t0 = CHUNK_TILES * c, t1 = min(nt, t0 + CHUNK_TILES);
            if (t1 > t0) { EpiSwiglu E{(bf16*)(ws + WS_HIDM), FFM, t0 * 256, nullptr};
                REP_X(REP_MOEGU, gemm_moe(X, (const bf16*)(ws + WS_XS), (const bf16*)(ws + WS_WT_MGU), t0, t1, 2 * FFM, DM, TILE_E, 0, 0, E);) } } SEAM(19 + 2 * c);
        PHASE(20 + 2 * c); { const int* NTp = (const int*)(ws + WS_MISC + MISC_NT); const int* TILE_E = (const int*)(ws + WS_MISC + MISC_TILE_E);
            const int nt = NTp[0], t0 = CHUNK_TILES * c, t1 = min(nt, t0 + CHUNK_TILES);
            if (t1 > t0) { EpiBf16Plain E{(bf16*)(ws + WS_YS), DM};
                REP_X(REP_MOEDN, gemm_moe(X, (const bf16*)(ws + WS_HIDM), (const bf16*)(ws + WS_WT_MDN), t0, t1, DM, FFM, TILE_E, t0, 0, E);) } } SEAM(20 + 2 * c);
    }
#endif
#if XR_BF16
    PHASE(25); { phase_combine(X, p, (const xr_t*)(p.ws + WS_XRB)); }
#else
    PHASE(25); { phase_combine(X, p, (const xr_t*)p.out); }
#endif
}
#undef PHASE
#undef SEAM

extern "C" void kernel_launch(void* const* d_in, const int* in_sizes, int n_in, void* d_out, int out_size, void* d_ws, size_t ws_size, hipStream_t stream) {
    static int grid = 0;
    if (grid == 0) {
        if (n_in != 20 || out_size != T * DM || ws_size < WS_END) { fprintf(stderr, "kernel_launch: unexpected shapes (n_in %d out %d ws %zu)\n", n_in, out_size, ws_size); grid = -1; return; }
        int dev = 0, cus = 0;
        if (hipGetDevice(&dev) != hipSuccess || hipDeviceGetAttribute(&cus, hipDeviceAttributeMultiprocessorCount, dev) != hipSuccess) { grid = -1; return; }
        if (hipFuncSetAttribute((const void*)mega, hipFuncAttributeMaxDynamicSharedMemorySize, LDS_BYTES) != hipSuccess) { fprintf(stderr, "kernel_launch: hipFuncSetAttribute failed\n"); grid = -1; return; }
        int per_cu = 0; (void)hipOccupancyMaxActiveBlocksPerMultiprocessor(&per_cu, (const void*)mega, NTHREADS, LDS_BYTES); (void)hipGetLastError();
        grid = cus;
    }
    if (grid < 0) return;
    (void)hipMemsetAsync((char*)d_ws + WS_CTL, 0, CTL_BYTES, stream);
    Params p{};
    for (int i = 0; i < 20; ++i) p.in[i] = (const float*)d_in[i];
    p.out = (float*)d_out; p.ws = (unsigned char*)d_ws;
    p.ph_lo = 0; p.ph_hi = NPHASES;
    hipLaunchKernelGGL(mega, dim3(grid), dim3(NTHREADS), LDS_BYTES, stream, p);
}
```
